# Optimizing an MI355X kernel written in HIP

```python
import math
import jax, jax.numpy as jnp
from jax import lax
import numpy as np

D_MODEL = 1024
BATCH = 4
SEQ = 8192
DEPTH = 1

CHUNK = 64
N_META = 16
META_PAD = (CHUNK - N_META % CHUNK) % CHUNK
RMS_EPS = 1e-6
GLA_HEADS = 4
GLA_DK = D_MODEL // 8
GLA_DV = D_MODEL // 4
GLA_GATE_RANK = 16
GLA_GATE_NORM = 16.0
GLA_QK = GLA_HEADS * GLA_DK
GLA_VW = GLA_HEADS * GLA_DV
SSD_D_INNER = 2 * D_MODEL
SSD_HEADDIM = 64
SSD_HEADS = SSD_D_INNER // SSD_HEADDIM
SSD_GROUPS = 4
SSD_HPG = SSD_HEADS // SSD_GROUPS
SSD_STATE = 128
SSD_CONV = 4
SSD_BC = SSD_GROUPS * SSD_STATE
SSD_XBC = SSD_D_INNER + 2 * SSD_BC
PEER_HEADS = 8
PEER_N_KEYS = 128
PEER_N_EXPERTS = PEER_N_KEYS * PEER_N_KEYS
PEER_KEY_DIM = 256
PEER_HALF = PEER_KEY_DIM // 2
PEER_TOPK = 16
PEER_BLOCK = 256
IN_SPLITS = (GLA_QK, GLA_QK, GLA_VW, GLA_VW, GLA_GATE_RANK, SSD_D_INNER, SSD_XBC, SSD_HEADS, D_MODEL, D_MODEL)
IN_WIDTH = GLA_QK * 2 + GLA_VW * 2 + GLA_GATE_RANK + SSD_D_INNER + SSD_XBC + SSD_HEADS + 2 * D_MODEL

kernel_name = 'hybrid_gla_ssd_peer_streaming_block'


def rmsnorm(x, w):
    xf = x.astype(jnp.float32)
    y = xf * lax.rsqrt(jnp.mean(xf * xf, axis=-1, keepdims=True) + RMS_EPS)
    return (y * w.astype(jnp.float32)).astype(x.dtype)


def split_cols(t, sizes):
    out, start = [], 0
    for s in sizes:
        out.append(t[..., start:start + s])
        start += s
    return out


def pad_front(t):
    return jnp.pad(t, [(0, 0), (META_PAD, 0)] + [(0, 0)] * (t.ndim - 2))


def to_chunks(t):
    b, lp = t.shape[:2]
    return jnp.moveaxis(t.reshape(b, lp // CHUNK, CHUNK, *t.shape[2:]), 1, 0)


def from_chunks(t):
    t = jnp.moveaxis(t, 0, 1)
    return t.reshape(t.shape[0], -1, *t.shape[3:])


def causal_dwconv(u, w, b):
    L = u.shape[1]
    up = jnp.pad(u, ((0, 0), (SSD_CONV - 1, 0), (0, 0)))
    return sum(up[:, i:i + L] * w[i] for i in range(SSD_CONV)) + b


def gla_chunk_step(S, inp):
    q, k, v, lg = inp
    G = jnp.cumsum(lg, axis=1)
    eG, eGn = jnp.exp(G), jnp.exp(-G)
    a_causal = jnp.einsum('bthk,bshk->bhts', q * eG, k * eGn)
    a_ahead = jnp.einsum('bthk,bshk->bhts', q * eGn, k * eG)
    tri = jnp.tril(jnp.ones((CHUNK, CHUNK), dtype=bool))
    att = jnp.where(tri, a_causal, a_ahead)
    o = jnp.einsum('bhts,bshv->bthv', att, v) + jnp.einsum('bthk,bhkv->bthv', q * eG, S)
    G_last = G[:, -1]
    S = S * jnp.exp(G_last)[..., None] + jnp.einsum('bshk,bshv->bhkv', k * jnp.exp(G_last[:, None] - G), v)
    return S, o


def gla_chunked(q, k, v, lg):
    S0 = jnp.zeros((q.shape[0], GLA_HEADS, GLA_DK, GLA_DV), jnp.float32)
    _, o = lax.scan(gla_chunk_step, S0, (to_chunks(q), to_chunks(k), to_chunks(v), to_chunks(lg)))
    return from_chunks(o)


def ssd_chunk_step(S, inp):
    xdt, a, Bc, Cc = inp
    acum = jnp.cumsum(a, axis=1)
    seg = jnp.exp(-jnp.abs(acum[:, :, None] - acum[:, None, :]))
    cb = jnp.einsum('btgn,bsgn->btsg', Cc, Bc)
    y = jnp.einsum('btsgr,btsg,bsgrp->btgrp', seg, cb, xdt)
    y = y + jnp.einsum('btgn,bgrpn,btgr->btgrp', Cc, S, jnp.exp(acum))
    to_end = jnp.exp(acum[:, -1:] - acum)
    S = S * jnp.exp(acum[:, -1])[..., None, None] + jnp.einsum('bsgn,bsgr,bsgrp->bgrpn', Bc, to_end, xdt)
    return S, y


def ssd_chunked(xdt, a, Bm, Cm):
    S0 = jnp.zeros((xdt.shape[0], SSD_GROUPS, SSD_HPG, SSD_HEADDIM, SSD_STATE), jnp.float32)
    _, y = lax.scan(ssd_chunk_step, S0, (to_chunks(xdt), to_chunks(a), to_chunks(Bm), to_chunks(Cm)))
    return from_chunks(y)


def hybrid_mixer(hn, w_in, gla_w_gate2, gla_b_gate, gla_norm_w, conv_w, conv_b, dt_bias, a_log, d_skip,
                 ssd_norm_w, w_up_gla, w_up_ssd, w_out):
    Bsz, L, _ = hn.shape
    f32 = jnp.float32
    proj = hn @ w_in
    q, k, v, g_out, g_low, z, xbc, dt_raw, gate_a, gate_b = split_cols(proj, IN_SPLITS)

    log_g = jax.nn.log_sigmoid((g_low @ gla_w_gate2 + gla_b_gate).astype(f32)) / GLA_GATE_NORM
    hd = lambda t, n: t.reshape(Bsz, L, GLA_HEADS, n)
    o = gla_chunked(pad_front(hd(q, GLA_DK) * GLA_DK ** -0.5), pad_front(hd(k, GLA_DK)),
                    pad_front(hd(v, GLA_DV)), pad_front(hd(log_g, GLA_DK)))[:, META_PAD:]
    o = rmsnorm(o, gla_norm_w) * jax.nn.silu(hd(g_out, GLA_DV))
    y_a = o.reshape(Bsz, L, GLA_VW).astype(hn.dtype) @ w_up_gla

    xbc = jax.nn.silu(causal_dwconv(xbc, conv_w, conv_b))
    xs, Bm, Cm = split_cols(xbc, (SSD_D_INNER, SSD_BC, SSD_BC))
    dt = jax.nn.softplus(dt_raw.astype(f32) + dt_bias)
    a = dt * (-jnp.exp(a_log.astype(f32)))
    grp = lambda t: t.reshape(Bsz, L, SSD_GROUPS, SSD_HPG)
    xs_h = xs.reshape(Bsz, L, SSD_GROUPS, SSD_HPG, SSD_HEADDIM)
    y = ssd_chunked(pad_front(xs_h * grp(dt)[..., None]), pad_front(grp(a)),
                    pad_front(Bm.reshape(Bsz, L, SSD_GROUPS, SSD_STATE)),
                    pad_front(Cm.reshape(Bsz, L, SSD_GROUPS, SSD_STATE)))[:, META_PAD:]
    y = y + d_skip.reshape(SSD_GROUPS, SSD_HPG)[:, :, None] * xs_h
    y = y.reshape(Bsz, L, SSD_D_INNER) * jax.nn.silu(z)
    y = rmsnorm(y.reshape(Bsz, L, SSD_GROUPS, SSD_D_INNER // SSD_GROUPS),
                ssd_norm_w.reshape(SSD_GROUPS, -1)).reshape(Bsz, L, SSD_D_INNER)
    y_b = y.astype(hn.dtype) @ w_up_ssd

    mixed = jax.nn.sigmoid(gate_a) * y_a + jax.nn.sigmoid(gate_b) * y_b
    return (mixed @ w_out).astype(hn.dtype)


def peer_ffn(h, w_q, sub_keys, u_tab, v_tab):
    T = h.shape[0]
    pad = (-T) % PEER_BLOCK
    hp = jnp.pad(h, ((0, pad), (0, 0))).reshape(-1, PEER_BLOCK, D_MODEL)

    def block(hb):
        n = hb.shape[0]
        q = (hb @ w_q).reshape(n, PEER_HEADS, 2, PEER_HALF)
        s = jnp.einsum('nhid,hikd->nhik', q, sub_keys).astype(jnp.float32)
        s_top, i_top = lax.top_k(s, PEER_TOPK)
        cand = s_top[:, :, 0, :, None] + s_top[:, :, 1, None, :]
        cand_idx = i_top[:, :, 0, :, None] * PEER_N_KEYS + i_top[:, :, 1, None, :]
        best, pos = lax.top_k(cand.reshape(n, PEER_HEADS, PEER_TOPK * PEER_TOPK), PEER_TOPK)
        idx = jnp.take_along_axis(cand_idx.reshape(n, PEER_HEADS, -1), pos, axis=-1)
        w = jax.nn.softmax(best, axis=-1)
        u = jnp.take(u_tab, idx, axis=0)
        act = jax.nn.gelu(jnp.einsum('nhkd,nd->nhk', u, hb).astype(jnp.float32))
        out = jnp.einsum('nhk,nhkd->nd', w * act, jnp.take(v_tab, idx, axis=0))
        return out.astype(hb.dtype)

    return lax.map(block, hp).reshape(-1, D_MODEL)[:T]


def setup_inputs(seed: int = 0) -> dict:
    key = jax.random.key(seed)
    ks = jax.random.split(key, 24)
    f32 = jnp.float32
    nrm = lambda k, shape, std: jax.random.normal(k, shape, f32) * std
    gain = lambda k, shape: 1.0 + 0.02 * jax.random.normal(k, shape, f32)
    Dp = DEPTH
    dt0 = jnp.exp(jax.random.uniform(ks[9], (Dp, SSD_HEADS), f32, math.log(1e-3), math.log(1e-1)))
    dt_bias = dt0 + jnp.log(-jnp.expm1(-dt0))
    a_log = jnp.log(jax.random.uniform(ks[10], (Dp, SSD_HEADS), f32, 1.0, 16.0))
    return {
        'x': nrm(ks[0], (BATCH, SEQ, D_MODEL), 1.0),
        'meta_tokens': nrm(ks[1], (N_META, D_MODEL), 1.0),
        'ln_mix_w': gain(ks[2], (Dp, D_MODEL)),
        'w_in': nrm(ks[3], (Dp, D_MODEL, IN_WIDTH), D_MODEL ** -0.5),
        'gla_w_gate2': nrm(ks[4], (Dp, GLA_GATE_RANK, GLA_QK), GLA_GATE_RANK ** -0.5),
        'gla_b_gate': nrm(ks[5], (Dp, GLA_QK), 0.1),
        'gla_norm_w': gain(ks[6], (Dp, GLA_DV)),
        'ssd_conv_w': nrm(ks[7], (Dp, SSD_CONV, SSD_XBC), SSD_CONV ** -0.5),
        'ssd_conv_b': nrm(ks[8], (Dp, SSD_XBC), 0.02),
        'ssd_dt_bias': dt_bias,
        'ssd_a_log': a_log,
        'ssd_d': gain(ks[11], (Dp, SSD_HEADS)),
        'ssd_norm_w': gain(ks[12], (Dp, SSD_D_INNER)),
        'w_up_gla': nrm(ks[13], (Dp, GLA_VW, D_MODEL), GLA_VW ** -0.5),
        'w_up_ssd': nrm(ks[14], (Dp, SSD_D_INNER, D_MODEL), SSD_D_INNER ** -0.5),
        'w_out': nrm(ks[15], (Dp, D_MODEL, D_MODEL), D_MODEL ** -0.5),
        'ln_ffn_w': gain(ks[16], (Dp, D_MODEL)),
        'peer_w_q': nrm(ks[17], (Dp, D_MODEL, PEER_HEADS * PEER_KEY_DIM), D_MODEL ** -0.5),
        'peer_sub_keys': nrm(ks[18], (Dp, PEER_HEADS, 2, PEER_N_KEYS, PEER_HALF), PEER_HALF ** -0.5),
        'peer_u': nrm(ks[19], (Dp, PEER_N_EXPERTS, D_MODEL), D_MODEL ** -0.5),
        'peer_v': nrm(ks[20], (Dp, PEER_N_EXPERTS, D_MODEL), PEER_HEADS ** -0.5),
        'ln_final_w': gain(ks[21], (D_MODEL,)),
    }


def reference(x, meta_tokens, ln_mix_w, w_in, gla_w_gate2, gla_b_gate, gla_norm_w, ssd_conv_w, ssd_conv_b,
              ssd_dt_bias, ssd_a_log, ssd_d, ssd_norm_w, w_up_gla, w_up_ssd, w_out, ln_ffn_w,
              peer_w_q, peer_sub_keys, peer_u, peer_v, ln_final_w):
    Bsz = x.shape[0]
    meta = jnp.broadcast_to(meta_tokens[None].astype(x.dtype), (Bsz, N_META, D_MODEL))
    h = jnp.concatenate([meta, x], axis=1)
    for l in range(DEPTH):
        hn = rmsnorm(h, ln_mix_w[l])
        h = h + hybrid_mixer(hn, w_in[l], gla_w_gate2[l], gla_b_gate[l], gla_norm_w[l], ssd_conv_w[l],
                             ssd_conv_b[l], ssd_dt_bias[l], ssd_a_log[l], ssd_d[l], ssd_norm_w[l],
                             w_up_gla[l], w_up_ssd[l], w_out[l])
        if l == DEPTH - 1:
            h = h[:, N_META:]
        hn = rmsnorm(h, ln_ffn_w[l])
        ffn = peer_ffn(hn.reshape(-1, D_MODEL), peer_w_q[l], peer_sub_keys[l], peer_u[l], peer_v[l])
        h = h + ffn.reshape(h.shape)
    return rmsnorm(h, ln_final_w)
```

```cpp
#include <hip/hip_runtime.h>
#include <cstdio>
#include <cstdint>
namespace pg8 {
#define PG8_LAS __attribute__((address_space(3)))
typedef unsigned short bf16_t;
typedef short bf16x8 __attribute__((ext_vector_type(8)));
typedef float f32x4 __attribute__((ext_vector_type(4)));
typedef unsigned u32x4 __attribute__((ext_vector_type(4)));
constexpr int BM = 256, BK = 64, HALF = 128, HTB = HALF * BK * 2  , STAGE_BYTES = 8 * HTB, NXCD = 8, WGM = 8;

__host__ __device__ __forceinline__ int lds_byte(int r, int c) { const int st = (r >> 4) * 2 + (c >> 5), rr = r & 15, cc = c & 31, ob = rr * 64 + cc * 2; return st * 1024 + (ob ^ (((ob >> 9) & 1) << 5)); }
__host__ __device__ __forceinline__ void stage_rc(int b, int& R, int& C) { const int st = b / 1024, sb = b % 1024, swz = sb ^ (((sb >> 9) & 1) << 5); R = (st >> 1) * 16 + swz / 64; C = (st & 1) * 32 + (swz % 64) / 2; }
__host__ __device__ __forceinline__ int perm32(int rho) { const int n = rho >> 4, i = rho & 15; return 8 * (i >> 2) + 4 * n + (i & 3); }

struct Unit { int pm, pn; };
struct Gemm { const bf16_t* A; const bf16_t* Bt; int M, N, K; };

struct StaticOrder {
    int nM, nN, nwg, G, c;
    __host__ __device__ void init(int M, int N, int G_, int c_) { nM = M / BM; nN = N / BM; nwg = nM * nN; G = G_; c = c_; }
    __host__ __device__ bool next(int i, Unit& u) const {
        const long L = (long)i * G + c; if (L >= nwg) return false;
        int wgid = (int)L; { const int q = nwg / NXCD, r = nwg % NXCD, xcd = wgid % NXCD, off = wgid / NXCD; wgid = (xcd < r ? xcd * (q + 1) : r * (q + 1) + (xcd - r) * q) + off; }
        const int nig = WGM * nN, gid = wgid / nig, fm = gid * WGM, gsz = (nM - fm) < WGM ? (nM - fm) : WGM;
        u.pm = fm + ((wgid % nig) % gsz); u.pn = (wgid % nig) / gsz; return true;
    }
    __device__ __forceinline__ void a_ready(const Unit&) const {}
    __device__ __forceinline__ void done(const Unit&) const {}
};

typedef float f32x2_t __attribute__((ext_vector_type(2))); typedef __bf16 bf16x2_t __attribute__((ext_vector_type(2)));
__device__ __forceinline__ unsigned cvt_pk_bf16(float lo, float hi) { f32x2_t v = {lo, hi}; bf16x2_t b = __builtin_convertvector(v, bf16x2_t); return __builtin_bit_cast(unsigned, b); }
template <class Epi, class Sched, bool ALIGN_EPI = false, bool SP2 = false>
__device__ __forceinline__ void gemm_phase(PG8_LAS unsigned char* lds, const Gemm g, const Sched& S, const Epi& E) {
    int tid_ = threadIdx.x; asm volatile("" : "+v"(tid_));
    const int tid = tid_, wid = __builtin_amdgcn_readfirstlane(tid >> 6), lane = tid & 63, wr = wid >> 2, wc = wid & 3, fr = lane & 15, fq = lane >> 4;
    const int K = g.K, nt = K / BK;
    unsigned voffA[2], voffB[2];
#pragma unroll
    for (int i = 0; i < 2; ++i) { int R, C; stage_rc(tid * 16 + i * 8192, R, C); const int Rb = Epi::PERM ? ((R & ~31) + perm32(R & 31)) : R;
        voffA[i] = (unsigned)(R * K + C) * 2u; voffB[i] = (unsigned)(Rb * K + C) * 2u; }
    const size_t kstep = (size_t)(BK * 2);
    const size_t hstep = (size_t)HALF * K * 2;
    const size_t tstep = 2 * hstep;
    const unsigned ldsw = (unsigned)wid * 1024u;
    const int aoff = lds_byte(wr * 64 + fr, fq * 8), boff = lds_byte(wc * 32 + fr, fq * 8);
#define PG8_SA(b, h) (((b) * 2 + (h)) * HTB)
#define PG8_SB(b, h) ((4 + (b) * 2 + (h)) * HTB)
#define PG8_STAGE(bufoff, gbase, voff) do { _Pragma("unroll") for (int _i = 0; _i < 2; ++_i) \
        __builtin_amdgcn_global_load_lds((const unsigned*)((const char*)(gbase) + (voff)[_i]), (PG8_LAS unsigned*)(lds + (bufoff) + ldsw + _i * 8192), 16, 0, 0); } while (0)
#define PG8_LDA(dst, b, h) do { _Pragma("unroll") for (int m = 0; m < 4; ++m) _Pragma("unroll") for (int k = 0; k < 2; ++k) dst[m][k] = *(const PG8_LAS bf16x8*)(lds + PG8_SA(b, h) + aoff + m * 2048 + k * 1024); } while (0)
#define PG8_LDB(dst, b, h) do { _Pragma("unroll") for (int n = 0; n < 2; ++n) _Pragma("unroll") for (int k = 0; k < 2; ++k) dst[n][k] = *(const PG8_LAS bf16x8*)(lds + PG8_SB(b, h) + boff + n * 2048 + k * 1024); } while (0)
#define PG8_MMA(ai, bj, At, Bt) do { __builtin_amdgcn_s_setprio(1); _Pragma("unroll") for (int m = 0; m < 4; ++m) _Pragma("unroll") for (int n = 0; n < 2; ++n) _Pragma("unroll") for (int k = 0; k < 2; ++k) \
        acc[ai][bj][m][n] = __builtin_amdgcn_mfma_f32_16x16x32_bf16(Bt[n][k], At[m][k], acc[ai][bj][m][n], 0, 0, 0); __builtin_amdgcn_s_setprio(0); } while (0)
#define PG8_WAIT_V(n) asm volatile("s_waitcnt vmcnt(" #n ")" ::: "memory")
#define PG8_WAIT_L(n) asm volatile("s_waitcnt lgkmcnt(" #n ")" ::: "memory")
#define PG8_BAR __builtin_amdgcn_s_barrier()
#define PG8_SCHED __builtin_amdgcn_sched_barrier(0)
    Unit cur, nxt; int ui = 0;
    if (!S.next(0, cur)) return;
    f32x4 acc[2][2][4][2];
#pragma unroll
    for (int a = 0; a < 2; ++a)
#pragma unroll
        for (int b = 0; b < 2; ++b)
#pragma unroll
            for (int m = 0; m < 4; ++m)
#pragma unroll
                for (int n = 0; n < 2; ++n) acc[a][b][m][n] = (f32x4){0.f, 0.f, 0.f, 0.f};
    bf16x8 At[4][2], B0[2][2], B1[2][2];
    const char* cA = (const char*)g.A + (size_t)cur.pm * tstep; const char* cB = (const char*)g.Bt + (size_t)cur.pn * tstep;
    S.a_ready(cur);
    if constexpr (SP2) {
        PG8_STAGE(PG8_SB(0, 0), cB, voffB); PG8_STAGE(PG8_SB(0, 1), cB + hstep, voffB); PG8_STAGE(PG8_SA(0, 0), cA, voffA); PG8_STAGE(PG8_SA(0, 1), cA + hstep, voffA);
        if (wr == 1) PG8_BAR;
        PG8_WAIT_V(2); PG8_BAR;
        PG8_STAGE(PG8_SB(1, 0), cB + kstep, voffB); PG8_STAGE(PG8_SA(1, 0), cA + kstep, voffA); PG8_STAGE(PG8_SB(1, 1), cB + hstep + kstep, voffB);
        PG8_WAIT_V(6); PG8_BAR;
    } else {
        PG8_STAGE(PG8_SB(0, 0), cB, voffB); PG8_STAGE(PG8_SA(0, 0), cA, voffA); PG8_STAGE(PG8_SB(0, 1), cB + hstep, voffB); PG8_STAGE(PG8_SA(0, 1), cA + hstep, voffA);
        if (wr == 1) PG8_BAR;
        PG8_WAIT_V(4); PG8_BAR;
        PG8_STAGE(PG8_SB(1, 0), cB + kstep, voffB); PG8_STAGE(PG8_SA(1, 0), cA + kstep, voffA); PG8_STAGE(PG8_SB(1, 1), cB + hstep + kstep, voffB);
        PG8_WAIT_V(6); PG8_BAR;
    }
    for (;;) {
        const bool has_next = S.next(ui + 1, nxt);
        const char* nA = has_next ? (const char*)g.A + (size_t)nxt.pm * tstep : cA; const char* nB = has_next ? (const char*)g.Bt + (size_t)nxt.pn * tstep : cB;
        for (int t = 0; t < nt; t += 2) {
            const bool last = (t == nt - 2);
            const char* a1 = cA + (size_t)(t + 1) * kstep;
            const char* a2 = last ? nA : cA + (size_t)(t + 2) * kstep; const char* b2 = last ? nB : cB + (size_t)(t + 2) * kstep;
            const char* a3 = a2 + kstep; const char* b3 = b2 + kstep;
            if (last && has_next) S.a_ready(nxt);
            if constexpr (SP2) {
            PG8_LDB(B0, 0, 0); PG8_LDB(B1, 0, 1); PG8_SCHED; PG8_LDA(At, 0, 0); PG8_STAGE(PG8_SA(1, 1), a1 + hstep, voffA);
            PG8_WAIT_V(8); PG8_WAIT_L(0); PG8_BAR; PG8_MMA(0, 0, At, B0); PG8_MMA(0, 1, At, B1); PG8_BAR; PG8_SCHED;
            PG8_LDA(At, 0, 1); PG8_STAGE(PG8_SB(0, 0), b2, voffB); PG8_STAGE(PG8_SB(0, 1), b2 + hstep, voffB); PG8_STAGE(PG8_SA(0, 0), a2, voffA);
            PG8_WAIT_V(8); PG8_WAIT_L(0); PG8_BAR; PG8_MMA(1, 0, At, B0); PG8_MMA(1, 1, At, B1); PG8_BAR; PG8_SCHED;
            PG8_LDB(B0, 1, 0); PG8_LDB(B1, 1, 1); PG8_SCHED; PG8_LDA(At, 1, 0); PG8_STAGE(PG8_SA(0, 1), a2 + hstep, voffA);
            PG8_WAIT_V(8); PG8_WAIT_L(0); PG8_BAR; PG8_MMA(0, 0, At, B0); PG8_MMA(0, 1, At, B1); PG8_BAR; PG8_SCHED;
            PG8_LDA(At, 1, 1); PG8_STAGE(PG8_SB(1, 0), b3, voffB); PG8_STAGE(PG8_SB(1, 1), b3 + hstep, voffB); PG8_STAGE(PG8_SA(1, 0), a3, voffA);
            PG8_WAIT_V(8); PG8_WAIT_L(0); PG8_BAR; PG8_MMA(1, 0, At, B0); PG8_MMA(1, 1, At, B1); PG8_BAR; PG8_SCHED;
            } else {
            PG8_LDB(B0, 0, 0); PG8_SCHED; PG8_LDA(At, 0, 0); PG8_STAGE(PG8_SA(1, 1), a1 + hstep, voffA);
            PG8_WAIT_L(8); PG8_BAR; PG8_WAIT_L(0); PG8_MMA(0, 0, At, B0); PG8_BAR; PG8_SCHED;
            PG8_LDB(B1, 0, 1); PG8_STAGE(PG8_SB(0, 0), b2, voffB);
            PG8_BAR; PG8_WAIT_L(0); PG8_MMA(0, 1, At, B1); PG8_BAR;
            PG8_LDA(At, 0, 1); PG8_STAGE(PG8_SA(0, 0), a2, voffA);
            PG8_BAR; PG8_WAIT_L(0); PG8_MMA(1, 0, At, B0); PG8_BAR; PG8_SCHED;
            PG8_STAGE(PG8_SB(0, 1), b2 + hstep, voffB);
            PG8_WAIT_V(6); PG8_BAR; PG8_MMA(1, 1, At, B1); PG8_BAR;
            PG8_LDB(B0, 1, 0); PG8_SCHED; PG8_LDA(At, 1, 0); PG8_STAGE(PG8_SA(0, 1), a2 + hstep, voffA);
            PG8_WAIT_L(8); PG8_BAR; PG8_WAIT_L(0); PG8_MMA(0, 0, At, B0); PG8_BAR; PG8_SCHED;
            PG8_LDB(B1, 1, 1); PG8_STAGE(PG8_SB(1, 0), b3, voffB);
            PG8_BAR; PG8_WAIT_L(0); PG8_MMA(0, 1, At, B1); PG8_BAR;
            PG8_LDA(At, 1, 1); PG8_STAGE(PG8_SA(1, 0), a3, voffA);
            PG8_BAR; PG8_WAIT_L(0); PG8_MMA(1, 0, At, B0); PG8_BAR; PG8_SCHED;
            PG8_STAGE(PG8_SB(1, 1), b3 + hstep, voffB);
            PG8_WAIT_V(6); PG8_BAR; PG8_MMA(1, 1, At, B1); PG8_BAR;
            }
        }
        if constexpr (ALIGN_EPI) { if (wr == 0) PG8_BAR; }
        if constexpr (!Epi::AFTER_DRAIN) { E(acc, cur, wr, wc, fr, fq); S.done(cur); }
        if (!has_next) break;
#pragma unroll
        for (int a = 0; a < 2; ++a)
#pragma unroll
            for (int b = 0; b < 2; ++b)
#pragma unroll
                for (int m = 0; m < 4; ++m)
#pragma unroll
                    for (int n = 0; n < 2; ++n) acc[a][b][m][n] = (f32x4){0.f, 0.f, 0.f, 0.f};
        cur = nxt; cA = nA; cB = nB; ++ui;
        if constexpr (ALIGN_EPI) { if (wr == 1) PG8_BAR; }
    }
    PG8_WAIT_V(0);
    if constexpr (!ALIGN_EPI) { if (wr == 0) PG8_BAR; }
    PG8_BAR;
    if constexpr (Epi::AFTER_DRAIN) { E.fused(acc, cur, wr, wc, fr, fq, lds, wid, lane); S.done(cur); }
#undef PG8_SA
#undef PG8_SB
#undef PG8_STAGE
#undef PG8_LDA
#undef PG8_LDB
#undef PG8_MMA
#undef PG8_WAIT_V
#undef PG8_WAIT_L
#undef PG8_BAR
#undef PG8_SCHED
}
}

constexpr int NWAVES = 8, NT = 512;
constexpr int D = 1024, BATCH = 4, SEQ = 8192, NMETA = 16;
constexpr int RPB = 8448;
constexpr int RFRONT = 48, RTOK = 64, REND = 8256;
constexpr int NCHUNK = 129;
constexpr int NPJ = 10240;
constexpr int N1 = 10496;
constexpr int PJ_Q = 0, PJ_K = 512, PJ_V = 1024, PJ_GO = 2048, PJ_Z = 3072, PJ_XBC = 5120, PJ_GA = 8192, PJ_GB = 9216;
constexpr int NTOK = BATCH * SEQ;
constexpr float RMS_EPS = 1e-6f;

constexpr size_t MiB = 1u << 20;
constexpr size_t WS_CTL = 0, CTL_ZERO_BYTES = 1 * MiB;
constexpr size_t WS_W1T = 2 * MiB;
constexpr size_t WS_WAT = 23 * MiB;
constexpr size_t WS_WBT = 25 * MiB;
constexpr size_t WS_WOT = 29 * MiB;
constexpr size_t WS_WET = 31 * MiB;
constexpr size_t WS_HN = 36 * MiB;
constexpr size_t WS_PJ = 53 * MiB;
constexpr size_t WS_TL = 218 * MiB;
constexpr size_t WS_XC = 220 * MiB;
constexpr size_t WS_GG = 270 * MiB;
constexpr size_t WS_DT = 287 * MiB;
constexpr size_t WS_AC = 289 * MiB;
constexpr size_t WS_LG = 291 * MiB;
constexpr size_t WS_LS = 324 * MiB;
constexpr size_t WS_OG = 389 * MiB;
constexpr size_t WS_YS = 406 * MiB;
constexpr size_t WS_T1 = 439 * MiB;
constexpr size_t WS_MX = 456 * MiB;
constexpr size_t WS_MIX_END = 473 * MiB;
constexpr size_t WS_HN2 = 36 * MiB;
constexpr size_t WS_SC = 100 * MiB;
constexpr size_t WS_UB = 356 * MiB;
constexpr size_t WS_VB = 388 * MiB;
constexpr size_t WS_END = 473 * MiB;
constexpr int CW_BAR = 4096;

constexpr int LDS_WORK = 147456;
constexpr int LDSCTL_OFF = LDS_WORK;
constexpr int LDS_BYTES = LDS_WORK + 512;

#define GAS __attribute__((address_space(1)))
#define LAS __attribute__((address_space(3)))
typedef unsigned short bf16;
typedef unsigned v4u __attribute__((ext_vector_type(4)));
typedef unsigned v2u __attribute__((ext_vector_type(2)));
typedef float f32x4 __attribute__((ext_vector_type(4)));
typedef float f32x2 __attribute__((ext_vector_type(2)));
typedef short bf16x8 __attribute__((ext_vector_type(8)));
typedef short s16x4 __attribute__((ext_vector_type(4)));
typedef short v4i16_t __attribute__((ext_vector_type(4)));
typedef LAS unsigned char* ldsp;
#define RLX_AGENT __ATOMIC_RELAXED, __HIP_MEMORY_SCOPE_AGENT
#define LDS_WAIT() asm volatile("s_waitcnt lgkmcnt(0)" ::: "memory")

__device__ __forceinline__ unsigned pk2(float lo, float hi) { return pg8::cvt_pk_bf16(lo, hi); }
__device__ __forceinline__ float bflo(unsigned u) { return __builtin_bit_cast(float, u << 16); }
__device__ __forceinline__ float bfhi(unsigned u) { return __builtin_bit_cast(float, u & 0xffff0000u); }
__device__ __forceinline__ float fast_rcp(float x) { return __builtin_amdgcn_rcpf(x); }
__device__ __forceinline__ float sigmoidf_(float x) { return fast_rcp(1.f + __expf(-x)); }
__device__ __forceinline__ float siluf_(float x) { return x * sigmoidf_(x); }
__device__ __forceinline__ float wave_sum(float v) {
#pragma unroll
    for (int o = 1; o < 64; o <<= 1) v += __shfl_xor(v, o);
    return v;
}
__device__ __forceinline__ float wave_max(float v) {
#pragma unroll
    for (int o = 1; o < 64; o <<= 1) v = fmaxf(v, __shfl_xor(v, o));
    return v;
}
__device__ __forceinline__ f32x4 mma16(bf16x8 a, bf16x8 b, f32x4 c) { return __builtin_amdgcn_mfma_f32_16x16x32_bf16(b, a, c, 0, 0, 0); }
__device__ __forceinline__ bf16x8 lds_frag(ldsp p) { return *(const LAS bf16x8*)p; }
__device__ __forceinline__ s16x4 lds_tr(ldsp p) { return __builtin_bit_cast(s16x4, __builtin_amdgcn_ds_read_tr16_b64_v4i16((LAS v4i16_t*)p)); }
__device__ __forceinline__ bf16x8 tr_frag(ldsp tile, int pitch, int k0, int n0, int fr, int fq) {
#ifdef TR_SLOW
    bf16x8 r;
#pragma unroll
    for (int e = 0; e < 8; ++e) r[e] = *(const LAS short*)(tile + (k0 + 8 * fq + e) * pitch + (n0 + fr) * 2);
    return r;
#else
    ldsp p = tile + (k0 + 8 * fq + (fr >> 2)) * pitch + (n0 + 4 * (fr & 3)) * 2;
    const s16x4 lo = lds_tr(p), hi = lds_tr(p + 4 * pitch);
    bf16x8 r; r[0] = lo[0]; r[1] = lo[1]; r[2] = lo[2]; r[3] = lo[3]; r[4] = hi[0]; r[5] = hi[1]; r[6] = hi[2]; r[7] = hi[3];
    return r;
#endif
}

#define XB_TMO      128
#define XB_XCNT(j)  (256  + 64 * (j))
#define XB_XSUB(j)  (1280 + 64 * (j))
#define XB_XGEN(j)  (2304 + 64 * (j))
#define XB_TOP      3328
#define XB_TOPGEN   3392
#define XCD_BAR_WORDS 3456
#define XB_SPIN_CAP (1u << 22)
__device__ __forceinline__ unsigned xb_ld(unsigned* p)              { return __hip_atomic_load(p, __ATOMIC_RELAXED, __HIP_MEMORY_SCOPE_AGENT); }
__device__ __forceinline__ unsigned xb_add(unsigned* p, unsigned v) { return __hip_atomic_fetch_add(p, v, __ATOMIC_RELAXED, __HIP_MEMORY_SCOPE_AGENT); }
__device__ __forceinline__ unsigned xb_xcc_id() { return (unsigned)__builtin_amdgcn_s_getreg((3 << 11) | 20) & 0xFu; }
#define XB_SPIN(cond, bar) do { unsigned _sp = 0; while (cond) { __builtin_amdgcn_s_sleep(1); \
    if ((++_sp & 255u) == 0u) { if (xb_ld(&(bar)[XB_TMO])) break; if (_sp > XB_SPIN_CAP) { atomicAdd(&(bar)[XB_TMO], 1u); break; } } } } while (0)
struct XcdBarrier { unsigned* bar; unsigned x; volatile LAS unsigned* st; };
__device__ __forceinline__ XcdBarrier xcd_barrier_post(unsigned* bar, volatile LAS unsigned* st) {
    XcdBarrier b; b.bar = bar; b.x = xb_xcc_id(); b.st = st;
    if (threadIdx.x == 0) (void)xb_add(&bar[XB_XCNT(b.x)], 1u);
    return b;
}
__device__ __forceinline__ void xcd_barrier_complete(unsigned* bar, unsigned x, unsigned& nloc, unsigned& nx) {
    const unsigned G = gridDim.x * gridDim.y * gridDim.z;
    unsigned sum, cnt, mine, sp = 0u;
    for (;;) {
        sum = 0u; cnt = 0u; mine = 0u;
#pragma unroll
        for (unsigned j = 0; j < 16; ++j) { const unsigned c = xb_ld(&bar[XB_XCNT(j)]); sum += c; cnt += (c > 0u) ? 1u : 0u; mine = (j == x) ? c : mine; }
        if (sum == G) break;
        __builtin_amdgcn_s_sleep(1);
        if ((++sp & 255u) == 0u) { if (xb_ld(&bar[XB_TMO])) break; if (sp > XB_SPIN_CAP) { atomicAdd(&bar[XB_TMO], 1u); break; } }
    }
    nloc = mine > 0u ? mine : 1u; nx = cnt > 0u ? cnt : 1u;
}
__device__ __forceinline__ void xcd_barrier(const XcdBarrier& b) {
    asm volatile("s_waitcnt vmcnt(0)" ::: "memory");
    __syncthreads();
    if (threadIdx.x == 0) {
        unsigned* bar = b.bar;
        __builtin_amdgcn_s_waitcnt(0);
        unsigned nloc = b.st[0], nx = b.st[1];
        if (nloc == 0u) { xcd_barrier_complete(bar, b.x, nloc, nx); b.st[0] = nloc; b.st[1] = nx; }
        const unsigned old = xb_add(&bar[XB_XSUB(b.x)], 1u);
        const unsigned gen = old / nloc;
        if (old + 1u == (gen + 1u) * nloc) {
            __builtin_amdgcn_fence(__ATOMIC_RELEASE, "agent");
            asm volatile("s_waitcnt vmcnt(0)" ::: "memory");
            const unsigned og = xb_add(&bar[XB_TOP], 1u);
            const unsigned tg = og / nx;
            if (og + 1u == (tg + 1u) * nx) xb_add(&bar[XB_TOPGEN], 1u);
            else XB_SPIN(xb_ld(&bar[XB_TOPGEN]) == tg, bar);
            __builtin_amdgcn_fence(__ATOMIC_ACQUIRE, "agent");
            xb_add(&bar[XB_XGEN(b.x)], 1u);
            asm volatile("s_waitcnt vmcnt(0)" ::: "memory");
        } else {
            XB_SPIN(xb_ld(&bar[XB_XGEN(b.x)]) == gen, bar);
            __builtin_amdgcn_fence(__ATOMIC_ACQUIRE, "agent");
            asm volatile("s_waitcnt vmcnt(0)" ::: "memory");
        }
    }
    __syncthreads();
}

struct Ctx {
    ldsp lds; int tid, lane, wave, G, bid;
    const float* in[22]; float* out; unsigned char* ws;
};
enum { I_X = 0, I_META, I_LNMIX, I_WIN, I_WG2, I_BG, I_GNW, I_CONVW, I_CONVB, I_DTB, I_ALOG, I_DSKIP, I_SNW, I_WUG, I_WUS, I_WOUT, I_LNFFN, I_WQ, I_KEYS, I_PU, I_PV, I_LNF };

using pg8::Unit; using pg8::cvt_pk_bf16;
struct EpiProj {
    static constexpr bool PERM = true, AFTER_DRAIN = false;
    bf16* PJ; float* TL;
    __device__ __forceinline__ void operator()(const f32x4 (&acc)[2][2][4][2], const Unit& u, int wr, int wc, int fr, int fq) const {
        const int row0 = u.pm * 256 + wr * 64 + fr; const int pn = u.pn;
        if (pn < 40) {
            const int mode = pn < 2 ? 1 : (pn < 8 ? 0 : (pn < 20 ? 2 : (pn < 32 ? 0 : 3)));
            const int col0 = pn * 256 + wc * 32 + 8 * fq;
#pragma unroll
            for (int ai = 0; ai < 2; ++ai)
#pragma unroll
                for (int m = 0; m < 4; ++m) { bf16* rowp = PJ + (size_t)(row0 + ai * 128 + m * 16) * NPJ + col0;
#pragma unroll
                    for (int bj = 0; bj < 2; ++bj) { f32x4 v0 = acc[ai][bj][m][0], v1 = acc[ai][bj][m][1];
                        if (mode == 1) { v0 = v0 * 0.08838834764831845f; v1 = v1 * 0.08838834764831845f; }
                        else if (mode == 2) {
#pragma unroll
                            for (int j = 0; j < 4; ++j) { v0[j] = siluf_(v0[j]); v1[j] = siluf_(v1[j]); } }
                        else if (mode == 3) {
#pragma unroll
                            for (int j = 0; j < 4; ++j) { v0[j] = sigmoidf_(v0[j]); v1[j] = sigmoidf_(v1[j]); } }
                        v4u w; w.x = cvt_pk_bf16(v0[0], v0[1]); w.y = cvt_pk_bf16(v0[2], v0[3]); w.z = cvt_pk_bf16(v1[0], v1[1]); w.w = cvt_pk_bf16(v1[2], v1[3]);
                        *(v4u*)(rowp + bj * 128) = w; } }
        } else {
            if (wc < 2) {
#pragma unroll
                for (int ai = 0; ai < 2; ++ai)
#pragma unroll
                    for (int m = 0; m < 4; ++m) { float* rowp = TL + (size_t)(row0 + ai * 128 + m * 16) * 48;
#pragma unroll
                        for (int n = 0; n < 2; ++n) { const int c = wc * 32 + 8 * fq + 4 * n; if (c < 48) *(f32x4*)(rowp + c) = acc[ai][0][m][n]; } }
            }
        }
    }
};
struct EpiAny {
    static constexpr bool PERM = true, AFTER_DRAIN = false;
    int mode;
    EpiProj P; bf16* O; const bf16* PJ; const bf16* T; int gcol; const float* X; float* OF; int b; int ldc;
    __device__ __forceinline__ void operator()(const f32x4 (&acc)[2][2][4][2], const Unit& u, int wr, int wc, int fr, int fq) const {
        if (mode == 0) { P(acc, u, wr, wc, fr, fq); return; }
        const int row0 = u.pm * 256 + wr * 64 + fr; const int col0 = u.pn * 256 + wc * 32 + 8 * fq;
        if (mode == 1) {
#pragma unroll
            for (int ai = 0; ai < 2; ++ai)
#pragma unroll
                for (int m = 0; m < 4; ++m) { const size_t r = (size_t)(row0 + ai * 128 + m * 16);
#pragma unroll
                    for (int bj = 0; bj < 2; ++bj) { const int c = col0 + bj * 128;
                        const v4u g = *(const v4u*)(PJ + r * NPJ + gcol + c);
                        f32x4 v0 = acc[ai][bj][m][0], v1 = acc[ai][bj][m][1];
                        v0[0] *= bflo(g.x); v0[1] *= bfhi(g.x); v0[2] *= bflo(g.y); v0[3] *= bfhi(g.y); v1[0] *= bflo(g.z); v1[1] *= bfhi(g.z); v1[2] *= bflo(g.w); v1[3] *= bfhi(g.w);
                        if (T) { const v4u t = *(const v4u*)(T + r * 1024 + c);
                            v0[0] += bflo(t.x); v0[1] += bfhi(t.x); v0[2] += bflo(t.y); v0[3] += bfhi(t.y); v1[0] += bflo(t.z); v1[1] += bfhi(t.z); v1[2] += bflo(t.w); v1[3] += bfhi(t.w); }
                        v4u w; w.x = cvt_pk_bf16(v0[0], v0[1]); w.y = cvt_pk_bf16(v0[2], v0[3]); w.z = cvt_pk_bf16(v1[0], v1[1]); w.w = cvt_pk_bf16(v1[2], v1[3]);
                        *(v4u*)(O + r * 1024 + c) = w; } }
        } else if (mode == 2) {
#pragma unroll
            for (int ai = 0; ai < 2; ++ai)
#pragma unroll
                for (int m = 0; m < 4; ++m) { const int r = row0 + ai * 128 + m * 16;
                    if (r >= RTOK && r < REND) { const size_t o = ((size_t)b * SEQ + (r - RTOK)) * D + col0;
#pragma unroll
                        for (int bj = 0; bj < 2; ++bj)
#pragma unroll
                            for (int n = 0; n < 2; ++n) { const f32x4 xv = *(const f32x4*)(X + o + bj * 128 + n * 4); *(f32x4*)(OF + o + bj * 128 + n * 4) = acc[ai][bj][m][n] + xv; } } }
        } else {
#pragma unroll
            for (int ai = 0; ai < 2; ++ai)
#pragma unroll
                for (int m = 0; m < 4; ++m) { float* rowp = OF + (size_t)(row0 + ai * 128 + m * 16) * ldc + col0;
#pragma unroll
                    for (int bj = 0; bj < 2; ++bj)
#pragma unroll
                        for (int n = 0; n < 2; ++n) *(f32x4*)(rowp + bj * 128 + n * 4) = acc[ai][bj][m][n]; }
        }
    }
};

struct MapIdent { __device__ __forceinline__ int operator()(int n) const { return n; } };
struct MapW1 { __device__ __forceinline__ int operator()(int n) const {
    if (n < 3072) return n;
    if (n < 8192) return n + 16;
    if (n < 10240) return n + 48;
    if (n < 10256) return n - 10240 + 3072;
    if (n < 10288) return n - 10256 + 8208;
    return -1; } };
template <class Map>
__device__ __forceinline__ void transpose_item(const float* W, int K, int NS, int N, bf16* WT, LAS float* scr, int item, int lane, const Map& map) {
    const int nblk = N / 32, kb = item / nblk, nb = item % nblk, k0 = 64 * kb, n0 = 32 * nb;
    const int sc = map(n0 + (lane & 31));
#pragma unroll 8
    for (int i = 0; i < 32; ++i) { const int kk = 2 * i + (lane >> 5); scr[kk * 33 + (lane & 31)] = sc >= 0 ? W[(size_t)(k0 + kk) * NS + sc] : 0.f; }
    LDS_WAIT(); asm volatile("" ::: "memory");
    const int c = lane & 7;
#pragma unroll
    for (int j = 0; j < 4; ++j) { const int n = (lane >> 3) + 8 * j; const LAS float* s = scr + (8 * c) * 33 + n;
        v4u o; o.x = pk2(s[0 * 33], s[1 * 33]); o.y = pk2(s[2 * 33], s[3 * 33]); o.z = pk2(s[4 * 33], s[5 * 33]); o.w = pk2(s[6 * 33], s[7 * 33]);
        *(v4u*)(WT + (size_t)(n0 + n) * K + k0 + 8 * c) = o; }
    LDS_WAIT(); asm volatile("" ::: "memory");
}
__device__ __forceinline__ void norm_row_bf16(const float* src, const float* w, bf16* dst, int lane) {
    v2u* o8 = (v2u*)dst + lane;
    if (src == nullptr) {
#pragma unroll
        for (int j = 0; j < 4; ++j) o8[64 * j] = (v2u){0u, 0u};
        return; }
    const f32x4* xr = (const f32x4*)src + lane; const f32x4* wr_ = (const f32x4*)w + lane;
    f32x4 v[4]; float s = 0.f;
#pragma unroll
    for (int j = 0; j < 4; ++j) { v[j] = xr[64 * j]; s += (v[j].x * v[j].x + v[j].y * v[j].y) + (v[j].z * v[j].z + v[j].w * v[j].w); }
    const float rs = rsqrtf(wave_sum(s) * (1.f / D) + RMS_EPS);
#pragma unroll
    for (int j = 0; j < 4; ++j) { const f32x4 ww = wr_[64 * j]; v2u o; o.x = pk2(v[j].x * rs * ww.x, v[j].y * rs * ww.y); o.y = pk2(v[j].z * rs * ww.z, v[j].w * rs * ww.w); o8[64 * j] = o; }
}
__device__ __forceinline__ void hn_batch(const Ctx& C, int b) {
    bf16* HN = (bf16*)(C.ws + WS_HN);
    const int gw = C.bid * NWAVES + C.wave, NGW = C.G * NWAVES;
    for (int r = gw; r < RPB; r += NGW) {
        const float* src = nullptr;
        if (r >= RFRONT && r < RTOK) src = C.in[I_META] + (size_t)(r - RFRONT) * D;
        else if (r >= RTOK && r < REND) src = C.in[I_X] + ((size_t)b * SEQ + (r - RTOK)) * D;
        norm_row_bf16(src, C.in[I_LNMIX], HN + (size_t)r * D, C.lane);
    }
}
__device__ __forceinline__ void weff_unit(const Ctx& C, int unit) {
    const int blk = unit >> 4, d0 = (unit & 15) * 64;
    LAS float* KT = (LAS float*)C.lds;
    LAS float* WQ = (LAS float*)(C.lds + 128 * 132 * 4);
    const float* keys = C.in[I_KEYS] + (size_t)blk * 128 * 128; const float* wq = C.in[I_WQ];
    for (int e = C.tid; e < 128 * 32; e += NT) { const int key = e >> 5, j4 = e & 31; *(LAS f32x4*)(KT + key * 132 + 4 * j4) = *(const f32x4*)(keys + key * 128 + 4 * j4); }
    for (int e = C.tid; e < 64 * 32; e += NT) { const int dd = e >> 5, j4 = e & 31; *(LAS f32x4*)(WQ + dd * 128 + 4 * j4) = *(const f32x4*)(wq + (size_t)(d0 + dd) * 2048 + blk * 128 + 4 * j4); }
    __syncthreads();
    const int key = C.tid & 127, dg = C.tid >> 7;
    float acc[16];
#pragma unroll
    for (int i = 0; i < 16; ++i) acc[i] = 0.f;
    for (int j4 = 0; j4 < 32; ++j4) {
        const f32x4 kv = *(const LAS f32x4*)(KT + key * 132 + 4 * j4);
#pragma unroll
        for (int i = 0; i < 16; ++i) { const f32x4 wv = *(const LAS f32x4*)(WQ + (dg * 16 + i) * 128 + 4 * j4); acc[i] += kv.x * wv.x + kv.y * wv.y + kv.z * wv.z + kv.w * wv.w; }
    }
    bf16* WET = (bf16*)(C.ws + WS_WET) + (size_t)(blk * 128 + key) * D + d0 + dg * 16;
    v4u o0, o1; o0.x = pk2(acc[0], acc[1]); o0.y = pk2(acc[2], acc[3]); o0.z = pk2(acc[4], acc[5]); o0.w = pk2(acc[6], acc[7]);
    o1.x = pk2(acc[8], acc[9]); o1.y = pk2(acc[10], acc[11]); o1.z = pk2(acc[12], acc[13]); o1.w = pk2(acc[14], acc[15]);
    *(v4u*)WET = o0; *(v4u*)(WET + 8) = o1;
    __syncthreads();
}
__device__ __forceinline__ void p0_prologue(const Ctx& C) {
    LAS float* scr = (LAS float*)(C.lds + C.wave * 16384);
    const int gw = C.bid * NWAVES + C.wave, NGW = C.G * NWAVES;
    constexpr int I_1 = (D / 64) * (N1 / 32), I_A = (1024 / 64) * (1024 / 32), I_B = (2048 / 64) * (1024 / 32), I_O = I_A;
    constexpr int NITEMS = I_1 + I_A + I_B + I_O;
    for (int it = gw; it < NITEMS; it += NGW) {
        int r = it;
        if (r < I_1) { transpose_item(C.in[I_WIN], 1024, 10288, N1, (bf16*)(C.ws + WS_W1T), scr, r, C.lane, MapW1()); continue; } r -= I_1;
        if (r < I_A) { transpose_item(C.in[I_WUG], 1024, 1024, 1024, (bf16*)(C.ws + WS_WAT), scr, r, C.lane, MapIdent()); continue; } r -= I_A;
        if (r < I_B) { transpose_item(C.in[I_WUS], 2048, 1024, 1024, (bf16*)(C.ws + WS_WBT), scr, r, C.lane, MapIdent()); continue; } r -= I_B;
        transpose_item(C.in[I_WOUT], 1024, 1024, 1024, (bf16*)(C.ws + WS_WOT), scr, r, C.lane, MapIdent());
    }
    __syncthreads();
    for (int u = C.bid; u < 256; u += C.G) weff_unit(C, u);
    hn_batch(C, 0);
}

__device__ __forceinline__ float softplusf_(float x) { return fmaxf(x, 0.f) + log1pf(__expf(-fabsf(x))); }
__device__ __forceinline__ void phaseC_unit(const Ctx& C, int c) {
    const bf16* PJ = (const bf16*)(C.ws + WS_PJ); const float* TL = (const float*)(C.ws + WS_TL);
    bf16* XC = (bf16*)(C.ws + WS_XC); float* GG = (float*)(C.ws + WS_GG); float* DT = (float*)(C.ws + WS_DT); float* AC = (float*)(C.ws + WS_AC);
    const int r0 = 64 * c;
    const float* cw = C.in[I_CONVW]; const float* cb = C.in[I_CONVB];
#pragma unroll 1
    for (int i = 0; i < 3; ++i) {
        const int col = 2 * (C.tid + NT * i);
        const f32x2 w0 = *(const f32x2*)(cw + col), w1 = *(const f32x2*)(cw + 3072 + col), w2 = *(const f32x2*)(cw + 2 * 3072 + col), w3 = *(const f32x2*)(cw + 3 * 3072 + col), bb = *(const f32x2*)(cb + col);
        f32x2 xm3 = {0.f, 0.f}, xm2 = {0.f, 0.f}, xm1 = {0.f, 0.f};
        if (c > 0) {
            const unsigned a = *(const unsigned*)(PJ + (size_t)(r0 - 3) * NPJ + PJ_XBC + col), b2 = *(const unsigned*)(PJ + (size_t)(r0 - 2) * NPJ + PJ_XBC + col), c2 = *(const unsigned*)(PJ + (size_t)(r0 - 1) * NPJ + PJ_XBC + col);
            xm3 = (f32x2){bflo(a), bfhi(a)}; xm2 = (f32x2){bflo(b2), bfhi(b2)}; xm1 = (f32x2){bflo(c2), bfhi(c2)};
        }
#pragma unroll 8
        for (int t = 0; t < 64; ++t) {
            const int r = r0 + t;
            const unsigned xu = *(const unsigned*)(PJ + (size_t)r * NPJ + PJ_XBC + col);
            const f32x2 x0 = {bflo(xu), bfhi(xu)};
            f32x2 o = bb + w0 * xm3 + w1 * xm2 + w2 * xm1 + w3 * x0;
            o.x = siluf_(o.x); o.y = siluf_(o.y);
            if (r < RFRONT) { o.x = 0.f; o.y = 0.f; }
            *(unsigned*)(XC + (size_t)r * 3072 + col) = pk2(o.x, o.y);
            xm3 = xm2; xm2 = xm1; xm1 = x0;
        }
    }
    {
        const int col = C.tid; const float* w2p = C.in[I_WG2]; float w2[16];
#pragma unroll
        for (int j = 0; j < 16; ++j) w2[j] = w2p[j * 512 + col];
        const float bg = C.in[I_BG][col]; float G = 0.f;
#pragma unroll 4
        for (int t = 0; t < 64; ++t) {
            const int r = r0 + t; const float* gl = TL + (size_t)r * 48;
            float z = bg;
#pragma unroll
            for (int j4 = 0; j4 < 4; ++j4) { const f32x4 g = *(const f32x4*)(gl + 4 * j4); z += g.x * w2[4 * j4] + g.y * w2[4 * j4 + 1] + g.z * w2[4 * j4 + 2] + g.w * w2[4 * j4 + 3]; }
            float ls = fminf(z, 0.f) - log1pf(__expf(-fabsf(z)));
            if (r < RFRONT) ls = 0.f;
            G += ls * (1.f / 16.f);
            GG[(size_t)r * 512 + col] = G;
        }
    }
    if (C.tid < 32) {
        const int hd = C.tid; const float bias = C.in[I_DTB][hd], A = -__expf(C.in[I_ALOG][hd]); float acum = 0.f;
        for (int t = 0; t < 64; ++t) {
            const int r = r0 + t; float dt = softplusf_(TL[(size_t)r * 48 + 16 + hd] + bias);
            if (r < RFRONT) dt = 0.f;
            acum += A * dt;
            DT[(size_t)r * 32 + hd] = dt; AC[(size_t)r * 32 + hd] = acum;
        }
    }
}

constexpr int P136 = 272, P264 = 528, P520 = 1040, P72 = 144;
__device__ __forceinline__ void gla_pass1_unit(const Ctx& C, int c, int h) {
    const bf16* PJ = (const bf16*)(C.ws + WS_PJ); const float* GG = (const float*)(C.ws + WS_GG); bf16* LG = (bf16*)(C.ws + WS_LG);
    ldsp KD = C.lds, VT = C.lds + 64 * P136;
    const int r0 = 64 * c;
    {
        const int s = C.tid >> 3, k0 = (C.tid & 7) * 16; const size_t r = (size_t)(r0 + s);
        const v4u ka = *(const v4u*)(PJ + r * NPJ + PJ_K + 128 * h + k0), kb = *(const v4u*)(PJ + r * NPJ + PJ_K + 128 * h + k0 + 8);
        const float* g = GG + r * 512 + 128 * h + k0; const float* gl = GG + (size_t)(r0 + 63) * 512 + 128 * h + k0;
        float e[16];
#pragma unroll
        for (int j = 0; j < 4; ++j) { const f32x4 a = *(const f32x4*)(g + 4 * j), l = *(const f32x4*)(gl + 4 * j); e[4 * j] = __expf(l.x - a.x); e[4 * j + 1] = __expf(l.y - a.y); e[4 * j + 2] = __expf(l.z - a.z); e[4 * j + 3] = __expf(l.w - a.w); }
        v4u o0, o1;
        o0.x = pk2(bflo(ka.x) * e[0], bfhi(ka.x) * e[1]); o0.y = pk2(bflo(ka.y) * e[2], bfhi(ka.y) * e[3]); o0.z = pk2(bflo(ka.z) * e[4], bfhi(ka.z) * e[5]); o0.w = pk2(bflo(ka.w) * e[6], bfhi(ka.w) * e[7]);
        o1.x = pk2(bflo(kb.x) * e[8], bfhi(kb.x) * e[9]); o1.y = pk2(bflo(kb.y) * e[10], bfhi(kb.y) * e[11]); o1.z = pk2(bflo(kb.z) * e[12], bfhi(kb.z) * e[13]); o1.w = pk2(bflo(kb.w) * e[14], bfhi(kb.w) * e[15]);
        *(LAS v4u*)(KD + s * P136 + k0 * 2) = o0; *(LAS v4u*)(KD + s * P136 + k0 * 2 + 16) = o1;
        const int v0 = (C.tid & 7) * 32; const bf16* vp = PJ + r * NPJ + PJ_V + 256 * h + v0;
#pragma unroll
        for (int j = 0; j < 4; ++j) *(LAS v4u*)(VT + s * P264 + (v0 + 8 * j) * 2) = *(const v4u*)(vp + 8 * j);
    }
    __syncthreads();
    const int fr = C.lane & 15, fq = C.lane >> 4, w = C.wave;
    f32x4 acc[2][8];
#pragma unroll
    for (int mi = 0; mi < 2; ++mi)
#pragma unroll
        for (int nt = 0; nt < 8; ++nt) acc[mi][nt] = (f32x4){0.f, 0.f, 0.f, 0.f};
#pragma unroll
    for (int ks = 0; ks < 2; ++ks) {
        bf16x8 af[2];
#pragma unroll
        for (int mi = 0; mi < 2; ++mi) af[mi] = tr_frag(VT, P264, 32 * ks, 32 * w + 16 * mi, fr, fq);
#pragma unroll
        for (int nt = 0; nt < 8; ++nt) { const bf16x8 bfm = tr_frag(KD, P136, 32 * ks, 16 * nt, fr, fq);
#pragma unroll
            for (int mi = 0; mi < 2; ++mi) acc[mi][nt] = mma16(af[mi], bfm, acc[mi][nt]); }
    }
    bf16* Lb = LG + ((size_t)(c * 4 + h) * 256) * 128;
#pragma unroll
    for (int mi = 0; mi < 2; ++mi)
#pragma unroll
        for (int nt = 0; nt < 8; ++nt) { const int v = 32 * w + 16 * mi + fr, k = 16 * nt + 4 * fq; const f32x4 a = acc[mi][nt];
            *(v2u*)(Lb + (size_t)v * 128 + k) = (v2u){cvt_pk_bf16(a[0], a[1]), cvt_pk_bf16(a[2], a[3])}; }
    __syncthreads();
}
__device__ __forceinline__ void ssd_pass1_unit(const Ctx& C, int c, int g) {
    const bf16* XC = (const bf16*)(C.ws + WS_XC); const float* DT = (const float*)(C.ws + WS_DT); const float* AC = (const float*)(C.ws + WS_AC); bf16* LS = (bf16*)(C.ws + WS_LS);
    ldsp XW = C.lds, BM = C.lds + 64 * P520;
    const int r0 = 64 * c;
    {
        const int s = C.tid >> 3, hl = C.tid & 7, hd = 8 * g + hl; const size_t r = (size_t)(r0 + s);
        const float sc = DT[r * 32 + hd] * __expf(AC[(size_t)(r0 + 63) * 32 + hd] - AC[r * 32 + hd]);
        const bf16* xp = XC + r * 3072 + 64 * hd;
#pragma unroll
        for (int j = 0; j < 8; ++j) { const v4u x = *(const v4u*)(xp + 8 * j); v4u o;
            o.x = pk2(bflo(x.x) * sc, bfhi(x.x) * sc); o.y = pk2(bflo(x.y) * sc, bfhi(x.y) * sc); o.z = pk2(bflo(x.z) * sc, bfhi(x.z) * sc); o.w = pk2(bflo(x.w) * sc, bfhi(x.w) * sc);
            *(LAS v4u*)(XW + s * P520 + (64 * hl + 8 * j) * 2) = o; }
        const bf16* bp = XC + r * 3072 + 2048 + 128 * g + 16 * hl;
        *(LAS v4u*)(BM + s * P136 + (16 * hl) * 2) = *(const v4u*)bp; *(LAS v4u*)(BM + s * P136 + (16 * hl + 8) * 2) = *(const v4u*)(bp + 8);
    }
    __syncthreads();
    const int fr = C.lane & 15, fq = C.lane >> 4, w = C.wave;
    bf16* Lb = LS + ((size_t)(c * 32 + 8 * g + w) * 64) * 128;
#pragma unroll
    for (int nh = 0; nh < 2; ++nh) {
        f32x4 acc[4][4];
#pragma unroll
        for (int mi = 0; mi < 4; ++mi)
#pragma unroll
            for (int nt = 0; nt < 4; ++nt) acc[mi][nt] = (f32x4){0.f, 0.f, 0.f, 0.f};
#pragma unroll
        for (int ks = 0; ks < 2; ++ks) {
            bf16x8 af[4];
#pragma unroll
            for (int mi = 0; mi < 4; ++mi) af[mi] = tr_frag(XW, P520, 32 * ks, 64 * w + 16 * mi, fr, fq);
#pragma unroll
            for (int nt = 0; nt < 4; ++nt) { const bf16x8 bfm = tr_frag(BM, P136, 32 * ks, 64 * nh + 16 * nt, fr, fq);
#pragma unroll
                for (int mi = 0; mi < 4; ++mi) acc[mi][nt] = mma16(af[mi], bfm, acc[mi][nt]); }
        }
#pragma unroll
        for (int mi = 0; mi < 4; ++mi)
#pragma unroll
            for (int nt = 0; nt < 4; ++nt) { const int p = 16 * mi + fr, n = 64 * nh + 16 * nt + 4 * fq; const f32x4 a = acc[mi][nt];
                *(v2u*)(Lb + (size_t)p * 128 + n) = (v2u){cvt_pk_bf16(a[0], a[1]), cvt_pk_bf16(a[2], a[3])}; }
    }
    __syncthreads();
}

__device__ __forceinline__ void phaseE(const Ctx& C) {
    const float* GG = (const float*)(C.ws + WS_GG); const float* AC = (const float*)(C.ws + WS_AC);
    for (int vb = C.bid; vb < 256; vb += C.G) {
        if (vb < 128) {
            const int e = vb * NT + C.tid, k2 = e & 63, v = (e >> 6) & 255, h = e >> 14;
            unsigned* Lp = (unsigned*)(C.ws + WS_LG) + ((size_t)h * 256 + v) * 64 + k2;
            const float* dp = GG + 63 * 512 + 128 * h + 2 * k2;
            float s0 = 0.f, s1 = 0.f;
            for (int c0 = 0; c0 < NCHUNK; c0 += 8) {
                unsigned l[8]; f32x2 d[8];
#pragma unroll
                for (int i = 0; i < 8; ++i) if (c0 + i < NCHUNK) { l[i] = Lp[(size_t)(c0 + i) * (4 * 256 * 64)]; d[i] = *(const f32x2*)(dp + (size_t)(c0 + i) * 64 * 512); }
#pragma unroll
                for (int i = 0; i < 8; ++i) if (c0 + i < NCHUNK) {
                    Lp[(size_t)(c0 + i) * (4 * 256 * 64)] = pk2(s0, s1);
                    s0 = s0 * __expf(d[i].x) + bflo(l[i]); s1 = s1 * __expf(d[i].y) + bfhi(l[i]); }
            }
        } else {
            const int e = (vb - 128) * NT + C.tid, n4 = e & 31, p = (e >> 5) & 63, hd = e >> 11;
            v2u* Lp = (v2u*)(C.ws + WS_LS) + ((size_t)hd * 64 + p) * 32 + n4;
            const float* dp = AC + 63 * 32 + hd;
            float s0 = 0.f, s1 = 0.f, s2 = 0.f, s3 = 0.f;
            for (int c0 = 0; c0 < NCHUNK; c0 += 8) {
                v2u l[8]; float d[8];
#pragma unroll
                for (int i = 0; i < 8; ++i) if (c0 + i < NCHUNK) { l[i] = Lp[(size_t)(c0 + i) * (32 * 64 * 32)]; d[i] = dp[(size_t)(c0 + i) * 64 * 32]; }
#pragma unroll
                for (int i = 0; i < 8; ++i) if (c0 + i < NCHUNK) {
                    Lp[(size_t)(c0 + i) * (32 * 64 * 32)] = (v2u){pk2(s0, s1), pk2(s2, s3)};
                    const float dd = __expf(d[i]);
                    s0 = s0 * dd + bflo(l[i].x); s1 = s1 * dd + bfhi(l[i].x); s2 = s2 * dd + bflo(l[i].y); s3 = s3 * dd + bfhi(l[i].y); }
            }
        }
    }
}

__device__ __forceinline__ void gla_pass3_unit(const Ctx& C, int c, int h) {
    const bf16* PJ = (const bf16*)(C.ws + WS_PJ); const float* GG = (const float*)(C.ws + WS_GG); const bf16* LG = (const bf16*)(C.ws + WS_LG); bf16* OG = (bf16*)(C.ws + WS_OG);
    ldsp QE = C.lds, QN = QE + 64 * P136, KE = QN + 64 * P136, KN = KE + 64 * P136, VT = KN + 64 * P136, ATT = VT + 64 * P264;
    LAS float* RED = (LAS float*)(ATT + 64 * P72);
    const int r0 = 64 * c;
    {
        const int s = C.tid >> 3, k0 = (C.tid & 7) * 16; const size_t r = (size_t)(r0 + s);
        const v4u qa = *(const v4u*)(PJ + r * NPJ + PJ_Q + 128 * h + k0), qb = *(const v4u*)(PJ + r * NPJ + PJ_Q + 128 * h + k0 + 8);
        const v4u ka = *(const v4u*)(PJ + r * NPJ + PJ_K + 128 * h + k0), kb = *(const v4u*)(PJ + r * NPJ + PJ_K + 128 * h + k0 + 8);
        const float* g = GG + r * 512 + 128 * h + k0;
        float ep[16], en[16];
#pragma unroll
        for (int j = 0; j < 4; ++j) { const f32x4 a = *(const f32x4*)(g + 4 * j);
            ep[4 * j] = __expf(a.x); ep[4 * j + 1] = __expf(a.y); ep[4 * j + 2] = __expf(a.z); ep[4 * j + 3] = __expf(a.w);
            en[4 * j] = __expf(-a.x); en[4 * j + 1] = __expf(-a.y); en[4 * j + 2] = __expf(-a.z); en[4 * j + 3] = __expf(-a.w); }
        const unsigned qs[8] = {qa.x, qa.y, qa.z, qa.w, qb.x, qb.y, qb.z, qb.w}, ksr[8] = {ka.x, ka.y, ka.z, ka.w, kb.x, kb.y, kb.z, kb.w};
        unsigned oqe[8], oqn[8], oke[8], okn[8];
#pragma unroll
        for (int j = 0; j < 8; ++j) { const float q0 = bflo(qs[j]), q1 = bfhi(qs[j]), kk0 = bflo(ksr[j]), kk1 = bfhi(ksr[j]);
            oqe[j] = pk2(q0 * ep[2 * j], q1 * ep[2 * j + 1]); oqn[j] = pk2(q0 * en[2 * j], q1 * en[2 * j + 1]);
            oke[j] = pk2(kk0 * ep[2 * j], kk1 * ep[2 * j + 1]); okn[j] = pk2(kk0 * en[2 * j], kk1 * en[2 * j + 1]); }
        const int off = s * P136 + k0 * 2;
        *(LAS v4u*)(QE + off) = (v4u){oqe[0], oqe[1], oqe[2], oqe[3]}; *(LAS v4u*)(QE + off + 16) = (v4u){oqe[4], oqe[5], oqe[6], oqe[7]};
        *(LAS v4u*)(QN + off) = (v4u){oqn[0], oqn[1], oqn[2], oqn[3]}; *(LAS v4u*)(QN + off + 16) = (v4u){oqn[4], oqn[5], oqn[6], oqn[7]};
        *(LAS v4u*)(KE + off) = (v4u){oke[0], oke[1], oke[2], oke[3]}; *(LAS v4u*)(KE + off + 16) = (v4u){oke[4], oke[5], oke[6], oke[7]};
        *(LAS v4u*)(KN + off) = (v4u){okn[0], okn[1], okn[2], okn[3]}; *(LAS v4u*)(KN + off + 16) = (v4u){okn[4], okn[5], okn[6], okn[7]};
        const int v0 = (C.tid & 7) * 32; const bf16* vp = PJ + r * NPJ + PJ_V + 256 * h + v0;
#pragma unroll
        for (int j = 0; j < 4; ++j) *(LAS v4u*)(VT + s * P264 + (v0 + 8 * j) * 2) = *(const v4u*)(vp + 8 * j);
    }
    __syncthreads();
    const int fr = C.lane & 15, fq = C.lane >> 4, w = C.wave;
#pragma unroll
    for (int ti = 0; ti < 2; ++ti) {
        const int id = 2 * w + ti, tm = id >> 2, sn = id & 3;
        f32x4 ac = {0.f, 0.f, 0.f, 0.f}, aa = {0.f, 0.f, 0.f, 0.f};
#pragma unroll
        for (int ks = 0; ks < 4; ++ks) {
            const int ao = (16 * tm + fr) * P136 + (32 * ks + 8 * fq) * 2, bo = (16 * sn + fr) * P136 + (32 * ks + 8 * fq) * 2;
            ac = mma16(lds_frag(QE + ao), lds_frag(KN + bo), ac);
            aa = mma16(lds_frag(QN + ao), lds_frag(KE + bo), aa);
        }
        const int t = 16 * tm + fr, s0 = 16 * sn + 4 * fq;
        float o[4];
#pragma unroll
        for (int j = 0; j < 4; ++j) o[j] = (s0 + j <= t) ? ac[j] : aa[j];
        *(LAS v2u*)(ATT + t * P72 + s0 * 2) = (v2u){pk2(o[0], o[1]), pk2(o[2], o[3])};
    }
    __syncthreads();
    f32x4 acc[4][2];
#pragma unroll
    for (int tm = 0; tm < 4; ++tm)
#pragma unroll
        for (int nt = 0; nt < 2; ++nt) acc[tm][nt] = (f32x4){0.f, 0.f, 0.f, 0.f};
    const bf16* Sb = LG + ((size_t)(c * 4 + h) * 256) * 128;
#pragma unroll
    for (int ks = 0; ks < 4; ++ks) {
        bf16x8 bfm[2];
#pragma unroll
        for (int nt = 0; nt < 2; ++nt) bfm[nt] = *(const bf16x8*)(Sb + (size_t)(32 * w + 16 * nt + fr) * 128 + 32 * ks + 8 * fq);
#pragma unroll
        for (int tm = 0; tm < 4; ++tm) { const bf16x8 af = lds_frag(QE + (16 * tm + fr) * P136 + (32 * ks + 8 * fq) * 2);
#pragma unroll
            for (int nt = 0; nt < 2; ++nt) acc[tm][nt] = mma16(af, bfm[nt], acc[tm][nt]); }
    }
#pragma unroll
    for (int ks = 0; ks < 2; ++ks) {
        bf16x8 bfm[2];
#pragma unroll
        for (int nt = 0; nt < 2; ++nt) bfm[nt] = tr_frag(VT, P264, 32 * ks, 32 * w + 16 * nt, fr, fq);
#pragma unroll
        for (int tm = 0; tm < 4; ++tm) { const bf16x8 af = lds_frag(ATT + (16 * tm + fr) * P72 + (32 * ks + 8 * fq) * 2);
#pragma unroll
            for (int nt = 0; nt < 2; ++nt) acc[tm][nt] = mma16(af, bfm[nt], acc[tm][nt]); }
    }
#pragma unroll
    for (int tm = 0; tm < 4; ++tm) { float s = 0.f;
#pragma unroll
        for (int nt = 0; nt < 2; ++nt) { const f32x4 a = acc[tm][nt]; s += (a[0] * a[0] + a[1] * a[1]) + (a[2] * a[2] + a[3] * a[3]); }
        s += __shfl_xor(s, 16); s += __shfl_xor(s, 32);
        if (fq == 0) RED[w * 64 + 16 * tm + fr] = s; }
    __syncthreads();
    const float* nw = C.in[I_GNW];
#pragma unroll
    for (int tm = 0; tm < 4; ++tm) { const int t = 16 * tm + fr; float tot = 0.f;
#pragma unroll
        for (int ww = 0; ww < 8; ++ww) tot += RED[ww * 64 + t];
        const float rs = rsqrtf(tot * (1.f / 256.f) + RMS_EPS); const size_t r = (size_t)(r0 + t);
#pragma unroll
        for (int nt = 0; nt < 2; ++nt) { const int v = 32 * w + 16 * nt + 4 * fq; const f32x4 a = acc[tm][nt];
            const f32x4 wv = *(const f32x4*)(nw + v); const v2u gv = *(const v2u*)(PJ + r * NPJ + PJ_GO + 256 * h + v);
            *(v2u*)(OG + r * 1024 + 256 * h + v) = (v2u){pk2(a[0] * rs * wv.x * bflo(gv.x), a[1] * rs * wv.y * bfhi(gv.x)), pk2(a[2] * rs * wv.z * bflo(gv.y), a[3] * rs * wv.w * bfhi(gv.y))}; } }
    __syncthreads();
}
__device__ __forceinline__ void ssd_pass3_unit(const Ctx& C, int c, int g) {
    const bf16* PJ = (const bf16*)(C.ws + WS_PJ); const bf16* XC = (const bf16*)(C.ws + WS_XC); const float* DT = (const float*)(C.ws + WS_DT); const float* AC = (const float*)(C.ws + WS_AC);
    const bf16* LS = (const bf16*)(C.ws + WS_LS); bf16* YS = (bf16*)(C.ws + WS_YS);
    ldsp XD = C.lds, CM = XD + 64 * P520, BM = CM + 64 * P136, WT = BM + 64 * P136;
    LAS float* ACL = (LAS float*)(WT + 8 * 32 * P72);
    LAS float* RED = ACL + 8 * 64;
    const int r0 = 64 * c;
    {
        const int s = C.tid >> 3, hl = C.tid & 7, hd = 8 * g + hl; const size_t r = (size_t)(r0 + s);
        const float sc = DT[r * 32 + hd];
        ACL[hl * 64 + s] = AC[r * 32 + hd];
        const bf16* xp = XC + r * 3072 + 64 * hd;
#pragma unroll
        for (int j = 0; j < 8; ++j) { const v4u x = *(const v4u*)(xp + 8 * j); v4u o;
            o.x = pk2(bflo(x.x) * sc, bfhi(x.x) * sc); o.y = pk2(bflo(x.y) * sc, bfhi(x.y) * sc); o.z = pk2(bflo(x.z) * sc, bfhi(x.z) * sc); o.w = pk2(bflo(x.w) * sc, bfhi(x.w) * sc);
            *(LAS v4u*)(XD + s * P520 + (64 * hl + 8 * j) * 2) = o; }
        const bf16* bp = XC + r * 3072 + 2048 + 128 * g + 16 * hl; const bf16* cp = XC + r * 3072 + 2560 + 128 * g + 16 * hl;
        *(LAS v4u*)(BM + s * P136 + (16 * hl) * 2) = *(const v4u*)bp; *(LAS v4u*)(BM + s * P136 + (16 * hl + 8) * 2) = *(const v4u*)(bp + 8);
        *(LAS v4u*)(CM + s * P136 + (16 * hl) * 2) = *(const v4u*)cp; *(LAS v4u*)(CM + s * P136 + (16 * hl + 8) * 2) = *(const v4u*)(cp + 8);
    }
    __syncthreads();
    const int fr = C.lane & 15, fq = C.lane >> 4, w = C.wave, rh = w & 1, hq = w >> 1, t0 = 32 * rh;
    ldsp WW = WT + w * 32 * P72;
    f32x4 cb[2][4];
#pragma unroll
    for (int tm = 0; tm < 2; ++tm)
#pragma unroll
        for (int sn = 0; sn < 4; ++sn) cb[tm][sn] = (f32x4){0.f, 0.f, 0.f, 0.f};
#pragma unroll
    for (int ks = 0; ks < 4; ++ks) {
        bf16x8 af[2];
#pragma unroll
        for (int tm = 0; tm < 2; ++tm) af[tm] = lds_frag(CM + (t0 + 16 * tm + fr) * P136 + (32 * ks + 8 * fq) * 2);
#pragma unroll
        for (int sn = 0; sn < 4; ++sn) { const bf16x8 bfm = lds_frag(BM + (16 * sn + fr) * P136 + (32 * ks + 8 * fq) * 2);
#pragma unroll
            for (int tm = 0; tm < 2; ++tm) cb[tm][sn] = mma16(af[tm], bfm, cb[tm][sn]); }
    }
    f32x4 y[2][2][4];
#pragma unroll
    for (int rd = 0; rd < 2; ++rd) {
        const int hl = hq + 4 * rd, hd = 8 * g + hl;
        float at[2];
#pragma unroll
        for (int tm = 0; tm < 2; ++tm) at[tm] = ACL[hl * 64 + t0 + 16 * tm + fr];
#pragma unroll
        for (int sn = 0; sn < 4; ++sn) { const f32x4 as = *(const LAS f32x4*)(ACL + hl * 64 + 16 * sn + 4 * fq);
#pragma unroll
            for (int tm = 0; tm < 2; ++tm) { const f32x4 cv = cb[tm][sn];
                const float w0 = cv[0] * __expf(-fabsf(at[tm] - as.x)), w1 = cv[1] * __expf(-fabsf(at[tm] - as.y)), w2 = cv[2] * __expf(-fabsf(at[tm] - as.z)), w3 = cv[3] * __expf(-fabsf(at[tm] - as.w));
                *(LAS v2u*)(WW + (16 * tm + fr) * P72 + (16 * sn + 4 * fq) * 2) = (v2u){pk2(w0, w1), pk2(w2, w3)}; } }
#pragma unroll
        for (int tm = 0; tm < 2; ++tm)
#pragma unroll
            for (int pn = 0; pn < 4; ++pn) y[rd][tm][pn] = (f32x4){0.f, 0.f, 0.f, 0.f};
        const bf16* Sb = LS + ((size_t)(c * 32 + hd) * 64) * 128;
#pragma unroll
        for (int ks = 0; ks < 4; ++ks) {
            bf16x8 af[2];
#pragma unroll
            for (int tm = 0; tm < 2; ++tm) af[tm] = lds_frag(CM + (t0 + 16 * tm + fr) * P136 + (32 * ks + 8 * fq) * 2);
#pragma unroll
            for (int pn = 0; pn < 4; ++pn) { const bf16x8 bfm = *(const bf16x8*)(Sb + (size_t)(16 * pn + fr) * 128 + 32 * ks + 8 * fq);
#pragma unroll
                for (int tm = 0; tm < 2; ++tm) y[rd][tm][pn] = mma16(af[tm], bfm, y[rd][tm][pn]); }
        }
#pragma unroll
        for (int tm = 0; tm < 2; ++tm) { const float ea = __expf(at[tm]);
#pragma unroll
            for (int pn = 0; pn < 4; ++pn) y[rd][tm][pn] = y[rd][tm][pn] * ea; }
        LDS_WAIT(); asm volatile("" ::: "memory");
#pragma unroll
        for (int ks = 0; ks < 2; ++ks) {
            bf16x8 af[2];
#pragma unroll
            for (int tm = 0; tm < 2; ++tm) af[tm] = lds_frag(WW + (16 * tm + fr) * P72 + (32 * ks + 8 * fq) * 2);
#pragma unroll
            for (int pn = 0; pn < 4; ++pn) { const bf16x8 bfm = tr_frag(XD, P520, 32 * ks, 64 * hl + 16 * pn, fr, fq);
#pragma unroll
                for (int tm = 0; tm < 2; ++tm) y[rd][tm][pn] = mma16(af[tm], bfm, y[rd][tm][pn]); }
        }
        LDS_WAIT(); asm volatile("" ::: "memory");
    }
    const float* dsk = C.in[I_DSKIP]; const float* nw = C.in[I_SNW];
    float ss[2] = {0.f, 0.f};
#pragma unroll
    for (int rd = 0; rd < 2; ++rd) { const int hd = 8 * g + hq + 4 * rd; const float dk = dsk[hd];
#pragma unroll
        for (int tm = 0; tm < 2; ++tm) { const size_t r = (size_t)(r0 + t0 + 16 * tm + fr);
#pragma unroll
            for (int pn = 0; pn < 4; ++pn) { const int col = 64 * hd + 16 * pn + 4 * fq;
                const v2u xv = *(const v2u*)(XC + r * 3072 + col), zv = *(const v2u*)(PJ + r * NPJ + PJ_Z + col);
                f32x4 a = y[rd][tm][pn];
                a[0] = (a[0] + dk * bflo(xv.x)) * bflo(zv.x); a[1] = (a[1] + dk * bfhi(xv.x)) * bfhi(zv.x); a[2] = (a[2] + dk * bflo(xv.y)) * bflo(zv.y); a[3] = (a[3] + dk * bfhi(xv.y)) * bfhi(zv.y);
                y[rd][tm][pn] = a; ss[tm] += (a[0] * a[0] + a[1] * a[1]) + (a[2] * a[2] + a[3] * a[3]); } } }
#pragma unroll
    for (int tm = 0; tm < 2; ++tm) { float s = ss[tm]; s += __shfl_xor(s, 16); s += __shfl_xor(s, 32); if (fq == 0) RED[w * 32 + 16 * tm + fr] = s; }
    __syncthreads();
#pragma unroll
    for (int tm = 0; tm < 2; ++tm) { const int tl = 16 * tm + fr; float tot = 0.f;
#pragma unroll
        for (int q = 0; q < 4; ++q) tot += RED[(2 * q + rh) * 32 + tl];
        const float rs = rsqrtf(tot * (1.f / 512.f) + RMS_EPS); const size_t r = (size_t)(r0 + t0 + tl);
#pragma unroll
        for (int rd = 0; rd < 2; ++rd) { const int hd = 8 * g + hq + 4 * rd;
#pragma unroll
            for (int pn = 0; pn < 4; ++pn) { const int col = 64 * hd + 16 * pn + 4 * fq; const f32x4 a = y[rd][tm][pn]; const f32x4 wv = *(const f32x4*)(nw + col);
                *(v2u*)(YS + r * 2048 + col) = (v2u){pk2(a[0] * rs * wv.x, a[1] * rs * wv.y), pk2(a[2] * rs * wv.z, a[3] * rs * wv.w)}; } } }
    __syncthreads();
}

__device__ __forceinline__ void phaseJ(const Ctx& C) {
    const int gw = C.bid * NWAVES + C.wave, NGW = C.G * NWAVES;
    bf16* HN2 = (bf16*)(C.ws + WS_HN2);
    for (int r = gw; r < NTOK; r += NGW) norm_row_bf16(C.out + (size_t)r * D, C.in[I_LNFFN], HN2 + (size_t)r * D, C.lane);
    const size_t n8 = (size_t)16384 * 1024 / 8, gt = (size_t)C.bid * NT + C.tid, GT = (size_t)C.G * NT;
    for (int tb = 0; tb < 2; ++tb) {
        const float* src = C.in[tb ? I_PV : I_PU]; bf16* dst = (bf16*)(C.ws + (tb ? WS_VB : WS_UB));
        for (size_t i = gt; i < n8; i += GT) { const f32x4 a = *(const f32x4*)(src + 8 * i), b = *(const f32x4*)(src + 8 * i + 4);
            *(v4u*)(dst + 8 * i) = (v4u){pk2(a.x, a.y), pk2(a.z, a.w), pk2(b.x, b.y), pk2(b.z, b.w)}; }
    }
}

__device__ __forceinline__ float gelu_tanh(float x) {
    const float y = 0.7978845608028654f * (x + 0.044715f * x * x * x);
    const float e = __expf(2.f * y);
    const float th = 1.f - 2.f * fast_rcp(e + 1.f);
    return 0.5f * x * (1.f + th);
}
__device__ __forceinline__ void top16_of_128(float s0, float s1, int lane, float& tv, int& ti) {
    tv = 0.f; ti = 0;
#pragma unroll 1
    for (int it = 0; it < 16; ++it) {
        const float m = wave_max(fmaxf(s0, s1));
        const unsigned long long b0 = __ballot(s0 == m);
        int idx;
        if (b0) { const int src = __builtin_ctzll(b0); idx = src; if (lane == src) s0 = -INFINITY; }
        else { const unsigned long long b1 = __ballot(s1 == m); const int src = b1 ? __builtin_ctzll(b1) : 0; idx = 64 + src; if (lane == src) s1 = -INFINITY; }
        if (lane == it) { tv = m; ti = idx; }
    }
}
__device__ __forceinline__ void peer_token(const Ctx& C, int t) {
    const int lane = C.lane;
    const float* SC = (const float*)(C.ws + WS_SC) + (size_t)t * 2048;
    const bf16* HN2 = (const bf16*)(C.ws + WS_HN2) + (size_t)t * D;
    const bf16* UB = (const bf16*)(C.ws + WS_UB); const bf16* VB = (const bf16*)(C.ws + WS_VB);
    int ci, cj; const bool cvalid = lane < 50;
    if (lane < 16) { ci = 0; cj = lane; } else if (lane < 24) { ci = 1; cj = lane - 16; } else if (lane < 29) { ci = 2; cj = lane - 24; } else if (lane < 33) { ci = 3; cj = lane - 29; }
    else if (lane < 36) { ci = 4; cj = lane - 33; } else if (lane < 38) { ci = 5; cj = lane - 36; } else if (lane < 40) { ci = 6; cj = lane - 38; } else if (lane < 42) { ci = 7; cj = lane - 40; }
    else if (lane < 50) { ci = lane - 34; cj = 0; } else { ci = 0; cj = 0; }
    int eA = 0, eB = 0; float wA = 0.f, wB = 0.f;
#pragma unroll 1
    for (int h = 0; h < 8; ++h) {
        float av, bv; int ai, bi;
        top16_of_128(SC[h * 256 + lane], SC[h * 256 + 64 + lane], lane, av, ai);
        top16_of_128(SC[h * 256 + 128 + lane], SC[h * 256 + 192 + lane], lane, bv, bi);
        float cv = __shfl(av, ci) + __shfl(bv, cj);
        const int ce = __shfl(ai, ci) * 128 + __shfl(bi, cj);
        if (!cvalid) cv = -INFINITY;
        float best = 0.f; int be = 0;
#pragma unroll 1
        for (int it = 0; it < 16; ++it) {
            const float m = wave_max(cv);
            const unsigned long long bb = __ballot(cv == m);
            const int src = bb ? __builtin_ctzll(bb) : 0;
            const int e = __shfl(ce, src);
            if (lane == src) cv = -INFINITY;
            if (lane == it) { best = m; be = e; }
        }
        const float mx = __shfl(best, 0);
        float ex = lane < 16 ? __expf(best - mx) : 0.f;
        float sm = ex; sm += __shfl_xor(sm, 1); sm += __shfl_xor(sm, 2); sm += __shfl_xor(sm, 4); sm += __shfl_xor(sm, 8);
        const float wgt = ex / sm;
        const float wmv = __shfl(wgt, lane & 15); const int emv = __shfl(be, lane & 15);
        if ((lane >> 4) == (h & 3)) { if (h < 4) { eA = emv; wA = wmv; } else { eB = emv; wB = wmv; } }
    }
    float hx[16];
    { const v4u a = *(const v4u*)(HN2 + 8 * lane), b = *(const v4u*)(HN2 + 512 + 8 * lane);
      hx[0] = bflo(a.x); hx[1] = bfhi(a.x); hx[2] = bflo(a.y); hx[3] = bfhi(a.y); hx[4] = bflo(a.z); hx[5] = bfhi(a.z); hx[6] = bflo(a.w); hx[7] = bfhi(a.w);
      hx[8] = bflo(b.x); hx[9] = bfhi(b.x); hx[10] = bflo(b.y); hx[11] = bfhi(b.y); hx[12] = bflo(b.z); hx[13] = bfhi(b.z); hx[14] = bflo(b.w); hx[15] = bfhi(b.w); }
    float acc[16];
#pragma unroll
    for (int i = 0; i < 16; ++i) acc[i] = 0.f;
#pragma unroll 1
    for (int p0 = 0; p0 < 128; p0 += 4) {
        int e[4]; float wg[4]; v4u ua[4], ub[4], va[4], vb[4];
#pragma unroll
        for (int q = 0; q < 4; ++q) { const int p = p0 + q;
            e[q] = __builtin_amdgcn_readlane(p0 < 64 ? eA : eB, p & 63);
            wg[q] = __builtin_bit_cast(float, __builtin_amdgcn_readlane(__builtin_bit_cast(int, p0 < 64 ? wA : wB), p & 63));
            const bf16* up = UB + (size_t)e[q] * D; const bf16* vp = VB + (size_t)e[q] * D;
            ua[q] = *(const v4u*)(up + 8 * lane); ub[q] = *(const v4u*)(up + 512 + 8 * lane);
            va[q] = *(const v4u*)(vp + 8 * lane); vb[q] = *(const v4u*)(vp + 512 + 8 * lane); }
#pragma unroll
        for (int q = 0; q < 4; ++q) {
            float d = bflo(ua[q].x) * hx[0] + bfhi(ua[q].x) * hx[1] + bflo(ua[q].y) * hx[2] + bfhi(ua[q].y) * hx[3] + bflo(ua[q].z) * hx[4] + bfhi(ua[q].z) * hx[5] + bflo(ua[q].w) * hx[6] + bfhi(ua[q].w) * hx[7]
                    + bflo(ub[q].x) * hx[8] + bfhi(ub[q].x) * hx[9] + bflo(ub[q].y) * hx[10] + bfhi(ub[q].y) * hx[11] + bflo(ub[q].z) * hx[12] + bfhi(ub[q].z) * hx[13] + bflo(ub[q].w) * hx[14] + bfhi(ub[q].w) * hx[15];
            d = wave_sum(d);
            const float cf = wg[q] * gelu_tanh(d);
            acc[0] += cf * bflo(va[q].x); acc[1] += cf * bfhi(va[q].x); acc[2] += cf * bflo(va[q].y); acc[3] += cf * bfhi(va[q].y); acc[4] += cf * bflo(va[q].z); acc[5] += cf * bfhi(va[q].z); acc[6] += cf * bflo(va[q].w); acc[7] += cf * bfhi(va[q].w);
            acc[8] += cf * bflo(vb[q].x); acc[9] += cf * bfhi(vb[q].x); acc[10] += cf * bflo(vb[q].y); acc[11] += cf * bfhi(vb[q].y); acc[12] += cf * bflo(vb[q].z); acc[13] += cf * bfhi(vb[q].z); acc[14] += cf * bflo(vb[q].w); acc[15] += cf * bfhi(vb[q].w);
        }
    }
    float* orow = C.out + (size_t)t * D; const float* lw = C.in[I_LNF];
    f32x4 hv[4]; hv[0] = *(const f32x4*)(orow + 8 * lane); hv[1] = *(const f32x4*)(orow + 8 * lane + 4); hv[2] = *(const f32x4*)(orow + 512 + 8 * lane); hv[3] = *(const f32x4*)(orow + 512 + 8 * lane + 4);
    float s = 0.f;
#pragma unroll
    for (int i = 0; i < 4; ++i) { hv[i].x += acc[4 * i]; hv[i].y += acc[4 * i + 1]; hv[i].z += acc[4 * i + 2]; hv[i].w += acc[4 * i + 3]; s += (hv[i].x * hv[i].x + hv[i].y * hv[i].y) + (hv[i].z * hv[i].z + hv[i].w * hv[i].w); }
    const float rs = rsqrtf(wave_sum(s) * (1.f / D) + RMS_EPS);
    const f32x4 w0 = *(const f32x4*)(lw + 8 * lane), w1 = *(const f32x4*)(lw + 8 * lane + 4), w2 = *(const f32x4*)(lw + 512 + 8 * lane), w3 = *(const f32x4*)(lw + 512 + 8 * lane + 4);
    *(f32x4*)(orow + 8 * lane) = hv[0] * rs * w0; *(f32x4*)(orow + 8 * lane + 4) = hv[1] * rs * w1; *(f32x4*)(orow + 512 + 8 * lane) = hv[2] * rs * w2; *(f32x4*)(orow + 512 + 8 * lane + 4) = hv[3] * rs * w3;
}

constexpr int NSTEPS = 36;
#ifndef PH_MASK
#define PH_MASK 0xFF
#endif
#define PH_ON(k) (((PH_MASK) >> (k)) & 1)
struct Args { const float* in[22]; float* out; unsigned char* ws; int ph_lo, ph_hi; };
typedef const __attribute__((address_space(4))) Args* kargp;
__device__ __forceinline__ void ctx_init(Ctx& C, unsigned char* smem) {
    kargp ap = (kargp)__builtin_amdgcn_kernarg_segment_ptr();
    asm volatile("" : "+s"(ap));
    int tid_ = threadIdx.x; asm volatile("" : "+v"(tid_));
    C.lds = (ldsp)smem; C.tid = tid_; C.lane = C.tid & 63; C.wave = __builtin_amdgcn_readfirstlane(C.tid >> 6); C.G = gridDim.x; C.bid = blockIdx.x;
#pragma unroll
    for (int i = 0; i < 22; ++i) C.in[i] = ap->in[i];
    C.out = ap->out; C.ws = ap->ws;
}
__global__ void __launch_bounds__(NT, 2) hyb_fwd(Args args) {
    extern __shared__ __attribute__((aligned(16))) unsigned char smem[];
    volatile LAS unsigned* MISC = (volatile LAS unsigned*)((ldsp)smem + LDSCTL_OFF);
    for (int u = threadIdx.x; u < (LDS_BYTES - LDSCTL_OFF) / 4; u += NT) MISC[u] = 0u;
    __syncthreads();
    const int lo = args.ph_lo, hi = args.ph_hi;
    unsigned* barw = (unsigned*)(args.ws + WS_CTL) + CW_BAR;
    XcdBarrier bar; bar.bar = barw; bar.x = 0; bar.st = MISC + 8;
    if (hi - lo > 1) bar = xcd_barrier_post(barw, MISC + 8);
#pragma unroll 1
    for (int step = lo; step < hi; ++step) {
        int kind, b = 0, gk = 0;
        if (step == 0) kind = 0;
        else if (step <= 32) { b = (step - 1) >> 3; const int k = (step - 1) & 7; gk = k; kind = (k == 0 || k >= 5) ? 1 : k + 1; }
        else if (step == 33) kind = 6;
        else if (step == 34) { kind = 1; gk = 8; }
        else kind = 7;
        Ctx C; ctx_init(C, smem);
        if (kind == 0 && PH_ON(0)) p0_prologue(C);
        else if (kind == 1 && PH_ON(1)) {
            pg8::Gemm g; EpiAny E; E.P.PJ = (bf16*)(C.ws + WS_PJ); E.P.TL = (float*)(C.ws + WS_TL); E.PJ = (const bf16*)(C.ws + WS_PJ); E.T = nullptr; E.O = nullptr; E.gcol = 0; E.X = C.in[I_X]; E.OF = C.out; E.b = b; E.ldc = 2048;
            if (gk == 0)      { g = pg8::Gemm{(const bf16*)(C.ws + WS_HN), (const bf16*)(C.ws + WS_W1T), RPB, N1, 1024}; E.mode = 0; }
            else if (gk == 5) { g = pg8::Gemm{(const bf16*)(C.ws + WS_OG), (const bf16*)(C.ws + WS_WAT), RPB, 1024, 1024}; E.mode = 1; E.O = (bf16*)(C.ws + WS_T1); E.gcol = PJ_GA; }
            else if (gk == 6) { g = pg8::Gemm{(const bf16*)(C.ws + WS_YS), (const bf16*)(C.ws + WS_WBT), RPB, 1024, 2048}; E.mode = 1; E.O = (bf16*)(C.ws + WS_MX); E.gcol = PJ_GB; E.T = (const bf16*)(C.ws + WS_T1); }
            else if (gk == 7) { g = pg8::Gemm{(const bf16*)(C.ws + WS_MX), (const bf16*)(C.ws + WS_WOT), RPB, 1024, 1024}; E.mode = 2; }
            else              { g = pg8::Gemm{(const bf16*)(C.ws + WS_HN2), (const bf16*)(C.ws + WS_WET), NTOK, 2048, 1024}; E.mode = 3; E.OF = (float*)(C.ws + WS_SC); }
            pg8::StaticOrder S; S.init(g.M, g.N, C.G, C.bid);
            pg8::gemm_phase<EpiAny, pg8::StaticOrder, true, true>(C.lds, g, S, E);
            if (gk == 7 && b + 1 < BATCH) hn_batch(C, b + 1);
        }
        else if (kind == 2 && PH_ON(2)) { for (int c = C.bid; c < NCHUNK; c += C.G) phaseC_unit(C, c); }
        else if (kind == 3 && PH_ON(3)) { for (int u = C.bid; u < NCHUNK * 8; u += C.G) { const int c = u >> 3, k = u & 7; if (k < 4) gla_pass1_unit(C, c, k); else ssd_pass1_unit(C, c, k - 4); } }
        else if (kind == 4 && PH_ON(4)) phaseE(C);
        else if (kind == 5 && PH_ON(5)) { for (int u = C.bid; u < NCHUNK * 8; u += C.G) { const int c = u >> 3, k = u & 7; if (k < 4) gla_pass3_unit(C, c, k); else ssd_pass3_unit(C, c, k - 4); } }
        else if (kind == 6 && PH_ON(6)) phaseJ(C);
        else if (kind == 7 && PH_ON(7)) { const int gw = C.bid * NWAVES + C.wave, NGW = C.G * NWAVES; for (int t = gw; t < NTOK; t += NGW) peer_token(C, t); }
        if (step + 1 < hi) xcd_barrier(bar);
    }
}

#ifdef DBG_STOP
__global__ void dbg_digest(const unsigned* w, size_t nwords, float* out, size_t nout) {
    for (size_t i = (size_t)blockIdx.x * blockDim.x + threadIdx.x; i < nout; i += (size_t)gridDim.x * blockDim.x) {
        unsigned h = 0; for (size_t j = i; j < nwords; j += nout) h ^= w[j] * 2654435761u + (unsigned)(j / nout);
        out[i] = (float)(h & 0xFFFFFFu);
    }
}
#endif
#ifndef HYB_N_LAUNCHES
#define HYB_N_LAUNCHES 1
#endif
extern "C" void kernel_launch(void* const* d_in, const int* in_sizes, int n_in, void* d_out, int out_size, void* d_ws, size_t ws_size, hipStream_t stream) {
    static int grid = 0;
    if (grid == 0) {
        if (n_in != 22 || out_size != NTOK * D || ws_size < WS_END) { fprintf(stderr, "kernel_launch: unexpected shapes: n_in %d out %d ws %zu (need %zu)\n", n_in, out_size, ws_size, (size_t)WS_END); grid = -1; return; }
        int dev = 0, cus = 0, per_cu = 0;
        if (hipGetDevice(&dev) != hipSuccess || hipDeviceGetAttribute(&cus, hipDeviceAttributeMultiprocessorCount, dev) != hipSuccess) { grid = -1; return; }
        if (hipFuncSetAttribute((const void*)hyb_fwd, hipFuncAttributeMaxDynamicSharedMemorySize, LDS_BYTES) != hipSuccess) { fprintf(stderr, "kernel_launch: hipFuncSetAttribute failed\n"); grid = -1; return; }
        if (hipOccupancyMaxActiveBlocksPerMultiprocessor(&per_cu, (const void*)hyb_fwd, NT, LDS_BYTES) != hipSuccess || per_cu < 1) { fprintf(stderr, "kernel_launch: occupancy query says %d blocks per CU\n", per_cu); per_cu = 1; }
        (void)hipGetLastError();
        grid = cus;
    }
    if (grid < 0) return;
    (void)hipMemsetAsync((char*)d_ws + WS_CTL, 0, CTL_ZERO_BYTES, stream);
    Args a{};
    for (int i = 0; i < 22; ++i) a.in[i] = (const float*)d_in[i];
    a.out = (float*)d_out; a.ws = (unsigned char*)d_ws;
    if (HYB_N_LAUNCHES == 1) { a.ph_lo = 0; a.ph_hi = NSTEPS; hipLaunchKernelGGL(hyb_fwd, dim3(grid), dim3(NT), LDS_BYTES, stream, a); }
    else {
#ifdef DBG_STOP
        for (int s = 0; s <= DBG_STOP; ++s) { a.ph_lo = s; a.ph_hi = s + 1; hipLaunchKernelGGL(hyb_fwd, dim3(grid), dim3(NT), LDS_BYTES, stream, a); }
        hipLaunchKernelGGL(dbg_digest, dim3(2048), dim3(256), 0, stream, (const unsigned*)((char*)d_ws + (size_t)(DBG_OFF)), (size_t)(DBG_LEN) / 4, (float*)d_out, (size_t)NTOK * D);
#else
        for (int s = 0; s < NSTEPS; ++s) { a.ph_lo = s; a.ph_hi = s + 1; hipLaunchKernelGGL(hyb_fwd, dim3(grid), dim3(NT), LDS_BYTES, stream, a); }
#endif
    }
}
```

```cpp
#include <hip/hip_runtime.h>
#include <cstdio>
#include <cstdint>
namespace pg8 {
#define PG8_LAS __attribute__((address_space(3)))
typedef unsigned short bf16_t;
typedef short bf16x8 __attribute__((ext_vector_type(8)));
typedef float f32x4 __attribute__((ext_vector_type(4)));
typedef unsigned u32x4 __attribute__((ext_vector_type(4)));
constexpr int BM = 256, BK = 64, HALF = 128, HTB = HALF * BK * 2  , STAGE_BYTES = 8 * HTB, NXCD = 8, WGM = 8;

__host__ __device__ __forceinline__ int lds_byte(int r, int c) { const int st = (r >> 4) * 2 + (c >> 5), rr = r & 15, cc = c & 31, ob = rr * 64 + cc * 2; return st * 1024 + (ob ^ (((ob >> 9) & 1) << 5)); }
__host__ __device__ __forceinline__ void stage_rc(int b, int& R, int& C) { const int st = b / 1024, sb = b % 1024, swz = sb ^ (((sb >> 9) & 1) << 5); R = (st >> 1) * 16 + swz / 64; C = (st & 1) * 32 + (swz % 64) / 2; }
__host__ __device__ __forceinline__ int perm32(int rho) { const int n = rho >> 4, i = rho & 15; return 8 * (i >> 2) + 4 * n + (i & 3); }

struct Unit { int pm, pn; };
struct Gemm { const bf16_t* A; const bf16_t* Bt; int M, N, K; };

struct StaticOrder {
    int nM, nN, nwg, G, c;
    __host__ __device__ void init(int M, int N, int G_, int c_) { nM = M / BM; nN = N / BM; nwg = nM * nN; G = G_; c = c_; }
    __host__ __device__ bool next(int i, Unit& u) const {
        const long L = (long)i * G + c; if (L >= nwg) return false;
        int wgid = (int)L; { const int q = nwg / NXCD, r = nwg % NXCD, xcd = wgid % NXCD, off = wgid / NXCD; wgid = (xcd < r ? xcd * (q + 1) : r * (q + 1) + (xcd - r) * q) + off; }
        const int nig = WGM * nN, gid = wgid / nig, fm = gid * WGM, gsz = (nM - fm) < WGM ? (nM - fm) : WGM;
        u.pm = fm + ((wgid % nig) % gsz); u.pn = (wgid % nig) / gsz; return true;
    }
    __device__ __forceinline__ void a_ready(const Unit&) const {}
    __device__ __forceinline__ void done(const Unit&) const {}
};

typedef float f32x2_t __attribute__((ext_vector_type(2))); typedef __bf16 bf16x2_t __attribute__((ext_vector_type(2)));
__device__ __forceinline__ unsigned cvt_pk_bf16(float lo, float hi) { f32x2_t v = {lo, hi}; bf16x2_t b = __builtin_convertvector(v, bf16x2_t); return __builtin_bit_cast(unsigned, b); }
template <class Epi, class Sched, bool ALIGN_EPI = false, bool SP2 = false>
__device__ __forceinline__ void gemm_phase(PG8_LAS unsigned char* lds, const Gemm g, const Sched& S, const Epi& E) {
    int tid_ = threadIdx.x; asm volatile("" : "+v"(tid_));
    const int tid = tid_, wid = __builtin_amdgcn_readfirstlane(tid >> 6), lane = tid & 63, wr = wid >> 2, wc = wid & 3, fr = lane & 15, fq = lane >> 4;
    const int K = g.K, nt = K / BK;
    unsigned voffA[2], voffB[2];
#pragma unroll
    for (int i = 0; i < 2; ++i) { int R, C; stage_rc(tid * 16 + i * 8192, R, C); const int Rb = Epi::PERM ? ((R & ~31) + perm32(R & 31)) : R;
        voffA[i] = (unsigned)(R * K + C) * 2u; voffB[i] = (unsigned)(Rb * K + C) * 2u; }
    const size_t kstep = (size_t)(BK * 2);
    const size_t hstep = (size_t)HALF * K * 2;
    const size_t tstep = 2 * hstep;
    const unsigned ldsw = (unsigned)wid * 1024u;
    const int aoff = lds_byte(wr * 64 + fr, fq * 8), boff = lds_byte(wc * 32 + fr, fq * 8);
#define PG8_SA(b, h) (((b) * 2 + (h)) * HTB)
#define PG8_SB(b, h) ((4 + (b) * 2 + (h)) * HTB)
#define PG8_STAGE(bufoff, gbase, voff) do { _Pragma("unroll") for (int _i = 0; _i < 2; ++_i) \
        __builtin_amdgcn_global_load_lds((const unsigned*)((const char*)(gbase) + (voff)[_i]), (PG8_LAS unsigned*)(lds + (bufoff) + ldsw + _i * 8192), 16, 0, 0); } while (0)
#define PG8_LDA(dst, b, h) do { _Pragma("unroll") for (int m = 0; m < 4; ++m) _Pragma("unroll") for (int k = 0; k < 2; ++k) dst[m][k] = *(const PG8_LAS bf16x8*)(lds + PG8_SA(b, h) + aoff + m * 2048 + k * 1024); } while (0)
#define PG8_LDB(dst, b, h) do { _Pragma("unroll") for (int n = 0; n < 2; ++n) _Pragma("unroll") for (int k = 0; k < 2; ++k) dst[n][k] = *(const PG8_LAS bf16x8*)(lds + PG8_SB(b, h) + boff + n * 2048 + k * 1024); } while (0)
#define PG8_MMA(ai, bj, At, Bt) do { __builtin_amdgcn_s_setprio(1); _Pragma("unroll") for (int m = 0; m < 4; ++m) _Pragma("unroll") for (int n = 0; n < 2; ++n) _Pragma("unroll") for (int k = 0; k < 2; ++k) \
        acc[ai][bj][m][n] = __builtin_amdgcn_mfma_f32_16x16x32_bf16(Bt[n][k], At[m][k], acc[ai][bj][m][n], 0, 0, 0); __builtin_amdgcn_s_setprio(0); } while (0)
#define PG8_WAIT_V(n) asm volatile("s_waitcnt vmcnt(" #n ")" ::: "memory")
#define PG8_WAIT_L(n) asm volatile("s_waitcnt lgkmcnt(" #n ")" ::: "memory")
#define PG8_BAR __builtin_amdgcn_s_barrier()
#define PG8_SCHED __builtin_amdgcn_sched_barrier(0)
    Unit cur, nxt; int ui = 0;
    if (!S.next(0, cur)) return;
    f32x4 acc[2][2][4][2];
#pragma unroll
    for (int a = 0; a < 2; ++a)
#pragma unroll
        for (int b = 0; b < 2; ++b)
#pragma unroll
            for (int m = 0; m < 4; ++m)
#pragma unroll
                for (int n = 0; n < 2; ++n) acc[a][b][m][n] = (f32x4){0.f, 0.f, 0.f, 0.f};
    bf16x8 At[4][2], B0[2][2], B1[2][2];
    const char* cA = (const char*)g.A + (size_t)cur.pm * tstep; const char* cB = (const char*)g.Bt + (size_t)cur.pn * tstep;
    S.a_ready(cur);
    if constexpr (SP2) {
        PG8_STAGE(PG8_SB(0, 0), cB, voffB); PG8_STAGE(PG8_SB(0, 1), cB + hstep, voffB); PG8_STAGE(PG8_SA(0, 0), cA, voffA); PG8_STAGE(PG8_SA(0, 1), cA + hstep, voffA);
        if (wr == 1) PG8_BAR;
        PG8_WAIT_V(2); PG8_BAR;
        PG8_STAGE(PG8_SB(1, 0), cB + kstep, voffB); PG8_STAGE(PG8_SA(1, 0), cA + kstep, voffA); PG8_STAGE(PG8_SB(1, 1), cB + hstep + kstep, voffB);
        PG8_WAIT_V(6); PG8_BAR;
    } else {
        PG8_STAGE(PG8_SB(0, 0), cB, voffB); PG8_STAGE(PG8_SA(0, 0), cA, voffA); PG8_STAGE(PG8_SB(0, 1), cB + hstep, voffB); PG8_STAGE(PG8_SA(0, 1), cA + hstep, voffA);
        if (wr == 1) PG8_BAR;
        PG8_WAIT_V(4); PG8_BAR;
        PG8_STAGE(PG8_SB(1, 0), cB + kstep, voffB); PG8_STAGE(PG8_SA(1, 0), cA + kstep, voffA); PG8_STAGE(PG8_SB(1, 1), cB + hstep + kstep, voffB);
        PG8_WAIT_V(6); PG8_BAR;
    }
    for (;;) {
        const bool has_next = S.next(ui + 1, nxt);
        const char* nA = has_next ? (const char*)g.A + (size_t)nxt.pm * tstep : cA; const char* nB = has_next ? (const char*)g.Bt + (size_t)nxt.pn * tstep : cB;
        for (int t = 0; t < nt; t += 2) {
            const bool last = (t == nt - 2);
            const char* a1 = cA + (size_t)(t + 1) * kstep;
            const char* a2 = last ? nA : cA + (size_t)(t + 2) * kstep; const char* b2 = last ? nB : cB + (size_t)(t + 2) * kstep;
            const char* a3 = a2 + kstep; const char* b3 = b2 + kstep;
            if (last && has_next) S.a_ready(nxt);
            if constexpr (SP2) {
            PG8_LDB(B0, 0, 0); PG8_LDB(B1, 0, 1); PG8_SCHED; PG8_LDA(At, 0, 0); PG8_STAGE(PG8_SA(1, 1), a1 + hstep, voffA);
            PG8_WAIT_V(8); PG8_WAIT_L(0); PG8_BAR; PG8_MMA(0, 0, At, B0); PG8_MMA(0, 1, At, B1); PG8_BAR; PG8_SCHED;
            PG8_LDA(At, 0, 1); PG8_STAGE(PG8_SB(0, 0), b2, voffB); PG8_STAGE(PG8_SB(0, 1), b2 + hstep, voffB); PG8_STAGE(PG8_SA(0, 0), a2, voffA);
            PG8_WAIT_V(8); PG8_WAIT_L(0); PG8_BAR; PG8_MMA(1, 0, At, B0); PG8_MMA(1, 1, At, B1); PG8_BAR; PG8_SCHED;
            PG8_LDB(B0, 1, 0); PG8_LDB(B1, 1, 1); PG8_SCHED; PG8_LDA(At, 1, 0); PG8_STAGE(PG8_SA(0, 1), a2 + hstep, voffA);
            PG8_WAIT_V(8); PG8_WAIT_L(0); PG8_BAR; PG8_MMA(0, 0, At, B0); PG8_MMA(0, 1, At, B1); PG8_BAR; PG8_SCHED;
            PG8_LDA(At, 1, 1); PG8_STAGE(PG8_SB(1, 0), b3, voffB); PG8_STAGE(PG8_SB(1, 1), b3 + hstep, voffB); PG8_STAGE(PG8_SA(1, 0), a3, voffA);
            PG8_WAIT_V(8); PG8_WAIT_L(0); PG8_BAR; PG8_MMA(1, 0, At, B0); PG8_MMA(1, 1, At, B1); PG8_BAR; PG8_SCHED;
            } else {
            PG8_LDB(B0, 0, 0); PG8_SCHED; PG8_LDA(At, 0, 0); PG8_STAGE(PG8_SA(1, 1), a1 + hstep, voffA);
            PG8_WAIT_L(8); PG8_BAR; PG8_WAIT_L(0); PG8_MMA(0, 0, At, B0); PG8_BAR; PG8_SCHED;
            PG8_LDB(B1, 0, 1); PG8_STAGE(PG8_SB(0, 0), b2, voffB);
            PG8_BAR; PG8_WAIT_L(0); PG8_MMA(0, 1, At, B1); PG8_BAR;
            PG8_LDA(At, 0, 1); PG8_STAGE(PG8_SA(0, 0), a2, voffA);
            PG8_BAR; PG8_WAIT_L(0); PG8_MMA(1, 0, At, B0); PG8_BAR; PG8_SCHED;
            PG8_STAGE(PG8_SB(0, 1), b2 + hstep, voffB);
            PG8_WAIT_V(6); PG8_BAR; PG8_MMA(1, 1, At, B1); PG8_BAR;
            PG8_LDB(B0, 1, 0); PG8_SCHED; PG8_LDA(At, 1, 0); PG8_STAGE(PG8_SA(0, 1), a2 + hstep, voffA);
            PG8_WAIT_L(8); PG8_BAR; PG8_WAIT_L(0); PG8_MMA(0, 0, At, B0); PG8_BAR; PG8_SCHED;
            PG8_LDB(B1, 1, 1); PG8_STAGE(PG8_SB(1, 0), b3, voffB);
            PG8_BAR; PG8_WAIT_L(0); PG8_MMA(0, 1, At, B1); PG8_BAR;
            PG8_LDA(At, 1, 1); PG8_STAGE(PG8_SA(1, 0), a3, voffA);
            PG8_BAR; PG8_WAIT_L(0); PG8_MMA(1, 0, At, B0); PG8_BAR; PG8_SCHED;
            PG8_STAGE(PG8_SB(1, 1), b3 + hstep, voffB);
            PG8_WAIT_V(6); PG8_BAR; PG8_MMA(1, 1, At, B1); PG8_BAR;
            }
        }
        if constexpr (ALIGN_EPI) { if (wr == 0) PG8_BAR; }
        if constexpr (!Epi::AFTER_DRAIN) { E(acc, cur, wr, wc, fr, fq); S.done(cur); }
        if (!has_next) break;
#pragma unroll
        for (int a = 0; a < 2; ++a)
#pragma unroll
            for (int b = 0; b < 2; ++b)
#pragma unroll
                for (int m = 0; m < 4; ++m)
#pragma unroll
                    for (int n = 0; n < 2; ++n) acc[a][b][m][n] = (f32x4){0.f, 0.f, 0.f, 0.f};
        cur = nxt; cA = nA; cB = nB; ++ui;
        if constexpr (ALIGN_EPI) { if (wr == 1) PG8_BAR; }
    }
    PG8_WAIT_V(0);
    if constexpr (!ALIGN_EPI) { if (wr == 0) PG8_BAR; }
    PG8_BAR;
    if constexpr (Epi::AFTER_DRAIN) { E.fused(acc, cur, wr, wc, fr, fq, lds, wid, lane); S.done(cur); }
#undef PG8_SA
#undef PG8_SB
#undef PG8_STAGE
#undef PG8_LDA
#undef PG8_LDB
#undef PG8_MMA
#undef PG8_WAIT_V
#undef PG8_WAIT_L
#undef PG8_BAR
#undef PG8_SCHED
}
}

constexpr int NWAVES = 8, NT = 512;
constexpr int D = 1024, BATCH = 4, SEQ = 8192, NMETA = 16;
constexpr int RPB = 8448;
constexpr int RFRONT = 48, RTOK = 64, REND = 8256;
constexpr int NCHUNK = 129;
constexpr int NPJ = 10240;
constexpr int N1 = 10496;
constexpr int PJ_Q = 0, PJ_K = 512, PJ_V = 1024, PJ_GO = 2048, PJ_Z = 3072, PJ_XBC = 5120, PJ_GA = 8192, PJ_GB = 9216;
constexpr int NTOK = BATCH * SEQ;
constexpr float RMS_EPS = 1e-6f;

constexpr size_t MiB = 1u << 20;
constexpr size_t WS_CTL = 0, CTL_ZERO_BYTES = 1 * MiB;
constexpr size_t WS_W1T = 2 * MiB;
constexpr size_t WS_WAT = 23 * MiB;
constexpr size_t WS_WBT = 25 * MiB;
constexpr size_t WS_WOT = 29 * MiB;
constexpr size_t WS_WET = 31 * MiB;
constexpr size_t WS_HN = 36 * MiB;
constexpr size_t WS_PJ = 53 * MiB;
constexpr size_t WS_TL = 218 * MiB;
constexpr size_t WS_XC = 220 * MiB;
constexpr size_t WS_GG = 270 * MiB;
constexpr size_t WS_DT = 287 * MiB;
constexpr size_t WS_AC = 289 * MiB;
constexpr size_t WS_LG = 291 * MiB;
constexpr size_t WS_LS = 324 * MiB;
constexpr size_t WS_OG = 389 * MiB;
constexpr size_t WS_YS = 406 * MiB;
constexpr size_t WS_T1 = 439 * MiB;
constexpr size_t WS_MX = 456 * MiB;
constexpr size_t WS_MIX_END = 473 * MiB;
constexpr size_t WS_HN2 = 36 * MiB;
constexpr size_t WS_SC = 100 * MiB;
constexpr size_t WS_U8 = 356 * MiB;
constexpr size_t WS_V8 = 372 * MiB;
constexpr size_t WS_END = 473 * MiB;
constexpr int CW_BAR = 4096;

constexpr int LDS_WORK = 147456;
constexpr int LDSCTL_OFF = LDS_WORK;
constexpr int LDS_BYTES = LDS_WORK + 512;

#define GAS __attribute__((address_space(1)))
#define LAS __attribute__((address_space(3)))
typedef unsigned short bf16;
typedef unsigned v4u __attribute__((ext_vector_type(4)));
typedef unsigned v2u __attribute__((ext_vector_type(2)));
typedef float f32x4 __attribute__((ext_vector_type(4)));
typedef float f32x2 __attribute__((ext_vector_type(2)));
typedef short bf16x8 __attribute__((ext_vector_type(8)));
typedef short s16x4 __attribute__((ext_vector_type(4)));
typedef short v4i16_t __attribute__((ext_vector_type(4)));
typedef LAS unsigned char* ldsp;
#define RLX_AGENT __ATOMIC_RELAXED, __HIP_MEMORY_SCOPE_AGENT
#define LDS_WAIT() asm volatile("s_waitcnt lgkmcnt(0)" ::: "memory")

__device__ __forceinline__ unsigned pk2(float lo, float hi) { return pg8::cvt_pk_bf16(lo, hi); }
__device__ __forceinline__ float bflo(unsigned u) { return __builtin_bit_cast(float, u << 16); }
__device__ __forceinline__ float bfhi(unsigned u) { return __builtin_bit_cast(float, u & 0xffff0000u); }
__device__ __forceinline__ float fast_rcp(float x) { return __builtin_amdgcn_rcpf(x); }
__device__ __forceinline__ float sigmoidf_(float x) { return fast_rcp(1.f + __expf(-x)); }
__device__ __forceinline__ float siluf_(float x) { return x * sigmoidf_(x); }
__device__ __forceinline__ float wave_sum(float v) {
#pragma unroll
    for (int o = 1; o < 64; o <<= 1) v += __shfl_xor(v, o);
    return v;
}
__device__ __forceinline__ float wave_max(float v) {
#pragma unroll
    for (int o = 1; o < 64; o <<= 1) v = fmaxf(v, __shfl_xor(v, o));
    return v;
}
__device__ __forceinline__ f32x4 mma16(bf16x8 a, bf16x8 b, f32x4 c) { return __builtin_amdgcn_mfma_f32_16x16x32_bf16(b, a, c, 0, 0, 0); }
__device__ __forceinline__ bf16x8 lds_frag(ldsp p) { return *(const LAS bf16x8*)p; }
__device__ __forceinline__ s16x4 lds_tr(ldsp p) { return __builtin_bit_cast(s16x4, __builtin_amdgcn_ds_read_tr16_b64_v4i16((LAS v4i16_t*)p)); }
__device__ __forceinline__ bf16x8 tr_frag(ldsp tile, int pitch, int k0, int n0, int fr, int fq) {
#ifdef TR_SLOW
    bf16x8 r;
#pragma unroll
    for (int e = 0; e < 8; ++e) r[e] = *(const LAS short*)(tile + (k0 + 8 * fq + e) * pitch + (n0 + fr) * 2);
    return r;
#else
    ldsp p = tile + (k0 + 8 * fq + (fr >> 2)) * pitch + (n0 + 4 * (fr & 3)) * 2;
    const s16x4 lo = lds_tr(p), hi = lds_tr(p + 4 * pitch);
    bf16x8 r; r[0] = lo[0]; r[1] = lo[1]; r[2] = lo[2]; r[3] = lo[3]; r[4] = hi[0]; r[5] = hi[1]; r[6] = hi[2]; r[7] = hi[3];
    return r;
#endif
}

#define XB_TMO      128
#define XB_XCNT(j)  (256  + 64 * (j))
#define XB_XSUB(j)  (1280 + 64 * (j))
#define XB_XGEN(j)  (2304 + 64 * (j))
#define XB_TOP      3328
#define XB_TOPGEN   3392
#define XCD_BAR_WORDS 3456
#define XB_SPIN_CAP (1u << 22)
__device__ __forceinline__ unsigned xb_ld(unsigned* p)              { return __hip_atomic_load(p, __ATOMIC_RELAXED, __HIP_MEMORY_SCOPE_AGENT); }
__device__ __forceinline__ unsigned xb_add(unsigned* p, unsigned v) { return __hip_atomic_fetch_add(p, v, __ATOMIC_RELAXED, __HIP_MEMORY_SCOPE_AGENT); }
__device__ __forceinline__ unsigned xb_xcc_id() { return (unsigned)__builtin_amdgcn_s_getreg((3 << 11) | 20) & 0xFu; }
#define XB_SPIN(cond, bar) do { unsigned _sp = 0; while (cond) { __builtin_amdgcn_s_sleep(1); \
    if ((++_sp & 255u) == 0u) { if (xb_ld(&(bar)[XB_TMO])) break; if (_sp > XB_SPIN_CAP) { atomicAdd(&(bar)[XB_TMO], 1u); break; } } } } while (0)
struct XcdBarrier { unsigned* bar; unsigned x; volatile LAS unsigned* st; };
__device__ __forceinline__ XcdBarrier xcd_barrier_post(unsigned* bar, volatile LAS unsigned* st) {
    XcdBarrier b; b.bar = bar; b.x = xb_xcc_id(); b.st = st;
    if (threadIdx.x == 0) (void)xb_add(&bar[XB_XCNT(b.x)], 1u);
    return b;
}
__device__ __forceinline__ void xcd_barrier_complete(unsigned* bar, unsigned x, unsigned& nloc, unsigned& nx) {
    const unsigned G = gridDim.x * gridDim.y * gridDim.z;
    unsigned sum, cnt, mine, sp = 0u;
    for (;;) {
        sum = 0u; cnt = 0u; mine = 0u;
#pragma unroll
        for (unsigned j = 0; j < 16; ++j) { const unsigned c = xb_ld(&bar[XB_XCNT(j)]); sum += c; cnt += (c > 0u) ? 1u : 0u; mine = (j == x) ? c : mine; }
        if (sum == G) break;
        __builtin_amdgcn_s_sleep(1);
        if ((++sp & 255u) == 0u) { if (xb_ld(&bar[XB_TMO])) break; if (sp > XB_SPIN_CAP) { atomicAdd(&bar[XB_TMO], 1u); break; } }
    }
    nloc = mine > 0u ? mine : 1u; nx = cnt > 0u ? cnt : 1u;
}
__device__ __forceinline__ void xcd_barrier(const XcdBarrier& b) {
    asm volatile("s_waitcnt vmcnt(0)" ::: "memory");
    __syncthreads();
    if (threadIdx.x == 0) {
        unsigned* bar = b.bar;
        __builtin_amdgcn_s_waitcnt(0);
        unsigned nloc = b.st[0], nx = b.st[1];
        if (nloc == 0u) { xcd_barrier_complete(bar, b.x, nloc, nx); b.st[0] = nloc; b.st[1] = nx; }
        const unsigned old = xb_add(&bar[XB_XSUB(b.x)], 1u);
        const unsigned gen = old / nloc;
        if (old + 1u == (gen + 1u) * nloc) {
            __builtin_amdgcn_fence(__ATOMIC_RELEASE, "agent");
            asm volatile("s_waitcnt vmcnt(0)" ::: "memory");
            const unsigned og = xb_add(&bar[XB_TOP], 1u);
            const unsigned tg = og / nx;
            if (og + 1u == (tg + 1u) * nx) xb_add(&bar[XB_TOPGEN], 1u);
            else XB_SPIN(xb_ld(&bar[XB_TOPGEN]) == tg, bar);
            __builtin_amdgcn_fence(__ATOMIC_ACQUIRE, "agent");
            xb_add(&bar[XB_XGEN(b.x)], 1u);
            asm volatile("s_waitcnt vmcnt(0)" ::: "memory");
        } else {
            XB_SPIN(xb_ld(&bar[XB_XGEN(b.x)]) == gen, bar);
            __builtin_amdgcn_fence(__ATOMIC_ACQUIRE, "agent");
            asm volatile("s_waitcnt vmcnt(0)" ::: "memory");
        }
    }
    __syncthreads();
}

struct Ctx {
    ldsp lds; int tid, lane, wave, G, bid;
    const float* in[22]; float* out; unsigned char* ws;
};
enum { I_X = 0, I_META, I_LNMIX, I_WIN, I_WG2, I_BG, I_GNW, I_CONVW, I_CONVB, I_DTB, I_ALOG, I_DSKIP, I_SNW, I_WUG, I_WUS, I_WOUT, I_LNFFN, I_WQ, I_KEYS, I_PU, I_PV, I_LNF };

using pg8::Unit; using pg8::cvt_pk_bf16;
struct EpiProj {
    static constexpr bool PERM = true, AFTER_DRAIN = false;
    bf16* PJ; float* TL;
    __device__ __forceinline__ void operator()(const f32x4 (&acc)[2][2][4][2], const Unit& u, int wr, int wc, int fr, int fq) const {
        const int row0 = u.pm * 256 + wr * 64 + fr; const int pn = u.pn;
        if (pn < 40) {
            const int mode = pn < 2 ? 1 : (pn < 8 ? 0 : (pn < 20 ? 2 : (pn < 32 ? 0 : 3)));
            const int col0 = pn * 256 + wc * 32 + 8 * fq;
#pragma unroll
            for (int ai = 0; ai < 2; ++ai)
#pragma unroll
                for (int m = 0; m < 4; ++m) { bf16* rowp = PJ + (size_t)(row0 + ai * 128 + m * 16) * NPJ + col0;
#pragma unroll
                    for (int bj = 0; bj < 2; ++bj) { f32x4 v0 = acc[ai][bj][m][0], v1 = acc[ai][bj][m][1];
                        if (mode == 1) { v0 = v0 * 0.08838834764831845f; v1 = v1 * 0.08838834764831845f; }
                        else if (mode == 2) {
#pragma unroll
                            for (int j = 0; j < 4; ++j) { v0[j] = siluf_(v0[j]); v1[j] = siluf_(v1[j]); } }
                        else if (mode == 3) {
#pragma unroll
                            for (int j = 0; j < 4; ++j) { v0[j] = sigmoidf_(v0[j]); v1[j] = sigmoidf_(v1[j]); } }
                        v4u w; w.x = cvt_pk_bf16(v0[0], v0[1]); w.y = cvt_pk_bf16(v0[2], v0[3]); w.z = cvt_pk_bf16(v1[0], v1[1]); w.w = cvt_pk_bf16(v1[2], v1[3]);
                        *(v4u*)(rowp + bj * 128) = w; } }
        } else {
            if (wc < 2) {
#pragma unroll
                for (int ai = 0; ai < 2; ++ai)
#pragma unroll
                    for (int m = 0; m < 4; ++m) { float* rowp = TL + (size_t)(row0 + ai * 128 + m * 16) * 48;
#pragma unroll
                        for (int n = 0; n < 2; ++n) { const int c = wc * 32 + 8 * fq + 4 * n; if (c < 48) *(f32x4*)(rowp + c) = acc[ai][0][m][n]; } }
            }
        }
    }
};
struct EpiAny {
    static constexpr bool PERM = true, AFTER_DRAIN = false;
    int mode;
    EpiProj P; bf16* O; const bf16* PJ; const bf16* T; int gcol; const float* X; float* OF; int b; int ldc;
    __device__ __forceinline__ void operator()(const f32x4 (&acc)[2][2][4][2], const Unit& u, int wr, int wc, int fr, int fq) const {
        if (mode == 0) { P(acc, u, wr, wc, fr, fq); return; }
        const int row0 = u.pm * 256 + wr * 64 + fr; const int col0 = u.pn * 256 + wc * 32 + 8 * fq;
        if (mode == 1) {
#pragma unroll
            for (int ai = 0; ai < 2; ++ai)
#pragma unroll
                for (int m = 0; m < 4; ++m) { const size_t r = (size_t)(row0 + ai * 128 + m * 16);
#pragma unroll
                    for (int bj = 0; bj < 2; ++bj) { const int c = col0 + bj * 128;
                        const v4u g = *(const v4u*)(PJ + r * NPJ + gcol + c);
                        f32x4 v0 = acc[ai][bj][m][0], v1 = acc[ai][bj][m][1];
                        v0[0] *= bflo(g.x); v0[1] *= bfhi(g.x); v0[2] *= bflo(g.y); v0[3] *= bfhi(g.y); v1[0] *= bflo(g.z); v1[1] *= bfhi(g.z); v1[2] *= bflo(g.w); v1[3] *= bfhi(g.w);
                        if (T) { const v4u t = *(const v4u*)(T + r * 1024 + c);
                            v0[0] += bflo(t.x); v0[1] += bfhi(t.x); v0[2] += bflo(t.y); v0[3] += bfhi(t.y); v1[0] += bflo(t.z); v1[1] += bfhi(t.z); v1[2] += bflo(t.w); v1[3] += bfhi(t.w); }
                        v4u w; w.x = cvt_pk_bf16(v0[0], v0[1]); w.y = cvt_pk_bf16(v0[2], v0[3]); w.z = cvt_pk_bf16(v1[0], v1[1]); w.w = cvt_pk_bf16(v1[2], v1[3]);
                        *(v4u*)(O + r * 1024 + c) = w; } }
        } else if (mode == 2) {
#pragma unroll
            for (int ai = 0; ai < 2; ++ai)
#pragma unroll
                for (int m = 0; m < 4; ++m) { const int r = row0 + ai * 128 + m * 16;
                    if (r >= RTOK && r < REND) { const size_t o = ((size_t)b * SEQ + (r - RTOK)) * D + col0;
#pragma unroll
                        for (int bj = 0; bj < 2; ++bj)
#pragma unroll
                            for (int n = 0; n < 2; ++n) { const f32x4 xv = *(const f32x4*)(X + o + bj * 128 + n * 4); *(f32x4*)(OF + o + bj * 128 + n * 4) = acc[ai][bj][m][n] + xv; } } }
        } else {
#pragma unroll
            for (int ai = 0; ai < 2; ++ai)
#pragma unroll
                for (int m = 0; m < 4; ++m) { float* rowp = OF + (size_t)(row0 + ai * 128 + m * 16) * ldc + col0;
#pragma unroll
                    for (int bj = 0; bj < 2; ++bj)
#pragma unroll
                        for (int n = 0; n < 2; ++n) *(f32x4*)(rowp + bj * 128 + n * 4) = acc[ai][bj][m][n]; }
        }
    }
};

struct MapIdent { __device__ __forceinline__ int operator()(int n) const { return n; } };
struct MapW1 { __device__ __forceinline__ int operator()(int n) const {
    if (n < 3072) return n;
    if (n < 8192) return n + 16;
    if (n < 10240) return n + 48;
    if (n < 10256) return n - 10240 + 3072;
    if (n < 10288) return n - 10256 + 8208;
    return -1; } };
template <class Map>
__device__ __forceinline__ void transpose_item(const float* W, int K, int NS, int N, bf16* WT, LAS float* scr, int item, int lane, const Map& map) {
    const int nblk = N / 32, kb = item / nblk, nb = item % nblk, k0 = 64 * kb, n0 = 32 * nb;
    const int sc = map(n0 + (lane & 31));
#pragma unroll 8
    for (int i = 0; i < 32; ++i) { const int kk = 2 * i + (lane >> 5); scr[kk * 33 + (lane & 31)] = sc >= 0 ? W[(size_t)(k0 + kk) * NS + sc] : 0.f; }
    LDS_WAIT(); asm volatile("" ::: "memory");
    const int c = lane & 7;
#pragma unroll
    for (int j = 0; j < 4; ++j) { const int n = (lane >> 3) + 8 * j; const LAS float* s = scr + (8 * c) * 33 + n;
        v4u o; o.x = pk2(s[0 * 33], s[1 * 33]); o.y = pk2(s[2 * 33], s[3 * 33]); o.z = pk2(s[4 * 33], s[5 * 33]); o.w = pk2(s[6 * 33], s[7 * 33]);
        *(v4u*)(WT + (size_t)(n0 + n) * K + k0 + 8 * c) = o; }
    LDS_WAIT(); asm volatile("" ::: "memory");
}
__device__ __forceinline__ void norm_row_bf16(const float* src, const float* w, bf16* dst, int lane) {
    v2u* o8 = (v2u*)dst + lane;
    if (src == nullptr) {
#pragma unroll
        for (int j = 0; j < 4; ++j) o8[64 * j] = (v2u){0u, 0u};
        return; }
    const f32x4* xr = (const f32x4*)src + lane; const f32x4* wr_ = (const f32x4*)w + lane;
    f32x4 v[4]; float s = 0.f;
#pragma unroll
    for (int j = 0; j < 4; ++j) { v[j] = xr[64 * j]; s += (v[j].x * v[j].x + v[j].y * v[j].y) + (v[j].z * v[j].z + v[j].w * v[j].w); }
    const float rs = rsqrtf(wave_sum(s) * (1.f / D) + RMS_EPS);
#pragma unroll
    for (int j = 0; j < 4; ++j) { const f32x4 ww = wr_[64 * j]; v2u o; o.x = pk2(v[j].x * rs * ww.x, v[j].y * rs * ww.y); o.y = pk2(v[j].z * rs * ww.z, v[j].w * rs * ww.w); o8[64 * j] = o; }
}
__device__ __forceinline__ void hn_batch(const Ctx& C, int b) {
    bf16* HN = (bf16*)(C.ws + WS_HN);
    const int gw = C.bid * NWAVES + C.wave, NGW = C.G * NWAVES;
    for (int r = gw; r < RPB; r += NGW) {
        const float* src = nullptr;
        if (r >= RFRONT && r < RTOK) src = C.in[I_META] + (size_t)(r - RFRONT) * D;
        else if (r >= RTOK && r < REND) src = C.in[I_X] + ((size_t)b * SEQ + (r - RTOK)) * D;
        norm_row_bf16(src, C.in[I_LNMIX], HN + (size_t)r * D, C.lane);
    }
}
__device__ __forceinline__ void weff_unit(const Ctx& C, int unit) {
    const int blk = unit >> 4, d0 = (unit & 15) * 64;
    LAS float* KT = (LAS float*)C.lds;
    LAS float* WQ = (LAS float*)(C.lds + 128 * 132 * 4);
    const float* keys = C.in[I_KEYS] + (size_t)blk * 128 * 128; const float* wq = C.in[I_WQ];
    for (int e = C.tid; e < 128 * 32; e += NT) { const int key = e >> 5, j4 = e & 31; *(LAS f32x4*)(KT + key * 132 + 4 * j4) = *(const f32x4*)(keys + key * 128 + 4 * j4); }
    for (int e = C.tid; e < 64 * 32; e += NT) { const int dd = e >> 5, j4 = e & 31; *(LAS f32x4*)(WQ + dd * 128 + 4 * j4) = *(const f32x4*)(wq + (size_t)(d0 + dd) * 2048 + blk * 128 + 4 * j4); }
    __syncthreads();
    const int key = C.tid & 127, dg = C.tid >> 7;
    float acc[16];
#pragma unroll
    for (int i = 0; i < 16; ++i) acc[i] = 0.f;
    for (int j4 = 0; j4 < 32; ++j4) {
        const f32x4 kv = *(const LAS f32x4*)(KT + key * 132 + 4 * j4);
#pragma unroll
        for (int i = 0; i < 16; ++i) { const f32x4 wv = *(const LAS f32x4*)(WQ + (dg * 16 + i) * 128 + 4 * j4); acc[i] += kv.x * wv.x + kv.y * wv.y + kv.z * wv.z + kv.w * wv.w; }
    }
    bf16* WET = (bf16*)(C.ws + WS_WET) + (size_t)(blk * 128 + key) * D + d0 + dg * 16;
    v4u o0, o1; o0.x = pk2(acc[0], acc[1]); o0.y = pk2(acc[2], acc[3]); o0.z = pk2(acc[4], acc[5]); o0.w = pk2(acc[6], acc[7]);
    o1.x = pk2(acc[8], acc[9]); o1.y = pk2(acc[10], acc[11]); o1.z = pk2(acc[12], acc[13]); o1.w = pk2(acc[14], acc[15]);
    *(v4u*)WET = o0; *(v4u*)(WET + 8) = o1;
    __syncthreads();
}
__device__ __forceinline__ void p0_prologue(const Ctx& C) {
    LAS float* scr = (LAS float*)(C.lds + C.wave * 16384);
    const int gw = C.bid * NWAVES + C.wave, NGW = C.G * NWAVES;
    constexpr int I_1 = (D / 64) * (N1 / 32), I_A = (1024 / 64) * (1024 / 32), I_B = (2048 / 64) * (1024 / 32), I_O = I_A;
    constexpr int NITEMS = I_1 + I_A + I_B + I_O;
    for (int it = gw; it < NITEMS; it += NGW) {
        int r = it;
        if (r < I_1) { transpose_item(C.in[I_WIN], 1024, 10288, N1, (bf16*)(C.ws + WS_W1T), scr, r, C.lane, MapW1()); continue; } r -= I_1;
        if (r < I_A) { transpose_item(C.in[I_WUG], 1024, 1024, 1024, (bf16*)(C.ws + WS_WAT), scr, r, C.lane, MapIdent()); continue; } r -= I_A;
        if (r < I_B) { transpose_item(C.in[I_WUS], 2048, 1024, 1024, (bf16*)(C.ws + WS_WBT), scr, r, C.lane, MapIdent()); continue; } r -= I_B;
        transpose_item(C.in[I_WOUT], 1024, 1024, 1024, (bf16*)(C.ws + WS_WOT), scr, r, C.lane, MapIdent());
    }
    __syncthreads();
    for (int u = C.bid; u < 256; u += C.G) weff_unit(C, u);
    hn_batch(C, 0);
}

__device__ __forceinline__ float softplusf_(float x) { return fmaxf(x, 0.f) + log1pf(__expf(-fabsf(x))); }
__device__ __forceinline__ void phaseC_unit(const Ctx& C, int c) {
    const bf16* PJ = (const bf16*)(C.ws + WS_PJ); const float* TL = (const float*)(C.ws + WS_TL);
    bf16* XC = (bf16*)(C.ws + WS_XC); float* GG = (float*)(C.ws + WS_GG); float* DT = (float*)(C.ws + WS_DT); float* AC = (float*)(C.ws + WS_AC);
    const int r0 = 64 * c;
    const float* cw = C.in[I_CONVW]; const float* cb = C.in[I_CONVB];
#pragma unroll 1
    for (int i = 0; i < 3; ++i) {
        const int col = 2 * (C.tid + NT * i);
        const f32x2 w0 = *(const f32x2*)(cw + col), w1 = *(const f32x2*)(cw + 3072 + col), w2 = *(const f32x2*)(cw + 2 * 3072 + col), w3 = *(const f32x2*)(cw + 3 * 3072 + col), bb = *(const f32x2*)(cb + col);
        f32x2 xm3 = {0.f, 0.f}, xm2 = {0.f, 0.f}, xm1 = {0.f, 0.f};
        if (c > 0) {
            const unsigned a = *(const unsigned*)(PJ + (size_t)(r0 - 3) * NPJ + PJ_XBC + col), b2 = *(const unsigned*)(PJ + (size_t)(r0 - 2) * NPJ + PJ_XBC + col), c2 = *(const unsigned*)(PJ + (size_t)(r0 - 1) * NPJ + PJ_XBC + col);
            xm3 = (f32x2){bflo(a), bfhi(a)}; xm2 = (f32x2){bflo(b2), bfhi(b2)}; xm1 = (f32x2){bflo(c2), bfhi(c2)};
        }
#pragma unroll 8
        for (int t = 0; t < 64; ++t) {
            const int r = r0 + t;
            const unsigned xu = *(const unsigned*)(PJ + (size_t)r * NPJ + PJ_XBC + col);
            const f32x2 x0 = {bflo(xu), bfhi(xu)};
            f32x2 o = bb + w0 * xm3 + w1 * xm2 + w2 * xm1 + w3 * x0;
            o.x = siluf_(o.x); o.y = siluf_(o.y);
            if (r < RFRONT) { o.x = 0.f; o.y = 0.f; }
            *(unsigned*)(XC + (size_t)r * 3072 + col) = pk2(o.x, o.y);
            xm3 = xm2; xm2 = xm1; xm1 = x0;
        }
    }
    {
        const int col = C.tid; const float* w2p = C.in[I_WG2]; float w2[16];
#pragma unroll
        for (int j = 0; j < 16; ++j) w2[j] = w2p[j * 512 + col];
        const float bg = C.in[I_BG][col]; float G = 0.f;
#pragma unroll 4
        for (int t = 0; t < 64; ++t) {
            const int r = r0 + t; const float* gl = TL + (size_t)r * 48;
            float z = bg;
#pragma unroll
            for (int j4 = 0; j4 < 4; ++j4) { const f32x4 g = *(const f32x4*)(gl + 4 * j4); z += g.x * w2[4 * j4] + g.y * w2[4 * j4 + 1] + g.z * w2[4 * j4 + 2] + g.w * w2[4 * j4 + 3]; }
            float ls = fminf(z, 0.f) - log1pf(__expf(-fabsf(z)));
            if (r < RFRONT) ls = 0.f;
            G += ls * (1.f / 16.f);
            GG[(size_t)r * 512 + col] = G;
        }
    }
    if (C.tid < 32) {
        const int hd = C.tid; const float bias = C.in[I_DTB][hd], A = -__expf(C.in[I_ALOG][hd]); float acum = 0.f;
        for (int t = 0; t < 64; ++t) {
            const int r = r0 + t; float dt = softplusf_(TL[(size_t)r * 48 + 16 + hd] + bias);
            if (r < RFRONT) dt = 0.f;
            acum += A * dt;
            DT[(size_t)r * 32 + hd] = dt; AC[(size_t)r * 32 + hd] = acum;
        }
    }
}

constexpr int P136 = 272, P264 = 528, P520 = 1040, P72 = 144;
__device__ __forceinline__ void gla_pass1_unit(const Ctx& C, int c, int h) {
    const bf16* PJ = (const bf16*)(C.ws + WS_PJ); const float* GG = (const float*)(C.ws + WS_GG); bf16* LG = (bf16*)(C.ws + WS_LG);
    ldsp KD = C.lds, VT = C.lds + 64 * P136;
    const int r0 = 64 * c;
    {
        const int s = C.tid >> 3, k0 = (C.tid & 7) * 16; const size_t r = (size_t)(r0 + s);
        const v4u ka = *(const v4u*)(PJ + r * NPJ + PJ_K + 128 * h + k0), kb = *(const v4u*)(PJ + r * NPJ + PJ_K + 128 * h + k0 + 8);
        const float* g = GG + r * 512 + 128 * h + k0; const float* gl = GG + (size_t)(r0 + 63) * 512 + 128 * h + k0;
        float e[16];
#pragma unroll
        for (int j = 0; j < 4; ++j) { const f32x4 a = *(const f32x4*)(g + 4 * j), l = *(const f32x4*)(gl + 4 * j); e[4 * j] = __expf(l.x - a.x); e[4 * j + 1] = __expf(l.y - a.y); e[4 * j + 2] = __expf(l.z - a.z); e[4 * j + 3] = __expf(l.w - a.w); }
        v4u o0, o1;
        o0.x = pk2(bflo(ka.x) * e[0], bfhi(ka.x) * e[1]); o0.y = pk2(bflo(ka.y) * e[2], bfhi(ka.y) * e[3]); o0.z = pk2(bflo(ka.z) * e[4], bfhi(ka.z) * e[5]); o0.w = pk2(bflo(ka.w) * e[6], bfhi(ka.w) * e[7]);
        o1.x = pk2(bflo(kb.x) * e[8], bfhi(kb.x) * e[9]); o1.y = pk2(bflo(kb.y) * e[10], bfhi(kb.y) * e[11]); o1.z = pk2(bflo(kb.z) * e[12], bfhi(kb.z) * e[13]); o1.w = pk2(bflo(kb.w) * e[14], bfhi(kb.w) * e[15]);
        *(LAS v4u*)(KD + s * P136 + k0 * 2) = o0; *(LAS v4u*)(KD + s * P136 + k0 * 2 + 16) = o1;
        const int v0 = (C.tid & 7) * 32; const bf16* vp = PJ + r * NPJ + PJ_V + 256 * h + v0;
#pragma unroll
        for (int j = 0; j < 4; ++j) *(LAS v4u*)(VT + s * P264 + (v0 + 8 * j) * 2) = *(const v4u*)(vp + 8 * j);
    }
    __syncthreads();
    const int fr = C.lane & 15, fq = C.lane >> 4, w = C.wave;
    f32x4 acc[2][8];
#pragma unroll
    for (int mi = 0; mi < 2; ++mi)
#pragma unroll
        for (int nt = 0; nt < 8; ++nt) acc[mi][nt] = (f32x4){0.f, 0.f, 0.f, 0.f};
#pragma unroll
    for (int ks = 0; ks < 2; ++ks) {
        bf16x8 af[2];
#pragma unroll
        for (int mi = 0; mi < 2; ++mi) af[mi] = tr_frag(VT, P264, 32 * ks, 32 * w + 16 * mi, fr, fq);
#pragma unroll
        for (int nt = 0; nt < 8; ++nt) { const bf16x8 bfm = tr_frag(KD, P136, 32 * ks, 16 * nt, fr, fq);
#pragma unroll
            for (int mi = 0; mi < 2; ++mi) acc[mi][nt] = mma16(af[mi], bfm, acc[mi][nt]); }
    }
    bf16* Lb = LG + ((size_t)(c * 4 + h) * 256) * 128;
#pragma unroll
    for (int mi = 0; mi < 2; ++mi)
#pragma unroll
        for (int nt = 0; nt < 8; ++nt) { const int v = 32 * w + 16 * mi + fr, k = 16 * nt + 4 * fq; const f32x4 a = acc[mi][nt];
            *(v2u*)(Lb + (size_t)v * 128 + k) = (v2u){cvt_pk_bf16(a[0], a[1]), cvt_pk_bf16(a[2], a[3])}; }
    __syncthreads();
}
__device__ __forceinline__ void ssd_pass1_unit(const Ctx& C, int c, int g) {
    const bf16* XC = (const bf16*)(C.ws + WS_XC); const float* DT = (const float*)(C.ws + WS_DT); const float* AC = (const float*)(C.ws + WS_AC); bf16* LS = (bf16*)(C.ws + WS_LS);
    ldsp XW = C.lds, BM = C.lds + 64 * P520;
    const int r0 = 64 * c;
    {
        const int s = C.tid >> 3, hl = C.tid & 7, hd = 8 * g + hl; const size_t r = (size_t)(r0 + s);
        const float sc = DT[r * 32 + hd] * __expf(AC[(size_t)(r0 + 63) * 32 + hd] - AC[r * 32 + hd]);
        const bf16* xp = XC + r * 3072 + 64 * hd;
#pragma unroll
        for (int j = 0; j < 8; ++j) { const v4u x = *(const v4u*)(xp + 8 * j); v4u o;
            o.x = pk2(bflo(x.x) * sc, bfhi(x.x) * sc); o.y = pk2(bflo(x.y) * sc, bfhi(x.y) * sc); o.z = pk2(bflo(x.z) * sc, bfhi(x.z) * sc); o.w = pk2(bflo(x.w) * sc, bfhi(x.w) * sc);
            *(LAS v4u*)(XW + s * P520 + (64 * hl + 8 * j) * 2) = o; }
        const bf16* bp = XC + r * 3072 + 2048 + 128 * g + 16 * hl;
        *(LAS v4u*)(BM + s * P136 + (16 * hl) * 2) = *(const v4u*)bp; *(LAS v4u*)(BM + s * P136 + (16 * hl + 8) * 2) = *(const v4u*)(bp + 8);
    }
    __syncthreads();
    const int fr = C.lane & 15, fq = C.lane >> 4, w = C.wave;
    bf16* Lb = LS + ((size_t)(c * 32 + 8 * g + w) * 64) * 128;
#pragma unroll
    for (int nh = 0; nh < 2; ++nh) {
        f32x4 acc[4][4];
#pragma unroll
        for (int mi = 0; mi < 4; ++mi)
#pragma unroll
            for (int nt = 0; nt < 4; ++nt) acc[mi][nt] = (f32x4){0.f, 0.f, 0.f, 0.f};
#pragma unroll
        for (int ks = 0; ks < 2; ++ks) {
            bf16x8 af[4];
#pragma unroll
            for (int mi = 0; mi < 4; ++mi) af[mi] = tr_frag(XW, P520, 32 * ks, 64 * w + 16 * mi, fr, fq);
#pragma unroll
            for (int nt = 0; nt < 4; ++nt) { const bf16x8 bfm = tr_frag(BM, P136, 32 * ks, 64 * nh + 16 * nt, fr, fq);
#pragma unroll
                for (int mi = 0; mi < 4; ++mi) acc[mi][nt] = mma16(af[mi], bfm, acc[mi][nt]); }
        }
#pragma unroll
        for (int mi = 0; mi < 4; ++mi)
#pragma unroll
            for (int nt = 0; nt < 4; ++nt) { const int p = 16 * mi + fr, n = 64 * nh + 16 * nt + 4 * fq; const f32x4 a = acc[mi][nt];
                *(v2u*)(Lb + (size_t)p * 128 + n) = (v2u){cvt_pk_bf16(a[0], a[1]), cvt_pk_bf16(a[2], a[3])}; }
    }
    __syncthreads();
}

__device__ __forceinline__ void phaseE(const Ctx& C) {
    const float* GG = (const float*)(C.ws + WS_GG); const float* AC = (const float*)(C.ws + WS_AC);
    for (int vb = C.bid; vb < 256; vb += C.G) {
        if (vb < 128) {
            const int e = vb * NT + C.tid, k2 = e & 63, v = (e >> 6) & 255, h = e >> 14;
            unsigned* Lp = (unsigned*)(C.ws + WS_LG) + ((size_t)h * 256 + v) * 64 + k2;
            const float* dp = GG + 63 * 512 + 128 * h + 2 * k2;
            float s0 = 0.f, s1 = 0.f;
            for (int c0 = 0; c0 < NCHUNK; c0 += 8) {
                unsigned l[8]; f32x2 d[8];
#pragma unroll
                for (int i = 0; i < 8; ++i) if (c0 + i < NCHUNK) { l[i] = Lp[(size_t)(c0 + i) * (4 * 256 * 64)]; d[i] = *(const f32x2*)(dp + (size_t)(c0 + i) * 64 * 512); }
#pragma unroll
                for (int i = 0; i < 8; ++i) if (c0 + i < NCHUNK) {
                    Lp[(size_t)(c0 + i) * (4 * 256 * 64)] = pk2(s0, s1);
                    s0 = s0 * __expf(d[i].x) + bflo(l[i]); s1 = s1 * __expf(d[i].y) + bfhi(l[i]); }
            }
        } else {
            const int e = (vb - 128) * NT + C.tid, n4 = e & 31, p = (e >> 5) & 63, hd = e >> 11;
            v2u* Lp = (v2u*)(C.ws + WS_LS) + ((size_t)hd * 64 + p) * 32 + n4;
            const float* dp = AC + 63 * 32 + hd;
            float s0 = 0.f, s1 = 0.f, s2 = 0.f, s3 = 0.f;
            for (int c0 = 0; c0 < NCHUNK; c0 += 8) {
                v2u l[8]; float d[8];
#pragma unroll
                for (int i = 0; i < 8; ++i) if (c0 + i < NCHUNK) { l[i] = Lp[(size_t)(c0 + i) * (32 * 64 * 32)]; d[i] = dp[(size_t)(c0 + i) * 64 * 32]; }
#pragma unroll
                for (int i = 0; i < 8; ++i) if (c0 + i < NCHUNK) {
                    Lp[(size_t)(c0 + i) * (32 * 64 * 32)] = (v2u){pk2(s0, s1), pk2(s2, s3)};
                    const float dd = __expf(d[i]);
                    s0 = s0 * dd + bflo(l[i].x); s1 = s1 * dd + bfhi(l[i].x); s2 = s2 * dd + bflo(l[i].y); s3 = s3 * dd + bfhi(l[i].y); }
            }
        }
    }
}

__device__ __forceinline__ void gla_pass3_unit(const Ctx& C, int c, int h) {
    const bf16* PJ = (const bf16*)(C.ws + WS_PJ); const float* GG = (const float*)(C.ws + WS_GG); const bf16* LG = (const bf16*)(C.ws + WS_LG); bf16* OG = (bf16*)(C.ws + WS_OG);
    ldsp QE = C.lds, QN = QE + 64 * P136, KE = QN + 64 * P136, KN = KE + 64 * P136, VT = KN + 64 * P136, ATT = VT + 64 * P264;
    LAS float* RED = (LAS float*)(ATT + 64 * P72);
    const int r0 = 64 * c;
    {
        const int s = C.tid >> 3, k0 = (C.tid & 7) * 16; const size_t r = (size_t)(r0 + s);
        const v4u qa = *(const v4u*)(PJ + r * NPJ + PJ_Q + 128 * h + k0), qb = *(const v4u*)(PJ + r * NPJ + PJ_Q + 128 * h + k0 + 8);
        const v4u ka = *(const v4u*)(PJ + r * NPJ + PJ_K + 128 * h + k0), kb = *(const v4u*)(PJ + r * NPJ + PJ_K + 128 * h + k0 + 8);
        const float* g = GG + r * 512 + 128 * h + k0;
        float ep[16], en[16];
#pragma unroll
        for (int j = 0; j < 4; ++j) { const f32x4 a = *(const f32x4*)(g + 4 * j);
            ep[4 * j] = __expf(a.x); ep[4 * j + 1] = __expf(a.y); ep[4 * j + 2] = __expf(a.z); ep[4 * j + 3] = __expf(a.w);
            en[4 * j] = __expf(-a.x); en[4 * j + 1] = __expf(-a.y); en[4 * j + 2] = __expf(-a.z); en[4 * j + 3] = __expf(-a.w); }
        const unsigned qs[8] = {qa.x, qa.y, qa.z, qa.w, qb.x, qb.y, qb.z, qb.w}, ksr[8] = {ka.x, ka.y, ka.z, ka.w, kb.x, kb.y, kb.z, kb.w};
        unsigned oqe[8], oqn[8], oke[8], okn[8];
#pragma unroll
        for (int j = 0; j < 8; ++j) { const float q0 = bflo(qs[j]), q1 = bfhi(qs[j]), kk0 = bflo(ksr[j]), kk1 = bfhi(ksr[j]);
            oqe[j] = pk2(q0 * ep[2 * j], q1 * ep[2 * j + 1]); oqn[j] = pk2(q0 * en[2 * j], q1 * en[2 * j + 1]);
            oke[j] = pk2(kk0 * ep[2 * j], kk1 * ep[2 * j + 1]); okn[j] = pk2(kk0 * en[2 * j], kk1 * en[2 * j + 1]); }
        const int off = s * P136 + k0 * 2;
        *(LAS v4u*)(QE + off) = (v4u){oqe[0], oqe[1], oqe[2], oqe[3]}; *(LAS v4u*)(QE + off + 16) = (v4u){oqe[4], oqe[5], oqe[6], oqe[7]};
        *(LAS v4u*)(QN + off) = (v4u){oqn[0], oqn[1], oqn[2], oqn[3]}; *(LAS v4u*)(QN + off + 16) = (v4u){oqn[4], oqn[5], oqn[6], oqn[7]};
        *(LAS v4u*)(KE + off) = (v4u){oke[0], oke[1], oke[2], oke[3]}; *(LAS v4u*)(KE + off + 16) = (v4u){oke[4], oke[5], oke[6], oke[7]};
        *(LAS v4u*)(KN + off) = (v4u){okn[0], okn[1], okn[2], okn[3]}; *(LAS v4u*)(KN + off + 16) = (v4u){okn[4], okn[5], okn[6], okn[7]};
        const int v0 = (C.tid & 7) * 32; const bf16* vp = PJ + r * NPJ + PJ_V + 256 * h + v0;
#pragma unroll
        for (int j = 0; j < 4; ++j) *(LAS v4u*)(VT + s * P264 + (v0 + 8 * j) * 2) = *(const v4u*)(vp + 8 * j);
    }
    __syncthreads();
    const int fr = C.lane & 15, fq = C.lane >> 4, w = C.wave;
#pragma unroll
    for (int ti = 0; ti < 2; ++ti) {
        const int id = 2 * w + ti, tm = id >> 2, sn = id & 3;
        f32x4 ac = {0.f, 0.f, 0.f, 0.f}, aa = {0.f, 0.f, 0.f, 0.f};
#pragma unroll
        for (int ks = 0; ks < 4; ++ks) {
            const int ao = (16 * tm + fr) * P136 + (32 * ks + 8 * fq) * 2, bo = (16 * sn + fr) * P136 + (32 * ks + 8 * fq) * 2;
            ac = mma16(lds_frag(QE + ao), lds_frag(KN + bo), ac);
            aa = mma16(lds_frag(QN + ao), lds_frag(KE + bo), aa);
        }
        const int t = 16 * tm + fr, s0 = 16 * sn + 4 * fq;
        float o[4];
#pragma unroll
        for (int j = 0; j < 4; ++j) o[j] = (s0 + j <= t) ? ac[j] : aa[j];
        *(LAS v2u*)(ATT + t * P72 + s0 * 2) = (v2u){pk2(o[0], o[1]), pk2(o[2], o[3])};
    }
    __syncthreads();
    f32x4 acc[4][2];
#pragma unroll
    for (int tm = 0; tm < 4; ++tm)
#pragma unroll
        for (int nt = 0; nt < 2; ++nt) acc[tm][nt] = (f32x4){0.f, 0.f, 0.f, 0.f};
    const bf16* Sb = LG + ((size_t)(c * 4 + h) * 256) * 128;
#pragma unroll
    for (int ks = 0; ks < 4; ++ks) {
        bf16x8 bfm[2];
#pragma unroll
        for (int nt = 0; nt < 2; ++nt) bfm[nt] = *(const bf16x8*)(Sb + (size_t)(32 * w + 16 * nt + fr) * 128 + 32 * ks + 8 * fq);
#pragma unroll
        for (int tm = 0; tm < 4; ++tm) { const bf16x8 af = lds_frag(QE + (16 * tm + fr) * P136 + (32 * ks + 8 * fq) * 2);
#pragma unroll
            for (int nt = 0; nt < 2; ++nt) acc[tm][nt] = mma16(af, bfm[nt], acc[tm][nt]); }
    }
#pragma unroll
    for (int ks = 0; ks < 2; ++ks) {
        bf16x8 bfm[2];
#pragma unroll
        for (int nt = 0; nt < 2; ++nt) bfm[nt] = tr_frag(VT, P264, 32 * ks, 32 * w + 16 * nt, fr, fq);
#pragma unroll
        for (int tm = 0; tm < 4; ++tm) { const bf16x8 af = lds_frag(ATT + (16 * tm + fr) * P72 + (32 * ks + 8 * fq) * 2);
#pragma unroll
            for (int nt = 0; nt < 2; ++nt) acc[tm][nt] = mma16(af, bfm[nt], acc[tm][nt]); }
    }
#pragma unroll
    for (int tm = 0; tm < 4; ++tm) { float s = 0.f;
#pragma unroll
        for (int nt = 0; nt < 2; ++nt) { const f32x4 a = acc[tm][nt]; s += (a[0] * a[0] + a[1] * a[1]) + (a[2] * a[2] + a[3] * a[3]); }
        s += __shfl_xor(s, 16); s += __shfl_xor(s, 32);
        if (fq == 0) RED[w * 64 + 16 * tm + fr] = s; }
    __syncthreads();
    const float* nw = C.in[I_GNW];
#pragma unroll
    for (int tm = 0; tm < 4; ++tm) { const int t = 16 * tm + fr; float tot = 0.f;
#pragma unroll
        for (int ww = 0; ww < 8; ++ww) tot += RED[ww * 64 + t];
        const float rs = rsqrtf(tot * (1.f / 256.f) + RMS_EPS); const size_t r = (size_t)(r0 + t);
#pragma unroll
        for (int nt = 0; nt < 2; ++nt) { const int v = 32 * w + 16 * nt + 4 * fq; const f32x4 a = acc[tm][nt];
            const f32x4 wv = *(const f32x4*)(nw + v); const v2u gv = *(const v2u*)(PJ + r * NPJ + PJ_GO + 256 * h + v);
            *(v2u*)(OG + r * 1024 + 256 * h + v) = (v2u){pk2(a[0] * rs * wv.x * bflo(gv.x), a[1] * rs * wv.y * bfhi(gv.x)), pk2(a[2] * rs * wv.z * bflo(gv.y), a[3] * rs * wv.w * bfhi(gv.y))}; } }
    __syncthreads();
}
__device__ __forceinline__ void ssd_pass3_unit(const Ctx& C, int c, int g) {
    const bf16* PJ = (const bf16*)(C.ws + WS_PJ); const bf16* XC = (const bf16*)(C.ws + WS_XC); const float* DT = (const float*)(C.ws + WS_DT); const float* AC = (const float*)(C.ws + WS_AC);
    const bf16* LS = (const bf16*)(C.ws + WS_LS); bf16* YS = (bf16*)(C.ws + WS_YS);
    ldsp XD = C.lds, CM = XD + 64 * P520, BM = CM + 64 * P136, WT = BM + 64 * P136;
    LAS float* ACL = (LAS float*)(WT + 8 * 32 * P72);
    LAS float* RED = ACL + 8 * 64;
    const int r0 = 64 * c;
    {
        const int s = C.tid >> 3, hl = C.tid & 7, hd = 8 * g + hl; const size_t r = (size_t)(r0 + s);
        const float sc = DT[r * 32 + hd];
        ACL[hl * 64 + s] = AC[r * 32 + hd];
        const bf16* xp = XC + r * 3072 + 64 * hd;
#pragma unroll
        for (int j = 0; j < 8; ++j) { const v4u x = *(const v4u*)(xp + 8 * j); v4u o;
            o.x = pk2(bflo(x.x) * sc, bfhi(x.x) * sc); o.y = pk2(bflo(x.y) * sc, bfhi(x.y) * sc); o.z = pk2(bflo(x.z) * sc, bfhi(x.z) * sc); o.w = pk2(bflo(x.w) * sc, bfhi(x.w) * sc);
            *(LAS v4u*)(XD + s * P520 + (64 * hl + 8 * j) * 2) = o; }
        const bf16* bp = XC + r * 3072 + 2048 + 128 * g + 16 * hl; const bf16* cp = XC + r * 3072 + 2560 + 128 * g + 16 * hl;
        *(LAS v4u*)(BM + s * P136 + (16 * hl) * 2) = *(const v4u*)bp; *(LAS v4u*)(BM + s * P136 + (16 * hl + 8) * 2) = *(const v4u*)(bp + 8);
        *(LAS v4u*)(CM + s * P136 + (16 * hl) * 2) = *(const v4u*)cp; *(LAS v4u*)(CM + s * P136 + (16 * hl + 8) * 2) = *(const v4u*)(cp + 8);
    }
    __syncthreads();
    const int fr = C.lane & 15, fq = C.lane >> 4, w = C.wave, rh = w & 1, hq = w >> 1, t0 = 32 * rh;
    ldsp WW = WT + w * 32 * P72;
    f32x4 cb[2][4];
#pragma unroll
    for (int tm = 0; tm < 2; ++tm)
#pragma unroll
        for (int sn = 0; sn < 4; ++sn) cb[tm][sn] = (f32x4){0.f, 0.f, 0.f, 0.f};
#pragma unroll
    for (int ks = 0; ks < 4; ++ks) {
        bf16x8 af[2];
#pragma unroll
        for (int tm = 0; tm < 2; ++tm) af[tm] = lds_frag(CM + (t0 + 16 * tm + fr) * P136 + (32 * ks + 8 * fq) * 2);
#pragma unroll
        for (int sn = 0; sn < 4; ++sn) { const bf16x8 bfm = lds_frag(BM + (16 * sn + fr) * P136 + (32 * ks + 8 * fq) * 2);
#pragma unroll
            for (int tm = 0; tm < 2; ++tm) cb[tm][sn] = mma16(af[tm], bfm, cb[tm][sn]); }
    }
    f32x4 y[2][2][4];
#pragma unroll
    for (int rd = 0; rd < 2; ++rd) {
        const int hl = hq + 4 * rd, hd = 8 * g + hl;
        float at[2];
#pragma unroll
        for (int tm = 0; tm < 2; ++tm) at[tm] = ACL[hl * 64 + t0 + 16 * tm + fr];
#pragma unroll
        for (int sn = 0; sn < 4; ++sn) { const f32x4 as = *(const LAS f32x4*)(ACL + hl * 64 + 16 * sn + 4 * fq);
#pragma unroll
            for (int tm = 0; tm < 2; ++tm) { const f32x4 cv = cb[tm][sn];
                const float w0 = cv[0] * __expf(-fabsf(at[tm] - as.x)), w1 = cv[1] * __expf(-fabsf(at[tm] - as.y)), w2 = cv[2] * __expf(-fabsf(at[tm] - as.z)), w3 = cv[3] * __expf(-fabsf(at[tm] - as.w));
                *(LAS v2u*)(WW + (16 * tm + fr) * P72 + (16 * sn + 4 * fq) * 2) = (v2u){pk2(w0, w1), pk2(w2, w3)}; } }
#pragma unroll
        for (int tm = 0; tm < 2; ++tm)
#pragma unroll
            for (int pn = 0; pn < 4; ++pn) y[rd][tm][pn] = (f32x4){0.f, 0.f, 0.f, 0.f};
        const bf16* Sb = LS + ((size_t)(c * 32 + hd) * 64) * 128;
#pragma unroll
        for (int ks = 0; ks < 4; ++ks) {
            bf16x8 af[2];
#pragma unroll
            for (int tm = 0; tm < 2; ++tm) af[tm] = lds_frag(CM + (t0 + 16 * tm + fr) * P136 + (32 * ks + 8 * fq) * 2);
#pragma unroll
            for (int pn = 0; pn < 4; ++pn) { const bf16x8 bfm = *(const bf16x8*)(Sb + (size_t)(16 * pn + fr) * 128 + 32 * ks + 8 * fq);
#pragma unroll
                for (int tm = 0; tm < 2; ++tm) y[rd][tm][pn] = mma16(af[tm], bfm, y[rd][tm][pn]); }
        }
#pragma unroll
        for (int tm = 0; tm < 2; ++tm) { const float ea = __expf(at[tm]);
#pragma unroll
            for (int pn = 0; pn < 4; ++pn) y[rd][tm][pn] = y[rd][tm][pn] * ea; }
        LDS_WAIT(); asm volatile("" ::: "memory");
#pragma unroll
        for (int ks = 0; ks < 2; ++ks) {
            bf16x8 af[2];
#pragma unroll
            for (int tm = 0; tm < 2; ++tm) af[tm] = lds_frag(WW + (16 * tm + fr) * P72 + (32 * ks + 8 * fq) * 2);
#pragma unroll
            for (int pn = 0; pn < 4; ++pn) { const bf16x8 bfm = tr_frag(XD, P520, 32 * ks, 64 * hl + 16 * pn, fr, fq);
#pragma unroll
                for (int tm = 0; tm < 2; ++tm) y[rd][tm][pn] = mma16(af[tm], bfm, y[rd][tm][pn]); }
        }
        LDS_WAIT(); asm volatile("" ::: "memory");
    }
    const float* dsk = C.in[I_DSKIP]; const float* nw = C.in[I_SNW];
    float ss[2] = {0.f, 0.f};
#pragma unroll
    for (int rd = 0; rd < 2; ++rd) { const int hd = 8 * g + hq + 4 * rd; const float dk = dsk[hd];
#pragma unroll
        for (int tm = 0; tm < 2; ++tm) { const size_t r = (size_t)(r0 + t0 + 16 * tm + fr);
#pragma unroll
            for (int pn = 0; pn < 4; ++pn) { const int col = 64 * hd + 16 * pn + 4 * fq;
                const v2u xv = *(const v2u*)(XC + r * 3072 + col), zv = *(const v2u*)(PJ + r * NPJ + PJ_Z + col);
                f32x4 a = y[rd][tm][pn];
                a[0] = (a[0] + dk * bflo(xv.x)) * bflo(zv.x); a[1] = (a[1] + dk * bfhi(xv.x)) * bfhi(zv.x); a[2] = (a[2] + dk * bflo(xv.y)) * bflo(zv.y); a[3] = (a[3] + dk * bfhi(xv.y)) * bfhi(zv.y);
                y[rd][tm][pn] = a; ss[tm] += (a[0] * a[0] + a[1] * a[1]) + (a[2] * a[2] + a[3] * a[3]); } } }
#pragma unroll
    for (int tm = 0; tm < 2; ++tm) { float s = ss[tm]; s += __shfl_xor(s, 16); s += __shfl_xor(s, 32); if (fq == 0) RED[w * 32 + 16 * tm + fr] = s; }
    __syncthreads();
#pragma unroll
    for (int tm = 0; tm < 2; ++tm) { const int tl = 16 * tm + fr; float tot = 0.f;
#pragma unroll
        for (int q = 0; q < 4; ++q) tot += RED[(2 * q + rh) * 32 + tl];
        const float rs = rsqrtf(tot * (1.f / 512.f) + RMS_EPS); const size_t r = (size_t)(r0 + t0 + tl);
#pragma unroll
        for (int rd = 0; rd < 2; ++rd) { const int hd = 8 * g + hq + 4 * rd;
#pragma unroll
            for (int pn = 0; pn < 4; ++pn) { const int col = 64 * hd + 16 * pn + 4 * fq; const f32x4 a = y[rd][tm][pn]; const f32x4 wv = *(const f32x4*)(nw + col);
                *(v2u*)(YS + r * 2048 + col) = (v2u){pk2(a[0] * rs * wv.x, a[1] * rs * wv.y), pk2(a[2] * rs * wv.z, a[3] * rs * wv.w)}; } } }
    __syncthreads();
}

__device__ __forceinline__ void phaseJ(const Ctx& C) {
    const int gw = C.bid * NWAVES + C.wave, NGW = C.G * NWAVES;
    bf16* HN2 = (bf16*)(C.ws + WS_HN2);
    for (int r = gw; r < NTOK; r += NGW) norm_row_bf16(C.out + (size_t)r * D, C.in[I_LNFFN], HN2 + (size_t)r * D, C.lane);
    const size_t n16 = (size_t)16384 * 1024 / 16, gt = (size_t)C.bid * NT + C.tid, GT = (size_t)C.G * NT;
    for (int tb = 0; tb < 2; ++tb) {
        const float* src = C.in[tb ? I_PV : I_PU]; unsigned char* dst = C.ws + (tb ? WS_V8 : WS_U8); const float gain = tb ? 16.f : 256.f;
        for (size_t i = gt; i < n16; i += GT) { v4u o;
#pragma unroll
            for (int q = 0; q < 4; ++q) { const f32x4 a = *(const f32x4*)(src + 16 * i + 4 * q); int w = 0;
                w = __builtin_amdgcn_cvt_pk_fp8_f32(a.x * gain, a.y * gain, w, false); w = __builtin_amdgcn_cvt_pk_fp8_f32(a.z * gain, a.w * gain, w, true); o[q] = (unsigned)w; }
            *(v4u*)(dst + 16 * i) = o; }
    }
}

__device__ __forceinline__ float gelu_tanh(float x) {
    const float y = 0.7978845608028654f * (x + 0.044715f * x * x * x);
    const float e = __expf(2.f * y);
    const float th = 1.f - 2.f * fast_rcp(e + 1.f);
    return 0.5f * x * (1.f + th);
}
template <int CTRL> __device__ __forceinline__ unsigned dppu(unsigned x) { return (unsigned)__builtin_amdgcn_mov_dpp((int)x, CTRL, 0xf, 0xf, true); }
template <int CTRL> __device__ __forceinline__ float dppf(float x) { return __builtin_bit_cast(float, __builtin_amdgcn_mov_dpp(__builtin_bit_cast(int, x), CTRL, 0xf, 0xf, true)); }
__device__ __forceinline__ unsigned row_max_u(unsigned m) { m = max(m, dppu<0xB1>(m)); m = max(m, dppu<0x4E>(m)); m = max(m, dppu<0x141>(m)); m = max(m, dppu<0x128>(m)); return m; }
__device__ __forceinline__ float row_sum_f(float v) { v += dppf<0xB1>(v); v += dppf<0x4E>(v); v += dppf<0x141>(v); v += dppf<0x128>(v); return v; }
__device__ __forceinline__ unsigned mono(float f) { const unsigned b = __builtin_bit_cast(unsigned, f); return b ^ ((unsigned)((int)b >> 31) | 0x80000000u); }
__device__ __forceinline__ float unmono(unsigned u) { const unsigned b = (u & 0x80000000u) ? (u ^ 0x80000000u) : ~u; return __builtin_bit_cast(float, b); }
__device__ __forceinline__ void cand_ij(int c, int& ci, int& cj) {
    if (c < 16) { ci = 0; cj = c; } else if (c < 24) { ci = 1; cj = c - 16; } else if (c < 29) { ci = 2; cj = c - 24; } else if (c < 33) { ci = 3; cj = c - 29; }
    else if (c < 36) { ci = 4; cj = c - 33; } else if (c < 38) { ci = 5; cj = c - 36; } else if (c < 40) { ci = 6; cj = c - 38; } else if (c < 42) { ci = 7; cj = c - 40; }
    else if (c < 50) { ci = c - 34; cj = 0; } else { ci = 0; cj = 0; }
}
constexpr int PEER_LDS_PER_WAVE = 3072;
__device__ __forceinline__ void peer_token(const Ctx& C, int t, bool dry = false) {
    const int lane = C.lane, g = lane >> 4, j = lane & 15;
    const float* SC = (const float*)(C.ws + WS_SC) + (size_t)t * 2048;
    const bf16* HN2 = (const bf16*)(C.ws + WS_HN2) + (size_t)t * D;
    ldsp LST = C.lds + C.wave * PEER_LDS_PER_WAVE; ldsp EL = LST + 2048;
#pragma unroll 1
    for (int P = 0; P < 4; ++P) {
        const float* sp = SC + (4 * P + g) * 128 + 8 * j;
        const f32x4 s0 = *(const f32x4*)sp, s1 = *(const f32x4*)(sp + 4);
        unsigned k[8];
        k[0] = (mono(s0.x) & ~127u) | (unsigned)(127 - (8 * j + 0)); k[1] = (mono(s0.y) & ~127u) | (unsigned)(127 - (8 * j + 1));
        k[2] = (mono(s0.z) & ~127u) | (unsigned)(127 - (8 * j + 2)); k[3] = (mono(s0.w) & ~127u) | (unsigned)(127 - (8 * j + 3));
        k[4] = (mono(s1.x) & ~127u) | (unsigned)(127 - (8 * j + 4)); k[5] = (mono(s1.y) & ~127u) | (unsigned)(127 - (8 * j + 5));
        k[6] = (mono(s1.z) & ~127u) | (unsigned)(127 - (8 * j + 6)); k[7] = (mono(s1.w) & ~127u) | (unsigned)(127 - (8 * j + 7));
        unsigned res = 0u;
#pragma unroll 4
        for (int it = 0; it < 16; ++it) {
            unsigned m = max(max(max(k[0], k[1]), max(k[2], k[3])), max(max(k[4], k[5]), max(k[6], k[7])));
            m = row_max_u(m);
#pragma unroll
            for (int q = 0; q < 8; ++q) k[q] = (k[q] == m) ? 0u : k[q];
            res = (j == it) ? m : res;
        }
        *(LAS v2u*)(LST + ((4 * P + g) * 16 + j) * 8) = (v2u){__builtin_bit_cast(unsigned, unmono(res & ~127u)), 127u - (res & 127u)};
    }
    LDS_WAIT(); asm volatile("" ::: "memory");
    int eA = 0, eB = 0; float wA = 0.f, wB = 0.f;
#pragma unroll
    for (int Q = 0; Q < 2; ++Q) {
        const int h = 4 * Q + g;
        unsigned k[4];
#pragma unroll
        for (int m = 0; m < 4; ++m) {
            const int c = j + 16 * m; int ci, cj; cand_ij(c, ci, cj);
            const v2u a = *(const LAS v2u*)(LST + ((2 * h) * 16 + ci) * 8), b = *(const LAS v2u*)(LST + ((2 * h + 1) * 16 + cj) * 8);
            const float val = __builtin_bit_cast(float, a.x) + __builtin_bit_cast(float, b.x);
            k[m] = (c < 50) ? ((mono(val) & ~63u) | (unsigned)(63 - c)) : 0u;
            *(LAS unsigned*)(EL + (g * 64 + c) * 4) = a.y * 128u + b.y;
        }
        unsigned res = 0u, mtop = 0u;
#pragma unroll 4
        for (int it = 0; it < 16; ++it) {
            unsigned m = max(max(k[0], k[1]), max(k[2], k[3]));
            m = row_max_u(m);
            if (it == 0) mtop = m;
#pragma unroll
            for (int q = 0; q < 4; ++q) k[q] = (k[q] == m) ? 0u : k[q];
            res = (j == it) ? m : res;
        }
        LDS_WAIT(); asm volatile("" ::: "memory");
        const int cw = 63 - (int)(res & 63u);
        const int e = (int)*(const LAS unsigned*)(EL + (g * 64 + cw) * 4);
        const float ex = __expf(unmono(res & ~63u) - unmono(mtop & ~63u));
        const float wgt = ex / row_sum_f(ex);
        if (Q == 0) { eA = e; wA = wgt; } else { eB = e; wB = wgt; }
        LDS_WAIT(); asm volatile("" ::: "memory");
    }
#ifdef DRY_TOPK_ONLY
    if (dry) { ((float*)(C.ws + WS_T1))[(size_t)t * 64 + lane] = (float)(eA + eB) + wA + wB; return; }
#endif
    const unsigned char* U8 = C.ws + WS_U8; const unsigned char* V8 = C.ws + WS_V8;
    f32x2 hx[8];
    { const v4u a = *(const v4u*)(HN2 + 16 * lane), b = *(const v4u*)(HN2 + 16 * lane + 8);
      hx[0] = (f32x2){bflo(a.x), bfhi(a.x)}; hx[1] = (f32x2){bflo(a.y), bfhi(a.y)}; hx[2] = (f32x2){bflo(a.z), bfhi(a.z)}; hx[3] = (f32x2){bflo(a.w), bfhi(a.w)};
      hx[4] = (f32x2){bflo(b.x), bfhi(b.x)}; hx[5] = (f32x2){bflo(b.y), bfhi(b.y)}; hx[6] = (f32x2){bflo(b.z), bfhi(b.z)}; hx[7] = (f32x2){bflo(b.w), bfhi(b.w)}; }
    f32x2 acc[8];
#pragma unroll
    for (int i = 0; i < 8; ++i) acc[i] = (f32x2){0.f, 0.f};
#pragma unroll 1
    for (int p0 = 0; p0 < 128; p0 += 8) {
        const int l0 = p0 & 63; const int ev = p0 < 64 ? eA : eB; const float wv = p0 < 64 ? wA : wB;
        v4u uq[8], vq[8];
#pragma unroll
        for (int q = 0; q < 8; ++q) { const size_t eo = (size_t)__builtin_amdgcn_readlane(ev, l0 + q) * 1024 + 16 * lane;
            uq[q] = *(const v4u*)(U8 + eo); vq[q] = *(const v4u*)(V8 + eo); }
        float dv = 0.f;
#pragma unroll
        for (int q = 0; q < 8; ++q) {
            f32x2 d2 = {0.f, 0.f};
#pragma unroll
            for (int w4 = 0; w4 < 4; ++w4) { const f32x2 lo = __builtin_amdgcn_cvt_pk_f32_fp8((int)uq[q][w4], false), hi = __builtin_amdgcn_cvt_pk_f32_fp8((int)uq[q][w4], true);
                d2 = lo * hx[2 * w4] + d2; d2 = hi * hx[2 * w4 + 1] + d2; }
            float s = row_sum_f(d2.x + d2.y);
            s += __builtin_bit_cast(float, __builtin_amdgcn_update_dpp(0, __builtin_bit_cast(int, s), 0x142, 0xa, 0xf, false));
            s += __builtin_bit_cast(float, __builtin_amdgcn_update_dpp(0, __builtin_bit_cast(int, s), 0x143, 0xc, 0xf, false));
            const float tot = __builtin_bit_cast(float, __builtin_amdgcn_readlane(__builtin_bit_cast(int, s), 63));
            dv = (lane == l0 + q) ? tot : dv;
        }
        const float cfv = wv * gelu_tanh(dv * (1.f / 256.f)) * (1.f / 16.f);
#pragma unroll
        for (int q = 0; q < 8; ++q) {
            const float cf = __builtin_bit_cast(float, __builtin_amdgcn_readlane(__builtin_bit_cast(int, cfv), l0 + q));
#pragma unroll
            for (int w4 = 0; w4 < 4; ++w4) { const f32x2 lo = __builtin_amdgcn_cvt_pk_f32_fp8((int)vq[q][w4], false), hi = __builtin_amdgcn_cvt_pk_f32_fp8((int)vq[q][w4], true);
                acc[2 * w4] = lo * cf + acc[2 * w4]; acc[2 * w4 + 1] = hi * cf + acc[2 * w4 + 1]; }
        }
    }
    float* orow = C.out + (size_t)t * D + 16 * lane; const float* lw = C.in[I_LNF] + 16 * lane;
    f32x4 hv[4]; float s = 0.f;
#pragma unroll
    for (int i = 0; i < 4; ++i) { hv[i] = *(const f32x4*)(orow + 4 * i); hv[i].x += acc[2 * i].x; hv[i].y += acc[2 * i].y; hv[i].z += acc[2 * i + 1].x; hv[i].w += acc[2 * i + 1].y;
        s += (hv[i].x * hv[i].x + hv[i].y * hv[i].y) + (hv[i].z * hv[i].z + hv[i].w * hv[i].w); }
    const float rs = rsqrtf(wave_sum(s) * (1.f / D) + RMS_EPS);
    if (dry) return;
#pragma unroll
    for (int i = 0; i < 4; ++i) { const f32x4 w4 = *(const f32x4*)(lw + 4 * i); *(f32x4*)(orow + 4 * i) = hv[i] * rs * w4; }
}

constexpr int NSTEPS = 36;
#ifndef PH_MASK
#define PH_MASK 0xFF
#endif
#define PH_ON(k) (((PH_MASK) >> (k)) & 1)
struct Args { const float* in[22]; float* out; unsigned char* ws; int ph_lo, ph_hi; };
typedef const __attribute__((address_space(4))) Args* kargp;
__device__ __forceinline__ void ctx_init(Ctx& C, unsigned char* smem) {
    kargp ap = (kargp)__builtin_amdgcn_kernarg_segment_ptr();
    asm volatile("" : "+s"(ap));
    int tid_ = threadIdx.x; asm volatile("" : "+v"(tid_));
    C.lds = (ldsp)smem; C.tid = tid_; C.lane = C.tid & 63; C.wave = __builtin_amdgcn_readfirstlane(C.tid >> 6); C.G = gridDim.x; C.bid = blockIdx.x;
#pragma unroll
    for (int i = 0; i < 22; ++i) C.in[i] = ap->in[i];
    C.out = ap->out; C.ws = ap->ws;
}
__global__ void __launch_bounds__(NT, 2) hyb_fwd(Args args) {
    extern __shared__ __attribute__((aligned(16))) unsigned char smem[];
    volatile LAS unsigned* MISC = (volatile LAS unsigned*)((ldsp)smem + LDSCTL_OFF);
    for (int u = threadIdx.x; u < (LDS_BYTES - LDSCTL_OFF) / 4; u += NT) MISC[u] = 0u;
    __syncthreads();
    const int lo = args.ph_lo, hi = args.ph_hi;
    unsigned* barw = (unsigned*)(args.ws + WS_CTL) + CW_BAR;
    XcdBarrier bar; bar.bar = barw; bar.x = 0; bar.st = MISC + 8;
    if (hi - lo > 1) bar = xcd_barrier_post(barw, MISC + 8);
#pragma unroll 1
    for (int step = lo; step < hi; ++step) {
        int kind, b = 0, gk = 0;
        if (step == 0) kind = 0;
        else if (step <= 32) { b = (step - 1) >> 3; const int k = (step - 1) & 7; gk = k; kind = (k == 0 || k >= 5) ? 1 : k + 1; }
        else if (step == 33) kind = 6;
        else if (step == 34) { kind = 1; gk = 8; }
        else kind = 7;
#ifdef REP_KIND
        for (int rep = (kind == REP_KIND ? 0 : 1); rep < 2; ++rep) {
        const bool dry = (rep == 0);
#else
        const bool dry = false; {
#endif
        Ctx C; ctx_init(C, smem);
        if (kind == 0 && PH_ON(0)) p0_prologue(C);
        else if (kind == 1 && PH_ON(1)) {
            pg8::Gemm g; EpiAny E; E.P.PJ = (bf16*)(C.ws + WS_PJ); E.P.TL = (float*)(C.ws + WS_TL); E.PJ = (const bf16*)(C.ws + WS_PJ); E.T = nullptr; E.O = nullptr; E.gcol = 0; E.X = C.in[I_X]; E.OF = C.out; E.b = b; E.ldc = 2048;
            if (gk == 0)      { g = pg8::Gemm{(const bf16*)(C.ws + WS_HN), (const bf16*)(C.ws + WS_W1T), RPB, N1, 1024}; E.mode = 0; }
            else if (gk == 5) { g = pg8::Gemm{(const bf16*)(C.ws + WS_OG), (const bf16*)(C.ws + WS_WAT), RPB, 1024, 1024}; E.mode = 1; E.O = (bf16*)(C.ws + WS_T1); E.gcol = PJ_GA; }
            else if (gk == 6) { g = pg8::Gemm{(const bf16*)(C.ws + WS_YS), (const bf16*)(C.ws + WS_WBT), RPB, 1024, 2048}; E.mode = 1; E.O = (bf16*)(C.ws + WS_MX); E.gcol = PJ_GB; E.T = (const bf16*)(C.ws + WS_T1); }
            else if (gk == 7) { g = pg8::Gemm{(const bf16*)(C.ws + WS_MX), (const bf16*)(C.ws + WS_WOT), RPB, 1024, 1024}; E.mode = 2; }
            else              { g = pg8::Gemm{(const bf16*)(C.ws + WS_HN2), (const bf16*)(C.ws + WS_WET), NTOK, 2048, 1024}; E.mode = 3; E.OF = (float*)(C.ws + WS_SC); }
            pg8::StaticOrder S; S.init(g.M, g.N, C.G, C.bid);
            pg8::gemm_phase<EpiAny, pg8::StaticOrder, true, true>(C.lds, g, S, E);
            if (gk == 7 && b + 1 < BATCH) hn_batch(C, b + 1);
        }
        else if (kind == 2 && PH_ON(2)) { for (int c = C.bid; c < NCHUNK; c += C.G) phaseC_unit(C, c); }
        else if (kind == 3 && PH_ON(3)) { for (int u = C.bid; u < NCHUNK * 8; u += C.G) { const int c = u >> 3, k = u & 7; if (k < 4) gla_pass1_unit(C, c, k); else ssd_pass1_unit(C, c, k - 4); } }
        else if (kind == 4 && PH_ON(4)) phaseE(C);
        else if (kind == 5 && PH_ON(5)) { for (int u = C.bid; u < NCHUNK * 8; u += C.G) { const int c = u >> 3, k = u & 7; if (k < 4) gla_pass3_unit(C, c, k); else ssd_pass3_unit(C, c, k - 4); } }
        else if (kind == 6 && PH_ON(6)) phaseJ(C);
        else if (kind == 7 && PH_ON(7)) { const int gw = C.bid * NWAVES + C.wave, NGW = C.G * NWAVES; for (int t = gw; t < NTOK; t += NGW) peer_token(C, t, dry); }
#ifdef REP_KIND
        if (rep == 0) xcd_barrier(bar);
#endif
        }
        if (step + 1 < hi) xcd_barrier(bar);
    }
}

#ifdef DBG_STOP
__global__ void dbg_digest(const unsigned* w, size_t nwords, float* out, size_t nout) {
    for (size_t i = (size_t)blockIdx.x * blockDim.x + threadIdx.x; i < nout; i += (size_t)gridDim.x * blockDim.x) {
        unsigned h = 0; for (size_t j = i; j < nwords; j += nout) h ^= w[j] * 2654435761u + (unsigned)(j / nout);
        out[i] = (float)(h & 0xFFFFFFu);
    }
}
#endif
#ifndef HYB_N_LAUNCHES
#define HYB_N_LAUNCHES 1
#endif
extern "C" void kernel_launch(void* const* d_in, const int* in_sizes, int n_in, void* d_out, int out_size, void* d_ws, size_t ws_size, hipStream_t stream) {
    static int grid = 0;
    if (grid == 0) {
        if (n_in != 22 || out_size != NTOK * D || ws_size < WS_END) { fprintf(stderr, "kernel_launch: unexpected shapes: n_in %d out %d ws %zu (need %zu)\n", n_in, out_size, ws_size, (size_t)WS_END); grid = -1; return; }
        int dev = 0, cus = 0, per_cu = 0;
        if (hipGetDevice(&dev) != hipSuccess || hipDeviceGetAttribute(&cus, hipDeviceAttributeMultiprocessorCount, dev) != hipSuccess) { grid = -1; return; }
        if (hipFuncSetAttribute((const void*)hyb_fwd, hipFuncAttributeMaxDynamicSharedMemorySize, LDS_BYTES) != hipSuccess) { fprintf(stderr, "kernel_launch: hipFuncSetAttribute failed\n"); grid = -1; return; }
        if (hipOccupancyMaxActiveBlocksPerMultiprocessor(&per_cu, (const void*)hyb_fwd, NT, LDS_BYTES) != hipSuccess || per_cu < 1) { fprintf(stderr, "kernel_launch: occupancy query says %d blocks per CU\n", per_cu); per_cu = 1; }
        (void)hipGetLastError();
        grid = cus;
    }
    if (grid < 0) return;
    (void)hipMemsetAsync((char*)d_ws + WS_CTL, 0, CTL_ZERO_BYTES, stream);
    Args a{};
    for (int i = 0; i < 22; ++i) a.in[i] = (const float*)d_in[i];
    a.out = (float*)d_out; a.ws = (unsigned char*)d_ws;
    if (HYB_N_LAUNCHES == 1) { a.ph_lo = 0; a.ph_hi = NSTEPS; hipLaunchKernelGGL(hyb_fwd, dim3(grid), dim3(NT), LDS_BYTES, stream, a); }
    else {
#ifdef DBG_STOP
        for (int s = 0; s <= DBG_STOP; ++s) { a.ph_lo = s; a.ph_hi = s + 1; hipLaunchKernelGGL(hyb_fwd, dim3(grid), dim3(NT), LDS_BYTES, stream, a); }
        hipLaunchKernelGGL(dbg_digest, dim3(2048), dim3(256), 0, stream, (const unsigned*)((char*)d_ws + (size_t)(DBG_OFF)), (size_t)(DBG_LEN) / 4, (float*)d_out, (size_t)NTOK * D);
#else
        for (int s = 0; s < NSTEPS; ++s) { a.ph_lo = s; a.ph_hi = s + 1; hipLaunchKernelGGL(hyb_fwd, dim3(grid), dim3(NT), LDS_BYTES, stream, a); }
#endif
    }
}
```

```cpp
#include <hip/hip_runtime.h>
#include <cstdio>
#include <cstdint>
namespace pg8 {
#define PG8_LAS __attribute__((address_space(3)))
typedef unsigned short bf16_t;
typedef short bf16x8 __attribute__((ext_vector_type(8)));
typedef float f32x4 __attribute__((ext_vector_type(4)));
typedef unsigned u32x4 __attribute__((ext_vector_type(4)));
constexpr int BM = 256, BK = 64, HALF = 128, HTB = HALF * BK * 2  , STAGE_BYTES = 8 * HTB, NXCD = 8, WGM = 8;

__host__ __device__ __forceinline__ int lds_byte(int r, int c) { const int st = (r >> 4) * 2 + (c >> 5), rr = r & 15, cc = c & 31, ob = rr * 64 + cc * 2; return st * 1024 + (ob ^ (((ob >> 9) & 1) << 5)); }
__host__ __device__ __forceinline__ void stage_rc(int b, int& R, int& C) { const int st = b / 1024, sb = b % 1024, swz = sb ^ (((sb >> 9) & 1) << 5); R = (st >> 1) * 16 + swz / 64; C = (st & 1) * 32 + (swz % 64) / 2; }
__host__ __device__ __forceinline__ int perm32(int rho) { const int n = rho >> 4, i = rho & 15; return 8 * (i >> 2) + 4 * n + (i & 3); }

struct Unit { int pm, pn; };
struct Gemm { const bf16_t* A; const bf16_t* Bt; int M, N, K; };

struct StaticOrder {
    int nM, nN, nwg, G, c;
    __host__ __device__ void init(int M, int N, int G_, int c_) { nM = M / BM; nN = N / BM; nwg = nM * nN; G = G_; c = c_; }
    __host__ __device__ bool next(int i, Unit& u) const {
        const long L = (long)i * G + c; if (L >= nwg) return false;
        int wgid = (int)L; { const int q = nwg / NXCD, r = nwg % NXCD, xcd = wgid % NXCD, off = wgid / NXCD; wgid = (xcd < r ? xcd * (q + 1) : r * (q + 1) + (xcd - r) * q) + off; }
        const int nig = WGM * nN, gid = wgid / nig, fm = gid * WGM, gsz = (nM - fm) < WGM ? (nM - fm) : WGM;
        u.pm = fm + ((wgid % nig) % gsz); u.pn = (wgid % nig) / gsz; return true;
    }
    __device__ __forceinline__ void a_ready(const Unit&) const {}
    __device__ __forceinline__ void done(const Unit&) const {}
};

typedef float f32x2_t __attribute__((ext_vector_type(2))); typedef __bf16 bf16x2_t __attribute__((ext_vector_type(2)));
__device__ __forceinline__ unsigned cvt_pk_bf16(float lo, float hi) { f32x2_t v = {lo, hi}; bf16x2_t b = __builtin_convertvector(v, bf16x2_t); return __builtin_bit_cast(unsigned, b); }
template <class Epi, class Sched, bool ALIGN_EPI = false, bool SP2 = false>
__device__ __forceinline__ void gemm_phase(PG8_LAS unsigned char* lds, const Gemm g, const Sched& S, const Epi& E) {
    int tid_ = threadIdx.x; asm volatile("" : "+v"(tid_));
    const int tid = tid_, wid = __builtin_amdgcn_readfirstlane(tid >> 6), lane = tid & 63, wr = wid >> 2, wc = wid & 3, fr = lane & 15, fq = lane >> 4;
    const int K = g.K, nt = K / BK;
    unsigned voffA[2], voffB[2];
#pragma unroll
    for (int i = 0; i < 2; ++i) { int R, C; stage_rc(tid * 16 + i * 8192, R, C); const int Rb = Epi::PERM ? ((R & ~31) + perm32(R & 31)) : R;
        voffA[i] = (unsigned)(R * K + C) * 2u; voffB[i] = (unsigned)(Rb * K + C) * 2u; }
    const size_t kstep = (size_t)(BK * 2);
    const size_t hstep = (size_t)HALF * K * 2;
    const size_t tstep = 2 * hstep;
    const unsigned ldsw = (unsigned)wid * 1024u;
    const int aoff = lds_byte(wr * 64 + fr, fq * 8), boff = lds_byte(wc * 32 + fr, fq * 8);
#define PG8_SA(b, h) (((b) * 2 + (h)) * HTB)
#define PG8_SB(b, h) ((4 + (b) * 2 + (h)) * HTB)
#define PG8_STAGE(bufoff, gbase, voff) do { _Pragma("unroll") for (int _i = 0; _i < 2; ++_i) \
        __builtin_amdgcn_global_load_lds((const unsigned*)((const char*)(gbase) + (voff)[_i]), (PG8_LAS unsigned*)(lds + (bufoff) + ldsw + _i * 8192), 16, 0, 0); } while (0)
#define PG8_LDA(dst, b, h) do { _Pragma("unroll") for (int m = 0; m < 4; ++m) _Pragma("unroll") for (int k = 0; k < 2; ++k) dst[m][k] = *(const PG8_LAS bf16x8*)(lds + PG8_SA(b, h) + aoff + m * 2048 + k * 1024); } while (0)
#define PG8_LDB(dst, b, h) do { _Pragma("unroll") for (int n = 0; n < 2; ++n) _Pragma("unroll") for (int k = 0; k < 2; ++k) dst[n][k] = *(const PG8_LAS bf16x8*)(lds + PG8_SB(b, h) + boff + n * 2048 + k * 1024); } while (0)
#define PG8_MMA(ai, bj, At, Bt) do { __builtin_amdgcn_s_setprio(1); _Pragma("unroll") for (int m = 0; m < 4; ++m) _Pragma("unroll") for (int n = 0; n < 2; ++n) _Pragma("unroll") for (int k = 0; k < 2; ++k) \
        acc[ai][bj][m][n] = __builtin_amdgcn_mfma_f32_16x16x32_bf16(Bt[n][k], At[m][k], acc[ai][bj][m][n], 0, 0, 0); __builtin_amdgcn_s_setprio(0); } while (0)
#define PG8_WAIT_V(n) asm volatile("s_waitcnt vmcnt(" #n ")" ::: "memory")
#define PG8_WAIT_L(n) asm volatile("s_waitcnt lgkmcnt(" #n ")" ::: "memory")
#define PG8_BAR __builtin_amdgcn_s_barrier()
#define PG8_SCHED __builtin_amdgcn_sched_barrier(0)
    Unit cur, nxt; int ui = 0;
    if (!S.next(0, cur)) return;
    f32x4 acc[2][2][4][2];
#pragma unroll
    for (int a = 0; a < 2; ++a)
#pragma unroll
        for (int b = 0; b < 2; ++b)
#pragma unroll
            for (int m = 0; m < 4; ++m)
#pragma unroll
                for (int n = 0; n < 2; ++n) acc[a][b][m][n] = (f32x4){0.f, 0.f, 0.f, 0.f};
    bf16x8 At[4][2], B0[2][2], B1[2][2];
    const char* cA = (const char*)g.A + (size_t)cur.pm * tstep; const char* cB = (const char*)g.Bt + (size_t)cur.pn * tstep;
    S.a_ready(cur);
    if constexpr (SP2) {
        PG8_STAGE(PG8_SB(0, 0), cB, voffB); PG8_STAGE(PG8_SB(0, 1), cB + hstep, voffB); PG8_STAGE(PG8_SA(0, 0), cA, voffA); PG8_STAGE(PG8_SA(0, 1), cA + hstep, voffA);
        if (wr == 1) PG8_BAR;
        PG8_WAIT_V(2); PG8_BAR;
        PG8_STAGE(PG8_SB(1, 0), cB + kstep, voffB); PG8_STAGE(PG8_SA(1, 0), cA + kstep, voffA); PG8_STAGE(PG8_SB(1, 1), cB + hstep + kstep, voffB);
        PG8_WAIT_V(6); PG8_BAR;
    } else {
        PG8_STAGE(PG8_SB(0, 0), cB, voffB); PG8_STAGE(PG8_SA(0, 0), cA, voffA); PG8_STAGE(PG8_SB(0, 1), cB + hstep, voffB); PG8_STAGE(PG8_SA(0, 1), cA + hstep, voffA);
        if (wr == 1) PG8_BAR;
        PG8_WAIT_V(4); PG8_BAR;
        PG8_STAGE(PG8_SB(1, 0), cB + kstep, voffB); PG8_STAGE(PG8_SA(1, 0), cA + kstep, voffA); PG8_STAGE(PG8_SB(1, 1), cB + hstep + kstep, voffB);
        PG8_WAIT_V(6); PG8_BAR;
    }
    for (;;) {
        const bool has_next = S.next(ui + 1, nxt);
        const char* nA = has_next ? (const char*)g.A + (size_t)nxt.pm * tstep : cA; const char* nB = has_next ? (const char*)g.Bt + (size_t)nxt.pn * tstep : cB;
        for (int t = 0; t < nt; t += 2) {
            const bool last = (t == nt - 2);
            const char* a1 = cA + (size_t)(t + 1) * kstep;
            const char* a2 = last ? nA : cA + (size_t)(t + 2) * kstep; const char* b2 = last ? nB : cB + (size_t)(t + 2) * kstep;
            const char* a3 = a2 + kstep; const char* b3 = b2 + kstep;
            if (last && has_next) S.a_ready(nxt);
            if constexpr (SP2) {
            PG8_LDB(B0, 0, 0); PG8_LDB(B1, 0, 1); PG8_SCHED; PG8_LDA(At, 0, 0); PG8_STAGE(PG8_SA(1, 1), a1 + hstep, voffA);
            PG8_WAIT_V(8); PG8_WAIT_L(0); PG8_BAR; PG8_MMA(0, 0, At, B0); PG8_MMA(0, 1, At, B1); PG8_BAR; PG8_SCHED;
            PG8_LDA(At, 0, 1); PG8_STAGE(PG8_SB(0, 0), b2, voffB); PG8_STAGE(PG8_SB(0, 1), b2 + hstep, voffB); PG8_STAGE(PG8_SA(0, 0), a2, voffA);
            PG8_WAIT_V(8); PG8_WAIT_L(0); PG8_BAR; PG8_MMA(1, 0, At, B0); PG8_MMA(1, 1, At, B1); PG8_BAR; PG8_SCHED;
            PG8_LDB(B0, 1, 0); PG8_LDB(B1, 1, 1); PG8_SCHED; PG8_LDA(At, 1, 0); PG8_STAGE(PG8_SA(0, 1), a2 + hstep, voffA);
            PG8_WAIT_V(8); PG8_WAIT_L(0); PG8_BAR; PG8_MMA(0, 0, At, B0); PG8_MMA(0, 1, At, B1); PG8_BAR; PG8_SCHED;
            PG8_LDA(At, 1, 1); PG8_STAGE(PG8_SB(1, 0), b3, voffB); PG8_STAGE(PG8_SB(1, 1), b3 + hstep, voffB); PG8_STAGE(PG8_SA(1, 0), a3, voffA);
            PG8_WAIT_V(8); PG8_WAIT_L(0); PG8_BAR; PG8_MMA(1, 0, At, B0); PG8_MMA(1, 1, At, B1); PG8_BAR; PG8_SCHED;
            } else {
            PG8_LDB(B0, 0, 0); PG8_SCHED; PG8_LDA(At, 0, 0); PG8_STAGE(PG8_SA(1, 1), a1 + hstep, voffA);
            PG8_WAIT_L(8); PG8_BAR; PG8_WAIT_L(0); PG8_MMA(0, 0, At, B0); PG8_BAR; PG8_SCHED;
            PG8_LDB(B1, 0, 1); PG8_STAGE(PG8_SB(0, 0), b2, voffB);
            PG8_BAR; PG8_WAIT_L(0); PG8_MMA(0, 1, At, B1); PG8_BAR;
            PG8_LDA(At, 0, 1); PG8_STAGE(PG8_SA(0, 0), a2, voffA);
            PG8_BAR; PG8_WAIT_L(0); PG8_MMA(1, 0, At, B0); PG8_BAR; PG8_SCHED;
            PG8_STAGE(PG8_SB(0, 1), b2 + hstep, voffB);
            PG8_WAIT_V(6); PG8_BAR; PG8_MMA(1, 1, At, B1); PG8_BAR;
            PG8_LDB(B0, 1, 0); PG8_SCHED; PG8_LDA(At, 1, 0); PG8_STAGE(PG8_SA(0, 1), a2 + hstep, voffA);
            PG8_WAIT_L(8); PG8_BAR; PG8_WAIT_L(0); PG8_MMA(0, 0, At, B0); PG8_BAR; PG8_SCHED;
            PG8_LDB(B1, 1, 1); PG8_STAGE(PG8_SB(1, 0), b3, voffB);
            PG8_BAR; PG8_WAIT_L(0); PG8_MMA(0, 1, At, B1); PG8_BAR;
            PG8_LDA(At, 1, 1); PG8_STAGE(PG8_SA(1, 0), a3, voffA);
            PG8_BAR; PG8_WAIT_L(0); PG8_MMA(1, 0, At, B0); PG8_BAR; PG8_SCHED;
            PG8_STAGE(PG8_SB(1, 1), b3 + hstep, voffB);
            PG8_WAIT_V(6); PG8_BAR; PG8_MMA(1, 1, At, B1); PG8_BAR;
            }
        }
        if constexpr (ALIGN_EPI) { if (wr == 0) PG8_BAR; }
        if constexpr (!Epi::AFTER_DRAIN) { E(acc, cur, wr, wc, fr, fq); S.done(cur); }
        if (!has_next) break;
#pragma unroll
        for (int a = 0; a < 2; ++a)
#pragma unroll
            for (int b = 0; b < 2; ++b)
#pragma unroll
                for (int m = 0; m < 4; ++m)
#pragma unroll
                    for (int n = 0; n < 2; ++n) acc[a][b][m][n] = (f32x4){0.f, 0.f, 0.f, 0.f};
        cur = nxt; cA = nA; cB = nB; ++ui;
        if constexpr (ALIGN_EPI) { if (wr == 1) PG8_BAR; }
    }
    PG8_WAIT_V(0);
    if constexpr (!ALIGN_EPI) { if (wr == 0) PG8_BAR; }
    PG8_BAR;
    if constexpr (Epi::AFTER_DRAIN) { E.fused(acc, cur, wr, wc, fr, fq, lds, wid, lane); S.done(cur); }
#undef PG8_SA
#undef PG8_SB
#undef PG8_STAGE
#undef PG8_LDA
#undef PG8_LDB
#undef PG8_MMA
#undef PG8_WAIT_V
#undef PG8_WAIT_L
#undef PG8_BAR
#undef PG8_SCHED
}
}

constexpr int NWAVES = 8, NT = 512;
constexpr int D = 1024, BATCH = 4, SEQ = 8192, NMETA = 16;
constexpr int RPB = 8448;
constexpr int RFRONT = 48, RTOK = 64, REND = 8256;
constexpr int NCHUNK = 129;
constexpr int NPJ = 10240;
constexpr int N1 = 10496;
constexpr int PJ_Q = 0, PJ_K = 512, PJ_V = 1024, PJ_GO = 2048, PJ_Z = 3072, PJ_XBC = 5120, PJ_GA = 8192, PJ_GB = 9216;
constexpr int NTOK = BATCH * SEQ;
constexpr float RMS_EPS = 1e-6f;

constexpr size_t MiB = 1u << 20;
constexpr size_t WS_CTL = 0, CTL_ZERO_BYTES = 1 * MiB;
constexpr size_t WS_W1T = 2 * MiB;
constexpr size_t WS_WAT = 23 * MiB;
constexpr size_t WS_WBT = 25 * MiB;
constexpr size_t WS_WOT = 29 * MiB;
constexpr size_t WS_WET = 31 * MiB;
constexpr size_t WS_HNM = 35 * MiB;
constexpr size_t WS_HN = 36 * MiB;
constexpr size_t WS_PJ = 53 * MiB;
constexpr size_t WS_TL = 218 * MiB;
constexpr size_t WS_XC = 220 * MiB;
constexpr size_t WS_GG = 270 * MiB;
constexpr size_t WS_DT = 287 * MiB;
constexpr size_t WS_AC = 289 * MiB;
constexpr size_t WS_LG = 291 * MiB;
constexpr size_t WS_LS = 324 * MiB;
constexpr size_t WS_OG = 389 * MiB;
constexpr size_t WS_YS = 406 * MiB;
constexpr size_t WS_T1 = 439 * MiB;
constexpr size_t WS_MX = 456 * MiB;
constexpr size_t WS_MIX_END = 473 * MiB;
constexpr size_t WS_HN2 = 36 * MiB;
constexpr size_t WS_SC = 100 * MiB;
constexpr size_t WS_U8 = 356 * MiB;
constexpr size_t WS_V8 = 372 * MiB;
constexpr size_t WS_END = 473 * MiB;
constexpr int CW_BAR = 4096;

constexpr int LDS_WORK = 147456;
constexpr int LDSCTL_OFF = LDS_WORK;
constexpr int LDS_BYTES = LDS_WORK + 512;

#define GAS __attribute__((address_space(1)))
#define LAS __attribute__((address_space(3)))
typedef unsigned short bf16;
typedef unsigned v4u __attribute__((ext_vector_type(4)));
typedef unsigned v2u __attribute__((ext_vector_type(2)));
typedef float f32x4 __attribute__((ext_vector_type(4)));
typedef float f32x2 __attribute__((ext_vector_type(2)));
typedef short bf16x8 __attribute__((ext_vector_type(8)));
typedef short s16x4 __attribute__((ext_vector_type(4)));
typedef short v4i16_t __attribute__((ext_vector_type(4)));
typedef LAS unsigned char* ldsp;
#define RLX_AGENT __ATOMIC_RELAXED, __HIP_MEMORY_SCOPE_AGENT
#define LDS_WAIT() asm volatile("s_waitcnt lgkmcnt(0)" ::: "memory")

__device__ __forceinline__ unsigned pk2(float lo, float hi) { return pg8::cvt_pk_bf16(lo, hi); }
__device__ __forceinline__ float bflo(unsigned u) { return __builtin_bit_cast(float, u << 16); }
__device__ __forceinline__ float bfhi(unsigned u) { return __builtin_bit_cast(float, u & 0xffff0000u); }
__device__ __forceinline__ float fast_rcp(float x) { return __builtin_amdgcn_rcpf(x); }
__device__ __forceinline__ float sigmoidf_(float x) { return fast_rcp(1.f + __expf(-x)); }
__device__ __forceinline__ float siluf_(float x) { return x * sigmoidf_(x); }
__device__ __forceinline__ float wave_sum(float v) {
#pragma unroll
    for (int o = 1; o < 64; o <<= 1) v += __shfl_xor(v, o);
    return v;
}
__device__ __forceinline__ float wave_max(float v) {
#pragma unroll
    for (int o = 1; o < 64; o <<= 1) v = fmaxf(v, __shfl_xor(v, o));
    return v;
}
__device__ __forceinline__ f32x4 mma16(bf16x8 a, bf16x8 b, f32x4 c) { return __builtin_amdgcn_mfma_f32_16x16x32_bf16(b, a, c, 0, 0, 0); }
__device__ __forceinline__ bf16x8 lds_frag(ldsp p) { return *(const LAS bf16x8*)p; }
__device__ __forceinline__ s16x4 lds_tr(ldsp p) { return __builtin_bit_cast(s16x4, __builtin_amdgcn_ds_read_tr16_b64_v4i16((LAS v4i16_t*)p)); }
__device__ __forceinline__ bf16x8 tr_frag(ldsp tile, int pitch, int k0, int n0, int fr, int fq) {
#ifdef TR_SLOW
    bf16x8 r;
#pragma unroll
    for (int e = 0; e < 8; ++e) r[e] = *(const LAS short*)(tile + (k0 + 8 * fq + e) * pitch + (n0 + fr) * 2);
    return r;
#else
    ldsp p = tile + (k0 + 8 * fq + (fr >> 2)) * pitch + (n0 + 4 * (fr & 3)) * 2;
    const s16x4 lo = lds_tr(p), hi = lds_tr(p + 4 * pitch);
    bf16x8 r; r[0] = lo[0]; r[1] = lo[1]; r[2] = lo[2]; r[3] = lo[3]; r[4] = hi[0]; r[5] = hi[1]; r[6] = hi[2]; r[7] = hi[3];
    return r;
#endif
}

#define XB_TMO      128
#define XB_XCNT(j)  (256  + 64 * (j))
#define XB_XSUB(j)  (1280 + 64 * (j))
#define XB_XGEN(j)  (2304 + 64 * (j))
#define XB_TOP      3328
#define XB_TOPGEN   3392
#define XCD_BAR_WORDS 3456
#define XB_SPIN_CAP (1u << 22)
__device__ __forceinline__ unsigned xb_ld(unsigned* p)              { return __hip_atomic_load(p, __ATOMIC_RELAXED, __HIP_MEMORY_SCOPE_AGENT); }
__device__ __forceinline__ unsigned xb_add(unsigned* p, unsigned v) { return __hip_atomic_fetch_add(p, v, __ATOMIC_RELAXED, __HIP_MEMORY_SCOPE_AGENT); }
__device__ __forceinline__ unsigned xb_xcc_id() { return (unsigned)__builtin_amdgcn_s_getreg((3 << 11) | 20) & 0xFu; }
#define XB_SPIN(cond, bar) do { unsigned _sp = 0; while (cond) { __builtin_amdgcn_s_sleep(1); \
    if ((++_sp & 255u) == 0u) { if (xb_ld(&(bar)[XB_TMO])) break; if (_sp > XB_SPIN_CAP) { atomicAdd(&(bar)[XB_TMO], 1u); break; } } } } while (0)
struct XcdBarrier { unsigned* bar; unsigned x; volatile LAS unsigned* st; };
__device__ __forceinline__ XcdBarrier xcd_barrier_post(unsigned* bar, volatile LAS unsigned* st) {
    XcdBarrier b; b.bar = bar; b.x = xb_xcc_id(); b.st = st;
    if (threadIdx.x == 0) (void)xb_add(&bar[XB_XCNT(b.x)], 1u);
    return b;
}
__device__ __forceinline__ void xcd_barrier_complete(unsigned* bar, unsigned x, unsigned& nloc, unsigned& nx) {
    const unsigned G = gridDim.x * gridDim.y * gridDim.z;
    unsigned sum, cnt, mine, sp = 0u;
    for (;;) {
        sum = 0u; cnt = 0u; mine = 0u;
#pragma unroll
        for (unsigned j = 0; j < 16; ++j) { const unsigned c = xb_ld(&bar[XB_XCNT(j)]); sum += c; cnt += (c > 0u) ? 1u : 0u; mine = (j == x) ? c : mine; }
        if (sum == G) break;
        __builtin_amdgcn_s_sleep(1);
        if ((++sp & 255u) == 0u) { if (xb_ld(&bar[XB_TMO])) break; if (sp > XB_SPIN_CAP) { atomicAdd(&bar[XB_TMO], 1u); break; } }
    }
    nloc = mine > 0u ? mine : 1u; nx = cnt > 0u ? cnt : 1u;
}
__device__ __forceinline__ void xcd_barrier(const XcdBarrier& b) {
    asm volatile("s_waitcnt vmcnt(0)" ::: "memory");
    __syncthreads();
    if (threadIdx.x == 0) {
        unsigned* bar = b.bar;
        __builtin_amdgcn_s_waitcnt(0);
        unsigned nloc = b.st[0], nx = b.st[1];
        if (nloc == 0u) { xcd_barrier_complete(bar, b.x, nloc, nx); b.st[0] = nloc; b.st[1] = nx; }
        const unsigned old = xb_add(&bar[XB_XSUB(b.x)], 1u);
        const unsigned gen = old / nloc;
        if (old + 1u == (gen + 1u) * nloc) {
            __builtin_amdgcn_fence(__ATOMIC_RELEASE, "agent");
            asm volatile("s_waitcnt vmcnt(0)" ::: "memory");
            const unsigned og = xb_add(&bar[XB_TOP], 1u);
            const unsigned tg = og / nx;
            if (og + 1u == (tg + 1u) * nx) xb_add(&bar[XB_TOPGEN], 1u);
            else XB_SPIN(xb_ld(&bar[XB_TOPGEN]) == tg, bar);
            __builtin_amdgcn_fence(__ATOMIC_ACQUIRE, "agent");
            xb_add(&bar[XB_XGEN(b.x)], 1u);
            asm volatile("s_waitcnt vmcnt(0)" ::: "memory");
        } else {
            XB_SPIN(xb_ld(&bar[XB_XGEN(b.x)]) == gen, bar);
            __builtin_amdgcn_fence(__ATOMIC_ACQUIRE, "agent");
            asm volatile("s_waitcnt vmcnt(0)" ::: "memory");
        }
    }
    __syncthreads();
}

struct Ctx {
    ldsp lds; int tid, lane, wave, G, bid;
    const float* in[22]; float* out; unsigned char* ws;
};
enum { I_X = 0, I_META, I_LNMIX, I_WIN, I_WG2, I_BG, I_GNW, I_CONVW, I_CONVB, I_DTB, I_ALOG, I_DSKIP, I_SNW, I_WUG, I_WUS, I_WOUT, I_LNFFN, I_WQ, I_KEYS, I_PU, I_PV, I_LNF };

using pg8::Unit; using pg8::cvt_pk_bf16;
struct EpiProj {
    static constexpr bool PERM = true, AFTER_DRAIN = false;
    bf16* PJ; float* TL;
    __device__ __forceinline__ void operator()(const f32x4 (&acc)[2][2][4][2], const Unit& u, int wr, int wc, int fr, int fq) const {
        const int row0 = RTOK + u.pm * 256 + wr * 64 + fr; const int pn = u.pn;
        const int mode = pn < 2 ? 1 : (pn < 8 ? 0 : (pn < 20 ? 2 : (pn < 32 ? 0 : 3)));
        const int col0 = pn * 256 + wc * 32 + 8 * fq;
#pragma unroll
        for (int ai = 0; ai < 2; ++ai)
#pragma unroll
            for (int m = 0; m < 4; ++m) { bf16* rowp = PJ + (size_t)(row0 + ai * 128 + m * 16) * NPJ + col0;
#pragma unroll
                for (int bj = 0; bj < 2; ++bj) { f32x4 v0 = acc[ai][bj][m][0], v1 = acc[ai][bj][m][1];
                    if (mode == 1) { v0 = v0 * 0.08838834764831845f; v1 = v1 * 0.08838834764831845f; }
                    else if (mode == 2) {
#pragma unroll
                        for (int j = 0; j < 4; ++j) { v0[j] = siluf_(v0[j]); v1[j] = siluf_(v1[j]); } }
                    else if (mode == 3) {
#pragma unroll
                        for (int j = 0; j < 4; ++j) { v0[j] = sigmoidf_(v0[j]); v1[j] = sigmoidf_(v1[j]); } }
                    v4u w; w.x = cvt_pk_bf16(v0[0], v0[1]); w.y = cvt_pk_bf16(v0[2], v0[3]); w.z = cvt_pk_bf16(v1[0], v1[1]); w.w = cvt_pk_bf16(v1[2], v1[3]);
                    *(v4u*)(rowp + bj * 128) = w; } }
    }
};
struct EpiAny {
    static constexpr bool PERM = true, AFTER_DRAIN = false;
    int mode;
    EpiProj P; bf16* O; const bf16* PJ; const bf16* T; int gcol; const float* X; float* OF; int b; int ldc;
    __device__ __forceinline__ void operator()(const f32x4 (&acc)[2][2][4][2], const Unit& u, int wr, int wc, int fr, int fq) const {
        if (mode == 0) { P(acc, u, wr, wc, fr, fq); return; }
        const int row0 = u.pm * 256 + wr * 64 + fr; const int col0 = u.pn * 256 + wc * 32 + 8 * fq;
        if (mode == 1) {
#pragma unroll
            for (int ai = 0; ai < 2; ++ai)
#pragma unroll
                for (int m = 0; m < 4; ++m) { const size_t r = (size_t)(row0 + ai * 128 + m * 16);
#pragma unroll
                    for (int bj = 0; bj < 2; ++bj) { const int c = col0 + bj * 128;
                        const v4u g = *(const v4u*)(PJ + r * NPJ + gcol + c);
                        f32x4 v0 = acc[ai][bj][m][0], v1 = acc[ai][bj][m][1];
                        v0[0] *= bflo(g.x); v0[1] *= bfhi(g.x); v0[2] *= bflo(g.y); v0[3] *= bfhi(g.y); v1[0] *= bflo(g.z); v1[1] *= bfhi(g.z); v1[2] *= bflo(g.w); v1[3] *= bfhi(g.w);
                        if (T) { const v4u t = *(const v4u*)(T + r * 1024 + c);
                            v0[0] += bflo(t.x); v0[1] += bfhi(t.x); v0[2] += bflo(t.y); v0[3] += bfhi(t.y); v1[0] += bflo(t.z); v1[1] += bfhi(t.z); v1[2] += bflo(t.w); v1[3] += bfhi(t.w); }
                        v4u w; w.x = cvt_pk_bf16(v0[0], v0[1]); w.y = cvt_pk_bf16(v0[2], v0[3]); w.z = cvt_pk_bf16(v1[0], v1[1]); w.w = cvt_pk_bf16(v1[2], v1[3]);
                        *(v4u*)(O + r * 1024 + c) = w; } }
        } else if (mode == 2) {
#pragma unroll
            for (int ai = 0; ai < 2; ++ai)
#pragma unroll
                for (int m = 0; m < 4; ++m) { const int r = row0 + ai * 128 + m * 16;
                    if (r >= RTOK && r < REND) { const size_t o = ((size_t)b * SEQ + (r - RTOK)) * D + col0;
#pragma unroll
                        for (int bj = 0; bj < 2; ++bj)
#pragma unroll
                            for (int n = 0; n < 2; ++n) { const f32x4 xv = *(const f32x4*)(X + o + bj * 128 + n * 4); *(f32x4*)(OF + o + bj * 128 + n * 4) = acc[ai][bj][m][n] + xv; } } }
        } else {
#pragma unroll
            for (int ai = 0; ai < 2; ++ai)
#pragma unroll
                for (int m = 0; m < 4; ++m) { float* rowp = OF + (size_t)(row0 + ai * 128 + m * 16) * ldc + col0;
#pragma unroll
                    for (int bj = 0; bj < 2; ++bj)
#pragma unroll
                        for (int n = 0; n < 2; ++n) *(f32x4*)(rowp + bj * 128 + n * 4) = acc[ai][bj][m][n]; }
        }
    }
};

struct MapIdent { __device__ __forceinline__ int operator()(int n) const { return n; } };
struct MapW1 { __device__ __forceinline__ int operator()(int n) const {
    if (n < 3072) return n;
    if (n < 8192) return n + 16;
    if (n < 10240) return n + 48;
    if (n < 10256) return n - 10240 + 3072;
    if (n < 10288) return n - 10256 + 8208;
    return -1; } };
template <class Map>
__device__ __forceinline__ void transpose_item(const float* W, int K, int NS, int N, bf16* WT, LAS float* scr, int item, int lane, const Map& map) {
    const int nblk = N / 32, kb = item / nblk, nb = item % nblk, k0 = 64 * kb, n0 = 32 * nb;
    const int sc = map(n0 + (lane & 31));
#pragma unroll 8
    for (int i = 0; i < 32; ++i) { const int kk = 2 * i + (lane >> 5); scr[kk * 33 + (lane & 31)] = sc >= 0 ? W[(size_t)(k0 + kk) * NS + sc] : 0.f; }
    LDS_WAIT(); asm volatile("" ::: "memory");
    const int c = lane & 7;
#pragma unroll
    for (int j = 0; j < 4; ++j) { const int n = (lane >> 3) + 8 * j; const LAS float* s = scr + (8 * c) * 33 + n;
        v4u o; o.x = pk2(s[0 * 33], s[1 * 33]); o.y = pk2(s[2 * 33], s[3 * 33]); o.z = pk2(s[4 * 33], s[5 * 33]); o.w = pk2(s[6 * 33], s[7 * 33]);
        *(v4u*)(WT + (size_t)(n0 + n) * K + k0 + 8 * c) = o; }
    LDS_WAIT(); asm volatile("" ::: "memory");
}
__device__ __forceinline__ void norm_row_bf16(const float* src, const float* w, bf16* dst, int lane) {
    v2u* o8 = (v2u*)dst + lane;
    if (src == nullptr) {
#pragma unroll
        for (int j = 0; j < 4; ++j) o8[64 * j] = (v2u){0u, 0u};
        return; }
    const f32x4* xr = (const f32x4*)src + lane; const f32x4* wr_ = (const f32x4*)w + lane;
    f32x4 v[4]; float s = 0.f;
#pragma unroll
    for (int j = 0; j < 4; ++j) { v[j] = xr[64 * j]; s += (v[j].x * v[j].x + v[j].y * v[j].y) + (v[j].z * v[j].z + v[j].w * v[j].w); }
    const float rs = rsqrtf(wave_sum(s) * (1.f / D) + RMS_EPS);
#pragma unroll
    for (int j = 0; j < 4; ++j) { const f32x4 ww = wr_[64 * j]; v2u o; o.x = pk2(v[j].x * rs * ww.x, v[j].y * rs * ww.y); o.y = pk2(v[j].z * rs * ww.z, v[j].w * rs * ww.w); o8[64 * j] = o; }
}
__device__ __forceinline__ float wave_sum63(float v) {
    v += __builtin_bit_cast(float, __builtin_amdgcn_mov_dpp(__builtin_bit_cast(int, v), 0xB1, 0xf, 0xf, true));
    v += __builtin_bit_cast(float, __builtin_amdgcn_mov_dpp(__builtin_bit_cast(int, v), 0x4E, 0xf, 0xf, true));
    v += __builtin_bit_cast(float, __builtin_amdgcn_mov_dpp(__builtin_bit_cast(int, v), 0x141, 0xf, 0xf, true));
    v += __builtin_bit_cast(float, __builtin_amdgcn_mov_dpp(__builtin_bit_cast(int, v), 0x128, 0xf, 0xf, true));
    v += __builtin_bit_cast(float, __builtin_amdgcn_update_dpp(0, __builtin_bit_cast(int, v), 0x142, 0xa, 0xf, false));
    v += __builtin_bit_cast(float, __builtin_amdgcn_update_dpp(0, __builtin_bit_cast(int, v), 0x143, 0xc, 0xf, false));
    return v;
}
__device__ __forceinline__ void hn_token_rows2(const Ctx& C, int b, int s0, int s1) {
    const int lane = C.lane;
    const f32x4* x0 = (const f32x4*)(C.in[I_X] + ((size_t)b * SEQ + s0) * D) + lane; const f32x4* x1 = (const f32x4*)(C.in[I_X] + ((size_t)b * SEQ + s1) * D) + lane;
    const f32x4* wr_ = (const f32x4*)C.in[I_LNMIX] + lane;
    f32x4 v[4], u[4]; float q0 = 0.f, q1 = 0.f;
#pragma unroll
    for (int j = 0; j < 4; ++j) { v[j] = x0[64 * j]; u[j] = x1[64 * j]; }
#pragma unroll
    for (int j = 0; j < 4; ++j) { q0 += (v[j].x * v[j].x + v[j].y * v[j].y) + (v[j].z * v[j].z + v[j].w * v[j].w); q1 += (u[j].x * u[j].x + u[j].y * u[j].y) + (u[j].z * u[j].z + u[j].w * u[j].w); }
    const float r0 = rsqrtf(wave_sum(q0) * (1.f / D) + RMS_EPS), r1 = rsqrtf(wave_sum(q1) * (1.f / D) + RMS_EPS);
    v2u* o0 = (v2u*)((bf16*)(C.ws + WS_HN) + (size_t)s0 * D) + lane; v2u* o1 = (v2u*)((bf16*)(C.ws + WS_HN) + (size_t)s1 * D) + lane;
#pragma unroll
    for (int j = 0; j < 4; ++j) { const f32x4 ww = wr_[64 * j]; const f32x4 a = v[j] * r0 * ww, bq = u[j] * r1 * ww;
        o0[64 * j] = (v2u){pk2(a.x, a.y), pk2(a.z, a.w)}; o1[64 * j] = (v2u){pk2(bq.x, bq.y), pk2(bq.z, bq.w)}; }
}
__device__ __forceinline__ void hn_batch(const Ctx& C, int b, int first_blk) {
    if (C.bid < first_blk) return;
    const int gw = (C.bid - first_blk) * NWAVES + C.wave, NGW = (C.G - first_blk) * NWAVES;
    for (int s = gw; s < SEQ / 2; s += NGW) hn_token_rows2(C, b, s, s + SEQ / 2);
}
__device__ __forceinline__ void meta_proj(const Ctx& C) {
    const bf16* HNM = (const bf16*)(C.ws + WS_HNM); const bf16* W1T = (const bf16*)(C.ws + WS_W1T);
    bf16* PJ = (bf16*)(C.ws + WS_PJ); float* TL = (float*)(C.ws + WS_TL);
    const int gw = C.bid * NWAVES + C.wave, NGW = C.G * NWAVES, fr = C.lane & 15, fq = C.lane >> 4;
    for (int nt = gw; nt < 643; nt += NGW) {
        f32x4 acc = {0.f, 0.f, 0.f, 0.f};
#pragma unroll 8
        for (int ks = 0; ks < 32; ++ks) acc = mma16(*(const bf16x8*)(HNM + fr * D + 32 * ks + 8 * fq), *(const bf16x8*)(W1T + (size_t)(16 * nt + fr) * D + 32 * ks + 8 * fq), acc);
        const int n = 16 * nt + 4 * fq;
        if (n >= NPJ) { if (n < NPJ + 48) *(f32x4*)(TL + (size_t)(RFRONT + fr) * 48 + (n - NPJ)) = acc; continue; }
        if (n < 512) acc = acc * 0.08838834764831845f;
        else if ((n >= PJ_GO && n < PJ_XBC)) { acc[0] = siluf_(acc[0]); acc[1] = siluf_(acc[1]); acc[2] = siluf_(acc[2]); acc[3] = siluf_(acc[3]); }
        else if (n >= PJ_GA) { acc[0] = sigmoidf_(acc[0]); acc[1] = sigmoidf_(acc[1]); acc[2] = sigmoidf_(acc[2]); acc[3] = sigmoidf_(acc[3]); }
        *(v2u*)(PJ + (size_t)(RFRONT + fr) * NPJ + n) = (v2u){pk2(acc[0], acc[1]), pk2(acc[2], acc[3])};
    }
}
__device__ __forceinline__ void tail_proj(const Ctx& C) {
    int tid_ = C.tid; asm volatile("" : "+v"(tid_));
    const int lane_ = tid_ & 63, wave_ = __builtin_amdgcn_readfirstlane(tid_ >> 6), fr = lane_ & 15, fq = lane_ >> 4;
    const bf16* HN = (const bf16*)(C.ws + WS_HN); const bf16* WT = (const bf16*)(C.ws + WS_W1T) + (size_t)NPJ * D; float* TL = (float*)(C.ws + WS_TL);
    constexpr int PW = 2064;
    ldsp WL = C.lds; LAS f32x4* PR = (LAS f32x4*)(C.lds + 48 * PW);
#pragma unroll
    for (int i = 0; i < 12; ++i) { const int e = tid_ + NT * i, row = e >> 7, ch = e & 127; *(LAS v4u*)(WL + row * PW + ch * 16) = *(const v4u*)(WT + (size_t)row * D + 8 * ch); }
    const int rsel = wave_ & 1, kq = wave_ >> 1;
    for (int rp = C.bid; rp < SEQ / 32; rp += C.G) {
        const int rt = 2 * rp + rsel;
        bf16x8 a[8];
#pragma unroll
        for (int i = 0; i < 8; ++i) a[i] = *(const bf16x8*)(HN + (size_t)(16 * rt + fr) * D + 32 * (8 * kq + i) + 8 * fq);
        __syncthreads();
        f32x4 acc[3] = {{0.f, 0.f, 0.f, 0.f}, {0.f, 0.f, 0.f, 0.f}, {0.f, 0.f, 0.f, 0.f}};
#pragma unroll
        for (int i = 0; i < 8; ++i)
#pragma unroll
            for (int n = 0; n < 3; ++n) acc[n] = mma16(a[i], lds_frag(WL + (16 * n + fr) * PW + (32 * (8 * kq + i) + 8 * fq) * 2), acc[n]);
#pragma unroll
        for (int n = 0; n < 3; ++n) PR[(wave_ * 3 + n) * 64 + lane_] = acc[n];
        __syncthreads();
        if (wave_ < 2) {
#pragma unroll
            for (int n = 0; n < 3; ++n) { f32x4 s = PR[((0 * 2 + wave_) * 3 + n) * 64 + lane_] + PR[((1 * 2 + wave_) * 3 + n) * 64 + lane_] + PR[((2 * 2 + wave_) * 3 + n) * 64 + lane_] + PR[((3 * 2 + wave_) * 3 + n) * 64 + lane_];
                *(f32x4*)(TL + (size_t)(RTOK + 16 * (2 * rp + wave_) + fr) * 48 + 16 * n + 4 * fq) = s; }
        }
    }
    __syncthreads();
}
__device__ __forceinline__ void p0b_prologue(const Ctx& C) {
    const int gw = C.bid * NWAVES + C.wave;
    if (gw < NMETA) norm_row_bf16(C.in[I_META] + (size_t)gw * D, C.in[I_LNMIX], (bf16*)(C.ws + WS_HNM) + (size_t)gw * D, C.lane);
    { v4u* z = (v4u*)(C.ws + WS_PJ); const size_t n = (size_t)RFRONT * NPJ * 2 / 16; for (size_t i = (size_t)C.bid * NT + C.tid; i < n; i += (size_t)C.G * NT) z[i] = (v4u){0u, 0u, 0u, 0u}; }
    { v4u* z = (v4u*)(C.ws + WS_TL); const size_t n = (size_t)RFRONT * 48 * 4 / 16; for (size_t i = (size_t)C.bid * NT + C.tid; i < n; i += (size_t)C.G * NT) z[i] = (v4u){0u, 0u, 0u, 0u}; }
    hn_batch(C, 0, 0);
}
__device__ __forceinline__ void weff_unit(const Ctx& C, int unit) {
    int tid_ = C.tid; asm volatile("" : "+v"(tid_));
    const int lane_ = tid_ & 63, wave_ = __builtin_amdgcn_readfirstlane(tid_ >> 6); (void)lane_; (void)wave_;
    const int blk = unit >> 4, d0 = (unit & 15) * 64;
    LAS float* KT = (LAS float*)C.lds;
    LAS float* WQ = (LAS float*)(C.lds + 128 * 132 * 4);
    const float* keys = C.in[I_KEYS] + (size_t)blk * 128 * 128; const float* wq = C.in[I_WQ];
    for (int e = tid_; e < 128 * 32; e += NT) { const int key = e >> 5, j4 = e & 31; *(LAS f32x4*)(KT + key * 132 + 4 * j4) = *(const f32x4*)(keys + key * 128 + 4 * j4); }
    for (int e = tid_; e < 64 * 32; e += NT) { const int dd = e >> 5, j4 = e & 31; *(LAS f32x4*)(WQ + dd * 128 + 4 * j4) = *(const f32x4*)(wq + (size_t)(d0 + dd) * 2048 + blk * 128 + 4 * j4); }
    __syncthreads();
    const int key = tid_ & 127, dg = tid_ >> 7;
    float acc[16];
#pragma unroll
    for (int i = 0; i < 16; ++i) acc[i] = 0.f;
    for (int j4 = 0; j4 < 32; ++j4) {
        const f32x4 kv = *(const LAS f32x4*)(KT + key * 132 + 4 * j4);
#pragma unroll
        for (int i = 0; i < 16; ++i) { const f32x4 wv = *(const LAS f32x4*)(WQ + (dg * 16 + i) * 128 + 4 * j4); acc[i] += kv.x * wv.x + kv.y * wv.y + kv.z * wv.z + kv.w * wv.w; }
    }
    bf16* WET = (bf16*)(C.ws + WS_WET) + (size_t)(blk * 128 + key) * D + d0 + dg * 16;
    v4u o0, o1; o0.x = pk2(acc[0], acc[1]); o0.y = pk2(acc[2], acc[3]); o0.z = pk2(acc[4], acc[5]); o0.w = pk2(acc[6], acc[7]);
    o1.x = pk2(acc[8], acc[9]); o1.y = pk2(acc[10], acc[11]); o1.z = pk2(acc[12], acc[13]); o1.w = pk2(acc[14], acc[15]);
    *(v4u*)WET = o0; *(v4u*)(WET + 8) = o1;
    __syncthreads();
}
__device__ __forceinline__ void p0_prologue(const Ctx& C) {
    LAS float* scr = (LAS float*)(C.lds + C.wave * 16384);
    const int gw = C.bid * NWAVES + C.wave, NGW = C.G * NWAVES;
    constexpr int I_1 = (D / 64) * (N1 / 32), I_A = (1024 / 64) * (1024 / 32), I_B = (2048 / 64) * (1024 / 32), I_O = I_A;
    constexpr int NITEMS = I_1 + I_A + I_B + I_O;
    for (int it = gw; it < NITEMS; it += NGW) {
        int r = it;
        if (r < I_1) { transpose_item(C.in[I_WIN], 1024, 10288, N1, (bf16*)(C.ws + WS_W1T), scr, r, C.lane, MapW1()); continue; } r -= I_1;
        if (r < I_A) { transpose_item(C.in[I_WUG], 1024, 1024, 1024, (bf16*)(C.ws + WS_WAT), scr, r, C.lane, MapIdent()); continue; } r -= I_A;
        if (r < I_B) { transpose_item(C.in[I_WUS], 2048, 1024, 1024, (bf16*)(C.ws + WS_WBT), scr, r, C.lane, MapIdent()); continue; } r -= I_B;
        transpose_item(C.in[I_WOUT], 1024, 1024, 1024, (bf16*)(C.ws + WS_WOT), scr, r, C.lane, MapIdent());
    }
    __syncthreads();
    for (int u = C.bid; u < 256; u += C.G) weff_unit(C, u);
}

__device__ __forceinline__ float softplusf_(float x) { return fmaxf(x, 0.f) + log1pf(__expf(-fabsf(x))); }
__device__ __forceinline__ void phaseC_unit(const Ctx& C, int c, int k) {
    int tid_ = C.tid; asm volatile("" : "+v"(tid_));
    const int lane_ = tid_ & 63, wave_ = __builtin_amdgcn_readfirstlane(tid_ >> 6); (void)lane_; (void)wave_;
    const bf16* PJ = (const bf16*)(C.ws + WS_PJ); const float* TL = (const float*)(C.ws + WS_TL);
    bf16* XC = (bf16*)(C.ws + WS_XC); float* GG = (float*)(C.ws + WS_GG); float* DT = (float*)(C.ws + WS_DT); float* AC = (float*)(C.ws + WS_AC);
    const int r0 = 64 * c;
    if (k < 6) {
        const float* cw = C.in[I_CONVW]; const float* cb = C.in[I_CONVB];
        const int col = 512 * k + 2 * (tid_ & 255), rb = r0 + 32 * (tid_ >> 8);
        const f32x2 w0 = *(const f32x2*)(cw + col), w1 = *(const f32x2*)(cw + 3072 + col), w2 = *(const f32x2*)(cw + 2 * 3072 + col), w3 = *(const f32x2*)(cw + 3 * 3072 + col), bb = *(const f32x2*)(cb + col);
        f32x2 xm3 = {0.f, 0.f}, xm2 = {0.f, 0.f}, xm1 = {0.f, 0.f};
        if (rb > 0) {
            const unsigned a = *(const unsigned*)(PJ + (size_t)(rb - 3) * NPJ + PJ_XBC + col), b2 = *(const unsigned*)(PJ + (size_t)(rb - 2) * NPJ + PJ_XBC + col), c2 = *(const unsigned*)(PJ + (size_t)(rb - 1) * NPJ + PJ_XBC + col);
            xm3 = (f32x2){bflo(a), bfhi(a)}; xm2 = (f32x2){bflo(b2), bfhi(b2)}; xm1 = (f32x2){bflo(c2), bfhi(c2)};
        }
#pragma unroll 16
        for (int t = 0; t < 32; ++t) {
            const int r = rb + t;
            const unsigned xu = *(const unsigned*)(PJ + (size_t)r * NPJ + PJ_XBC + col);
            const f32x2 x0 = {bflo(xu), bfhi(xu)};
            f32x2 o = bb + w0 * xm3 + w1 * xm2 + w2 * xm1 + w3 * x0;
            o.x = siluf_(o.x); o.y = siluf_(o.y);
            if (r < RFRONT) { o.x = 0.f; o.y = 0.f; }
            *(unsigned*)(XC + (size_t)r * 3072 + col) = pk2(o.x, o.y);
            xm3 = xm2; xm2 = xm1; xm1 = x0;
        }
        return;
    }
    if (k < 10) {
        const int col = 128 * (k - 6) + (tid_ & 127), rq = tid_ >> 7; const float* w2p = C.in[I_WG2]; float w2[16];
        LAS float* PS = (LAS float*)C.lds;
#pragma unroll
        for (int j = 0; j < 16; ++j) w2[j] = w2p[j * 512 + col];
        const float bg = C.in[I_BG][col]; float G = 0.f; float gv[16];
#pragma unroll
        for (int t = 0; t < 16; ++t) {
            const int r = r0 + 16 * rq + t; const float* gl = TL + (size_t)r * 48;
            float z = bg;
#pragma unroll
            for (int j4 = 0; j4 < 4; ++j4) { const f32x4 g = *(const f32x4*)(gl + 4 * j4); z += g.x * w2[4 * j4] + g.y * w2[4 * j4 + 1] + g.z * w2[4 * j4 + 2] + g.w * w2[4 * j4 + 3]; }
            float ls = fminf(z, 0.f) - __logf(1.f + __expf(-fabsf(z)));
            if (r < RFRONT) ls = 0.f;
            G += ls * (1.f / 16.f); gv[t] = G;
        }
        PS[rq * 128 + (tid_ & 127)] = G;
        __syncthreads();
        float base = 0.f;
#pragma unroll
        for (int q = 0; q < 3; ++q) base += (q < rq) ? PS[q * 128 + (tid_ & 127)] : 0.f;
#pragma unroll
        for (int t = 0; t < 16; ++t) GG[(size_t)(r0 + 16 * rq + t) * 512 + col] = gv[t] + base;
        __syncthreads();
        return;
    }
    {
        const int hd = tid_ & 31, rg = tid_ >> 5; const float bias = C.in[I_DTB][hd], A = -__expf(C.in[I_ALOG][hd]);
        LAS float* PS = (LAS float*)C.lds;
        float dtv[4], av[4], acum = 0.f;
#pragma unroll
        for (int t = 0; t < 4; ++t) {
            const int r = r0 + 4 * rg + t; const float x = TL[(size_t)r * 48 + 16 + hd] + bias;
            float dt = fmaxf(x, 0.f) + __logf(1.f + __expf(-fabsf(x)));
            if (r < RFRONT) dt = 0.f;
            acum += A * dt; dtv[t] = dt; av[t] = acum;
        }
        PS[rg * 32 + hd] = acum;
        __syncthreads();
        float base = 0.f;
#pragma unroll
        for (int q = 0; q < 15; ++q) base += (q < rg) ? PS[q * 32 + hd] : 0.f;
#pragma unroll
        for (int t = 0; t < 4; ++t) { const size_t r = (size_t)(r0 + 4 * rg + t); DT[r * 32 + hd] = dtv[t]; AC[r * 32 + hd] = av[t] + base; }
        __syncthreads();
    }
}

constexpr int P136 = 272, P264 = 528, P520 = 1040, P72 = 144;
__device__ __forceinline__ void gla_pass1_unit(const Ctx& C, int c, int h) {
    int tid_ = C.tid; asm volatile("" : "+v"(tid_));
    const int lane_ = tid_ & 63, wave_ = __builtin_amdgcn_readfirstlane(tid_ >> 6); (void)lane_; (void)wave_;
    const bf16* PJ = (const bf16*)(C.ws + WS_PJ); const float* GG = (const float*)(C.ws + WS_GG); bf16* LG = (bf16*)(C.ws + WS_LG);
    ldsp KD = C.lds, VT = C.lds + 64 * P136;
    const int r0 = 64 * c;
#pragma unroll
    for (int i = 0; i < 2; ++i) {
        const int e = tid_ + NT * i, s = e >> 4, k0 = (e & 15) * 8; const size_t r = (size_t)(r0 + s);
        const v4u ka = *(const v4u*)(PJ + r * NPJ + PJ_K + 128 * h + k0);
        const float* g = GG + r * 512 + 128 * h + k0; const float* gl = GG + (size_t)(r0 + 63) * 512 + 128 * h + k0;
        const f32x4 a0 = *(const f32x4*)g, a1 = *(const f32x4*)(g + 4), l0 = *(const f32x4*)gl, l1 = *(const f32x4*)(gl + 4);
        v4u o;
        o.x = pk2(bflo(ka.x) * __expf(l0.x - a0.x), bfhi(ka.x) * __expf(l0.y - a0.y)); o.y = pk2(bflo(ka.y) * __expf(l0.z - a0.z), bfhi(ka.y) * __expf(l0.w - a0.w));
        o.z = pk2(bflo(ka.z) * __expf(l1.x - a1.x), bfhi(ka.z) * __expf(l1.y - a1.y)); o.w = pk2(bflo(ka.w) * __expf(l1.z - a1.z), bfhi(ka.w) * __expf(l1.w - a1.w));
        *(LAS v4u*)(KD + s * P136 + k0 * 2) = o;
    }
#pragma unroll
    for (int i = 0; i < 4; ++i) { const int e = tid_ + NT * i, s = e >> 5, v0 = (e & 31) * 8;
        *(LAS v4u*)(VT + s * P264 + v0 * 2) = *(const v4u*)(PJ + (size_t)(r0 + s) * NPJ + PJ_V + 256 * h + v0); }
    __syncthreads();
    const int fr = lane_ & 15, fq = lane_ >> 4, w = wave_;
    f32x4 acc[2][8];
#pragma unroll
    for (int mi = 0; mi < 2; ++mi)
#pragma unroll
        for (int nt = 0; nt < 8; ++nt) acc[mi][nt] = (f32x4){0.f, 0.f, 0.f, 0.f};
#pragma unroll
    for (int ks = 0; ks < 2; ++ks) {
        bf16x8 af[2];
#pragma unroll
        for (int mi = 0; mi < 2; ++mi) af[mi] = tr_frag(VT, P264, 32 * ks, 32 * w + 16 * mi, fr, fq);
#pragma unroll
        for (int nt = 0; nt < 8; ++nt) { const bf16x8 bfm = tr_frag(KD, P136, 32 * ks, 16 * nt, fr, fq);
#pragma unroll
            for (int mi = 0; mi < 2; ++mi) acc[mi][nt] = mma16(af[mi], bfm, acc[mi][nt]); }
    }
    bf16* Lb = LG + ((size_t)(c * 4 + h) * 256) * 128;
#pragma unroll
    for (int mi = 0; mi < 2; ++mi)
#pragma unroll
        for (int nt = 0; nt < 8; ++nt) { const int v = 32 * w + 16 * mi + fr, k = 16 * nt + 4 * fq; const f32x4 a = acc[mi][nt];
            *(v2u*)(Lb + (size_t)v * 128 + k) = (v2u){cvt_pk_bf16(a[0], a[1]), cvt_pk_bf16(a[2], a[3])}; }
    __syncthreads();
}
__device__ __forceinline__ void ssd_pass1_unit(const Ctx& C, int c, int g) {
    int tid_ = C.tid; asm volatile("" : "+v"(tid_));
    const int lane_ = tid_ & 63, wave_ = __builtin_amdgcn_readfirstlane(tid_ >> 6); (void)lane_; (void)wave_;
    const bf16* XC = (const bf16*)(C.ws + WS_XC); const float* DT = (const float*)(C.ws + WS_DT); const float* AC = (const float*)(C.ws + WS_AC); bf16* LS = (bf16*)(C.ws + WS_LS);
    ldsp XW = C.lds, BM = C.lds + 64 * P520;
    const int r0 = 64 * c;
    { const int ch = tid_ & 63, hd = 8 * g + (ch >> 3); const float al = AC[(size_t)(r0 + 63) * 32 + hd];
#pragma unroll
      for (int i = 0; i < 8; ++i) { const int s = (tid_ >> 6) + 8 * i; const size_t r = (size_t)(r0 + s);
        const float sc = DT[r * 32 + hd] * __expf(al - AC[r * 32 + hd]); const v4u x = *(const v4u*)(XC + r * 3072 + 512 * g + 8 * ch); v4u o;
        o.x = pk2(bflo(x.x) * sc, bfhi(x.x) * sc); o.y = pk2(bflo(x.y) * sc, bfhi(x.y) * sc); o.z = pk2(bflo(x.z) * sc, bfhi(x.z) * sc); o.w = pk2(bflo(x.w) * sc, bfhi(x.w) * sc);
        *(LAS v4u*)(XW + s * P520 + ch * 16) = o; } }
#pragma unroll
    for (int i = 0; i < 2; ++i) { const int e = tid_ + NT * i, s = e >> 4, ch = e & 15;
        *(LAS v4u*)(BM + s * P136 + ch * 16) = *(const v4u*)(XC + (size_t)(r0 + s) * 3072 + 2048 + 128 * g + 8 * ch); }
    __syncthreads();
    const int fr = lane_ & 15, fq = lane_ >> 4, w = wave_;
    bf16* Lb = LS + ((size_t)(c * 32 + 8 * g + w) * 64) * 128;
#pragma unroll
    for (int nh = 0; nh < 2; ++nh) {
        f32x4 acc[4][4];
#pragma unroll
        for (int mi = 0; mi < 4; ++mi)
#pragma unroll
            for (int nt = 0; nt < 4; ++nt) acc[mi][nt] = (f32x4){0.f, 0.f, 0.f, 0.f};
#pragma unroll
        for (int ks = 0; ks < 2; ++ks) {
            bf16x8 af[4];
#pragma unroll
            for (int mi = 0; mi < 4; ++mi) af[mi] = tr_frag(XW, P520, 32 * ks, 64 * w + 16 * mi, fr, fq);
#pragma unroll
            for (int nt = 0; nt < 4; ++nt) { const bf16x8 bfm = tr_frag(BM, P136, 32 * ks, 64 * nh + 16 * nt, fr, fq);
#pragma unroll
                for (int mi = 0; mi < 4; ++mi) acc[mi][nt] = mma16(af[mi], bfm, acc[mi][nt]); }
        }
#pragma unroll
        for (int mi = 0; mi < 4; ++mi)
#pragma unroll
            for (int nt = 0; nt < 4; ++nt) { const int p = 16 * mi + fr, n = 64 * nh + 16 * nt + 4 * fq; const f32x4 a = acc[mi][nt];
                *(v2u*)(Lb + (size_t)p * 128 + n) = (v2u){cvt_pk_bf16(a[0], a[1]), cvt_pk_bf16(a[2], a[3])}; }
    }
    __syncthreads();
}

__device__ __forceinline__ void phaseE(const Ctx& C) {
    const float* GG = (const float*)(C.ws + WS_GG); const float* AC = (const float*)(C.ws + WS_AC);
    for (int vb = C.bid; vb < 256; vb += C.G) {
        if (vb < 128) {
            const int e = vb * NT + C.tid, k2 = e & 63, v = (e >> 6) & 255, h = e >> 14;
            unsigned* Lp = (unsigned*)(C.ws + WS_LG) + ((size_t)h * 256 + v) * 64 + k2;
            const float* dp = GG + 63 * 512 + 128 * h + 2 * k2;
            float s0 = 0.f, s1 = 0.f;
            for (int c0 = 0; c0 < NCHUNK; c0 += 8) {
                unsigned l[8]; f32x2 d[8];
#pragma unroll
                for (int i = 0; i < 8; ++i) if (c0 + i < NCHUNK) { l[i] = Lp[(size_t)(c0 + i) * (4 * 256 * 64)]; d[i] = *(const f32x2*)(dp + (size_t)(c0 + i) * 64 * 512); }
#pragma unroll
                for (int i = 0; i < 8; ++i) if (c0 + i < NCHUNK) {
                    Lp[(size_t)(c0 + i) * (4 * 256 * 64)] = pk2(s0, s1);
                    s0 = s0 * __expf(d[i].x) + bflo(l[i]); s1 = s1 * __expf(d[i].y) + bfhi(l[i]); }
            }
        } else {
            const int e = (vb - 128) * NT + C.tid, n4 = e & 31, p = (e >> 5) & 63, hd = e >> 11;
            v2u* Lp = (v2u*)(C.ws + WS_LS) + ((size_t)hd * 64 + p) * 32 + n4;
            const float* dp = AC + 63 * 32 + hd;
            float s0 = 0.f, s1 = 0.f, s2 = 0.f, s3 = 0.f;
            for (int c0 = 0; c0 < NCHUNK; c0 += 8) {
                v2u l[8]; float d[8];
#pragma unroll
                for (int i = 0; i < 8; ++i) if (c0 + i < NCHUNK) { l[i] = Lp[(size_t)(c0 + i) * (32 * 64 * 32)]; d[i] = dp[(size_t)(c0 + i) * 64 * 32]; }
#pragma unroll
                for (int i = 0; i < 8; ++i) if (c0 + i < NCHUNK) {
                    Lp[(size_t)(c0 + i) * (32 * 64 * 32)] = (v2u){pk2(s0, s1), pk2(s2, s3)};
                    const float dd = __expf(d[i]);
                    s0 = s0 * dd + bflo(l[i].x); s1 = s1 * dd + bfhi(l[i].x); s2 = s2 * dd + bflo(l[i].y); s3 = s3 * dd + bfhi(l[i].y); }
            }
        }
    }
}

__device__ __forceinline__ void gla_pass3_unit(const Ctx& C, int c, int h) {
    int tid_ = C.tid; asm volatile("" : "+v"(tid_));
    const int lane_ = tid_ & 63, wave_ = __builtin_amdgcn_readfirstlane(tid_ >> 6); (void)lane_; (void)wave_;
    const bf16* PJ = (const bf16*)(C.ws + WS_PJ); const float* GG = (const float*)(C.ws + WS_GG); const bf16* LG = (const bf16*)(C.ws + WS_LG); bf16* OG = (bf16*)(C.ws + WS_OG);
    ldsp QE = C.lds, QN = QE + 64 * P136, KE = QN + 64 * P136, KN = KE + 64 * P136, VT = KN + 64 * P136, ATT = VT + 64 * P264;
    LAS float* RED = (LAS float*)(ATT + 64 * P72);
    const int r0 = 64 * c;
    bf16x8 sfr[4][2];
    { const bf16* Sb = LG + ((size_t)(c * 4 + h) * 256) * 128; const int fr_ = lane_ & 15, fq_ = lane_ >> 4;
#pragma unroll
      for (int ks = 0; ks < 4; ++ks)
#pragma unroll
        for (int nt = 0; nt < 2; ++nt) sfr[ks][nt] = *(const bf16x8*)(Sb + (size_t)(32 * wave_ + 16 * nt + fr_) * 128 + 32 * ks + 8 * fq_); }
#pragma unroll
    for (int i = 0; i < 2; ++i) {
        const int e = tid_ + NT * i, s = e >> 4, k0 = (e & 15) * 8; const size_t r = (size_t)(r0 + s);
        const v4u qa = *(const v4u*)(PJ + r * NPJ + PJ_Q + 128 * h + k0), ka = *(const v4u*)(PJ + r * NPJ + PJ_K + 128 * h + k0);
        const float* g = GG + r * 512 + 128 * h + k0; const f32x4 g0 = *(const f32x4*)g, g1 = *(const f32x4*)(g + 4);
        const float gv[8] = {g0.x, g0.y, g0.z, g0.w, g1.x, g1.y, g1.z, g1.w};
        const unsigned qs[4] = {qa.x, qa.y, qa.z, qa.w}, ksr[4] = {ka.x, ka.y, ka.z, ka.w};
        unsigned oqe[4], oqn[4], oke[4], okn[4];
#pragma unroll
        for (int j = 0; j < 4; ++j) { const float e0 = __expf(gv[2 * j]), e1 = __expf(gv[2 * j + 1]), n0 = __expf(-gv[2 * j]), n1 = __expf(-gv[2 * j + 1]);
            const float q0 = bflo(qs[j]), q1 = bfhi(qs[j]), kk0 = bflo(ksr[j]), kk1 = bfhi(ksr[j]);
            oqe[j] = pk2(q0 * e0, q1 * e1); oqn[j] = pk2(q0 * n0, q1 * n1); oke[j] = pk2(kk0 * e0, kk1 * e1); okn[j] = pk2(kk0 * n0, kk1 * n1); }
        const int off = s * P136 + k0 * 2;
        *(LAS v4u*)(QE + off) = (v4u){oqe[0], oqe[1], oqe[2], oqe[3]}; *(LAS v4u*)(QN + off) = (v4u){oqn[0], oqn[1], oqn[2], oqn[3]};
        *(LAS v4u*)(KE + off) = (v4u){oke[0], oke[1], oke[2], oke[3]}; *(LAS v4u*)(KN + off) = (v4u){okn[0], okn[1], okn[2], okn[3]};
    }
#pragma unroll
    for (int i = 0; i < 4; ++i) { const int e = tid_ + NT * i, s = e >> 5, v0 = (e & 31) * 8;
        *(LAS v4u*)(VT + s * P264 + v0 * 2) = *(const v4u*)(PJ + (size_t)(r0 + s) * NPJ + PJ_V + 256 * h + v0); }
    __syncthreads();
    const int fr = lane_ & 15, fq = lane_ >> 4, w = wave_;
#pragma unroll
    for (int ti = 0; ti < 2; ++ti) {
        const int id = 2 * w + ti, tm = id >> 2, sn = id & 3;
        f32x4 ac = {0.f, 0.f, 0.f, 0.f}, aa = {0.f, 0.f, 0.f, 0.f};
#pragma unroll
        for (int ks = 0; ks < 4; ++ks) {
            const int ao = (16 * tm + fr) * P136 + (32 * ks + 8 * fq) * 2, bo = (16 * sn + fr) * P136 + (32 * ks + 8 * fq) * 2;
            ac = mma16(lds_frag(QE + ao), lds_frag(KN + bo), ac);
            aa = mma16(lds_frag(QN + ao), lds_frag(KE + bo), aa);
        }
        const int t = 16 * tm + fr, s0 = 16 * sn + 4 * fq;
        float o[4];
#pragma unroll
        for (int j = 0; j < 4; ++j) o[j] = (s0 + j <= t) ? ac[j] : aa[j];
        *(LAS v2u*)(ATT + t * P72 + s0 * 2) = (v2u){pk2(o[0], o[1]), pk2(o[2], o[3])};
    }
    __syncthreads();
    f32x4 acc[4][2];
#pragma unroll
    for (int tm = 0; tm < 4; ++tm)
#pragma unroll
        for (int nt = 0; nt < 2; ++nt) acc[tm][nt] = (f32x4){0.f, 0.f, 0.f, 0.f};
#pragma unroll
    for (int ks = 0; ks < 4; ++ks) {
#pragma unroll
        for (int tm = 0; tm < 4; ++tm) { const bf16x8 af = lds_frag(QE + (16 * tm + fr) * P136 + (32 * ks + 8 * fq) * 2);
#pragma unroll
            for (int nt = 0; nt < 2; ++nt) acc[tm][nt] = mma16(af, sfr[ks][nt], acc[tm][nt]); }
    }
#pragma unroll
    for (int ks = 0; ks < 2; ++ks) {
        bf16x8 bfm[2];
#pragma unroll
        for (int nt = 0; nt < 2; ++nt) bfm[nt] = tr_frag(VT, P264, 32 * ks, 32 * w + 16 * nt, fr, fq);
#pragma unroll
        for (int tm = 0; tm < 4; ++tm) { const bf16x8 af = lds_frag(ATT + (16 * tm + fr) * P72 + (32 * ks + 8 * fq) * 2);
#pragma unroll
            for (int nt = 0; nt < 2; ++nt) acc[tm][nt] = mma16(af, bfm[nt], acc[tm][nt]); }
    }
#pragma unroll
    for (int tm = 0; tm < 4; ++tm) { float s = 0.f;
#pragma unroll
        for (int nt = 0; nt < 2; ++nt) { const f32x4 a = acc[tm][nt]; s += (a[0] * a[0] + a[1] * a[1]) + (a[2] * a[2] + a[3] * a[3]); }
        s += __shfl_xor(s, 16); s += __shfl_xor(s, 32);
        if (fq == 0) RED[w * 64 + 16 * tm + fr] = s; }
    __syncthreads();
    const float* nw = C.in[I_GNW];
#pragma unroll
    for (int tm = 0; tm < 4; ++tm) { const int t = 16 * tm + fr; float tot = 0.f;
#pragma unroll
        for (int ww = 0; ww < 8; ++ww) tot += RED[ww * 64 + t];
        const float rs = rsqrtf(tot * (1.f / 256.f) + RMS_EPS); const size_t r = (size_t)(r0 + t);
#pragma unroll
        for (int nt = 0; nt < 2; ++nt) { const int v = 32 * w + 16 * nt + 4 * fq; const f32x4 a = acc[tm][nt];
            const f32x4 wv = *(const f32x4*)(nw + v); const v2u gv = *(const v2u*)(PJ + r * NPJ + PJ_GO + 256 * h + v);
            *(v2u*)(OG + r * 1024 + 256 * h + v) = (v2u){pk2(a[0] * rs * wv.x * bflo(gv.x), a[1] * rs * wv.y * bfhi(gv.x)), pk2(a[2] * rs * wv.z * bflo(gv.y), a[3] * rs * wv.w * bfhi(gv.y))}; } }
    __syncthreads();
}
__device__ __forceinline__ void ssd_pass3_unit(const Ctx& C, int c, int g) {
    int tid_ = C.tid; asm volatile("" : "+v"(tid_));
    const int lane_ = tid_ & 63, wave_ = __builtin_amdgcn_readfirstlane(tid_ >> 6); (void)lane_; (void)wave_;
    const bf16* PJ = (const bf16*)(C.ws + WS_PJ); const bf16* XC = (const bf16*)(C.ws + WS_XC); const float* DT = (const float*)(C.ws + WS_DT); const float* AC = (const float*)(C.ws + WS_AC);
    const bf16* LS = (const bf16*)(C.ws + WS_LS); bf16* YS = (bf16*)(C.ws + WS_YS);
    ldsp XD = C.lds, CM = XD + 64 * P520, BM = CM + 64 * P136, WT = BM + 64 * P136;
    LAS float* ACL = (LAS float*)(WT + 8 * 32 * P72);
    LAS float* DTL = ACL + 8 * 64;
    LAS float* RED = DTL + 8 * 64;
    const int r0 = 64 * c;
    bf16x8 sfr[4][4];
    { const bf16* Sb = LS + ((size_t)(c * 32 + 8 * g + (wave_ >> 1)) * 64) * 128; const int fr_ = lane_ & 15, fq_ = lane_ >> 4;
#pragma unroll
      for (int ks = 0; ks < 2; ++ks)
#pragma unroll
        for (int pn = 0; pn < 4; ++pn) sfr[ks][pn] = *(const bf16x8*)(Sb + (size_t)(16 * pn + fr_) * 128 + 32 * ks + 8 * fq_); }
    { const int s = tid_ >> 3, hl = tid_ & 7; const size_t ri = (size_t)(r0 + s) * 32 + 8 * g + hl; ACL[hl * 64 + s] = AC[ri]; DTL[hl * 64 + s] = DT[ri]; }
#pragma unroll
    for (int i = 0; i < 8; ++i) { const int s = (tid_ >> 6) + 8 * i, ch = tid_ & 63;
        *(LAS v4u*)(XD + s * P520 + ch * 16) = *(const v4u*)(XC + (size_t)(r0 + s) * 3072 + 512 * g + 8 * ch); }
#pragma unroll
    for (int i = 0; i < 2; ++i) { const int e = tid_ + NT * i, s = e >> 4, ch = e & 15; const size_t r = (size_t)(r0 + s);
        *(LAS v4u*)(BM + s * P136 + ch * 16) = *(const v4u*)(XC + r * 3072 + 2048 + 128 * g + 8 * ch);
        *(LAS v4u*)(CM + s * P136 + ch * 16) = *(const v4u*)(XC + r * 3072 + 2560 + 128 * g + 8 * ch); }
    __syncthreads();
    const int fr = lane_ & 15, fq = lane_ >> 4, w = wave_, rh = w & 1, hq = w >> 1, t0 = 32 * rh;
    ldsp WW = WT + w * 32 * P72;
    { const bf16* Sb = LS + ((size_t)(c * 32 + 8 * g + hq) * 64) * 128;
#pragma unroll
      for (int ks = 2; ks < 4; ++ks)
#pragma unroll
        for (int pn = 0; pn < 4; ++pn) sfr[ks][pn] = *(const bf16x8*)(Sb + (size_t)(16 * pn + fr) * 128 + 32 * ks + 8 * fq); }
    f32x4 cb[2][4];
#pragma unroll
    for (int tm = 0; tm < 2; ++tm)
#pragma unroll
        for (int sn = 0; sn < 4; ++sn) cb[tm][sn] = (f32x4){0.f, 0.f, 0.f, 0.f};
#pragma unroll
    for (int ks = 0; ks < 4; ++ks) {
        bf16x8 af[2];
#pragma unroll
        for (int tm = 0; tm < 2; ++tm) af[tm] = lds_frag(CM + (t0 + 16 * tm + fr) * P136 + (32 * ks + 8 * fq) * 2);
#pragma unroll
        for (int sn = 0; sn < 4; ++sn) { const bf16x8 bfm = lds_frag(BM + (16 * sn + fr) * P136 + (32 * ks + 8 * fq) * 2);
#pragma unroll
            for (int tm = 0; tm < 2; ++tm) cb[tm][sn] = mma16(af[tm], bfm, cb[tm][sn]); }
    }
    v2u yp[2][2][4];
    float ss[2] = {0.f, 0.f};
    const float* dsk = C.in[I_DSKIP]; const float* nw = C.in[I_SNW];
#pragma unroll
    for (int rd = 0; rd < 2; ++rd) {
        const int hl = hq + 4 * rd, hd = 8 * g + hl;
        float at[2];
#pragma unroll
        for (int tm = 0; tm < 2; ++tm) at[tm] = ACL[hl * 64 + t0 + 16 * tm + fr];
#pragma unroll
        for (int sn = 0; sn < 4; ++sn) { const f32x4 as = *(const LAS f32x4*)(ACL + hl * 64 + 16 * sn + 4 * fq), ds = *(const LAS f32x4*)(DTL + hl * 64 + 16 * sn + 4 * fq);
#pragma unroll
            for (int tm = 0; tm < 2; ++tm) { const f32x4 cv = cb[tm][sn];
                const float w0 = cv[0] * ds.x * __expf(-fabsf(at[tm] - as.x)), w1 = cv[1] * ds.y * __expf(-fabsf(at[tm] - as.y)), w2 = cv[2] * ds.z * __expf(-fabsf(at[tm] - as.z)), w3 = cv[3] * ds.w * __expf(-fabsf(at[tm] - as.w));
                *(LAS v2u*)(WW + (16 * tm + fr) * P72 + (16 * sn + 4 * fq) * 2) = (v2u){pk2(w0, w1), pk2(w2, w3)}; } }
        f32x4 y[2][4];
#pragma unroll
        for (int tm = 0; tm < 2; ++tm)
#pragma unroll
            for (int pn = 0; pn < 4; ++pn) y[tm][pn] = (f32x4){0.f, 0.f, 0.f, 0.f};
#pragma unroll
        for (int ks = 0; ks < 4; ++ks) {
            bf16x8 af[2];
#pragma unroll
            for (int tm = 0; tm < 2; ++tm) af[tm] = lds_frag(CM + (t0 + 16 * tm + fr) * P136 + (32 * ks + 8 * fq) * 2);
#pragma unroll
            for (int pn = 0; pn < 4; ++pn) {
#pragma unroll
                for (int tm = 0; tm < 2; ++tm) y[tm][pn] = mma16(af[tm], sfr[ks][pn], y[tm][pn]); }
        }
        if (rd == 0) {
            const bf16* Sb = LS + ((size_t)(c * 32 + 8 * g + hq + 4) * 64) * 128;
#pragma unroll
            for (int ks = 0; ks < 4; ++ks)
#pragma unroll
                for (int pn = 0; pn < 4; ++pn) sfr[ks][pn] = *(const bf16x8*)(Sb + (size_t)(16 * pn + fr) * 128 + 32 * ks + 8 * fq);
        }
#pragma unroll
        for (int tm = 0; tm < 2; ++tm) { const float ea = __expf(at[tm]);
#pragma unroll
            for (int pn = 0; pn < 4; ++pn) y[tm][pn] = y[tm][pn] * ea; }
        LDS_WAIT(); asm volatile("" ::: "memory");
#pragma unroll
        for (int ks = 0; ks < 2; ++ks) {
            bf16x8 af[2];
#pragma unroll
            for (int tm = 0; tm < 2; ++tm) af[tm] = lds_frag(WW + (16 * tm + fr) * P72 + (32 * ks + 8 * fq) * 2);
#pragma unroll
            for (int pn = 0; pn < 4; ++pn) { const bf16x8 bfm = tr_frag(XD, P520, 32 * ks, 64 * hl + 16 * pn, fr, fq);
#pragma unroll
                for (int tm = 0; tm < 2; ++tm) y[tm][pn] = mma16(af[tm], bfm, y[tm][pn]); }
        }
        LDS_WAIT(); asm volatile("" ::: "memory");
        const float dk = dsk[hd];
#pragma unroll
        for (int tm = 0; tm < 2; ++tm) { const size_t r = (size_t)(r0 + t0 + 16 * tm + fr);
#pragma unroll
            for (int pn = 0; pn < 4; ++pn) { const int col = 64 * hd + 16 * pn + 4 * fq;
                const v2u xv = *(const LAS v2u*)(XD + (t0 + 16 * tm + fr) * P520 + (64 * hl + 16 * pn + 4 * fq) * 2), zv = *(const v2u*)(PJ + r * NPJ + PJ_Z + col);
                f32x4 a = y[tm][pn];
                a[0] = (a[0] + dk * bflo(xv.x)) * bflo(zv.x); a[1] = (a[1] + dk * bfhi(xv.x)) * bfhi(zv.x); a[2] = (a[2] + dk * bflo(xv.y)) * bflo(zv.y); a[3] = (a[3] + dk * bfhi(xv.y)) * bfhi(zv.y);
                ss[tm] += (a[0] * a[0] + a[1] * a[1]) + (a[2] * a[2] + a[3] * a[3]); yp[rd][tm][pn] = (v2u){pk2(a[0], a[1]), pk2(a[2], a[3])}; } }
    }
#pragma unroll
    for (int tm = 0; tm < 2; ++tm) { float s = ss[tm]; s += __shfl_xor(s, 16); s += __shfl_xor(s, 32); if (fq == 0) RED[w * 32 + 16 * tm + fr] = s; }
    __syncthreads();
#pragma unroll
    for (int tm = 0; tm < 2; ++tm) { const int tl = 16 * tm + fr; float tot = 0.f;
#pragma unroll
        for (int q = 0; q < 4; ++q) tot += RED[(2 * q + rh) * 32 + tl];
        const float rs = rsqrtf(tot * (1.f / 512.f) + RMS_EPS); const size_t r = (size_t)(r0 + t0 + tl);
#pragma unroll
        for (int rd = 0; rd < 2; ++rd) { const int hd = 8 * g + hq + 4 * rd;
#pragma unroll
            for (int pn = 0; pn < 4; ++pn) { const int col = 64 * hd + 16 * pn + 4 * fq; const v2u a = yp[rd][tm][pn]; const f32x4 wv = *(const f32x4*)(nw + col);
                *(v2u*)(YS + r * 2048 + col) = (v2u){pk2(bflo(a.x) * rs * wv.x, bfhi(a.x) * rs * wv.y), pk2(bflo(a.y) * rs * wv.z, bfhi(a.y) * rs * wv.w)}; } } }
    __syncthreads();
}

__device__ __forceinline__ void phaseJ(const Ctx& C) {
    const int gw = C.bid * NWAVES + C.wave, NGW = C.G * NWAVES;
    bf16* HN2 = (bf16*)(C.ws + WS_HN2);
    for (int r = gw; r < NTOK; r += NGW) norm_row_bf16(C.out + (size_t)r * D, C.in[I_LNFFN], HN2 + (size_t)r * D, C.lane);
    const size_t n16 = (size_t)16384 * 1024 / 16, gt = (size_t)C.bid * NT + C.tid, GT = (size_t)C.G * NT;
    for (int tb = 0; tb < 2; ++tb) {
        const float* src = C.in[tb ? I_PV : I_PU]; unsigned char* dst = C.ws + (tb ? WS_V8 : WS_U8); const float gain = tb ? 16.f : 256.f;
        for (size_t i = gt; i < n16; i += GT) { v4u o;
#pragma unroll
            for (int q = 0; q < 4; ++q) { const f32x4 a = *(const f32x4*)(src + 16 * i + 4 * q); int w = 0;
                w = __builtin_amdgcn_cvt_pk_fp8_f32(a.x * gain, a.y * gain, w, false); w = __builtin_amdgcn_cvt_pk_fp8_f32(a.z * gain, a.w * gain, w, true); o[q] = (unsigned)w; }
            *(v4u*)(dst + 16 * i) = o; }
    }
}

__device__ __forceinline__ float gelu_tanh(float x) {
    const float y = 0.7978845608028654f * (x + 0.044715f * x * x * x);
    const float e = __expf(2.f * y);
    const float th = 1.f - 2.f * fast_rcp(e + 1.f);
    return 0.5f * x * (1.f + th);
}
template <int CTRL> __device__ __forceinline__ unsigned dppu(unsigned x) { return (unsigned)__builtin_amdgcn_mov_dpp((int)x, CTRL, 0xf, 0xf, true); }
template <int CTRL> __device__ __forceinline__ float dppf(float x) { return __builtin_bit_cast(float, __builtin_amdgcn_mov_dpp(__builtin_bit_cast(int, x), CTRL, 0xf, 0xf, true)); }
__device__ __forceinline__ unsigned row_max_u(unsigned m) { m = max(m, dppu<0xB1>(m)); m = max(m, dppu<0x4E>(m)); m = max(m, dppu<0x141>(m)); m = max(m, dppu<0x128>(m)); return m; }
__device__ __forceinline__ float row_sum_f(float v) { v += dppf<0xB1>(v); v += dppf<0x4E>(v); v += dppf<0x141>(v); v += dppf<0x128>(v); return v; }
__device__ __forceinline__ unsigned mono(float f) { const unsigned b = __builtin_bit_cast(unsigned, f); return b ^ ((unsigned)((int)b >> 31) | 0x80000000u); }
__device__ __forceinline__ float unmono(unsigned u) { const unsigned b = (u & 0x80000000u) ? (u ^ 0x80000000u) : ~u; return __builtin_bit_cast(float, b); }
__device__ __forceinline__ void cand_ij(int c, int& ci, int& cj) {
    if (c < 16) { ci = 0; cj = c; } else if (c < 24) { ci = 1; cj = c - 16; } else if (c < 29) { ci = 2; cj = c - 24; } else if (c < 33) { ci = 3; cj = c - 29; }
    else if (c < 36) { ci = 4; cj = c - 33; } else if (c < 38) { ci = 5; cj = c - 36; } else if (c < 40) { ci = 6; cj = c - 38; } else if (c < 42) { ci = 7; cj = c - 40; }
    else if (c < 50) { ci = c - 34; cj = 0; } else { ci = 0; cj = 0; }
}
constexpr int PEER_LDS_PER_WAVE = 3072;
__device__ __forceinline__ void peer_token(const Ctx& C, int t, bool dry = false) {
    const int lane = C.lane, g = lane >> 4, j = lane & 15;
    const float* SC = (const float*)(C.ws + WS_SC) + (size_t)t * 2048;
    const bf16* HN2 = (const bf16*)(C.ws + WS_HN2) + (size_t)t * D;
    ldsp LST = C.lds + C.wave * PEER_LDS_PER_WAVE; ldsp EL = LST + 2048;
#pragma unroll 1
    for (int P = 0; P < 4; ++P) {
        const float* sp = SC + (4 * P + g) * 128 + 8 * j;
        const f32x4 s0 = *(const f32x4*)sp, s1 = *(const f32x4*)(sp + 4);
        unsigned k[8];
        k[0] = (mono(s0.x) & ~127u) | (unsigned)(127 - (8 * j + 0)); k[1] = (mono(s0.y) & ~127u) | (unsigned)(127 - (8 * j + 1));
        k[2] = (mono(s0.z) & ~127u) | (unsigned)(127 - (8 * j + 2)); k[3] = (mono(s0.w) & ~127u) | (unsigned)(127 - (8 * j + 3));
        k[4] = (mono(s1.x) & ~127u) | (unsigned)(127 - (8 * j + 4)); k[5] = (mono(s1.y) & ~127u) | (unsigned)(127 - (8 * j + 5));
        k[6] = (mono(s1.z) & ~127u) | (unsigned)(127 - (8 * j + 6)); k[7] = (mono(s1.w) & ~127u) | (unsigned)(127 - (8 * j + 7));
        unsigned res = 0u;
#pragma unroll 4
        for (int it = 0; it < 16; ++it) {
            unsigned m = max(max(max(k[0], k[1]), max(k[2], k[3])), max(max(k[4], k[5]), max(k[6], k[7])));
            m = row_max_u(m);
#pragma unroll
            for (int q = 0; q < 8; ++q) k[q] = (k[q] == m) ? 0u : k[q];
            res = (j == it) ? m : res;
        }
        *(LAS v2u*)(LST + ((4 * P + g) * 16 + j) * 8) = (v2u){__builtin_bit_cast(unsigned, unmono(res & ~127u)), 127u - (res & 127u)};
    }
    LDS_WAIT(); asm volatile("" ::: "memory");
    int eA = 0, eB = 0; float wA = 0.f, wB = 0.f;
#pragma unroll
    for (int Q = 0; Q < 2; ++Q) {
        const int h = 4 * Q + g;
        unsigned k[4];
#pragma unroll
        for (int m = 0; m < 4; ++m) {
            const int c = j + 16 * m; int ci, cj; cand_ij(c, ci, cj);
            const v2u a = *(const LAS v2u*)(LST + ((2 * h) * 16 + ci) * 8), b = *(const LAS v2u*)(LST + ((2 * h + 1) * 16 + cj) * 8);
            const float val = __builtin_bit_cast(float, a.x) + __builtin_bit_cast(float, b.x);
            k[m] = (c < 50) ? ((mono(val) & ~63u) | (unsigned)(63 - c)) : 0u;
            *(LAS unsigned*)(EL + (g * 64 + c) * 4) = a.y * 128u + b.y;
        }
        unsigned res = 0u, mtop = 0u;
#pragma unroll 4
        for (int it = 0; it < 16; ++it) {
            unsigned m = max(max(k[0], k[1]), max(k[2], k[3]));
            m = row_max_u(m);
            if (it == 0) mtop = m;
#pragma unroll
            for (int q = 0; q < 4; ++q) k[q] = (k[q] == m) ? 0u : k[q];
            res = (j == it) ? m : res;
        }
        LDS_WAIT(); asm volatile("" ::: "memory");
        const int cw = 63 - (int)(res & 63u);
        const int e = (int)*(const LAS unsigned*)(EL + (g * 64 + cw) * 4);
        const float ex = __expf(unmono(res & ~63u) - unmono(mtop & ~63u));
        const float wgt = ex / row_sum_f(ex);
        if (Q == 0) { eA = e; wA = wgt; } else { eB = e; wB = wgt; }
        LDS_WAIT(); asm volatile("" ::: "memory");
    }
#ifdef DRY_TOPK_ONLY
    if (dry) { ((float*)(C.ws + WS_T1))[(size_t)t * 64 + lane] = (float)(eA + eB) + wA + wB; return; }
#endif
    const unsigned char* U8 = C.ws + WS_U8; const unsigned char* V8 = C.ws + WS_V8;
    f32x2 hx[8];
    { const v4u a = *(const v4u*)(HN2 + 16 * lane), b = *(const v4u*)(HN2 + 16 * lane + 8);
      hx[0] = (f32x2){bflo(a.x), bfhi(a.x)}; hx[1] = (f32x2){bflo(a.y), bfhi(a.y)}; hx[2] = (f32x2){bflo(a.z), bfhi(a.z)}; hx[3] = (f32x2){bflo(a.w), bfhi(a.w)};
      hx[4] = (f32x2){bflo(b.x), bfhi(b.x)}; hx[5] = (f32x2){bflo(b.y), bfhi(b.y)}; hx[6] = (f32x2){bflo(b.z), bfhi(b.z)}; hx[7] = (f32x2){bflo(b.w), bfhi(b.w)}; }
    f32x2 acc[8];
#pragma unroll
    for (int i = 0; i < 8; ++i) acc[i] = (f32x2){0.f, 0.f};
#pragma unroll 1
    for (int p0 = 0; p0 < 128; p0 += 8) {
        const int l0 = p0 & 63; const int ev = p0 < 64 ? eA : eB; const float wv = p0 < 64 ? wA : wB;
        v4u uq[8], vq[8];
#pragma unroll
        for (int q = 0; q < 8; ++q) { const size_t eo = (size_t)__builtin_amdgcn_readlane(ev, l0 + q) * 1024 + 16 * lane;
            uq[q] = *(const v4u*)(U8 + eo); vq[q] = *(const v4u*)(V8 + eo); }
        float dv = 0.f;
#pragma unroll
        for (int q = 0; q < 8; ++q) {
            f32x2 d2 = {0.f, 0.f};
#pragma unroll
            for (int w4 = 0; w4 < 4; ++w4) { const f32x2 lo = __builtin_amdgcn_cvt_pk_f32_fp8((int)uq[q][w4], false), hi = __builtin_amdgcn_cvt_pk_f32_fp8((int)uq[q][w4], true);
                d2 = lo * hx[2 * w4] + d2; d2 = hi * hx[2 * w4 + 1] + d2; }
            float s = row_sum_f(d2.x + d2.y);
            s += __builtin_bit_cast(float, __builtin_amdgcn_update_dpp(0, __builtin_bit_cast(int, s), 0x142, 0xa, 0xf, false));
            s += __builtin_bit_cast(float, __builtin_amdgcn_update_dpp(0, __builtin_bit_cast(int, s), 0x143, 0xc, 0xf, false));
            const float tot = __builtin_bit_cast(float, __builtin_amdgcn_readlane(__builtin_bit_cast(int, s), 63));
            dv = (lane == l0 + q) ? tot : dv;
        }
        const float cfv = wv * gelu_tanh(dv * (1.f / 256.f)) * (1.f / 16.f);
#pragma unroll
        for (int q = 0; q < 8; ++q) {
            const float cf = __builtin_bit_cast(float, __builtin_amdgcn_readlane(__builtin_bit_cast(int, cfv), l0 + q));
#pragma unroll
            for (int w4 = 0; w4 < 4; ++w4) { const f32x2 lo = __builtin_amdgcn_cvt_pk_f32_fp8((int)vq[q][w4], false), hi = __builtin_amdgcn_cvt_pk_f32_fp8((int)vq[q][w4], true);
                acc[2 * w4] = lo * cf + acc[2 * w4]; acc[2 * w4 + 1] = hi * cf + acc[2 * w4 + 1]; }
        }
    }
    float* orow = C.out + (size_t)t * D + 16 * lane; const float* lw = C.in[I_LNF] + 16 * lane;
    f32x4 hv[4]; float s = 0.f;
#pragma unroll
    for (int i = 0; i < 4; ++i) { hv[i] = *(const f32x4*)(orow + 4 * i); hv[i].x += acc[2 * i].x; hv[i].y += acc[2 * i].y; hv[i].z += acc[2 * i + 1].x; hv[i].w += acc[2 * i + 1].y;
        s += (hv[i].x * hv[i].x + hv[i].y * hv[i].y) + (hv[i].z * hv[i].z + hv[i].w * hv[i].w); }
    const float rs = rsqrtf(wave_sum(s) * (1.f / D) + RMS_EPS);
    if (dry) return;
#pragma unroll
    for (int i = 0; i < 4; ++i) { const f32x4 w4 = *(const f32x4*)(lw + 4 * i); *(f32x4*)(orow + 4 * i) = hv[i] * rs * w4; }
}

constexpr int NSTEPS = 37;
#ifndef PH_MASK
#define PH_MASK 0xFF
#endif
#define PH_ON(k) (((PH_MASK) >> (k)) & 1)
struct Args { const float* in[22]; float* out; unsigned char* ws; int ph_lo, ph_hi; };
typedef const __attribute__((address_space(4))) Args* kargp;
__device__ __forceinline__ void ctx_init(Ctx& C, unsigned char* smem) {
    kargp ap = (kargp)__builtin_amdgcn_kernarg_segment_ptr();
    asm volatile("" : "+s"(ap));
    int tid_ = threadIdx.x; asm volatile("" : "+v"(tid_));
    C.lds = (ldsp)smem; C.tid = tid_; C.lane = C.tid & 63; C.wave = __builtin_amdgcn_readfirstlane(C.tid >> 6); C.G = gridDim.x; C.bid = blockIdx.x;
#pragma unroll
    for (int i = 0; i < 22; ++i) C.in[i] = ap->in[i];
    C.out = ap->out; C.ws = ap->ws;
}
__global__ void __launch_bounds__(NT, 2) hyb_fwd(Args args) {
    extern __shared__ __attribute__((aligned(16))) unsigned char smem[];
    volatile LAS unsigned* MISC = (volatile LAS unsigned*)((ldsp)smem + LDSCTL_OFF);
    for (int u = threadIdx.x; u < (LDS_BYTES - LDSCTL_OFF) / 4; u += NT) MISC[u] = 0u;
    __syncthreads();
    const int lo = args.ph_lo, hi = args.ph_hi;
    unsigned* barw = (unsigned*)(args.ws + WS_CTL) + CW_BAR;
    XcdBarrier bar; bar.bar = barw; bar.x = 0; bar.st = MISC + 8;
    if (hi - lo > 1) bar = xcd_barrier_post(barw, MISC + 8);
#pragma unroll 1
    for (int step = lo; step < hi; ++step) {
        int kind, b = 0, gk = 0;
        if (step == 0) kind = 0;
        else if (step == 1) kind = 8;
        else if (step <= 33) { b = (step - 2) >> 3; const int k = (step - 2) & 7; gk = k; kind = (k == 0 || k >= 5) ? 1 : k + 1; }
        else if (step == 34) kind = 6;
        else if (step == 35) { kind = 1; gk = 8; }
        else kind = 7;
#ifdef REP_KIND
#ifndef REP_GK
#define REP_GK -1
#endif
        for (int rep = ((kind == REP_KIND && (REP_GK < 0 || gk == REP_GK)) ? 0 : 1); rep < 2; ++rep) {
        const bool dry = (rep == 0);
#else
        const bool dry = false; {
#endif
        Ctx C; ctx_init(C, smem);
        if (kind == 0 && PH_ON(0)) p0_prologue(C);
        else if (kind == 8) p0b_prologue(C);
        else if (kind == 1 && PH_ON(1)) {
            pg8::Gemm g; EpiAny E; E.P.PJ = (bf16*)(C.ws + WS_PJ); E.P.TL = (float*)(C.ws + WS_TL); E.PJ = (const bf16*)(C.ws + WS_PJ); E.T = nullptr; E.O = nullptr; E.gcol = 0; E.X = C.in[I_X]; E.OF = C.out; E.b = b; E.ldc = 2048;
            if (gk == 0)      { g = pg8::Gemm{(const bf16*)(C.ws + WS_HN), (const bf16*)(C.ws + WS_W1T), SEQ, NPJ, 1024}; E.mode = 0; if (b == 0) meta_proj(C); tail_proj(C); }
            else if (gk == 5) { g = pg8::Gemm{(const bf16*)(C.ws + WS_OG), (const bf16*)(C.ws + WS_WAT), RPB, 1024, 1024}; E.mode = 1; E.O = (bf16*)(C.ws + WS_T1); E.gcol = PJ_GA; }
            else if (gk == 6) { g = pg8::Gemm{(const bf16*)(C.ws + WS_YS), (const bf16*)(C.ws + WS_WBT), RPB, 1024, 2048}; E.mode = 1; E.O = (bf16*)(C.ws + WS_MX); E.gcol = PJ_GB; E.T = (const bf16*)(C.ws + WS_T1); }
            else if (gk == 7) { g = pg8::Gemm{(const bf16*)(C.ws + WS_MX), (const bf16*)(C.ws + WS_WOT), RPB, 1024, 1024}; E.mode = 2; }
            else              { g = pg8::Gemm{(const bf16*)(C.ws + WS_HN2), (const bf16*)(C.ws + WS_WET), NTOK, 2048, 1024}; E.mode = 3; E.OF = (float*)(C.ws + WS_SC); }
            pg8::StaticOrder S; S.init(g.M, g.N, C.G, C.bid);
#ifdef REP_TAIL_ONLY
            if (!dry)
#endif
            pg8::gemm_phase<EpiAny, pg8::StaticOrder, true, true>(C.lds, g, S, E);
            if (gk == 7 && b + 1 < BATCH) hn_batch(C, b + 1, (S.nwg < C.G) ? S.nwg : 0);
        }
        else if (kind == 2 && PH_ON(2)) { for (int u = C.bid; u < NCHUNK * 11; u += C.G) phaseC_unit(C, u / 11, u % 11); }
        else if (kind == 3 && PH_ON(3)) { int i = 0; for (int u = C.bid; u < NCHUNK * 8; u += C.G, ++i) { const int c = u >> 3, k = (C.G == 256) ? ((u & 7) + 4 * i) & 7 : (u & 7); if (k < 4) gla_pass1_unit(C, c, k); else ssd_pass1_unit(C, c, k - 4); } }
        else if (kind == 4 && PH_ON(4)) phaseE(C);
        else if (kind == 5 && PH_ON(5)) { int i = 0; for (int u = C.bid; u < NCHUNK * 8; u += C.G, ++i) { const int c = u >> 3, k = (C.G == 256) ? ((u & 7) + 4 * i) & 7 : (u & 7); if (k < 4) gla_pass3_unit(C, c, k); else ssd_pass3_unit(C, c, k - 4); } }
        else if (kind == 6 && PH_ON(6)) phaseJ(C);
        else if (kind == 7 && PH_ON(7)) { const int gw = C.bid * NWAVES + C.wave, NGW = C.G * NWAVES; for (int t = gw; t < NTOK; t += NGW) peer_token(C, t, dry); }
#ifdef REP_KIND
        if (rep == 0) xcd_barrier(bar);
#endif
        }
        if (step + 1 < hi && !(kind == 1 && gk == 5)) xcd_barrier(bar);
    }
}

#ifdef DBG_STOP
__global__ void dbg_digest(const unsigned* w, size_t nwords, float* out, size_t nout) {
    for (size_t i = (size_t)blockIdx.x * blockDim.x + threadIdx.x; i < nout; i += (size_t)gridDim.x * blockDim.x) {
        unsigned h = 0; for (size_t j = i; j < nwords; j += nout) h ^= w[j] * 2654435761u + (unsigned)(j / nout);
        out[i] = (float)(h & 0xFFFFFFu);
    }
}
#endif
#ifndef HYB_N_LAUNCHES
#define HYB_N_LAUNCHES 1
#endif
extern "C" void kernel_launch(void* const* d_in, const int* in_sizes, int n_in, void* d_out, int out_size, void* d_ws, size_t ws_size, hipStream_t stream) {
    static int grid = 0;
    if (grid == 0) {
        if (n_in != 22 || out_size != NTOK * D || ws_size < WS_END) { fprintf(stderr, "kernel_launch: unexpected shapes: n_in %d out %d ws %zu (need %zu)\n", n_in, out_size, ws_size, (size_t)WS_END); grid = -1; return; }
        int dev = 0, cus = 0, per_cu = 0;
        if (hipGetDevice(&dev) != hipSuccess || hipDeviceGetAttribute(&cus, hipDeviceAttributeMultiprocessorCount, dev) != hipSuccess) { grid = -1; return; }
        if (hipFuncSetAttribute((const void*)hyb_fwd, hipFuncAttributeMaxDynamicSharedMemorySize, LDS_BYTES) != hipSuccess) { fprintf(stderr, "kernel_launch: hipFuncSetAttribute failed\n"); grid = -1; return; }
        if (hipOccupancyMaxActiveBlocksPerMultiprocessor(&per_cu, (const void*)hyb_fwd, NT, LDS_BYTES) != hipSuccess || per_cu < 1) { fprintf(stderr, "kernel_launch: occupancy query says %d blocks per CU\n", per_cu); per_cu = 1; }
        (void)hipGetLastError();
        grid = cus;
    }
    if (grid < 0) return;
    (void)hipMemsetAsync((char*)d_ws + WS_CTL, 0, CTL_ZERO_BYTES, stream);
    Args a{};
    for (int i = 0; i < 22; ++i) a.in[i] = (const float*)d_in[i];
    a.out = (float*)d_out; a.ws = (unsigned char*)d_ws;
    if (HYB_N_LAUNCHES == 1) { a.ph_lo = 0; a.ph_hi = NSTEPS; hipLaunchKernelGGL(hyb_fwd, dim3(grid), dim3(NT), LDS_BYTES, stream, a); }
    else {
#ifdef DBG_STOP
        for (int s = 0; s <= DBG_STOP; ++s) { a.ph_lo = s; a.ph_hi = s + 1; hipLaunchKernelGGL(hyb_fwd, dim3(grid), dim3(NT), LDS_BYTES, stream, a); }
        hipLaunchKernelGGL(dbg_digest, dim3(2048), dim3(256), 0, stream, (const unsigned*)((char*)d_ws + (size_t)(DBG_OFF)), (size_t)(DBG_LEN) / 4, (float*)d_out, (size_t)NTOK * D);
#else
        for (int s = 0; s < NSTEPS; ++s) { a.ph_lo = s; a.ph_hi = s + 1; hipLaunchKernelGGL(hyb_fwd, dim3(grid), dim3(NT), LDS_BYTES, stream, a); }
#endif
    }
}
```

```cpp
#include <hip/hip_runtime.h>
#include <cstdio>
#include <cstdint>
namespace pg8 {
#define PG8_LAS __attribute__((address_space(3)))
typedef unsigned short bf16_t;
typedef short bf16x8 __attribute__((ext_vector_type(8)));
typedef float f32x4 __attribute__((ext_vector_type(4)));
typedef unsigned u32x4 __attribute__((ext_vector_type(4)));
constexpr int BM = 256, BK = 64, HALF = 128, HTB = HALF * BK * 2  , STAGE_BYTES = 8 * HTB, NXCD = 8, WGM = 8;

__host__ __device__ __forceinline__ int lds_byte(int r, int c) { const int st = (r >> 4) * 2 + (c >> 5), rr = r & 15, cc = c & 31, ob = rr * 64 + cc * 2; return st * 1024 + (ob ^ (((ob >> 9) & 1) << 5)); }
__host__ __device__ __forceinline__ void stage_rc(int b, int& R, int& C) { const int st = b / 1024, sb = b % 1024, swz = sb ^ (((sb >> 9) & 1) << 5); R = (st >> 1) * 16 + swz / 64; C = (st & 1) * 32 + (swz % 64) / 2; }
__host__ __device__ __forceinline__ int perm32(int rho) { const int n = rho >> 4, i = rho & 15; return 8 * (i >> 2) + 4 * n + (i & 3); }

struct Unit { int pm, pn; };
struct Gemm { const bf16_t* A; const bf16_t* Bt; int M, N, K; };

struct StaticOrder {
    int nM, nN, nwg, G, c;
    __host__ __device__ void init(int M, int N, int G_, int c_) { nM = M / BM; nN = N / BM; nwg = nM * nN; G = G_; c = c_; }
    __host__ __device__ bool next(int i, Unit& u) const {
        const long L = (long)i * G + c; if (L >= nwg) return false;
        int wgid = (int)L; { const int q = nwg / NXCD, r = nwg % NXCD, xcd = wgid % NXCD, off = wgid / NXCD; wgid = (xcd < r ? xcd * (q + 1) : r * (q + 1) + (xcd - r) * q) + off; }
        const int nig = WGM * nN, gid = wgid / nig, fm = gid * WGM, gsz = (nM - fm) < WGM ? (nM - fm) : WGM;
        u.pm = fm + ((wgid % nig) % gsz); u.pn = (wgid % nig) / gsz; return true;
    }
    __device__ __forceinline__ void a_ready(const Unit&) const {}
    __device__ __forceinline__ void done(const Unit&) const {}
};

typedef float f32x2_t __attribute__((ext_vector_type(2))); typedef __bf16 bf16x2_t __attribute__((ext_vector_type(2)));
__device__ __forceinline__ unsigned cvt_pk_bf16(float lo, float hi) { f32x2_t v = {lo, hi}; bf16x2_t b = __builtin_convertvector(v, bf16x2_t); return __builtin_bit_cast(unsigned, b); }
template <class Epi, class Sched, bool ALIGN_EPI = false, bool SP2 = false>
__device__ __forceinline__ void gemm_phase(PG8_LAS unsigned char* lds, const Gemm g, const Sched& S, const Epi& E) {
    int tid_ = threadIdx.x; asm volatile("" : "+v"(tid_));
    const int tid = tid_, wid = __builtin_amdgcn_readfirstlane(tid >> 6), lane = tid & 63, wr = wid >> 2, wc = wid & 3, fr = lane & 15, fq = lane >> 4;
    const int K = g.K, nt = K / BK;
    unsigned voffA[2], voffB[2];
#pragma unroll
    for (int i = 0; i < 2; ++i) { int R, C; stage_rc(tid * 16 + i * 8192, R, C); const int Rb = Epi::PERM ? ((R & ~31) + perm32(R & 31)) : R;
        voffA[i] = (unsigned)(R * K + C) * 2u; voffB[i] = (unsigned)(Rb * K + C) * 2u; }
    const size_t kstep = (size_t)(BK * 2);
    const size_t hstep = (size_t)HALF * K * 2;
    const size_t tstep = 2 * hstep;
    const unsigned ldsw = (unsigned)wid * 1024u;
    const int aoff = lds_byte(wr * 64 + fr, fq * 8), boff = lds_byte(wc * 32 + fr, fq * 8);
#define PG8_SA(b, h) (((b) * 2 + (h)) * HTB)
#define PG8_SB(b, h) ((4 + (b) * 2 + (h)) * HTB)
#define PG8_STAGE(bufoff, gbase, voff) do { _Pragma("unroll") for (int _i = 0; _i < 2; ++_i) \
        __builtin_amdgcn_global_load_lds((const unsigned*)((const char*)(gbase) + (voff)[_i]), (PG8_LAS unsigned*)(lds + (bufoff) + ldsw + _i * 8192), 16, 0, 0); } while (0)
#define PG8_LDA(dst, b, h) do { _Pragma("unroll") for (int m = 0; m < 4; ++m) _Pragma("unroll") for (int k = 0; k < 2; ++k) dst[m][k] = *(const PG8_LAS bf16x8*)(lds + PG8_SA(b, h) + aoff + m * 2048 + k * 1024); } while (0)
#define PG8_LDB(dst, b, h) do { _Pragma("unroll") for (int n = 0; n < 2; ++n) _Pragma("unroll") for (int k = 0; k < 2; ++k) dst[n][k] = *(const PG8_LAS bf16x8*)(lds + PG8_SB(b, h) + boff + n * 2048 + k * 1024); } while (0)
#define PG8_MMA(ai, bj, At, Bt) do { __builtin_amdgcn_s_setprio(1); _Pragma("unroll") for (int m = 0; m < 4; ++m) _Pragma("unroll") for (int n = 0; n < 2; ++n) _Pragma("unroll") for (int k = 0; k < 2; ++k) \
        acc[ai][bj][m][n] = __builtin_amdgcn_mfma_f32_16x16x32_bf16(Bt[n][k], At[m][k], acc[ai][bj][m][n], 0, 0, 0); __builtin_amdgcn_s_setprio(0); } while (0)
#define PG8_WAIT_V(n) asm volatile("s_waitcnt vmcnt(" #n ")" ::: "memory")
#define PG8_WAIT_L(n) asm volatile("s_waitcnt lgkmcnt(" #n ")" ::: "memory")
#define PG8_BAR __builtin_amdgcn_s_barrier()
#define PG8_SCHED __builtin_amdgcn_sched_barrier(0)
    Unit cur, nxt; int ui = 0;
    if (!S.next(0, cur)) return;
    f32x4 acc[2][2][4][2];
#pragma unroll
    for (int a = 0; a < 2; ++a)
#pragma unroll
        for (int b = 0; b < 2; ++b)
#pragma unroll
            for (int m = 0; m < 4; ++m)
#pragma unroll
                for (int n = 0; n < 2; ++n) acc[a][b][m][n] = (f32x4){0.f, 0.f, 0.f, 0.f};
    bf16x8 At[4][2], B0[2][2], B1[2][2];
    const char* cA = (const char*)g.A + (size_t)cur.pm * tstep; const char* cB = (const char*)g.Bt + (size_t)cur.pn * tstep;
    S.a_ready(cur);
    if constexpr (SP2) {
        PG8_STAGE(PG8_SB(0, 0), cB, voffB); PG8_STAGE(PG8_SB(0, 1), cB + hstep, voffB); PG8_STAGE(PG8_SA(0, 0), cA, voffA); PG8_STAGE(PG8_SA(0, 1), cA + hstep, voffA);
        if (wr == 1) PG8_BAR;
        PG8_WAIT_V(2); PG8_BAR;
        PG8_STAGE(PG8_SB(1, 0), cB + kstep, voffB); PG8_STAGE(PG8_SA(1, 0), cA + kstep, voffA); PG8_STAGE(PG8_SB(1, 1), cB + hstep + kstep, voffB);
        PG8_WAIT_V(6); PG8_BAR;
    } else {
        PG8_STAGE(PG8_SB(0, 0), cB, voffB); PG8_STAGE(PG8_SA(0, 0), cA, voffA); PG8_STAGE(PG8_SB(0, 1), cB + hstep, voffB); PG8_STAGE(PG8_SA(0, 1), cA + hstep, voffA);
        if (wr == 1) PG8_BAR;
        PG8_WAIT_V(4); PG8_BAR;
        PG8_STAGE(PG8_SB(1, 0), cB + kstep, voffB); PG8_STAGE(PG8_SA(1, 0), cA + kstep, voffA); PG8_STAGE(PG8_SB(1, 1), cB + hstep + kstep, voffB);
        PG8_WAIT_V(6); PG8_BAR;
    }
    for (;;) {
        const bool has_next = S.next(ui + 1, nxt);
        const char* nA = has_next ? (const char*)g.A + (size_t)nxt.pm * tstep : cA; const char* nB = has_next ? (const char*)g.Bt + (size_t)nxt.pn * tstep : cB;
        for (int t = 0; t < nt; t += 2) {
            const bool last = (t == nt - 2);
            const char* a1 = cA + (size_t)(t + 1) * kstep;
            const char* a2 = last ? nA : cA + (size_t)(t + 2) * kstep; const char* b2 = last ? nB : cB + (size_t)(t + 2) * kstep;
            const char* a3 = a2 + kstep; const char* b3 = b2 + kstep;
            if (last && has_next) S.a_ready(nxt);
            if constexpr (SP2) {
            PG8_LDB(B0, 0, 0); PG8_LDB(B1, 0, 1); PG8_SCHED; PG8_LDA(At, 0, 0); PG8_STAGE(PG8_SA(1, 1), a1 + hstep, voffA);
            PG8_WAIT_V(8); PG8_WAIT_L(0); PG8_BAR; PG8_MMA(0, 0, At, B0); PG8_MMA(0, 1, At, B1); PG8_BAR; PG8_SCHED;
            PG8_LDA(At, 0, 1); PG8_STAGE(PG8_SB(0, 0), b2, voffB); PG8_STAGE(PG8_SB(0, 1), b2 + hstep, voffB); PG8_STAGE(PG8_SA(0, 0), a2, voffA);
            PG8_WAIT_V(8); PG8_WAIT_L(0); PG8_BAR; PG8_MMA(1, 0, At, B0); PG8_MMA(1, 1, At, B1); PG8_BAR; PG8_SCHED;
            PG8_LDB(B0, 1, 0); PG8_LDB(B1, 1, 1); PG8_SCHED; PG8_LDA(At, 1, 0); PG8_STAGE(PG8_SA(0, 1), a2 + hstep, voffA);
            PG8_WAIT_V(8); PG8_WAIT_L(0); PG8_BAR; PG8_MMA(0, 0, At, B0); PG8_MMA(0, 1, At, B1); PG8_BAR; PG8_SCHED;
            PG8_LDA(At, 1, 1); PG8_STAGE(PG8_SB(1, 0), b3, voffB); PG8_STAGE(PG8_SB(1, 1), b3 + hstep, voffB); PG8_STAGE(PG8_SA(1, 0), a3, voffA);
            PG8_WAIT_V(8); PG8_WAIT_L(0); PG8_BAR; PG8_MMA(1, 0, At, B0); PG8_MMA(1, 1, At, B1); PG8_BAR; PG8_SCHED;
            } else {
            PG8_LDB(B0, 0, 0); PG8_SCHED; PG8_LDA(At, 0, 0); PG8_STAGE(PG8_SA(1, 1), a1 + hstep, voffA);
            PG8_WAIT_L(8); PG8_BAR; PG8_WAIT_L(0); PG8_MMA(0, 0, At, B0); PG8_BAR; PG8_SCHED;
            PG8_LDB(B1, 0, 1); PG8_STAGE(PG8_SB(0, 0), b2, voffB);
            PG8_BAR; PG8_WAIT_L(0); PG8_MMA(0, 1, At, B1); PG8_BAR;
            PG8_LDA(At, 0, 1); PG8_STAGE(PG8_SA(0, 0), a2, voffA);
            PG8_BAR; PG8_WAIT_L(0); PG8_MMA(1, 0, At, B0); PG8_BAR; PG8_SCHED;
            PG8_STAGE(PG8_SB(0, 1), b2 + hstep, voffB);
            PG8_WAIT_V(6); PG8_BAR; PG8_MMA(1, 1, At, B1); PG8_BAR;
            PG8_LDB(B0, 1, 0); PG8_SCHED; PG8_LDA(At, 1, 0); PG8_STAGE(PG8_SA(0, 1), a2 + hstep, voffA);
            PG8_WAIT_L(8); PG8_BAR; PG8_WAIT_L(0); PG8_MMA(0, 0, At, B0); PG8_BAR; PG8_SCHED;
            PG8_LDB(B1, 1, 1); PG8_STAGE(PG8_SB(1, 0), b3, voffB);
            PG8_BAR; PG8_WAIT_L(0); PG8_MMA(0, 1, At, B1); PG8_BAR;
            PG8_LDA(At, 1, 1); PG8_STAGE(PG8_SA(1, 0), a3, voffA);
            PG8_BAR; PG8_WAIT_L(0); PG8_MMA(1, 0, At, B0); PG8_BAR; PG8_SCHED;
            PG8_STAGE(PG8_SB(1, 1), b3 + hstep, voffB);
            PG8_WAIT_V(6); PG8_BAR; PG8_MMA(1, 1, At, B1); PG8_BAR;
            }
        }
        if constexpr (ALIGN_EPI) { if (wr == 0) PG8_BAR; }
        if constexpr (!Epi::AFTER_DRAIN) { E(acc, cur, wr, wc, fr, fq); S.done(cur); }
        if (!has_next) break;
#pragma unroll
        for (int a = 0; a < 2; ++a)
#pragma unroll
            for (int b = 0; b < 2; ++b)
#pragma unroll
                for (int m = 0; m < 4; ++m)
#pragma unroll
                    for (int n = 0; n < 2; ++n) acc[a][b][m][n] = (f32x4){0.f, 0.f, 0.f, 0.f};
        cur = nxt; cA = nA; cB = nB; ++ui;
        if constexpr (ALIGN_EPI) { if (wr == 1) PG8_BAR; }
    }
    PG8_WAIT_V(0);
    if constexpr (!ALIGN_EPI) { if (wr == 0) PG8_BAR; }
    PG8_BAR;
    if constexpr (Epi::AFTER_DRAIN) { E.fused(acc, cur, wr, wc, fr, fq, lds, wid, lane); S.done(cur); }
#undef PG8_SA
#undef PG8_SB
#undef PG8_STAGE
#undef PG8_LDA
#undef PG8_LDB
#undef PG8_MMA
#undef PG8_WAIT_V
#undef PG8_WAIT_L
#undef PG8_BAR
#undef PG8_SCHED
}
}

constexpr int NWAVES = 8, NT = 512;
constexpr int D = 1024, BATCH = 4, SEQ = 8192, NMETA = 16;
constexpr int RPB = 8448;
constexpr int RFRONT = 48, RTOK = 64, REND = 8256;
constexpr int NCHUNK = 129;
constexpr int NPJ = 10240;
constexpr int N1 = 10496;
constexpr int PJ_Q = 0, PJ_K = 512, PJ_V = 1024, PJ_GO = 2048, PJ_Z = 3072, PJ_XBC = 5120, PJ_GA = 8192, PJ_GB = 9216;
constexpr int NTOK = BATCH * SEQ;
constexpr float RMS_EPS = 1e-6f;

constexpr size_t MiB = 1u << 20;
constexpr size_t WS_CTL = 0, CTL_ZERO_BYTES = 1 * MiB;
constexpr size_t WS_W1T = 2 * MiB;
constexpr size_t WS_WAT = 23 * MiB;
constexpr size_t WS_WBT = 25 * MiB;
constexpr size_t WS_WOT = 29 * MiB;
constexpr size_t WS_WET = 31 * MiB;
constexpr size_t WS_HNM = 35 * MiB;
constexpr size_t WS_HN = 36 * MiB;
constexpr size_t WS_PJ = 53 * MiB;
constexpr size_t WS_TL = 218 * MiB;
constexpr size_t WS_XC = 220 * MiB;
constexpr size_t WS_GG = 270 * MiB;
constexpr size_t WS_DT = 287 * MiB;
constexpr size_t WS_AC = 289 * MiB;
constexpr size_t WS_LG = 291 * MiB;
constexpr size_t WS_LS = 324 * MiB;
constexpr size_t WS_OG = 389 * MiB;
constexpr size_t WS_YS = 406 * MiB;
constexpr size_t WS_T1 = 439 * MiB;
constexpr size_t WS_MX = 456 * MiB;
constexpr size_t WS_MIX_END = 473 * MiB;
constexpr size_t WS_HN2 = 36 * MiB;
constexpr size_t WS_SC = 100 * MiB;
constexpr size_t WS_U8 = 356 * MiB;
constexpr size_t WS_V8 = 372 * MiB;
constexpr size_t WS_END = 473 * MiB;
constexpr int CW_BAR = 4096, CW_QUEUE = 64;

constexpr int LDS_WORK = 147456;
constexpr int LDSCTL_OFF = LDS_WORK;
constexpr int LDS_BYTES = LDS_WORK + 512;

#define GAS __attribute__((address_space(1)))
#define LAS __attribute__((address_space(3)))
typedef unsigned short bf16;
typedef unsigned v4u __attribute__((ext_vector_type(4)));
typedef unsigned v2u __attribute__((ext_vector_type(2)));
typedef float f32x4 __attribute__((ext_vector_type(4)));
typedef float f32x2 __attribute__((ext_vector_type(2)));
typedef short bf16x8 __attribute__((ext_vector_type(8)));
typedef short s16x4 __attribute__((ext_vector_type(4)));
typedef short v4i16_t __attribute__((ext_vector_type(4)));
typedef LAS unsigned char* ldsp;
#define RLX_AGENT __ATOMIC_RELAXED, __HIP_MEMORY_SCOPE_AGENT
#define LDS_WAIT() asm volatile("s_waitcnt lgkmcnt(0)" ::: "memory")

__device__ __forceinline__ unsigned pk2(float lo, float hi) { return pg8::cvt_pk_bf16(lo, hi); }
__device__ __forceinline__ float bflo(unsigned u) { return __builtin_bit_cast(float, u << 16); }
__device__ __forceinline__ float bfhi(unsigned u) { return __builtin_bit_cast(float, u & 0xffff0000u); }
__device__ __forceinline__ float fast_rcp(float x) { return __builtin_amdgcn_rcpf(x); }
__device__ __forceinline__ float sigmoidf_(float x) { return fast_rcp(1.f + __expf(-x)); }
__device__ __forceinline__ float siluf_(float x) { return x * sigmoidf_(x); }
__device__ __forceinline__ float wave_sum(float v) {
#pragma unroll
    for (int o = 1; o < 64; o <<= 1) v += __shfl_xor(v, o);
    return v;
}
__device__ __forceinline__ float wave_max(float v) {
#pragma unroll
    for (int o = 1; o < 64; o <<= 1) v = fmaxf(v, __shfl_xor(v, o));
    return v;
}
__device__ __forceinline__ f32x4 mma16(bf16x8 a, bf16x8 b, f32x4 c) { return __builtin_amdgcn_mfma_f32_16x16x32_bf16(b, a, c, 0, 0, 0); }
__device__ __forceinline__ bf16x8 lds_frag(ldsp p) { return *(const LAS bf16x8*)p; }
__device__ __forceinline__ s16x4 lds_tr(ldsp p) { return __builtin_bit_cast(s16x4, __builtin_amdgcn_ds_read_tr16_b64_v4i16((LAS v4i16_t*)p)); }
__device__ __forceinline__ bf16x8 tr_frag(ldsp tile, int pitch, int k0, int n0, int fr, int fq) {
#ifdef TR_SLOW
    bf16x8 r;
#pragma unroll
    for (int e = 0; e < 8; ++e) r[e] = *(const LAS short*)(tile + (k0 + 8 * fq + e) * pitch + (n0 + fr) * 2);
    return r;
#else
    ldsp p = tile + (k0 + 8 * fq + (fr >> 2)) * pitch + (n0 + 4 * (fr & 3)) * 2;
    const s16x4 lo = lds_tr(p), hi = lds_tr(p + 4 * pitch);
    bf16x8 r; r[0] = lo[0]; r[1] = lo[1]; r[2] = lo[2]; r[3] = lo[3]; r[4] = hi[0]; r[5] = hi[1]; r[6] = hi[2]; r[7] = hi[3];
    return r;
#endif
}

#define XB_TMO      128
#define XB_XCNT(j)  (256  + 64 * (j))
#define XB_XSUB(j)  (1280 + 64 * (j))
#define XB_XGEN(j)  (2304 + 64 * (j))
#define XB_TOP      3328
#define XB_TOPGEN   3392
#define XCD_BAR_WORDS 3456
#define XB_SPIN_CAP (1u << 22)
__device__ __forceinline__ unsigned xb_ld(unsigned* p)              { return __hip_atomic_load(p, __ATOMIC_RELAXED, __HIP_MEMORY_SCOPE_AGENT); }
__device__ __forceinline__ unsigned xb_add(unsigned* p, unsigned v) { return __hip_atomic_fetch_add(p, v, __ATOMIC_RELAXED, __HIP_MEMORY_SCOPE_AGENT); }
__device__ __forceinline__ unsigned xb_xcc_id() { return (unsigned)__builtin_amdgcn_s_getreg((3 << 11) | 20) & 0xFu; }
#define XB_SPIN(cond, bar) do { unsigned _sp = 0; while (cond) { __builtin_amdgcn_s_sleep(1); \
    if ((++_sp & 255u) == 0u) { if (xb_ld(&(bar)[XB_TMO])) break; if (_sp > XB_SPIN_CAP) { atomicAdd(&(bar)[XB_TMO], 1u); break; } } } } while (0)
struct XcdBarrier { unsigned* bar; unsigned x; volatile LAS unsigned* st; };
__device__ __forceinline__ XcdBarrier xcd_barrier_post(unsigned* bar, volatile LAS unsigned* st) {
    XcdBarrier b; b.bar = bar; b.x = xb_xcc_id(); b.st = st;
    if (threadIdx.x == 0) (void)xb_add(&bar[XB_XCNT(b.x)], 1u);
    return b;
}
__device__ __forceinline__ void xcd_barrier_complete(unsigned* bar, unsigned x, unsigned& nloc, unsigned& nx) {
    const unsigned G = gridDim.x * gridDim.y * gridDim.z;
    unsigned sum, cnt, mine, sp = 0u;
    for (;;) {
        sum = 0u; cnt = 0u; mine = 0u;
#pragma unroll
        for (unsigned j = 0; j < 16; ++j) { const unsigned c = xb_ld(&bar[XB_XCNT(j)]); sum += c; cnt += (c > 0u) ? 1u : 0u; mine = (j == x) ? c : mine; }
        if (sum == G) break;
        __builtin_amdgcn_s_sleep(1);
        if ((++sp & 255u) == 0u) { if (xb_ld(&bar[XB_TMO])) break; if (sp > XB_SPIN_CAP) { atomicAdd(&bar[XB_TMO], 1u); break; } }
    }
    nloc = mine > 0u ? mine : 1u; nx = cnt > 0u ? cnt : 1u;
}
__device__ __forceinline__ void xcd_barrier(const XcdBarrier& b) {
    asm volatile("s_waitcnt vmcnt(0)" ::: "memory");
    __syncthreads();
    if (threadIdx.x == 0) {
        unsigned* bar = b.bar;
        __builtin_amdgcn_s_waitcnt(0);
        unsigned nloc = b.st[0], nx = b.st[1];
        if (nloc == 0u) { xcd_barrier_complete(bar, b.x, nloc, nx); b.st[0] = nloc; b.st[1] = nx; }
        const unsigned old = xb_add(&bar[XB_XSUB(b.x)], 1u);
        const unsigned gen = old / nloc;
        if (old + 1u == (gen + 1u) * nloc) {
            __builtin_amdgcn_fence(__ATOMIC_RELEASE, "agent");
            asm volatile("s_waitcnt vmcnt(0)" ::: "memory");
            const unsigned og = xb_add(&bar[XB_TOP], 1u);
            const unsigned tg = og / nx;
            if (og + 1u == (tg + 1u) * nx) xb_add(&bar[XB_TOPGEN], 1u);
            else XB_SPIN(xb_ld(&bar[XB_TOPGEN]) == tg, bar);
            __builtin_amdgcn_fence(__ATOMIC_ACQUIRE, "agent");
            xb_add(&bar[XB_XGEN(b.x)], 1u);
            asm volatile("s_waitcnt vmcnt(0)" ::: "memory");
        } else {
            XB_SPIN(xb_ld(&bar[XB_XGEN(b.x)]) == gen, bar);
            __builtin_amdgcn_fence(__ATOMIC_ACQUIRE, "agent");
            asm volatile("s_waitcnt vmcnt(0)" ::: "memory");
        }
    }
    __syncthreads();
}

struct Ctx {
    ldsp lds; int tid, lane, wave, G, bid;
    const float* in[22]; float* out; unsigned char* ws;
};
enum { I_X = 0, I_META, I_LNMIX, I_WIN, I_WG2, I_BG, I_GNW, I_CONVW, I_CONVB, I_DTB, I_ALOG, I_DSKIP, I_SNW, I_WUG, I_WUS, I_WOUT, I_LNFFN, I_WQ, I_KEYS, I_PU, I_PV, I_LNF };

using pg8::Unit; using pg8::cvt_pk_bf16;
struct EpiProj {
    static constexpr bool PERM = true, AFTER_DRAIN = false;
    bf16* PJ; float* TL;
    __device__ __forceinline__ void operator()(const f32x4 (&acc)[2][2][4][2], const Unit& u, int wr, int wc, int fr, int fq) const {
        const int row0 = RTOK + u.pm * 256 + wr * 64 + fr; const int pn = u.pn;
        const int mode = pn < 2 ? 1 : (pn < 8 ? 0 : (pn < 20 ? 2 : (pn < 32 ? 0 : 3)));
        const int col0 = pn * 256 + wc * 32 + 8 * fq;
#pragma unroll
        for (int ai = 0; ai < 2; ++ai)
#pragma unroll
            for (int m = 0; m < 4; ++m) { bf16* rowp = PJ + (size_t)(row0 + ai * 128 + m * 16) * NPJ + col0;
#pragma unroll
                for (int bj = 0; bj < 2; ++bj) { f32x4 v0 = acc[ai][bj][m][0], v1 = acc[ai][bj][m][1];
                    if (mode == 1) { v0 = v0 * 0.08838834764831845f; v1 = v1 * 0.08838834764831845f; }
                    else if (mode == 2) {
#pragma unroll
                        for (int j = 0; j < 4; ++j) { v0[j] = siluf_(v0[j]); v1[j] = siluf_(v1[j]); } }
                    else if (mode == 3) {
#pragma unroll
                        for (int j = 0; j < 4; ++j) { v0[j] = sigmoidf_(v0[j]); v1[j] = sigmoidf_(v1[j]); } }
                    v4u w; w.x = cvt_pk_bf16(v0[0], v0[1]); w.y = cvt_pk_bf16(v0[2], v0[3]); w.z = cvt_pk_bf16(v1[0], v1[1]); w.w = cvt_pk_bf16(v1[2], v1[3]);
                    *(GAS v4u*)(rowp + bj * 128) = w; } }
    }
};
struct EpiAny {
    static constexpr bool PERM = true, AFTER_DRAIN = false;
    int mode;
    EpiProj P; bf16* O; const bf16* PJ; const bf16* T; int gcol; const float* X; float* OF; int b; int ldc;
    __device__ __forceinline__ void operator()(const f32x4 (&acc)[2][2][4][2], const Unit& u, int wr, int wc, int fr, int fq) const {
        if (mode == 0) { P(acc, u, wr, wc, fr, fq); return; }
        const int row0 = u.pm * 256 + wr * 64 + fr; const int col0 = u.pn * 256 + wc * 32 + 8 * fq;
        if (mode == 1) {
#pragma unroll
            for (int ai = 0; ai < 2; ++ai)
#pragma unroll
                for (int m = 0; m < 4; ++m) { const size_t r = (size_t)(row0 + ai * 128 + m * 16);
                    v4u gq[2], tq[2];
#pragma unroll
                    for (int bj = 0; bj < 2; ++bj) { gq[bj] = *(const GAS v4u*)(PJ + r * NPJ + gcol + col0 + bj * 128); tq[bj] = T ? *(const GAS v4u*)(T + r * 1024 + col0 + bj * 128) : (v4u){0u, 0u, 0u, 0u}; }
#pragma unroll
                    for (int bj = 0; bj < 2; ++bj) { const int c = col0 + bj * 128;
                        const v4u g = gq[bj];
                        f32x4 v0 = acc[ai][bj][m][0], v1 = acc[ai][bj][m][1];
                        v0[0] *= bflo(g.x); v0[1] *= bfhi(g.x); v0[2] *= bflo(g.y); v0[3] *= bfhi(g.y); v1[0] *= bflo(g.z); v1[1] *= bfhi(g.z); v1[2] *= bflo(g.w); v1[3] *= bfhi(g.w);
                        { const v4u t = tq[bj];
                            v0[0] += bflo(t.x); v0[1] += bfhi(t.x); v0[2] += bflo(t.y); v0[3] += bfhi(t.y); v1[0] += bflo(t.z); v1[1] += bfhi(t.z); v1[2] += bflo(t.w); v1[3] += bfhi(t.w); }
                        v4u w; w.x = cvt_pk_bf16(v0[0], v0[1]); w.y = cvt_pk_bf16(v0[2], v0[3]); w.z = cvt_pk_bf16(v1[0], v1[1]); w.w = cvt_pk_bf16(v1[2], v1[3]);
                        *(GAS v4u*)(O + r * 1024 + c) = w; } }
        } else if (mode == 2) {
#pragma unroll
            for (int ai = 0; ai < 2; ++ai)
#pragma unroll
                for (int m = 0; m < 4; ++m) { const int r = row0 + ai * 128 + m * 16;
                    if (r >= RTOK && r < REND) { const size_t o = ((size_t)b * SEQ + (r - RTOK)) * D + col0;
                        f32x4 xv[2][2];
#pragma unroll
                        for (int bj = 0; bj < 2; ++bj)
#pragma unroll
                            for (int n = 0; n < 2; ++n) xv[bj][n] = *(const GAS f32x4*)(X + o + bj * 128 + n * 4);
#pragma unroll
                        for (int bj = 0; bj < 2; ++bj)
#pragma unroll
                            for (int n = 0; n < 2; ++n) *(GAS f32x4*)(OF + o + bj * 128 + n * 4) = acc[ai][bj][m][n] + xv[bj][n]; } }
        } else {
#pragma unroll
            for (int ai = 0; ai < 2; ++ai)
#pragma unroll
                for (int m = 0; m < 4; ++m) { float* rowp = OF + (size_t)(row0 + ai * 128 + m * 16) * ldc + col0;
#pragma unroll
                    for (int bj = 0; bj < 2; ++bj)
#pragma unroll
                        for (int n = 0; n < 2; ++n) *(GAS f32x4*)(rowp + bj * 128 + n * 4) = acc[ai][bj][m][n]; }
        }
    }
};

struct MapIdent { __device__ __forceinline__ int operator()(int n) const { return n; } };
struct MapW1 { __device__ __forceinline__ int operator()(int n) const {
    if (n < 3072) return n;
    if (n < 8192) return n + 16;
    if (n < 10240) return n + 48;
    if (n < 10256) return n - 10240 + 3072;
    if (n < 10288) return n - 10256 + 8208;
    return -1; } };
template <class Map>
__device__ __forceinline__ void transpose_item(const float* W, int K, int NS, int N, bf16* WT, LAS float* scr, int item, int lane, const Map& map) {
    const int nblk = N / 32, kb = item / nblk, nb = item % nblk, k0 = 64 * kb, n0 = 32 * nb;
    const int sc = map(n0 + (lane & 31));
#pragma unroll
    for (int i0 = 0; i0 < 32; i0 += 16) { float tv[16];
#pragma unroll
        for (int i = 0; i < 16; ++i) { const int kk = 2 * (i0 + i) + (lane >> 5); tv[i] = sc >= 0 ? *(const GAS float*)(W + (size_t)(k0 + kk) * NS + sc) : 0.f; }
#pragma unroll
        for (int i = 0; i < 16; ++i) { const int kk = 2 * (i0 + i) + (lane >> 5); scr[kk * 33 + (lane & 31)] = tv[i]; } }
    LDS_WAIT(); asm volatile("" ::: "memory");
    const int c = lane & 7;
#pragma unroll
    for (int j = 0; j < 4; ++j) { const int n = (lane >> 3) + 8 * j; const LAS float* s = scr + (8 * c) * 33 + n;
        v4u o; o.x = pk2(s[0 * 33], s[1 * 33]); o.y = pk2(s[2 * 33], s[3 * 33]); o.z = pk2(s[4 * 33], s[5 * 33]); o.w = pk2(s[6 * 33], s[7 * 33]);
        *(GAS v4u*)(WT + (size_t)(n0 + n) * K + k0 + 8 * c) = o; }
    LDS_WAIT(); asm volatile("" ::: "memory");
}
__device__ __forceinline__ void norm_row_bf16(const float* src, const float* w, bf16* dst, int lane) {
    v2u* o8 = (v2u*)dst + lane;
    if (src == nullptr) {
#pragma unroll
        for (int j = 0; j < 4; ++j) o8[64 * j] = (v2u){0u, 0u};
        return; }
    const f32x4* xr = (const f32x4*)src + lane; const f32x4* wr_ = (const f32x4*)w + lane;
    f32x4 v[4]; float s = 0.f;
#pragma unroll
    for (int j = 0; j < 4; ++j) { v[j] = xr[64 * j]; s += (v[j].x * v[j].x + v[j].y * v[j].y) + (v[j].z * v[j].z + v[j].w * v[j].w); }
    const float rs = rsqrtf(wave_sum(s) * (1.f / D) + RMS_EPS);
#pragma unroll
    for (int j = 0; j < 4; ++j) { const f32x4 ww = wr_[64 * j]; v2u o; o.x = pk2(v[j].x * rs * ww.x, v[j].y * rs * ww.y); o.y = pk2(v[j].z * rs * ww.z, v[j].w * rs * ww.w); o8[64 * j] = o; }
}
__device__ __forceinline__ float wave_sum63(float v) {
    v += __builtin_bit_cast(float, __builtin_amdgcn_mov_dpp(__builtin_bit_cast(int, v), 0xB1, 0xf, 0xf, true));
    v += __builtin_bit_cast(float, __builtin_amdgcn_mov_dpp(__builtin_bit_cast(int, v), 0x4E, 0xf, 0xf, true));
    v += __builtin_bit_cast(float, __builtin_amdgcn_mov_dpp(__builtin_bit_cast(int, v), 0x141, 0xf, 0xf, true));
    v += __builtin_bit_cast(float, __builtin_amdgcn_mov_dpp(__builtin_bit_cast(int, v), 0x128, 0xf, 0xf, true));
    v += __builtin_bit_cast(float, __builtin_amdgcn_update_dpp(0, __builtin_bit_cast(int, v), 0x142, 0xa, 0xf, false));
    v += __builtin_bit_cast(float, __builtin_amdgcn_update_dpp(0, __builtin_bit_cast(int, v), 0x143, 0xc, 0xf, false));
    return v;
}
__device__ __forceinline__ void hn_token_rows2(const Ctx& C, int b, int s0, int s1) {
    const int lane = C.lane;
    const f32x4* x0 = (const f32x4*)(C.in[I_X] + ((size_t)b * SEQ + s0) * D) + lane; const f32x4* x1 = (const f32x4*)(C.in[I_X] + ((size_t)b * SEQ + s1) * D) + lane;
    const f32x4* wr_ = (const f32x4*)C.in[I_LNMIX] + lane;
    f32x4 v[4], u[4]; float q0 = 0.f, q1 = 0.f;
#pragma unroll
    for (int j = 0; j < 4; ++j) { v[j] = x0[64 * j]; u[j] = x1[64 * j]; }
#pragma unroll
    for (int j = 0; j < 4; ++j) { q0 += (v[j].x * v[j].x + v[j].y * v[j].y) + (v[j].z * v[j].z + v[j].w * v[j].w); q1 += (u[j].x * u[j].x + u[j].y * u[j].y) + (u[j].z * u[j].z + u[j].w * u[j].w); }
    const float r0 = rsqrtf(wave_sum(q0) * (1.f / D) + RMS_EPS), r1 = rsqrtf(wave_sum(q1) * (1.f / D) + RMS_EPS);
    v2u* o0 = (v2u*)((bf16*)(C.ws + WS_HN) + (size_t)s0 * D) + lane; v2u* o1 = (v2u*)((bf16*)(C.ws + WS_HN) + (size_t)s1 * D) + lane;
#pragma unroll
    for (int j = 0; j < 4; ++j) { const f32x4 ww = wr_[64 * j]; const f32x4 a = v[j] * r0 * ww, bq = u[j] * r1 * ww;
        o0[64 * j] = (v2u){pk2(a.x, a.y), pk2(a.z, a.w)}; o1[64 * j] = (v2u){pk2(bq.x, bq.y), pk2(bq.z, bq.w)}; }
}
__device__ __forceinline__ void hn_batch(const Ctx& C, int b, int first_blk) {
    if (C.bid < first_blk) return;
    const int gw = (C.bid - first_blk) * NWAVES + C.wave, NGW = (C.G - first_blk) * NWAVES;
    for (int s = gw; s < SEQ / 2; s += NGW) hn_token_rows2(C, b, s, s + SEQ / 2);
}
__device__ __forceinline__ void meta_proj(const Ctx& C) {
    const bf16* HNM = (const bf16*)(C.ws + WS_HNM); const bf16* W1T = (const bf16*)(C.ws + WS_W1T);
    bf16* PJ = (bf16*)(C.ws + WS_PJ); float* TL = (float*)(C.ws + WS_TL);
    const int gw = C.bid * NWAVES + C.wave, NGW = C.G * NWAVES, fr = C.lane & 15, fq = C.lane >> 4;
    for (int nt = gw; nt < 643; nt += NGW) {
        f32x4 acc = {0.f, 0.f, 0.f, 0.f};
#pragma unroll 8
        for (int ks = 0; ks < 32; ++ks) acc = mma16(*(const GAS bf16x8*)(HNM + fr * D + 32 * ks + 8 * fq), *(const GAS bf16x8*)(W1T + (size_t)(16 * nt + fr) * D + 32 * ks + 8 * fq), acc);
        const int n = 16 * nt + 4 * fq;
        if (n >= NPJ) { if (n < NPJ + 48) *(GAS f32x4*)(TL + (size_t)(RFRONT + fr) * 48 + (n - NPJ)) = acc; continue; }
        if (n < 512) acc = acc * 0.08838834764831845f;
        else if ((n >= PJ_GO && n < PJ_XBC)) { acc[0] = siluf_(acc[0]); acc[1] = siluf_(acc[1]); acc[2] = siluf_(acc[2]); acc[3] = siluf_(acc[3]); }
        else if (n >= PJ_GA) { acc[0] = sigmoidf_(acc[0]); acc[1] = sigmoidf_(acc[1]); acc[2] = sigmoidf_(acc[2]); acc[3] = sigmoidf_(acc[3]); }
        *(GAS v2u*)(PJ + (size_t)(RFRONT + fr) * NPJ + n) = (v2u){pk2(acc[0], acc[1]), pk2(acc[2], acc[3])};
    }
}
__device__ __forceinline__ void tail_proj(const Ctx& C) {
    int tid_ = C.tid; asm volatile("" : "+v"(tid_));
    const int lane_ = tid_ & 63, wave_ = __builtin_amdgcn_readfirstlane(tid_ >> 6), fr = lane_ & 15, fq = lane_ >> 4;
    const bf16* HN = (const bf16*)(C.ws + WS_HN); const bf16* WT = (const bf16*)(C.ws + WS_W1T) + (size_t)NPJ * D; float* TL = (float*)(C.ws + WS_TL);
    constexpr int PW = 2064;
    ldsp WL = C.lds; LAS f32x4* PR = (LAS f32x4*)(C.lds + 48 * PW);
    { v4u ww[12];
#pragma unroll
      for (int i = 0; i < 12; ++i) { const int e = tid_ + NT * i, row = e >> 7, ch = e & 127; ww[i] = *(const GAS v4u*)(WT + (size_t)row * D + 8 * ch); }
#pragma unroll
      for (int i = 0; i < 12; ++i) { const int e = tid_ + NT * i, row = e >> 7, ch = e & 127; *(LAS v4u*)(WL + row * PW + ch * 16) = ww[i]; } }
    const int rsel = wave_ & 1, kq = wave_ >> 1;
    for (int rp = C.bid; rp < SEQ / 32; rp += C.G) {
        const int rt = 2 * rp + rsel;
        bf16x8 a[8];
#pragma unroll
        for (int i = 0; i < 8; ++i) a[i] = *(const GAS bf16x8*)(HN + (size_t)(16 * rt + fr) * D + 32 * (8 * kq + i) + 8 * fq);
        __syncthreads();
        f32x4 acc[3] = {{0.f, 0.f, 0.f, 0.f}, {0.f, 0.f, 0.f, 0.f}, {0.f, 0.f, 0.f, 0.f}};
#pragma unroll
        for (int i = 0; i < 8; ++i)
#pragma unroll
            for (int n = 0; n < 3; ++n) acc[n] = mma16(a[i], lds_frag(WL + (16 * n + fr) * PW + (32 * (8 * kq + i) + 8 * fq) * 2), acc[n]);
#pragma unroll
        for (int n = 0; n < 3; ++n) PR[(wave_ * 3 + n) * 64 + lane_] = acc[n];
        __syncthreads();
        if (wave_ < 2) {
#pragma unroll
            for (int n = 0; n < 3; ++n) { f32x4 s = PR[((0 * 2 + wave_) * 3 + n) * 64 + lane_] + PR[((1 * 2 + wave_) * 3 + n) * 64 + lane_] + PR[((2 * 2 + wave_) * 3 + n) * 64 + lane_] + PR[((3 * 2 + wave_) * 3 + n) * 64 + lane_];
                *(GAS f32x4*)(TL + (size_t)(RTOK + 16 * (2 * rp + wave_) + fr) * 48 + 16 * n + 4 * fq) = s; }
        }
    }
    __syncthreads();
}
__device__ __forceinline__ void p0b_prologue(const Ctx& C) {
    const int gw = C.bid * NWAVES + C.wave;
    if (gw < NMETA) norm_row_bf16(C.in[I_META] + (size_t)gw * D, C.in[I_LNMIX], (bf16*)(C.ws + WS_HNM) + (size_t)gw * D, C.lane);
    { v4u* z = (v4u*)(C.ws + WS_PJ); const size_t n = (size_t)RFRONT * NPJ * 2 / 16; for (size_t i = (size_t)C.bid * NT + C.tid; i < n; i += (size_t)C.G * NT) z[i] = (v4u){0u, 0u, 0u, 0u}; }
    { v4u* z = (v4u*)(C.ws + WS_TL); const size_t n = (size_t)RFRONT * 48 * 4 / 16; for (size_t i = (size_t)C.bid * NT + C.tid; i < n; i += (size_t)C.G * NT) z[i] = (v4u){0u, 0u, 0u, 0u}; }
    hn_batch(C, 0, 0);
}
__device__ __forceinline__ void weff_unit(const Ctx& C, int unit) {
    int tid_ = C.tid; asm volatile("" : "+v"(tid_));
    const int lane_ = tid_ & 63, wave_ = __builtin_amdgcn_readfirstlane(tid_ >> 6); (void)lane_; (void)wave_;
    const int blk = unit >> 4, d0 = (unit & 15) * 64;
    LAS float* KT = (LAS float*)C.lds;
    LAS float* WQ = (LAS float*)(C.lds + 128 * 132 * 4);
    const float* keys = C.in[I_KEYS] + (size_t)blk * 128 * 128; const float* wq = C.in[I_WQ];
    { f32x4 kv_[8];
#pragma unroll
      for (int i = 0; i < 8; ++i) { const int e = tid_ + NT * i, key = e >> 5, j4 = e & 31; kv_[i] = *(const GAS f32x4*)(keys + key * 128 + 4 * j4); }
#pragma unroll
      for (int i = 0; i < 8; ++i) { const int e = tid_ + NT * i, key = e >> 5, j4 = e & 31; *(LAS f32x4*)(KT + key * 132 + 4 * j4) = kv_[i]; } }
    { f32x4 wv_[4];
#pragma unroll
      for (int i = 0; i < 4; ++i) { const int e = tid_ + NT * i, dd = e >> 5, j4 = e & 31; wv_[i] = *(const GAS f32x4*)(wq + (size_t)(d0 + dd) * 2048 + blk * 128 + 4 * j4); }
#pragma unroll
      for (int i = 0; i < 4; ++i) { const int e = tid_ + NT * i, dd = e >> 5, j4 = e & 31; *(LAS f32x4*)(WQ + dd * 128 + 4 * j4) = wv_[i]; } }
    __syncthreads();
    const int key = tid_ & 127, dg = tid_ >> 7;
    float acc[16];
#pragma unroll
    for (int i = 0; i < 16; ++i) acc[i] = 0.f;
    for (int j4 = 0; j4 < 32; ++j4) {
        const f32x4 kv = *(const LAS f32x4*)(KT + key * 132 + 4 * j4);
#pragma unroll
        for (int i = 0; i < 16; ++i) { const f32x4 wv = *(const LAS f32x4*)(WQ + (dg * 16 + i) * 128 + 4 * j4); acc[i] += kv.x * wv.x + kv.y * wv.y + kv.z * wv.z + kv.w * wv.w; }
    }
    bf16* WET = (bf16*)(C.ws + WS_WET) + (size_t)(blk * 128 + key) * D + d0 + dg * 16;
    v4u o0, o1; o0.x = pk2(acc[0], acc[1]); o0.y = pk2(acc[2], acc[3]); o0.z = pk2(acc[4], acc[5]); o0.w = pk2(acc[6], acc[7]);
    o1.x = pk2(acc[8], acc[9]); o1.y = pk2(acc[10], acc[11]); o1.z = pk2(acc[12], acc[13]); o1.w = pk2(acc[14], acc[15]);
    *(v4u*)WET = o0; *(GAS v4u*)(WET + 8) = o1;
    __syncthreads();
}
__device__ __forceinline__ void p0_prologue(const Ctx& C) {
    LAS float* scr = (LAS float*)(C.lds + C.wave * 16384);
    const int gw = C.bid * NWAVES + C.wave, NGW = C.G * NWAVES;
    constexpr int I_1 = (D / 64) * (N1 / 32), I_A = (1024 / 64) * (1024 / 32), I_B = (2048 / 64) * (1024 / 32), I_O = I_A;
    constexpr int NITEMS = I_1 + I_A + I_B + I_O;
    for (int it = gw; it < NITEMS; it += NGW) {
        int r = it;
        if (r < I_1) { transpose_item(C.in[I_WIN], 1024, 10288, N1, (bf16*)(C.ws + WS_W1T), scr, r, C.lane, MapW1()); continue; } r -= I_1;
        if (r < I_A) { transpose_item(C.in[I_WUG], 1024, 1024, 1024, (bf16*)(C.ws + WS_WAT), scr, r, C.lane, MapIdent()); continue; } r -= I_A;
        if (r < I_B) { transpose_item(C.in[I_WUS], 2048, 1024, 1024, (bf16*)(C.ws + WS_WBT), scr, r, C.lane, MapIdent()); continue; } r -= I_B;
        transpose_item(C.in[I_WOUT], 1024, 1024, 1024, (bf16*)(C.ws + WS_WOT), scr, r, C.lane, MapIdent());
    }
    __syncthreads();
    for (int u = C.bid; u < 256; u += C.G) weff_unit(C, u);
}

__device__ __forceinline__ float softplusf_(float x) { return fmaxf(x, 0.f) + log1pf(__expf(-fabsf(x))); }
__device__ __forceinline__ void conv_batch(const Ctx& C) {
    const bf16* PJ = (const bf16*)(C.ws + WS_PJ); bf16* XC = (bf16*)(C.ws + WS_XC);
    const float* cw = C.in[I_CONVW]; const float* cb = C.in[I_CONVB];
    constexpr int SL = 25, NSEG = (REND + SL - 1) / SL, NITEM = 384 * NSEG;
    for (int id = C.bid * NT + C.tid; id < NITEM; id += C.G * NT) {
        const int ch = id % 384, seg = id / 384, col = 8 * ch, rb = SL * seg;
        v4u xr[SL + 3];
#pragma unroll
        for (int t = 0; t < SL + 3; ++t) { const int r = rb - 3 + t; xr[t] = (r >= 0 && r < REND) ? *(const GAS v4u*)(PJ + (size_t)r * NPJ + PJ_XBC + col) : (v4u){0u, 0u, 0u, 0u}; }
        f32x4 w[4][2], bb[2];
#pragma unroll
        for (int i = 0; i < 4; ++i) { w[i][0] = *(const GAS f32x4*)(cw + i * 3072 + col); w[i][1] = *(const GAS f32x4*)(cw + i * 3072 + col + 4); }
        bb[0] = *(const GAS f32x4*)(cb + col); bb[1] = *(const GAS f32x4*)(cb + col + 4);
#pragma unroll
        for (int t = 0; t < SL; ++t) {
            f32x4 o0 = bb[0], o1 = bb[1];
#pragma unroll
            for (int i = 0; i < 4; ++i) { const v4u x = xr[t + i];
                o0 += w[i][0] * (f32x4){bflo(x.x), bfhi(x.x), bflo(x.y), bfhi(x.y)}; o1 += w[i][1] * (f32x4){bflo(x.z), bfhi(x.z), bflo(x.w), bfhi(x.w)}; }
            v4u o = {pk2(siluf_(o0.x), siluf_(o0.y)), pk2(siluf_(o0.z), siluf_(o0.w)), pk2(siluf_(o1.x), siluf_(o1.y)), pk2(siluf_(o1.z), siluf_(o1.w))};
            if (rb + t < RFRONT) o = (v4u){0u, 0u, 0u, 0u};
            if (rb + t < REND) *(GAS v4u*)(XC + (size_t)(rb + t) * 3072 + col) = o;
        }
    }
}
__device__ __forceinline__ void phaseC_unit(const Ctx& C, int c, int k) {
    int tid_ = C.tid; asm volatile("" : "+v"(tid_));
    const int lane_ = tid_ & 63, wave_ = __builtin_amdgcn_readfirstlane(tid_ >> 6); (void)lane_; (void)wave_;
    const bf16* PJ = (const bf16*)(C.ws + WS_PJ); const float* TL = (const float*)(C.ws + WS_TL);
    bf16* XC = (bf16*)(C.ws + WS_XC); float* GG = (float*)(C.ws + WS_GG); float* DT = (float*)(C.ws + WS_DT); float* AC = (float*)(C.ws + WS_AC);
    const int r0 = 64 * c;
    if (k < 6) {
        const float* cw = C.in[I_CONVW]; const float* cb = C.in[I_CONVB];
        const int col = 512 * k + 2 * (tid_ & 255), rb = r0 + 32 * (tid_ >> 8);
        const f32x2 w0 = *(const GAS f32x2*)(cw + col), w1 = *(const GAS f32x2*)(cw + 3072 + col), w2 = *(const GAS f32x2*)(cw + 2 * 3072 + col), w3 = *(const GAS f32x2*)(cw + 3 * 3072 + col), bb = *(const GAS f32x2*)(cb + col);
        unsigned xr[35];
#pragma unroll
        for (int t = 0; t < 35; ++t) { const int r = rb - 3 + t; xr[t] = (r >= 0) ? *(const GAS unsigned*)(PJ + (size_t)r * NPJ + PJ_XBC + col) : 0u; }
#pragma unroll
        for (int t = 0; t < 32; ++t) {
            const int r = rb + t;
            const f32x2 xm3 = {bflo(xr[t]), bfhi(xr[t])}, xm2 = {bflo(xr[t + 1]), bfhi(xr[t + 1])}, xm1 = {bflo(xr[t + 2]), bfhi(xr[t + 2])}, x0 = {bflo(xr[t + 3]), bfhi(xr[t + 3])};
            f32x2 o = bb + w0 * xm3 + w1 * xm2 + w2 * xm1 + w3 * x0;
            o.x = siluf_(o.x); o.y = siluf_(o.y);
            if (r < RFRONT) { o.x = 0.f; o.y = 0.f; }
            *(GAS unsigned*)(XC + (size_t)r * 3072 + col) = pk2(o.x, o.y);
        }
        return;
    }
    if (k < 10) {
        const int col = 128 * (k - 6) + (tid_ & 127), rq = tid_ >> 7; const float* w2p = C.in[I_WG2]; float w2[16];
        LAS float* PS = (LAS float*)C.lds;
#pragma unroll
        for (int j = 0; j < 16; ++j) w2[j] = w2p[j * 512 + col];
        const float bg = C.in[I_BG][col]; float G = 0.f; float gv[16];
#pragma unroll
        for (int t = 0; t < 16; ++t) {
            const int r = r0 + 16 * rq + t; const float* gl = TL + (size_t)r * 48;
            float z = bg;
#pragma unroll
            for (int j4 = 0; j4 < 4; ++j4) { const f32x4 g = *(const GAS f32x4*)(gl + 4 * j4); z += g.x * w2[4 * j4] + g.y * w2[4 * j4 + 1] + g.z * w2[4 * j4 + 2] + g.w * w2[4 * j4 + 3]; }
            float ls = fminf(z, 0.f) - __logf(1.f + __expf(-fabsf(z)));
            if (r < RFRONT) ls = 0.f;
            G += ls * (1.f / 16.f); gv[t] = G;
        }
        PS[rq * 128 + (tid_ & 127)] = G;
        __syncthreads();
        float base = 0.f;
#pragma unroll
        for (int q = 0; q < 3; ++q) base += (q < rq) ? PS[q * 128 + (tid_ & 127)] : 0.f;
#pragma unroll
        for (int t = 0; t < 16; ++t) GG[(size_t)(r0 + 16 * rq + t) * 512 + col] = gv[t] + base;
        __syncthreads();
        return;
    }
    {
        const int hd = tid_ & 31, rg = tid_ >> 5; const float bias = C.in[I_DTB][hd], A = -__expf(C.in[I_ALOG][hd]);
        LAS float* PS = (LAS float*)C.lds;
        float dtv[4], av[4], acum = 0.f;
#pragma unroll
        for (int t = 0; t < 4; ++t) {
            const int r = r0 + 4 * rg + t; const float x = TL[(size_t)r * 48 + 16 + hd] + bias;
            float dt = fmaxf(x, 0.f) + __logf(1.f + __expf(-fabsf(x)));
            if (r < RFRONT) dt = 0.f;
            acum += A * dt; dtv[t] = dt; av[t] = acum;
        }
        PS[rg * 32 + hd] = acum;
        __syncthreads();
        float base = 0.f;
#pragma unroll
        for (int q = 0; q < 15; ++q) base += (q < rg) ? PS[q * 32 + hd] : 0.f;
#pragma unroll
        for (int t = 0; t < 4; ++t) { const size_t r = (size_t)(r0 + 4 * rg + t); DT[r * 32 + hd] = dtv[t]; AC[r * 32 + hd] = av[t] + base; }
        __syncthreads();
    }
}

constexpr int P136 = 272, P264 = 528, P520 = 1040, P72 = 144;
__device__ __forceinline__ void gla_pass1_unit(const Ctx& C, int c, int h) {
    int tid_ = C.tid; asm volatile("" : "+v"(tid_));
    const int lane_ = tid_ & 63, wave_ = __builtin_amdgcn_readfirstlane(tid_ >> 6); (void)lane_; (void)wave_;
    const bf16* PJ = (const bf16*)(C.ws + WS_PJ); const float* GG = (const float*)(C.ws + WS_GG); bf16* LG = (bf16*)(C.ws + WS_LG);
    ldsp KD = C.lds, VT = C.lds + 64 * P136;
    const int r0 = 64 * c;
    v4u ka_[2], vv[4]; f32x4 a0_[2], a1_[2], l0_[2], l1_[2];
#pragma unroll
    for (int i = 0; i < 2; ++i) { const int e = tid_ + NT * i, s = e >> 4, k0 = (e & 15) * 8; const size_t r = (size_t)(r0 + s);
        ka_[i] = *(const GAS v4u*)(PJ + r * NPJ + PJ_K + 128 * h + k0);
        const float* g = GG + r * 512 + 128 * h + k0; const float* gl = GG + (size_t)(r0 + 63) * 512 + 128 * h + k0;
        a0_[i] = *(const GAS f32x4*)g; a1_[i] = *(const GAS f32x4*)(g + 4); l0_[i] = *(const GAS f32x4*)gl; l1_[i] = *(const GAS f32x4*)(gl + 4); }
#pragma unroll
    for (int i = 0; i < 4; ++i) { const int e = tid_ + NT * i, s = e >> 5, v0 = (e & 31) * 8; vv[i] = *(const GAS v4u*)(PJ + (size_t)(r0 + s) * NPJ + PJ_V + 256 * h + v0); }
#pragma unroll
    for (int i = 0; i < 2; ++i) {
        const int e = tid_ + NT * i, s = e >> 4, k0 = (e & 15) * 8;
        const v4u ka = ka_[i]; const f32x4 a0 = a0_[i], a1 = a1_[i], l0 = l0_[i], l1 = l1_[i];
        v4u o;
        o.x = pk2(bflo(ka.x) * __expf(l0.x - a0.x), bfhi(ka.x) * __expf(l0.y - a0.y)); o.y = pk2(bflo(ka.y) * __expf(l0.z - a0.z), bfhi(ka.y) * __expf(l0.w - a0.w));
        o.z = pk2(bflo(ka.z) * __expf(l1.x - a1.x), bfhi(ka.z) * __expf(l1.y - a1.y)); o.w = pk2(bflo(ka.w) * __expf(l1.z - a1.z), bfhi(ka.w) * __expf(l1.w - a1.w));
        *(LAS v4u*)(KD + s * P136 + k0 * 2) = o;
    }
#pragma unroll
    for (int i = 0; i < 4; ++i) { const int e = tid_ + NT * i, s = e >> 5, v0 = (e & 31) * 8; *(LAS v4u*)(VT + s * P264 + v0 * 2) = vv[i]; }
    __syncthreads();
    const int fr = lane_ & 15, fq = lane_ >> 4, w = wave_;
    f32x4 acc[2][8];
#pragma unroll
    for (int mi = 0; mi < 2; ++mi)
#pragma unroll
        for (int nt = 0; nt < 8; ++nt) acc[mi][nt] = (f32x4){0.f, 0.f, 0.f, 0.f};
#pragma unroll
    for (int ks = 0; ks < 2; ++ks) {
        bf16x8 af[2];
#pragma unroll
        for (int mi = 0; mi < 2; ++mi) af[mi] = tr_frag(VT, P264, 32 * ks, 32 * w + 16 * mi, fr, fq);
#pragma unroll
        for (int nt = 0; nt < 8; ++nt) { const bf16x8 bfm = tr_frag(KD, P136, 32 * ks, 16 * nt, fr, fq);
#pragma unroll
            for (int mi = 0; mi < 2; ++mi) acc[mi][nt] = mma16(af[mi], bfm, acc[mi][nt]); }
    }
    bf16* Lb = LG + ((size_t)(c * 4 + h) * 256) * 128;
#pragma unroll
    for (int mi = 0; mi < 2; ++mi)
#pragma unroll
        for (int nt = 0; nt < 8; ++nt) { const int v = 32 * w + 16 * mi + fr, k = 16 * nt + 4 * fq; const f32x4 a = acc[mi][nt];
            *(GAS v2u*)(Lb + (size_t)v * 128 + k) = (v2u){cvt_pk_bf16(a[0], a[1]), cvt_pk_bf16(a[2], a[3])}; }
    __syncthreads();
}
__device__ __forceinline__ void ssd_pass1_unit(const Ctx& C, int c, int g) {
    int tid_ = C.tid; asm volatile("" : "+v"(tid_));
    const int lane_ = tid_ & 63, wave_ = __builtin_amdgcn_readfirstlane(tid_ >> 6); (void)lane_; (void)wave_;
    const bf16* XC = (const bf16*)(C.ws + WS_XC); const float* DT = (const float*)(C.ws + WS_DT); const float* AC = (const float*)(C.ws + WS_AC); bf16* LS = (bf16*)(C.ws + WS_LS);
    ldsp XW = C.lds, BM = C.lds + 64 * P520;
    const int r0 = 64 * c;
    { const int ch = tid_ & 63, hd = 8 * g + (ch >> 3); const float al = AC[(size_t)(r0 + 63) * 32 + hd];
      v4u xx[8], bb[2]; float dd[8], aa[8];
#pragma unroll
      for (int i = 0; i < 8; ++i) { const size_t r = (size_t)(r0 + (tid_ >> 6) + 8 * i); xx[i] = *(const GAS v4u*)(XC + r * 3072 + 512 * g + 8 * ch); dd[i] = DT[r * 32 + hd]; aa[i] = AC[r * 32 + hd]; }
#pragma unroll
      for (int i = 0; i < 2; ++i) { const int e = tid_ + NT * i, s = e >> 4, c2 = e & 15; bb[i] = *(const GAS v4u*)(XC + (size_t)(r0 + s) * 3072 + 2048 + 128 * g + 8 * c2); }
#pragma unroll
      for (int i = 0; i < 2; ++i) { const int e = tid_ + NT * i, s = e >> 4, c2 = e & 15; *(LAS v4u*)(BM + s * P136 + c2 * 16) = bb[i]; }
#pragma unroll
      for (int i = 0; i < 8; ++i) { const int s = (tid_ >> 6) + 8 * i;
        const float sc = dd[i] * __expf(al - aa[i]); const v4u x = xx[i]; v4u o;
        o.x = pk2(bflo(x.x) * sc, bfhi(x.x) * sc); o.y = pk2(bflo(x.y) * sc, bfhi(x.y) * sc); o.z = pk2(bflo(x.z) * sc, bfhi(x.z) * sc); o.w = pk2(bflo(x.w) * sc, bfhi(x.w) * sc);
        *(LAS v4u*)(XW + s * P520 + ch * 16) = o; } }
    __syncthreads();
    const int fr = lane_ & 15, fq = lane_ >> 4, w = wave_;
    bf16* Lb = LS + ((size_t)(c * 32 + 8 * g + w) * 64) * 128;
#pragma unroll
    for (int nh = 0; nh < 2; ++nh) {
        f32x4 acc[4][4];
#pragma unroll
        for (int mi = 0; mi < 4; ++mi)
#pragma unroll
            for (int nt = 0; nt < 4; ++nt) acc[mi][nt] = (f32x4){0.f, 0.f, 0.f, 0.f};
#pragma unroll
        for (int ks = 0; ks < 2; ++ks) {
            bf16x8 af[4];
#pragma unroll
            for (int mi = 0; mi < 4; ++mi) af[mi] = tr_frag(XW, P520, 32 * ks, 64 * w + 16 * mi, fr, fq);
#pragma unroll
            for (int nt = 0; nt < 4; ++nt) { const bf16x8 bfm = tr_frag(BM, P136, 32 * ks, 64 * nh + 16 * nt, fr, fq);
#pragma unroll
                for (int mi = 0; mi < 4; ++mi) acc[mi][nt] = mma16(af[mi], bfm, acc[mi][nt]); }
        }
#pragma unroll
        for (int mi = 0; mi < 4; ++mi)
#pragma unroll
            for (int nt = 0; nt < 4; ++nt) { const int p = 16 * mi + fr, n = 64 * nh + 16 * nt + 4 * fq; const f32x4 a = acc[mi][nt];
                *(GAS v2u*)(Lb + (size_t)p * 128 + n) = (v2u){cvt_pk_bf16(a[0], a[1]), cvt_pk_bf16(a[2], a[3])}; }
    }
    __syncthreads();
}

__device__ __forceinline__ void phaseE(const Ctx& C) {
    const float* GG = (const float*)(C.ws + WS_GG); const float* AC = (const float*)(C.ws + WS_AC);
    constexpr int NB = 8;
    for (int vb = C.bid; vb < 256; vb += C.G) {
        if (vb < 128) {
            const int e = vb * NT + C.tid, k2 = e & 63, v = (e >> 6) & 255, h = e >> 14;
            GAS unsigned* Lp = (GAS unsigned*)(C.ws + WS_LG) + ((size_t)h * 256 + v) * 64 + k2;
            const GAS float* dp = (const GAS float*)GG + 63 * 512 + 128 * h + 2 * k2;
            float s0 = 0.f, s1 = 0.f;
            unsigned l[2][NB]; f32x2 d[2][NB];
#pragma unroll
            for (int i = 0; i < NB; ++i) { l[0][i] = Lp[(size_t)i * (4 * 256 * 64)]; d[0][i] = *(const GAS f32x2*)(dp + (size_t)i * 64 * 512); }
#pragma unroll 1
            for (int c0 = 0; c0 < NCHUNK; c0 += 2 * NB) {
#pragma unroll
                for (int hb = 0; hb < 2; ++hb) {
                    const int cb = c0 + hb * NB, cn = cb + NB;
#pragma unroll
                    for (int i = 0; i < NB; ++i) if (cn + i < NCHUNK) { l[hb ^ 1][i] = Lp[(size_t)(cn + i) * (4 * 256 * 64)]; d[hb ^ 1][i] = *(const GAS f32x2*)(dp + (size_t)(cn + i) * 64 * 512); }
#pragma unroll
                    for (int i = 0; i < NB; ++i) if (cb + i < NCHUNK) {
                        Lp[(size_t)(cb + i) * (4 * 256 * 64)] = pk2(s0, s1);
                        s0 = s0 * __expf(d[hb][i].x) + bflo(l[hb][i]); s1 = s1 * __expf(d[hb][i].y) + bfhi(l[hb][i]); }
                }
            }
        } else {
            const int e = (vb - 128) * NT + C.tid, n4 = e & 31, p = (e >> 5) & 63, hd = e >> 11;
            GAS v2u* Lp = (GAS v2u*)(C.ws + WS_LS) + ((size_t)hd * 64 + p) * 32 + n4;
            const GAS float* dp = (const GAS float*)AC + 63 * 32 + hd;
            float s0 = 0.f, s1 = 0.f, s2 = 0.f, s3 = 0.f;
            v2u l[2][NB]; float d[2][NB];
#pragma unroll
            for (int i = 0; i < NB; ++i) { l[0][i] = Lp[(size_t)i * (32 * 64 * 32)]; d[0][i] = dp[(size_t)i * 64 * 32]; }
#pragma unroll 1
            for (int c0 = 0; c0 < NCHUNK; c0 += 2 * NB) {
#pragma unroll
                for (int hb = 0; hb < 2; ++hb) {
                    const int cb = c0 + hb * NB, cn = cb + NB;
#pragma unroll
                    for (int i = 0; i < NB; ++i) if (cn + i < NCHUNK) { l[hb ^ 1][i] = Lp[(size_t)(cn + i) * (32 * 64 * 32)]; d[hb ^ 1][i] = dp[(size_t)(cn + i) * 64 * 32]; }
#pragma unroll
                    for (int i = 0; i < NB; ++i) if (cb + i < NCHUNK) {
                        Lp[(size_t)(cb + i) * (32 * 64 * 32)] = (v2u){pk2(s0, s1), pk2(s2, s3)};
                        const float dd = __expf(d[hb][i]);
                        s0 = s0 * dd + bflo(l[hb][i].x); s1 = s1 * dd + bfhi(l[hb][i].x); s2 = s2 * dd + bflo(l[hb][i].y); s3 = s3 * dd + bfhi(l[hb][i].y); }
                }
            }
        }
    }
}

__device__ __forceinline__ void gla_pass3_unit(const Ctx& C, int c, int h) {
    int tid_ = C.tid; asm volatile("" : "+v"(tid_));
    const int lane_ = tid_ & 63, wave_ = __builtin_amdgcn_readfirstlane(tid_ >> 6); (void)lane_; (void)wave_;
    const bf16* PJ = (const bf16*)(C.ws + WS_PJ); const float* GG = (const float*)(C.ws + WS_GG); const bf16* LG = (const bf16*)(C.ws + WS_LG); bf16* OG = (bf16*)(C.ws + WS_OG);
    ldsp QE = C.lds, QN = QE + 64 * P136, KE = QN + 64 * P136, KN = KE + 64 * P136, VT = KN + 64 * P136, ATT = VT + 64 * P264;
    LAS float* RED = (LAS float*)(ATT + 64 * P72);
    const int r0 = 64 * c;
    bf16x8 sfr[4][2];
    { const bf16* Sb = LG + ((size_t)(c * 4 + h) * 256) * 128; const int fr_ = lane_ & 15, fq_ = lane_ >> 4;
#pragma unroll
      for (int ks = 0; ks < 4; ++ks)
#pragma unroll
        for (int nt = 0; nt < 2; ++nt) sfr[ks][nt] = *(const GAS bf16x8*)(Sb + (size_t)(32 * wave_ + 16 * nt + fr_) * 128 + 32 * ks + 8 * fq_); }
    v4u qa_[2], ka_[2]; f32x4 g0_[2], g1_[2];
#pragma unroll
    for (int i = 0; i < 2; ++i) { const int e = tid_ + NT * i, s = e >> 4, k0 = (e & 15) * 8; const size_t r = (size_t)(r0 + s);
        qa_[i] = *(const GAS v4u*)(PJ + r * NPJ + PJ_Q + 128 * h + k0); ka_[i] = *(const GAS v4u*)(PJ + r * NPJ + PJ_K + 128 * h + k0);
        const float* g = GG + r * 512 + 128 * h + k0; g0_[i] = *(const GAS f32x4*)g; g1_[i] = *(const GAS f32x4*)(g + 4); }
#pragma unroll
    for (int i = 0; i < 2; ++i) {
        const int e = tid_ + NT * i, s = e >> 4, k0 = (e & 15) * 8;
        const v4u qa = qa_[i], ka = ka_[i]; const f32x4 g0 = g0_[i], g1 = g1_[i];
        const float gv[8] = {g0.x, g0.y, g0.z, g0.w, g1.x, g1.y, g1.z, g1.w};
        const unsigned qs[4] = {qa.x, qa.y, qa.z, qa.w}, ksr[4] = {ka.x, ka.y, ka.z, ka.w};
        unsigned oqe[4], oqn[4], oke[4], okn[4];
#pragma unroll
        for (int j = 0; j < 4; ++j) { const float e0 = __expf(gv[2 * j]), e1 = __expf(gv[2 * j + 1]), n0 = __expf(-gv[2 * j]), n1 = __expf(-gv[2 * j + 1]);
            const float q0 = bflo(qs[j]), q1 = bfhi(qs[j]), kk0 = bflo(ksr[j]), kk1 = bfhi(ksr[j]);
            oqe[j] = pk2(q0 * e0, q1 * e1); oqn[j] = pk2(q0 * n0, q1 * n1); oke[j] = pk2(kk0 * e0, kk1 * e1); okn[j] = pk2(kk0 * n0, kk1 * n1); }
        const int off = s * P136 + k0 * 2;
        *(LAS v4u*)(QE + off) = (v4u){oqe[0], oqe[1], oqe[2], oqe[3]}; *(LAS v4u*)(QN + off) = (v4u){oqn[0], oqn[1], oqn[2], oqn[3]};
        *(LAS v4u*)(KE + off) = (v4u){oke[0], oke[1], oke[2], oke[3]}; *(LAS v4u*)(KN + off) = (v4u){okn[0], okn[1], okn[2], okn[3]};
    }
    { v4u vv[4];
#pragma unroll
      for (int i = 0; i < 4; ++i) { const int e = tid_ + NT * i, s = e >> 5, v0 = (e & 31) * 8; vv[i] = *(const GAS v4u*)(PJ + (size_t)(r0 + s) * NPJ + PJ_V + 256 * h + v0); }
#pragma unroll
      for (int i = 0; i < 4; ++i) { const int e = tid_ + NT * i, s = e >> 5, v0 = (e & 31) * 8; *(LAS v4u*)(VT + s * P264 + v0 * 2) = vv[i]; } }
    __syncthreads();
    const int fr = lane_ & 15, fq = lane_ >> 4, w = wave_;
#pragma unroll
    for (int ti = 0; ti < 2; ++ti) {
        const int id = 2 * w + ti, tm = id >> 2, sn = id & 3;
        f32x4 ac = {0.f, 0.f, 0.f, 0.f}, aa = {0.f, 0.f, 0.f, 0.f};
#pragma unroll
        for (int ks = 0; ks < 4; ++ks) {
            const int ao = (16 * tm + fr) * P136 + (32 * ks + 8 * fq) * 2, bo = (16 * sn + fr) * P136 + (32 * ks + 8 * fq) * 2;
            ac = mma16(lds_frag(QE + ao), lds_frag(KN + bo), ac);
            aa = mma16(lds_frag(QN + ao), lds_frag(KE + bo), aa);
        }
        const int t = 16 * tm + fr, s0 = 16 * sn + 4 * fq;
        float o[4];
#pragma unroll
        for (int j = 0; j < 4; ++j) o[j] = (s0 + j <= t) ? ac[j] : aa[j];
        *(LAS v2u*)(ATT + t * P72 + s0 * 2) = (v2u){pk2(o[0], o[1]), pk2(o[2], o[3])};
    }
    __syncthreads();
    f32x4 acc[4][2];
#pragma unroll
    for (int tm = 0; tm < 4; ++tm)
#pragma unroll
        for (int nt = 0; nt < 2; ++nt) acc[tm][nt] = (f32x4){0.f, 0.f, 0.f, 0.f};
#pragma unroll
    for (int ks = 0; ks < 4; ++ks) {
#pragma unroll
        for (int tm = 0; tm < 4; ++tm) { const bf16x8 af = lds_frag(QE + (16 * tm + fr) * P136 + (32 * ks + 8 * fq) * 2);
#pragma unroll
            for (int nt = 0; nt < 2; ++nt) acc[tm][nt] = mma16(af, sfr[ks][nt], acc[tm][nt]); }
    }
#pragma unroll
    for (int ks = 0; ks < 2; ++ks) {
        bf16x8 bfm[2];
#pragma unroll
        for (int nt = 0; nt < 2; ++nt) bfm[nt] = tr_frag(VT, P264, 32 * ks, 32 * w + 16 * nt, fr, fq);
#pragma unroll
        for (int tm = 0; tm < 4; ++tm) { const bf16x8 af = lds_frag(ATT + (16 * tm + fr) * P72 + (32 * ks + 8 * fq) * 2);
#pragma unroll
            for (int nt = 0; nt < 2; ++nt) acc[tm][nt] = mma16(af, bfm[nt], acc[tm][nt]); }
    }
    v2u gvp[4][2]; f32x4 wvp[2];
#pragma unroll
    for (int nt = 0; nt < 2; ++nt) { const int v = 32 * w + 16 * nt + 4 * fq; wvp[nt] = *(const GAS f32x4*)(C.in[I_GNW] + v);
#pragma unroll
        for (int tm = 0; tm < 4; ++tm) gvp[tm][nt] = *(const GAS v2u*)(PJ + (size_t)(r0 + 16 * tm + fr) * NPJ + PJ_GO + 256 * h + v); }
#pragma unroll
    for (int tm = 0; tm < 4; ++tm) { float s = 0.f;
#pragma unroll
        for (int nt = 0; nt < 2; ++nt) { const f32x4 a = acc[tm][nt]; s += (a[0] * a[0] + a[1] * a[1]) + (a[2] * a[2] + a[3] * a[3]); }
        s += __shfl_xor(s, 16); s += __shfl_xor(s, 32);
        if (fq == 0) RED[w * 64 + 16 * tm + fr] = s; }
    __syncthreads();
    const float* nw = C.in[I_GNW];
#pragma unroll
    for (int tm = 0; tm < 4; ++tm) { const int t = 16 * tm + fr; float tot = 0.f;
#pragma unroll
        for (int ww = 0; ww < 8; ++ww) tot += RED[ww * 64 + t];
        const float rs = rsqrtf(tot * (1.f / 256.f) + RMS_EPS); const size_t r = (size_t)(r0 + t);
#pragma unroll
        for (int nt = 0; nt < 2; ++nt) { const int v = 32 * w + 16 * nt + 4 * fq; const f32x4 a = acc[tm][nt];
            const f32x4 wv = wvp[nt]; const v2u gv = gvp[tm][nt];
            *(GAS v2u*)(OG + r * 1024 + 256 * h + v) = (v2u){pk2(a[0] * rs * wv.x * bflo(gv.x), a[1] * rs * wv.y * bfhi(gv.x)), pk2(a[2] * rs * wv.z * bflo(gv.y), a[3] * rs * wv.w * bfhi(gv.y))}; } }
    __syncthreads();
}
__device__ __forceinline__ void ssd_pass3_unit(const Ctx& C, int c, int g) {
    int tid_ = C.tid; asm volatile("" : "+v"(tid_));
    const int lane_ = tid_ & 63, wave_ = __builtin_amdgcn_readfirstlane(tid_ >> 6); (void)lane_; (void)wave_;
    const bf16* PJ = (const bf16*)(C.ws + WS_PJ); const bf16* XC = (const bf16*)(C.ws + WS_XC); const float* DT = (const float*)(C.ws + WS_DT); const float* AC = (const float*)(C.ws + WS_AC);
    const bf16* LS = (const bf16*)(C.ws + WS_LS); bf16* YS = (bf16*)(C.ws + WS_YS);
    ldsp XD = C.lds, CM = XD + 64 * P520, BM = CM + 64 * P136, WT = BM + 64 * P136;
    LAS float* ACL = (LAS float*)(WT + 8 * 32 * P72);
    LAS float* DTL = ACL + 8 * 64;
    LAS float* RED = DTL + 8 * 64;
    const int r0 = 64 * c;
    bf16x8 sfr[4][4];
    { const bf16* Sb = LS + ((size_t)(c * 32 + 8 * g + (wave_ >> 1)) * 64) * 128; const int fr_ = lane_ & 15, fq_ = lane_ >> 4;
#pragma unroll
      for (int ks = 0; ks < 2; ++ks)
#pragma unroll
        for (int pn = 0; pn < 4; ++pn) sfr[ks][pn] = *(const GAS bf16x8*)(Sb + (size_t)(16 * pn + fr_) * 128 + 32 * ks + 8 * fq_); }
    { v4u xx[8], bb[2], cc[2]; float a1, d1;
      { const int s = tid_ >> 3, hl = tid_ & 7; const size_t ri = (size_t)(r0 + s) * 32 + 8 * g + hl; a1 = AC[ri]; d1 = DT[ri]; }
#pragma unroll
      for (int i = 0; i < 8; ++i) { const int s = (tid_ >> 6) + 8 * i, ch = tid_ & 63; xx[i] = *(const GAS v4u*)(XC + (size_t)(r0 + s) * 3072 + 512 * g + 8 * ch); }
#pragma unroll
      for (int i = 0; i < 2; ++i) { const int e = tid_ + NT * i, s = e >> 4, ch = e & 15; const size_t r = (size_t)(r0 + s);
        bb[i] = *(const GAS v4u*)(XC + r * 3072 + 2048 + 128 * g + 8 * ch); cc[i] = *(const GAS v4u*)(XC + r * 3072 + 2560 + 128 * g + 8 * ch); }
      { const int s = tid_ >> 3, hl = tid_ & 7; ACL[hl * 64 + s] = a1; DTL[hl * 64 + s] = d1; }
#pragma unroll
      for (int i = 0; i < 8; ++i) { const int s = (tid_ >> 6) + 8 * i, ch = tid_ & 63; *(LAS v4u*)(XD + s * P520 + ch * 16) = xx[i]; }
#pragma unroll
      for (int i = 0; i < 2; ++i) { const int e = tid_ + NT * i, s = e >> 4, ch = e & 15; *(LAS v4u*)(BM + s * P136 + ch * 16) = bb[i]; *(LAS v4u*)(CM + s * P136 + ch * 16) = cc[i]; } }
    __syncthreads();
    const int fr = lane_ & 15, fq = lane_ >> 4, w = wave_, rh = w & 1, hq = w >> 1, t0 = 32 * rh;
    ldsp WW = WT + w * 32 * P72;
    { const bf16* Sb = LS + ((size_t)(c * 32 + 8 * g + hq) * 64) * 128;
#pragma unroll
      for (int ks = 2; ks < 4; ++ks)
#pragma unroll
        for (int pn = 0; pn < 4; ++pn) sfr[ks][pn] = *(const GAS bf16x8*)(Sb + (size_t)(16 * pn + fr) * 128 + 32 * ks + 8 * fq); }
    f32x4 cb[2][4];
#pragma unroll
    for (int tm = 0; tm < 2; ++tm)
#pragma unroll
        for (int sn = 0; sn < 4; ++sn) cb[tm][sn] = (f32x4){0.f, 0.f, 0.f, 0.f};
#pragma unroll
    for (int ks = 0; ks < 4; ++ks) {
        bf16x8 af[2];
#pragma unroll
        for (int tm = 0; tm < 2; ++tm) af[tm] = lds_frag(CM + (t0 + 16 * tm + fr) * P136 + (32 * ks + 8 * fq) * 2);
#pragma unroll
        for (int sn = 0; sn < 4; ++sn) { const bf16x8 bfm = lds_frag(BM + (16 * sn + fr) * P136 + (32 * ks + 8 * fq) * 2);
#pragma unroll
            for (int tm = 0; tm < 2; ++tm) cb[tm][sn] = mma16(af[tm], bfm, cb[tm][sn]); }
    }
    v2u yp[2][2][4];
    float ss[2] = {0.f, 0.f};
    const float* dsk = C.in[I_DSKIP]; const float* nw = C.in[I_SNW];
#pragma unroll
    for (int rd = 0; rd < 2; ++rd) {
        const int hl = hq + 4 * rd, hd = 8 * g + hl;
        float at[2];
#pragma unroll
        for (int tm = 0; tm < 2; ++tm) at[tm] = ACL[hl * 64 + t0 + 16 * tm + fr];
#pragma unroll
        for (int sn = 0; sn < 4; ++sn) { const f32x4 as = *(const LAS f32x4*)(ACL + hl * 64 + 16 * sn + 4 * fq), ds = *(const LAS f32x4*)(DTL + hl * 64 + 16 * sn + 4 * fq);
#pragma unroll
            for (int tm = 0; tm < 2; ++tm) { const f32x4 cv = cb[tm][sn];
                const float w0 = cv[0] * ds.x * __expf(-fabsf(at[tm] - as.x)), w1 = cv[1] * ds.y * __expf(-fabsf(at[tm] - as.y)), w2 = cv[2] * ds.z * __expf(-fabsf(at[tm] - as.z)), w3 = cv[3] * ds.w * __expf(-fabsf(at[tm] - as.w));
                *(LAS v2u*)(WW + (16 * tm + fr) * P72 + (16 * sn + 4 * fq) * 2) = (v2u){pk2(w0, w1), pk2(w2, w3)}; } }
        f32x4 y[2][4];
#pragma unroll
        for (int tm = 0; tm < 2; ++tm)
#pragma unroll
            for (int pn = 0; pn < 4; ++pn) y[tm][pn] = (f32x4){0.f, 0.f, 0.f, 0.f};
#pragma unroll
        for (int ks = 0; ks < 4; ++ks) {
            bf16x8 af[2];
#pragma unroll
            for (int tm = 0; tm < 2; ++tm) af[tm] = lds_frag(CM + (t0 + 16 * tm + fr) * P136 + (32 * ks + 8 * fq) * 2);
#pragma unroll
            for (int pn = 0; pn < 4; ++pn) {
#pragma unroll
                for (int tm = 0; tm < 2; ++tm) y[tm][pn] = mma16(af[tm], sfr[ks][pn], y[tm][pn]); }
        }
        if (rd == 0) {
            const bf16* Sb = LS + ((size_t)(c * 32 + 8 * g + hq + 4) * 64) * 128;
#pragma unroll
            for (int ks = 0; ks < 4; ++ks)
#pragma unroll
                for (int pn = 0; pn < 4; ++pn) sfr[ks][pn] = *(const GAS bf16x8*)(Sb + (size_t)(16 * pn + fr) * 128 + 32 * ks + 8 * fq);
        }
#pragma unroll
        for (int tm = 0; tm < 2; ++tm) { const float ea = __expf(at[tm]);
#pragma unroll
            for (int pn = 0; pn < 4; ++pn) y[tm][pn] = y[tm][pn] * ea; }
        LDS_WAIT(); asm volatile("" ::: "memory");
#pragma unroll
        for (int ks = 0; ks < 2; ++ks) {
            bf16x8 af[2];
#pragma unroll
            for (int tm = 0; tm < 2; ++tm) af[tm] = lds_frag(WW + (16 * tm + fr) * P72 + (32 * ks + 8 * fq) * 2);
#pragma unroll
            for (int pn = 0; pn < 4; ++pn) { const bf16x8 bfm = tr_frag(XD, P520, 32 * ks, 64 * hl + 16 * pn, fr, fq);
#pragma unroll
                for (int tm = 0; tm < 2; ++tm) y[tm][pn] = mma16(af[tm], bfm, y[tm][pn]); }
        }
        LDS_WAIT(); asm volatile("" ::: "memory");
        const float dk = dsk[hd];
#pragma unroll
        for (int tm = 0; tm < 2; ++tm) { const size_t r = (size_t)(r0 + t0 + 16 * tm + fr);
#pragma unroll
            for (int pn = 0; pn < 4; ++pn) { const int col = 64 * hd + 16 * pn + 4 * fq;
                const v2u xv = *(const LAS v2u*)(XD + (t0 + 16 * tm + fr) * P520 + (64 * hl + 16 * pn + 4 * fq) * 2), zv = *(const GAS v2u*)(PJ + r * NPJ + PJ_Z + col);
                f32x4 a = y[tm][pn];
                a[0] = (a[0] + dk * bflo(xv.x)) * bflo(zv.x); a[1] = (a[1] + dk * bfhi(xv.x)) * bfhi(zv.x); a[2] = (a[2] + dk * bflo(xv.y)) * bflo(zv.y); a[3] = (a[3] + dk * bfhi(xv.y)) * bfhi(zv.y);
                ss[tm] += (a[0] * a[0] + a[1] * a[1]) + (a[2] * a[2] + a[3] * a[3]); yp[rd][tm][pn] = (v2u){pk2(a[0], a[1]), pk2(a[2], a[3])}; } }
    }
#pragma unroll
    for (int tm = 0; tm < 2; ++tm) { float s = ss[tm]; s += __shfl_xor(s, 16); s += __shfl_xor(s, 32); if (fq == 0) RED[w * 32 + 16 * tm + fr] = s; }
    __syncthreads();
#pragma unroll
    for (int tm = 0; tm < 2; ++tm) { const int tl = 16 * tm + fr; float tot = 0.f;
#pragma unroll
        for (int q = 0; q < 4; ++q) tot += RED[(2 * q + rh) * 32 + tl];
        const float rs = rsqrtf(tot * (1.f / 512.f) + RMS_EPS); const size_t r = (size_t)(r0 + t0 + tl);
#pragma unroll
        for (int rd = 0; rd < 2; ++rd) { const int hd = 8 * g + hq + 4 * rd;
#pragma unroll
            for (int pn = 0; pn < 4; ++pn) { const int col = 64 * hd + 16 * pn + 4 * fq; const v2u a = yp[rd][tm][pn]; const f32x4 wv = *(const GAS f32x4*)(nw + col);
                *(GAS v2u*)(YS + r * 2048 + col) = (v2u){pk2(bflo(a.x) * rs * wv.x, bfhi(a.x) * rs * wv.y), pk2(bflo(a.y) * rs * wv.z, bfhi(a.y) * rs * wv.w)}; } } }
    __syncthreads();
}

__device__ __forceinline__ void phaseJ(const Ctx& C) {
    const int gw = C.bid * NWAVES + C.wave, NGW = C.G * NWAVES;
    bf16* HN2 = (bf16*)(C.ws + WS_HN2);
    for (int r = gw; r < NTOK; r += NGW) norm_row_bf16(C.out + (size_t)r * D, C.in[I_LNFFN], HN2 + (size_t)r * D, C.lane);
    const size_t n16 = (size_t)16384 * 1024 / 16, gt = (size_t)C.bid * NT + C.tid, GT = (size_t)C.G * NT;
    for (int tb = 0; tb < 2; ++tb) {
        const float* src = C.in[tb ? I_PV : I_PU]; unsigned char* dst = C.ws + WS_U8 + (tb ? 1024 : 0); const float gain = tb ? 16.f : 256.f;
        for (size_t i0 = gt; i0 < n16; i0 += 4 * GT) { f32x4 a[4][4];
#pragma unroll
            for (int p = 0; p < 4; ++p) { const size_t i = i0 + p * GT;
#pragma unroll
                for (int q = 0; q < 4; ++q) a[p][q] = (i < n16) ? *(const GAS f32x4*)(src + 16 * i + 4 * q) : (f32x4){0.f, 0.f, 0.f, 0.f}; }
#pragma unroll
            for (int p = 0; p < 4; ++p) { const size_t i = i0 + p * GT; v4u o;
#pragma unroll
                for (int q = 0; q < 4; ++q) { int w = 0; w = __builtin_amdgcn_cvt_pk_fp8_f32(a[p][q].x * gain, a[p][q].y * gain, w, false); w = __builtin_amdgcn_cvt_pk_fp8_f32(a[p][q].z * gain, a[p][q].w * gain, w, true); o[q] = (unsigned)w; }
                if (i < n16) *(GAS v4u*)(dst + (i >> 6) * 2048 + (i & 63) * 16) = o; } }
    }
}

__device__ __forceinline__ float gelu_tanh(float x) {
    const float y = 0.7978845608028654f * (x + 0.044715f * x * x * x);
    const float e = __expf(2.f * y);
    const float th = 1.f - 2.f * fast_rcp(e + 1.f);
    return 0.5f * x * (1.f + th);
}
template <int CTRL> __device__ __forceinline__ unsigned dppu(unsigned x) { return (unsigned)__builtin_amdgcn_mov_dpp((int)x, CTRL, 0xf, 0xf, true); }
template <int CTRL> __device__ __forceinline__ float dppf(float x) { return __builtin_bit_cast(float, __builtin_amdgcn_mov_dpp(__builtin_bit_cast(int, x), CTRL, 0xf, 0xf, true)); }
__device__ __forceinline__ unsigned row_max_u(unsigned m) { m = max(m, dppu<0xB1>(m)); m = max(m, dppu<0x4E>(m)); m = max(m, dppu<0x141>(m)); m = max(m, dppu<0x128>(m)); return m; }
__device__ __forceinline__ float row_sum_f(float v) { v += dppf<0xB1>(v); v += dppf<0x4E>(v); v += dppf<0x141>(v); v += dppf<0x128>(v); return v; }
__device__ __forceinline__ unsigned mono(float f) { const unsigned b = __builtin_bit_cast(unsigned, f); return b ^ ((unsigned)((int)b >> 31) | 0x80000000u); }
__device__ __forceinline__ float unmono(unsigned u) { const unsigned b = (u & 0x80000000u) ? (u ^ 0x80000000u) : ~u; return __builtin_bit_cast(float, b); }
__device__ __forceinline__ void cand_ij(int c, int& ci, int& cj) {
    if (c < 16) { ci = 0; cj = c; } else if (c < 24) { ci = 1; cj = c - 16; } else if (c < 29) { ci = 2; cj = c - 24; } else if (c < 33) { ci = 3; cj = c - 29; }
    else if (c < 36) { ci = 4; cj = c - 33; } else if (c < 38) { ci = 5; cj = c - 36; } else if (c < 40) { ci = 6; cj = c - 38; } else if (c < 42) { ci = 7; cj = c - 40; }
    else if (c < 50) { ci = c - 34; cj = 0; } else { ci = 0; cj = 0; }
}
constexpr int PEER_LDS_PER_WAVE = 3072;
__device__ __forceinline__ void peer_token(const Ctx& C, int t, bool dry = false) {
    const int lane = C.lane, g = lane >> 4, j = lane & 15;
    const float* SC = (const float*)(C.ws + WS_SC) + (size_t)t * 2048;
    const bf16* HN2 = (const bf16*)(C.ws + WS_HN2) + (size_t)t * D;
    ldsp LST = C.lds + C.wave * PEER_LDS_PER_WAVE; ldsp EL = LST + 2048;
#pragma unroll 1
    for (int P = 0; P < 4; ++P) {
        const float* sp = SC + (4 * P + g) * 128 + 8 * j;
        const f32x4 s0 = *(const GAS f32x4*)sp, s1 = *(const GAS f32x4*)(sp + 4);
        unsigned k[8];
        k[0] = (mono(s0.x) & ~127u) | (unsigned)(127 - (8 * j + 0)); k[1] = (mono(s0.y) & ~127u) | (unsigned)(127 - (8 * j + 1));
        k[2] = (mono(s0.z) & ~127u) | (unsigned)(127 - (8 * j + 2)); k[3] = (mono(s0.w) & ~127u) | (unsigned)(127 - (8 * j + 3));
        k[4] = (mono(s1.x) & ~127u) | (unsigned)(127 - (8 * j + 4)); k[5] = (mono(s1.y) & ~127u) | (unsigned)(127 - (8 * j + 5));
        k[6] = (mono(s1.z) & ~127u) | (unsigned)(127 - (8 * j + 6)); k[7] = (mono(s1.w) & ~127u) | (unsigned)(127 - (8 * j + 7));
        unsigned res = 0u;
#pragma unroll 4
        for (int it = 0; it < 16; ++it) {
            unsigned m = max(max(max(k[0], k[1]), max(k[2], k[3])), max(max(k[4], k[5]), max(k[6], k[7])));
            m = row_max_u(m);
#pragma unroll
            for (int q = 0; q < 8; ++q) k[q] = (k[q] == m) ? 0u : k[q];
            res = (j == it) ? m : res;
        }
        *(LAS v2u*)(LST + ((4 * P + g) * 16 + j) * 8) = (v2u){__builtin_bit_cast(unsigned, unmono(res & ~127u)), 127u - (res & 127u)};
    }
    LDS_WAIT(); asm volatile("" ::: "memory");
    int eA = 0, eB = 0; float wA = 0.f, wB = 0.f;
#pragma unroll
    for (int Q = 0; Q < 2; ++Q) {
        const int h = 4 * Q + g;
        unsigned k[4];
#pragma unroll
        for (int m = 0; m < 4; ++m) {
            const int c = j + 16 * m; int ci, cj; cand_ij(c, ci, cj);
            const v2u a = *(const LAS v2u*)(LST + ((2 * h) * 16 + ci) * 8), b = *(const LAS v2u*)(LST + ((2 * h + 1) * 16 + cj) * 8);
            const float val = __builtin_bit_cast(float, a.x) + __builtin_bit_cast(float, b.x);
            k[m] = (c < 50) ? ((mono(val) & ~63u) | (unsigned)(63 - c)) : 0u;
            *(LAS unsigned*)(EL + (g * 64 + c) * 4) = a.y * 128u + b.y;
        }
        unsigned res = 0u, mtop = 0u;
#pragma unroll 4
        for (int it = 0; it < 16; ++it) {
            unsigned m = max(max(k[0], k[1]), max(k[2], k[3]));
            m = row_max_u(m);
            if (it == 0) mtop = m;
#pragma unroll
            for (int q = 0; q < 4; ++q) k[q] = (k[q] == m) ? 0u : k[q];
            res = (j == it) ? m : res;
        }
        LDS_WAIT(); asm volatile("" ::: "memory");
        const int cw = 63 - (int)(res & 63u);
        const int e = (int)*(const LAS unsigned*)(EL + (g * 64 + cw) * 4);
        const float ex = __expf(unmono(res & ~63u) - unmono(mtop & ~63u));
        const float wgt = ex / row_sum_f(ex);
        if (Q == 0) { eA = e; wA = wgt; } else { eB = e; wB = wgt; }
        LDS_WAIT(); asm volatile("" ::: "memory");
    }
#ifdef DRY_TOPK_ONLY
    if (dry) { ((float*)(C.ws + WS_T1))[(size_t)t * 64 + lane] = (float)(eA + eB) + wA + wB; return; }
#endif
    const unsigned char* U8 = C.ws + WS_U8; const unsigned char* V8 = C.ws + WS_U8 + 1024;
    f32x2 hx[8];
    { const v4u a = *(const GAS v4u*)(HN2 + 16 * lane), b = *(const GAS v4u*)(HN2 + 16 * lane + 8);
      hx[0] = (f32x2){bflo(a.x), bfhi(a.x)}; hx[1] = (f32x2){bflo(a.y), bfhi(a.y)}; hx[2] = (f32x2){bflo(a.z), bfhi(a.z)}; hx[3] = (f32x2){bflo(a.w), bfhi(a.w)};
      hx[4] = (f32x2){bflo(b.x), bfhi(b.x)}; hx[5] = (f32x2){bflo(b.y), bfhi(b.y)}; hx[6] = (f32x2){bflo(b.z), bfhi(b.z)}; hx[7] = (f32x2){bflo(b.w), bfhi(b.w)}; }
    f32x2 acc[8];
#pragma unroll
    for (int i = 0; i < 8; ++i) acc[i] = (f32x2){0.f, 0.f};
#pragma unroll 1
    for (int p0 = 0; p0 < 128; p0 += 8) {
        const int l0 = p0 & 63; const int ev = p0 < 64 ? eA : eB; const float wv = p0 < 64 ? wA : wB;
        v4u uq[8], vq[8];
#pragma unroll
        for (int q = 0; q < 8; ++q) { const size_t eo = (size_t)__builtin_amdgcn_readlane(ev, l0 + q) * 2048 + 16 * lane;
            uq[q] = *(const GAS v4u*)(U8 + eo); vq[q] = *(const GAS v4u*)(V8 + eo); }
        float dv = 0.f;
#pragma unroll
        for (int q = 0; q < 8; ++q) {
            f32x2 d2 = {0.f, 0.f};
#pragma unroll
            for (int w4 = 0; w4 < 4; ++w4) { const f32x2 lo = __builtin_amdgcn_cvt_pk_f32_fp8((int)uq[q][w4], false), hi = __builtin_amdgcn_cvt_pk_f32_fp8((int)uq[q][w4], true);
                d2 = lo * hx[2 * w4] + d2; d2 = hi * hx[2 * w4 + 1] + d2; }
            float s = row_sum_f(d2.x + d2.y);
            s += __builtin_bit_cast(float, __builtin_amdgcn_update_dpp(0, __builtin_bit_cast(int, s), 0x142, 0xa, 0xf, false));
            s += __builtin_bit_cast(float, __builtin_amdgcn_update_dpp(0, __builtin_bit_cast(int, s), 0x143, 0xc, 0xf, false));
            const float tot = __builtin_bit_cast(float, __builtin_amdgcn_readlane(__builtin_bit_cast(int, s), 63));
            dv = (lane == l0 + q) ? tot : dv;
        }
        const float cfv = wv * gelu_tanh(dv * (1.f / 256.f)) * (1.f / 16.f);
#pragma unroll
        for (int q = 0; q < 8; ++q) {
            const float cf = __builtin_bit_cast(float, __builtin_amdgcn_readlane(__builtin_bit_cast(int, cfv), l0 + q));
#pragma unroll
            for (int w4 = 0; w4 < 4; ++w4) { const f32x2 lo = __builtin_amdgcn_cvt_pk_f32_fp8((int)vq[q][w4], false), hi = __builtin_amdgcn_cvt_pk_f32_fp8((int)vq[q][w4], true);
                acc[2 * w4] = lo * cf + acc[2 * w4]; acc[2 * w4 + 1] = hi * cf + acc[2 * w4 + 1]; }
        }
    }
    float* orow = C.out + (size_t)t * D + 16 * lane; const float* lw = C.in[I_LNF] + 16 * lane;
    f32x4 hv[4]; float s = 0.f;
#pragma unroll
    for (int i = 0; i < 4; ++i) { hv[i] = *(const GAS f32x4*)(orow + 4 * i); hv[i].x += acc[2 * i].x; hv[i].y += acc[2 * i].y; hv[i].z += acc[2 * i + 1].x; hv[i].w += acc[2 * i + 1].y;
        s += (hv[i].x * hv[i].x + hv[i].y * hv[i].y) + (hv[i].z * hv[i].z + hv[i].w * hv[i].w); }
    const float rs = rsqrtf(wave_sum(s) * (1.f / D) + RMS_EPS);
    if (dry) return;
#pragma unroll
    for (int i = 0; i < 4; ++i) { const f32x4 w4 = *(const GAS f32x4*)(lw + 4 * i); *(GAS f32x4*)(orow + 4 * i) = hv[i] * rs * w4; }
}

constexpr int NSTEPS = 37;
#ifndef PH_MASK
#define PH_MASK 0xFF
#endif
#define PH_ON(k) (((PH_MASK) >> (k)) & 1)
struct Args { const float* in[22]; float* out; unsigned char* ws; int ph_lo, ph_hi; };
typedef const __attribute__((address_space(4))) Args* kargp;
__device__ __forceinline__ void ctx_init(Ctx& C, unsigned char* smem) {
    kargp ap = (kargp)__builtin_amdgcn_kernarg_segment_ptr();
    asm volatile("" : "+s"(ap));
    int tid_ = threadIdx.x; asm volatile("" : "+v"(tid_));
    C.lds = (ldsp)smem; C.tid = tid_; C.lane = C.tid & 63; C.wave = __builtin_amdgcn_readfirstlane(C.tid >> 6); C.G = gridDim.x; C.bid = blockIdx.x;
#pragma unroll
    for (int i = 0; i < 22; ++i) C.in[i] = ap->in[i];
    C.out = ap->out; C.ws = ap->ws;
}
__global__ void __launch_bounds__(NT, 2) hyb_fwd(Args args) {
    extern __shared__ __attribute__((aligned(16))) unsigned char smem[];
    volatile LAS unsigned* MISC = (volatile LAS unsigned*)((ldsp)smem + LDSCTL_OFF);
    for (int u = threadIdx.x; u < (LDS_BYTES - LDSCTL_OFF) / 4; u += NT) MISC[u] = 0u;
    __syncthreads();
    const int lo = args.ph_lo, hi = args.ph_hi;
    unsigned* barw = (unsigned*)(args.ws + WS_CTL) + CW_BAR;
    XcdBarrier bar; bar.bar = barw; bar.x = 0; bar.st = MISC + 8;
    if (hi - lo > 1) bar = xcd_barrier_post(barw, MISC + 8);
#pragma unroll 1
    for (int step = lo; step < hi; ++step) {
        int kind, b = 0, gk = 0;
        if (step == 0) kind = 0;
        else if (step == 1) kind = 8;
        else if (step <= 33) { b = (step - 2) >> 3; const int k = (step - 2) & 7; gk = k; kind = (k == 0 || k >= 5) ? 1 : k + 1; }
        else if (step == 34) kind = 6;
        else if (step == 35) { kind = 1; gk = 8; }
        else kind = 7;
#ifdef REP_KIND
#ifndef REP_GK
#define REP_GK -1
#endif
        for (int rep = ((kind == REP_KIND && (REP_GK < 0 || gk == REP_GK)) ? 0 : 1); rep < 2; ++rep) {
        const bool dry = (rep == 0);
#else
        const bool dry = false; {
#endif
        Ctx C; ctx_init(C, smem);
        if (kind == 0 && PH_ON(0)) p0_prologue(C);
        else if (kind == 8) p0b_prologue(C);
        else if (kind == 1 && PH_ON(1)) {
            pg8::Gemm g; EpiAny E; E.P.PJ = (bf16*)(C.ws + WS_PJ); E.P.TL = (float*)(C.ws + WS_TL); E.PJ = (const bf16*)(C.ws + WS_PJ); E.T = nullptr; E.O = nullptr; E.gcol = 0; E.X = C.in[I_X]; E.OF = C.out; E.b = b; E.ldc = 2048;
            if (gk == 0)      { g = pg8::Gemm{(const bf16*)(C.ws + WS_HN), (const bf16*)(C.ws + WS_W1T), SEQ, NPJ, 1024}; E.mode = 0; if (b == 0) meta_proj(C); tail_proj(C); }
            else if (gk == 5) { g = pg8::Gemm{(const bf16*)(C.ws + WS_OG), (const bf16*)(C.ws + WS_WAT), RPB, 1024, 1024}; E.mode = 1; E.O = (bf16*)(C.ws + WS_T1); E.gcol = PJ_GA; }
            else if (gk == 6) { g = pg8::Gemm{(const bf16*)(C.ws + WS_YS), (const bf16*)(C.ws + WS_WBT), RPB, 1024, 2048}; E.mode = 1; E.O = (bf16*)(C.ws + WS_MX); E.gcol = PJ_GB; E.T = (const bf16*)(C.ws + WS_T1); }
            else if (gk == 7) { g = pg8::Gemm{(const bf16*)(C.ws + WS_MX), (const bf16*)(C.ws + WS_WOT), RPB, 1024, 1024}; E.mode = 2; }
            else              { g = pg8::Gemm{(const bf16*)(C.ws + WS_HN2), (const bf16*)(C.ws + WS_WET), NTOK, 2048, 1024}; E.mode = 3; E.OF = (float*)(C.ws + WS_SC); }
            pg8::StaticOrder S; S.init(g.M, g.N, C.G, C.bid);
#ifdef REP_TAIL_ONLY
            if (!dry)
#endif
            pg8::gemm_phase<EpiAny, pg8::StaticOrder, true, true>(C.lds, g, S, E);
            if (gk == 7 && b + 1 < BATCH) hn_batch(C, b + 1, (S.nwg < C.G) ? S.nwg : 0);
        }
        else if (kind == 2 && PH_ON(2)) {
#ifdef DRYC
            if (!dry || DRYC == 1) conv_batch(C);
            if (!dry || DRYC == 2) for (int u = C.bid; u < NCHUNK * 5; u += C.G) phaseC_unit(C, u / 5, 6 + u % 5);
#else
            conv_batch(C); for (int u = C.bid; u < NCHUNK * 5; u += C.G) phaseC_unit(C, u / 5, 6 + u % 5);
#endif
 }
        else if ((kind == 3 && PH_ON(3)) || (kind == 5 && PH_ON(5))) {
            unsigned* qc = (unsigned*)(C.ws + WS_CTL) + CW_QUEUE + 2 * step + (dry ? 1 : 0);
            for (;;) {
                if (C.tid == 0) MISC[16] = atomicAdd(qc, 1u);
                __syncthreads();
                const int u = (int)MISC[16];
                __syncthreads();
                if (u >= NCHUNK * 8) break;
                const bool ssd = u < NCHUNK * 4; const int v = ssd ? u : u - NCHUNK * 4, c = v >> 2, k = v & 3;
#ifdef DRYF
                if (dry && ssd != (DRYF == 2)) continue;
#endif
                if (kind == 3) { if (ssd) ssd_pass1_unit(C, c, k); else gla_pass1_unit(C, c, k); }
                else           { if (ssd) ssd_pass3_unit(C, c, k); else gla_pass3_unit(C, c, k); }
            }
        }
        else if (kind == 4 && PH_ON(4)) phaseE(C);
        else if (kind == 6 && PH_ON(6)) phaseJ(C);
        else if (kind == 7 && PH_ON(7)) { const int gw = C.bid * NWAVES + C.wave, NGW = C.G * NWAVES; for (int t = gw; t < NTOK; t += NGW) peer_token(C, t, dry); }
#ifdef REP_KIND
        if (rep == 0) xcd_barrier(bar);
#endif
        }
        if (step + 1 < hi && !(kind == 1 && gk == 5)) xcd_barrier(bar);
    }
}

#ifdef DBG_STOP
__global__ void dbg_digest(const unsigned* w, size_t nwords, float* out, size_t nout) {
    for (size_t i = (size_t)blockIdx.x * blockDim.x + threadIdx.x; i < nout; i += (size_t)gridDim.x * blockDim.x) {
        unsigned h = 0; for (size_t j = i; j < nwords; j += nout) h ^= w[j] * 2654435761u + (unsigned)(j / nout);
        out[i] = (float)(h & 0xFFFFFFu);
    }
}
#endif
#ifndef HYB_N_LAUNCHES
#define HYB_N_LAUNCHES 1
#endif
extern "C" void kernel_launch(void* const* d_in, const int* in_sizes, int n_in, void* d_out, int out_size, void* d_ws, size_t ws_size, hipStream_t stream) {
    static int grid = 0;
    if (grid == 0) {
        if (n_in != 22 || out_size != NTOK * D || ws_size < WS_END) { fprintf(stderr, "kernel_launch: unexpected shapes: n_in %d out %d ws %zu (need %zu)\n", n_in, out_size, ws_size, (size_t)WS_END); grid = -1; return; }
        int dev = 0, cus = 0, per_cu = 0;
        if (hipGetDevice(&dev) != hipSuccess || hipDeviceGetAttribute(&cus, hipDeviceAttributeMultiprocessorCount, dev) != hipSuccess) { grid = -1; return; }
        if (hipFuncSetAttribute((const void*)hyb_fwd, hipFuncAttributeMaxDynamicSharedMemorySize, LDS_BYTES) != hipSuccess) { fprintf(stderr, "kernel_launch: hipFuncSetAttribute failed\n"); grid = -1; return; }
        if (hipOccupancyMaxActiveBlocksPerMultiprocessor(&per_cu, (const void*)hyb_fwd, NT, LDS_BYTES) != hipSuccess || per_cu < 1) { fprintf(stderr, "kernel_launch: occupancy query says %d blocks per CU\n", per_cu); per_cu = 1; }
        (void)hipGetLastError();
        grid = cus;
    }
    if (grid < 0) return;
    (void)hipMemsetAsync((char*)d_ws + WS_CTL, 0, CTL_ZERO_BYTES, stream);
    Args a{};
    for (int i = 0; i < 22; ++i) a.in[i] = (const float*)d_in[i];
    a.out = (float*)d_out; a.ws = (unsigned char*)d_ws;
    if (HYB_N_LAUNCHES == 1) { a.ph_lo = 0; a.ph_hi = NSTEPS; hipLaunchKernelGGL(hyb_fwd, dim3(grid), dim3(NT), LDS_BYTES, stream, a); }
    else {
#ifdef DBG_STOP
        for (int s = 0; s <= DBG_STOP; ++s) { a.ph_lo = s; a.ph_hi = s + 1; hipLaunchKernelGGL(hyb_fwd, dim3(grid), dim3(NT), LDS_BYTES, stream, a); }
        hipLaunchKernelGGL(dbg_digest, dim3(2048), dim3(256), 0, stream, (const unsigned*)((char*)d_ws + (size_t)(DBG_OFF)), (size_t)(DBG_LEN) / 4, (float*)d_out, (size_t)NTOK * D);
#else
        for (int s = 0; s < NSTEPS; ++s) { a.ph_lo = s; a.ph_hi = s + 1; hipLaunchKernelGGL(hyb_fwd, dim3(grid), dim3(NT), LDS_BYTES, stream, a); }
#endif
    }
}
```

```cpp
#include <hip/hip_runtime.h>
#include <cstdio>
#include <cstdint>
namespace pg8 {
#define PG8_LAS __attribute__((address_space(3)))
typedef unsigned short bf16_t;
typedef short bf16x8 __attribute__((ext_vector_type(8)));
typedef float f32x4 __attribute__((ext_vector_type(4)));
typedef unsigned u32x4 __attribute__((ext_vector_type(4)));
constexpr int BM = 256, BK = 64, HALF = 128, HTB = HALF * BK * 2  , STAGE_BYTES = 8 * HTB, NXCD = 8, WGM = 8;

__host__ __device__ __forceinline__ int lds_byte(int r, int c) { const int st = (r >> 4) * 2 + (c >> 5), rr = r & 15, cc = c & 31, ob = rr * 64 + cc * 2; return st * 1024 + (ob ^ (((ob >> 9) & 1) << 5)); }
__host__ __device__ __forceinline__ void stage_rc(int b, int& R, int& C) { const int st = b / 1024, sb = b % 1024, swz = sb ^ (((sb >> 9) & 1) << 5); R = (st >> 1) * 16 + swz / 64; C = (st & 1) * 32 + (swz % 64) / 2; }
__host__ __device__ __forceinline__ int perm32(int rho) { const int n = rho >> 4, i = rho & 15; return 8 * (i >> 2) + 4 * n + (i & 3); }

struct Unit { int pm, pn; };
struct Gemm { const bf16_t* A; const bf16_t* Bt; int M, N, K; };

struct StaticOrder {
    int nM, nN, nwg, G, c;
    __host__ __device__ void init(int M, int N, int G_, int c_) { nM = M / BM; nN = N / BM; nwg = nM * nN; G = G_; c = c_; }
    __host__ __device__ bool next(int i, Unit& u) const {
        const long L = (long)i * G + c; if (L >= nwg) return false;
        int wgid = (int)L; { const int q = nwg / NXCD, r = nwg % NXCD, xcd = wgid % NXCD, off = wgid / NXCD; wgid = (xcd < r ? xcd * (q + 1) : r * (q + 1) + (xcd - r) * q) + off; }
        const int nig = WGM * nN, gid = wgid / nig, fm = gid * WGM, gsz = (nM - fm) < WGM ? (nM - fm) : WGM;
        u.pm = fm + ((wgid % nig) % gsz); u.pn = (wgid % nig) / gsz; return true;
    }
    __device__ __forceinline__ void a_ready(const Unit&) const {}
    __device__ __forceinline__ void done(const Unit&) const {}
};

typedef float f32x2_t __attribute__((ext_vector_type(2))); typedef __bf16 bf16x2_t __attribute__((ext_vector_type(2)));
__device__ __forceinline__ unsigned cvt_pk_bf16(float lo, float hi) { f32x2_t v = {lo, hi}; bf16x2_t b = __builtin_convertvector(v, bf16x2_t); return __builtin_bit_cast(unsigned, b); }
template <class Epi, class Sched, bool ALIGN_EPI = false, bool SP2 = false>
__device__ __forceinline__ void gemm_phase(PG8_LAS unsigned char* lds, const Gemm g, const Sched& S, const Epi& E) {
    int tid_ = threadIdx.x; asm volatile("" : "+v"(tid_));
    const int tid = tid_, wid = __builtin_amdgcn_readfirstlane(tid >> 6), lane = tid & 63, wr = wid >> 2, wc = wid & 3, fr = lane & 15, fq = lane >> 4;
    const int K = g.K, nt = K / BK;
    unsigned voffA[2], voffB[2];
#pragma unroll
    for (int i = 0; i < 2; ++i) { int R, C; stage_rc(tid * 16 + i * 8192, R, C); const int Rb = Epi::PERM ? ((R & ~31) + perm32(R & 31)) : R;
        voffA[i] = (unsigned)(R * K + C) * 2u; voffB[i] = (unsigned)(Rb * K + C) * 2u; }
    const size_t kstep = (size_t)(BK * 2);
    const size_t hstep = (size_t)HALF * K * 2;
    const size_t tstep = 2 * hstep;
    const unsigned ldsw = (unsigned)wid * 1024u;
    const int aoff = lds_byte(wr * 64 + fr, fq * 8), boff = lds_byte(wc * 32 + fr, fq * 8);
#define PG8_SA(b, h) (((b) * 2 + (h)) * HTB)
#define PG8_SB(b, h) ((4 + (b) * 2 + (h)) * HTB)
#define PG8_STAGE(bufoff, gbase, voff) do { _Pragma("unroll") for (int _i = 0; _i < 2; ++_i) \
        __builtin_amdgcn_global_load_lds((const unsigned*)((const char*)(gbase) + (voff)[_i]), (PG8_LAS unsigned*)(lds + (bufoff) + ldsw + _i * 8192), 16, 0, 0); } while (0)
#define PG8_LDA(dst, b, h) do { _Pragma("unroll") for (int m = 0; m < 4; ++m) _Pragma("unroll") for (int k = 0; k < 2; ++k) dst[m][k] = *(const PG8_LAS bf16x8*)(lds + PG8_SA(b, h) + aoff + m * 2048 + k * 1024); } while (0)
#define PG8_LDB(dst, b, h) do { _Pragma("unroll") for (int n = 0; n < 2; ++n) _Pragma("unroll") for (int k = 0; k < 2; ++k) dst[n][k] = *(const PG8_LAS bf16x8*)(lds + PG8_SB(b, h) + boff + n * 2048 + k * 1024); } while (0)
#define PG8_MMA(ai, bj, At, Bt) do { __builtin_amdgcn_s_setprio(1); _Pragma("unroll") for (int m = 0; m < 4; ++m) _Pragma("unroll") for (int n = 0; n < 2; ++n) _Pragma("unroll") for (int k = 0; k < 2; ++k) \
        acc[ai][bj][m][n] = __builtin_amdgcn_mfma_f32_16x16x32_bf16(Bt[n][k], At[m][k], acc[ai][bj][m][n], 0, 0, 0); __builtin_amdgcn_s_setprio(0); } while (0)
#define PG8_WAIT_V(n) asm volatile("s_waitcnt vmcnt(" #n ")" ::: "memory")
#define PG8_WAIT_L(n) asm volatile("s_waitcnt lgkmcnt(" #n ")" ::: "memory")
#define PG8_BAR __builtin_amdgcn_s_barrier()
#define PG8_SCHED __builtin_amdgcn_sched_barrier(0)
    Unit cur, nxt; int ui = 0;
    if (!S.next(0, cur)) return;
    f32x4 acc[2][2][4][2];
#pragma unroll
    for (int a = 0; a < 2; ++a)
#pragma unroll
        for (int b = 0; b < 2; ++b)
#pragma unroll
            for (int m = 0; m < 4; ++m)
#pragma unroll
                for (int n = 0; n < 2; ++n) acc[a][b][m][n] = (f32x4){0.f, 0.f, 0.f, 0.f};
    bf16x8 At[4][2], B0[2][2], B1[2][2];
    const char* cA = (const char*)g.A + (size_t)cur.pm * tstep; const char* cB = (const char*)g.Bt + (size_t)cur.pn * tstep;
    S.a_ready(cur);
    if constexpr (SP2) {
        PG8_STAGE(PG8_SB(0, 0), cB, voffB); PG8_STAGE(PG8_SB(0, 1), cB + hstep, voffB); PG8_STAGE(PG8_SA(0, 0), cA, voffA); PG8_STAGE(PG8_SA(0, 1), cA + hstep, voffA);
        if (wr == 1) PG8_BAR;
        PG8_WAIT_V(2); PG8_BAR;
        PG8_STAGE(PG8_SB(1, 0), cB + kstep, voffB); PG8_STAGE(PG8_SA(1, 0), cA + kstep, voffA); PG8_STAGE(PG8_SB(1, 1), cB + hstep + kstep, voffB);
        PG8_WAIT_V(6); PG8_BAR;
    } else {
        PG8_STAGE(PG8_SB(0, 0), cB, voffB); PG8_STAGE(PG8_SA(0, 0), cA, voffA); PG8_STAGE(PG8_SB(0, 1), cB + hstep, voffB); PG8_STAGE(PG8_SA(0, 1), cA + hstep, voffA);
        if (wr == 1) PG8_BAR;
        PG8_WAIT_V(4); PG8_BAR;
        PG8_STAGE(PG8_SB(1, 0), cB + kstep, voffB); PG8_STAGE(PG8_SA(1, 0), cA + kstep, voffA); PG8_STAGE(PG8_SB(1, 1), cB + hstep + kstep, voffB);
        PG8_WAIT_V(6); PG8_BAR;
    }
    for (;;) {
        const bool has_next = S.next(ui + 1, nxt);
        const char* nA = has_next ? (const char*)g.A + (size_t)nxt.pm * tstep : cA; const char* nB = has_next ? (const char*)g.Bt + (size_t)nxt.pn * tstep : cB;
        for (int t = 0; t < nt; t += 2) {
            const bool last = (t == nt - 2);
            const char* a1 = cA + (size_t)(t + 1) * kstep;
            const char* a2 = last ? nA : cA + (size_t)(t + 2) * kstep; const char* b2 = last ? nB : cB + (size_t)(t + 2) * kstep;
            const char* a3 = a2 + kstep; const char* b3 = b2 + kstep;
            if (last && has_next) S.a_ready(nxt);
            if constexpr (SP2) {
            PG8_LDB(B0, 0, 0); PG8_LDB(B1, 0, 1); PG8_SCHED; PG8_LDA(At, 0, 0); PG8_STAGE(PG8_SA(1, 1), a1 + hstep, voffA);
            PG8_WAIT_V(8); PG8_WAIT_L(0); PG8_BAR; PG8_MMA(0, 0, At, B0); PG8_MMA(0, 1, At, B1); PG8_BAR; PG8_SCHED;
            PG8_LDA(At, 0, 1); PG8_STAGE(PG8_SB(0, 0), b2, voffB); PG8_STAGE(PG8_SB(0, 1), b2 + hstep, voffB); PG8_STAGE(PG8_SA(0, 0), a2, voffA);
            PG8_WAIT_V(8); PG8_WAIT_L(0); PG8_BAR; PG8_MMA(1, 0, At, B0); PG8_MMA(1, 1, At, B1); PG8_BAR; PG8_SCHED;
            PG8_LDB(B0, 1, 0); PG8_LDB(B1, 1, 1); PG8_SCHED; PG8_LDA(At, 1, 0); PG8_STAGE(PG8_SA(0, 1), a2 + hstep, voffA);
            PG8_WAIT_V(8); PG8_WAIT_L(0); PG8_BAR; PG8_MMA(0, 0, At, B0); PG8_MMA(0, 1, At, B1); PG8_BAR; PG8_SCHED;
            PG8_LDA(At, 1, 1); PG8_STAGE(PG8_SB(1, 0), b3, voffB); PG8_STAGE(PG8_SB(1, 1), b3 + hstep, voffB); PG8_STAGE(PG8_SA(1, 0), a3, voffA);
            PG8_WAIT_V(8); PG8_WAIT_L(0); PG8_BAR; PG8_MMA(1, 0, At, B0); PG8_MMA(1, 1, At, B1); PG8_BAR; PG8_SCHED;
            } else {
            PG8_LDB(B0, 0, 0); PG8_SCHED; PG8_LDA(At, 0, 0); PG8_STAGE(PG8_SA(1, 1), a1 + hstep, voffA);
            PG8_WAIT_L(8); PG8_BAR; PG8_WAIT_L(0); PG8_MMA(0, 0, At, B0); PG8_BAR; PG8_SCHED;
            PG8_LDB(B1, 0, 1); PG8_STAGE(PG8_SB(0, 0), b2, voffB);
            PG8_BAR; PG8_WAIT_L(0); PG8_MMA(0, 1, At, B1); PG8_BAR;
            PG8_LDA(At, 0, 1); PG8_STAGE(PG8_SA(0, 0), a2, voffA);
            PG8_BAR; PG8_WAIT_L(0); PG8_MMA(1, 0, At, B0); PG8_BAR; PG8_SCHED;
            PG8_STAGE(PG8_SB(0, 1), b2 + hstep, voffB);
            PG8_WAIT_V(6); PG8_BAR; PG8_MMA(1, 1, At, B1); PG8_BAR;
            PG8_LDB(B0, 1, 0); PG8_SCHED; PG8_LDA(At, 1, 0); PG8_STAGE(PG8_SA(0, 1), a2 + hstep, voffA);
            PG8_WAIT_L(8); PG8_BAR; PG8_WAIT_L(0); PG8_MMA(0, 0, At, B0); PG8_BAR; PG8_SCHED;
            PG8_LDB(B1, 1, 1); PG8_STAGE(PG8_SB(1, 0), b3, voffB);
            PG8_BAR; PG8_WAIT_L(0); PG8_MMA(0, 1, At, B1); PG8_BAR;
            PG8_LDA(At, 1, 1); PG8_STAGE(PG8_SA(1, 0), a3, voffA);
            PG8_BAR; PG8_WAIT_L(0); PG8_MMA(1, 0, At, B0); PG8_BAR; PG8_SCHED;
            PG8_STAGE(PG8_SB(1, 1), b3 + hstep, voffB);
            PG8_WAIT_V(6); PG8_BAR; PG8_MMA(1, 1, At, B1); PG8_BAR;
            }
        }
        if constexpr (ALIGN_EPI) { if (wr == 0) PG8_BAR; }
        if constexpr (!Epi::AFTER_DRAIN) { E(acc, cur, wr, wc, fr, fq); S.done(cur); }
        if (!has_next) break;
#pragma unroll
        for (int a = 0; a < 2; ++a)
#pragma unroll
            for (int b = 0; b < 2; ++b)
#pragma unroll
                for (int m = 0; m < 4; ++m)
#pragma unroll
                    for (int n = 0; n < 2; ++n) acc[a][b][m][n] = (f32x4){0.f, 0.f, 0.f, 0.f};
        cur = nxt; cA = nA; cB = nB; ++ui;
        if constexpr (ALIGN_EPI) { if (wr == 1) PG8_BAR; }
    }
    PG8_WAIT_V(0);
    if constexpr (!ALIGN_EPI) { if (wr == 0) PG8_BAR; }
    PG8_BAR;
    if constexpr (Epi::AFTER_DRAIN) { E.fused(acc, cur, wr, wc, fr, fq, lds, wid, lane); S.done(cur); }
#undef PG8_SA
#undef PG8_SB
#undef PG8_STAGE
#undef PG8_LDA
#undef PG8_LDB
#undef PG8_MMA
#undef PG8_WAIT_V
#undef PG8_WAIT_L
#undef PG8_BAR
#undef PG8_SCHED
}
}

constexpr int NWAVES = 8, NT = 512;
constexpr int D = 1024, BATCH = 4, SEQ = 8192, NMETA = 16;
constexpr int RPB = 8448;
constexpr int RFRONT = 48, RTOK = 64, REND = 8256;
constexpr int NCHUNK = 129;
constexpr int NPJ = 10240;
constexpr int N1 = 10496;
constexpr int PJ_Q = 0, PJ_K = 512, PJ_V = 1024, PJ_GO = 2048, PJ_Z = 3072, PJ_XBC = 5120, PJ_GA = 8192, PJ_GB = 9216;
constexpr int NTOK = BATCH * SEQ;
constexpr float RMS_EPS = 1e-6f;

constexpr size_t MiB = 1u << 20;
constexpr size_t WS_CTL = 0, CTL_ZERO_BYTES = 1 * MiB;
constexpr size_t WS_W1T = 2 * MiB;
constexpr size_t WS_WAT = 23 * MiB;
constexpr size_t WS_WBT = 25 * MiB;
constexpr size_t WS_WOT = 29 * MiB;
constexpr size_t WS_WET = 31 * MiB;
constexpr size_t WS_HNM = 35 * MiB;
constexpr size_t WS_HN = 36 * MiB;
constexpr size_t WS_PJ = 53 * MiB;
constexpr size_t WS_TL = 218 * MiB;
constexpr size_t WS_XC = 220 * MiB;
constexpr size_t WS_GG = 270 * MiB;
constexpr size_t WS_DT = 287 * MiB;
constexpr size_t WS_AC = 289 * MiB;
constexpr size_t WS_LG = 291 * MiB;
constexpr size_t WS_LS = 324 * MiB;
constexpr size_t WS_OG = 389 * MiB;
constexpr size_t WS_YS = 406 * MiB;
constexpr size_t WS_T1 = 439 * MiB;
constexpr size_t WS_MX = 456 * MiB;
constexpr size_t WS_MIX_END = 473 * MiB;
constexpr size_t WS_HN2 = 36 * MiB;
constexpr size_t WS_SC = 100 * MiB;
constexpr size_t WS_HN8 = 356 * MiB;
constexpr size_t WS_U8 = 474 * MiB;
constexpr size_t WS_END = 506 * MiB;
constexpr int CW_BAR = 4096, CW_QUEUE = 64;

constexpr int LDS_WORK = 147456;
constexpr int LDSCTL_OFF = LDS_WORK;
constexpr int LDS_BYTES = LDS_WORK + 512;

#define GAS __attribute__((address_space(1)))
#define LAS __attribute__((address_space(3)))
typedef unsigned short bf16;
typedef unsigned v4u __attribute__((ext_vector_type(4)));
typedef unsigned v2u __attribute__((ext_vector_type(2)));
typedef float f32x4 __attribute__((ext_vector_type(4)));
typedef float f32x2 __attribute__((ext_vector_type(2)));
typedef short bf16x8 __attribute__((ext_vector_type(8)));
typedef short s16x4 __attribute__((ext_vector_type(4)));
typedef short v4i16_t __attribute__((ext_vector_type(4)));
typedef LAS unsigned char* ldsp;
#define RLX_AGENT __ATOMIC_RELAXED, __HIP_MEMORY_SCOPE_AGENT
#define LDS_WAIT() asm volatile("s_waitcnt lgkmcnt(0)" ::: "memory")

__device__ __forceinline__ unsigned pk2(float lo, float hi) { return pg8::cvt_pk_bf16(lo, hi); }
__device__ __forceinline__ float bflo(unsigned u) { return __builtin_bit_cast(float, u << 16); }
__device__ __forceinline__ float bfhi(unsigned u) { return __builtin_bit_cast(float, u & 0xffff0000u); }
__device__ __forceinline__ float fast_rcp(float x) { return __builtin_amdgcn_rcpf(x); }
__device__ __forceinline__ float sigmoidf_(float x) { return fast_rcp(1.f + __expf(-x)); }
__device__ __forceinline__ float siluf_(float x) { return x * sigmoidf_(x); }
__device__ __forceinline__ float wave_sum(float v) {
#pragma unroll
    for (int o = 1; o < 64; o <<= 1) v += __shfl_xor(v, o);
    return v;
}
__device__ __forceinline__ float wave_max(float v) {
#pragma unroll
    for (int o = 1; o < 64; o <<= 1) v = fmaxf(v, __shfl_xor(v, o));
    return v;
}
__device__ __forceinline__ f32x4 mma16(bf16x8 a, bf16x8 b, f32x4 c) { return __builtin_amdgcn_mfma_f32_16x16x32_bf16(b, a, c, 0, 0, 0); }
__device__ __forceinline__ bf16x8 lds_frag(ldsp p) { return *(const LAS bf16x8*)p; }
__device__ __forceinline__ s16x4 lds_tr(ldsp p) { return __builtin_bit_cast(s16x4, __builtin_amdgcn_ds_read_tr16_b64_v4i16((LAS v4i16_t*)p)); }
__device__ __forceinline__ bf16x8 tr_frag(ldsp tile, int pitch, int k0, int n0, int fr, int fq) {
#ifdef TR_SLOW
    bf16x8 r;
#pragma unroll
    for (int e = 0; e < 8; ++e) r[e] = *(const LAS short*)(tile + (k0 + 8 * fq + e) * pitch + (n0 + fr) * 2);
    return r;
#else
    ldsp p = tile + (k0 + 8 * fq + (fr >> 2)) * pitch + (n0 + 4 * (fr & 3)) * 2;
    const s16x4 lo = lds_tr(p), hi = lds_tr(p + 4 * pitch);
    bf16x8 r; r[0] = lo[0]; r[1] = lo[1]; r[2] = lo[2]; r[3] = lo[3]; r[4] = hi[0]; r[5] = hi[1]; r[6] = hi[2]; r[7] = hi[3];
    return r;
#endif
}

#define XB_TMO      128
#define XB_XCNT(j)  (256  + 64 * (j))
#define XB_XSUB(j)  (1280 + 64 * (j))
#define XB_XGEN(j)  (2304 + 64 * (j))
#define XB_TOP      3328
#define XB_TOPGEN   3392
#define XCD_BAR_WORDS 3456
#define XB_SPIN_CAP (1u << 22)
__device__ __forceinline__ unsigned xb_ld(unsigned* p)              { return __hip_atomic_load(p, __ATOMIC_RELAXED, __HIP_MEMORY_SCOPE_AGENT); }
__device__ __forceinline__ unsigned xb_add(unsigned* p, unsigned v) { return __hip_atomic_fetch_add(p, v, __ATOMIC_RELAXED, __HIP_MEMORY_SCOPE_AGENT); }
__device__ __forceinline__ unsigned xb_xcc_id() { return (unsigned)__builtin_amdgcn_s_getreg((3 << 11) | 20) & 0xFu; }
#define XB_SPIN(cond, bar) do { unsigned _sp = 0; while (cond) { __builtin_amdgcn_s_sleep(1); \
    if ((++_sp & 255u) == 0u) { if (xb_ld(&(bar)[XB_TMO])) break; if (_sp > XB_SPIN_CAP) { atomicAdd(&(bar)[XB_TMO], 1u); break; } } } } while (0)
struct XcdBarrier { unsigned* bar; unsigned x; volatile LAS unsigned* st; };
__device__ __forceinline__ XcdBarrier xcd_barrier_post(unsigned* bar, volatile LAS unsigned* st) {
    XcdBarrier b; b.bar = bar; b.x = xb_xcc_id(); b.st = st;
    if (threadIdx.x == 0) (void)xb_add(&bar[XB_XCNT(b.x)], 1u);
    return b;
}
__device__ __forceinline__ void xcd_barrier_complete(unsigned* bar, unsigned x, unsigned& nloc, unsigned& nx) {
    const unsigned G = gridDim.x * gridDim.y * gridDim.z;
    unsigned sum, cnt, mine, sp = 0u;
    for (;;) {
        sum = 0u; cnt = 0u; mine = 0u;
#pragma unroll
        for (unsigned j = 0; j < 16; ++j) { const unsigned c = xb_ld(&bar[XB_XCNT(j)]); sum += c; cnt += (c > 0u) ? 1u : 0u; mine = (j == x) ? c : mine; }
        if (sum == G) break;
        __builtin_amdgcn_s_sleep(1);
        if ((++sp & 255u) == 0u) { if (xb_ld(&bar[XB_TMO])) break; if (sp > XB_SPIN_CAP) { atomicAdd(&bar[XB_TMO], 1u); break; } }
    }
    nloc = mine > 0u ? mine : 1u; nx = cnt > 0u ? cnt : 1u;
}
__device__ __forceinline__ void xcd_barrier(const XcdBarrier& b) {
    asm volatile("s_waitcnt vmcnt(0)" ::: "memory");
    __syncthreads();
    if (threadIdx.x == 0) {
        unsigned* bar = b.bar;
        __builtin_amdgcn_s_waitcnt(0);
        unsigned nloc = b.st[0], nx = b.st[1];
        if (nloc == 0u) { xcd_barrier_complete(bar, b.x, nloc, nx); b.st[0] = nloc; b.st[1] = nx; }
        const unsigned old = xb_add(&bar[XB_XSUB(b.x)], 1u);
        const unsigned gen = old / nloc;
        if (old + 1u == (gen + 1u) * nloc) {
            __builtin_amdgcn_fence(__ATOMIC_RELEASE, "agent");
            asm volatile("s_waitcnt vmcnt(0)" ::: "memory");
            const unsigned og = xb_add(&bar[XB_TOP], 1u);
            const unsigned tg = og / nx;
            if (og + 1u == (tg + 1u) * nx) xb_add(&bar[XB_TOPGEN], 1u);
            else XB_SPIN(xb_ld(&bar[XB_TOPGEN]) == tg, bar);
            __builtin_amdgcn_fence(__ATOMIC_ACQUIRE, "agent");
            xb_add(&bar[XB_XGEN(b.x)], 1u);
            asm volatile("s_waitcnt vmcnt(0)" ::: "memory");
        } else {
            XB_SPIN(xb_ld(&bar[XB_XGEN(b.x)]) == gen, bar);
            __builtin_amdgcn_fence(__ATOMIC_ACQUIRE, "agent");
            asm volatile("s_waitcnt vmcnt(0)" ::: "memory");
        }
    }
    __syncthreads();
}

struct Ctx {
    ldsp lds; int tid, lane, wave, G, bid;
    const float* in[22]; float* out; unsigned char* ws;
};
enum { I_X = 0, I_META, I_LNMIX, I_WIN, I_WG2, I_BG, I_GNW, I_CONVW, I_CONVB, I_DTB, I_ALOG, I_DSKIP, I_SNW, I_WUG, I_WUS, I_WOUT, I_LNFFN, I_WQ, I_KEYS, I_PU, I_PV, I_LNF };

using pg8::Unit; using pg8::cvt_pk_bf16;
struct EpiProj {
    static constexpr bool PERM = true, AFTER_DRAIN = false;
    bf16* PJ; float* TL;
    __device__ __forceinline__ void operator()(const f32x4 (&acc)[2][2][4][2], const Unit& u, int wr, int wc, int fr, int fq) const {
        const int row0 = RTOK + u.pm * 256 + wr * 64 + fr; const int pn = u.pn;
        const int mode = pn < 2 ? 1 : (pn < 8 ? 0 : (pn < 20 ? 2 : (pn < 32 ? 0 : 3)));
        const int col0 = pn * 256 + wc * 32 + 8 * fq;
#pragma unroll
        for (int ai = 0; ai < 2; ++ai)
#pragma unroll
            for (int m = 0; m < 4; ++m) { bf16* rowp = PJ + (size_t)(row0 + ai * 128 + m * 16) * NPJ + col0;
#pragma unroll
                for (int bj = 0; bj < 2; ++bj) { f32x4 v0 = acc[ai][bj][m][0], v1 = acc[ai][bj][m][1];
                    if (mode == 1) { v0 = v0 * 0.08838834764831845f; v1 = v1 * 0.08838834764831845f; }
                    else if (mode == 2) {
#pragma unroll
                        for (int j = 0; j < 4; ++j) { v0[j] = siluf_(v0[j]); v1[j] = siluf_(v1[j]); } }
                    else if (mode == 3) {
#pragma unroll
                        for (int j = 0; j < 4; ++j) { v0[j] = sigmoidf_(v0[j]); v1[j] = sigmoidf_(v1[j]); } }
                    v4u w; w.x = cvt_pk_bf16(v0[0], v0[1]); w.y = cvt_pk_bf16(v0[2], v0[3]); w.z = cvt_pk_bf16(v1[0], v1[1]); w.w = cvt_pk_bf16(v1[2], v1[3]);
                    *(GAS v4u*)(rowp + bj * 128) = w; } }
    }
};
struct EpiAny {
    static constexpr bool PERM = true, AFTER_DRAIN = false;
    int mode;
    EpiProj P; bf16* O; const bf16* PJ; const bf16* T; int gcol; const float* X; float* OF; int b; int ldc;
    __device__ __forceinline__ void operator()(const f32x4 (&acc)[2][2][4][2], const Unit& u, int wr, int wc, int fr, int fq) const {
        if (mode == 0) { P(acc, u, wr, wc, fr, fq); return; }
        const int row0 = u.pm * 256 + wr * 64 + fr; const int col0 = u.pn * 256 + wc * 32 + 8 * fq;
        if (mode == 1) {
#pragma unroll
            for (int ai = 0; ai < 2; ++ai)
#pragma unroll
                for (int m = 0; m < 4; ++m) { const size_t r = (size_t)(row0 + ai * 128 + m * 16);
                    v4u gq[2], tq[2];
#pragma unroll
                    for (int bj = 0; bj < 2; ++bj) { gq[bj] = *(const GAS v4u*)(PJ + r * NPJ + gcol + col0 + bj * 128); tq[bj] = T ? *(const GAS v4u*)(T + r * 1024 + col0 + bj * 128) : (v4u){0u, 0u, 0u, 0u}; }
#pragma unroll
                    for (int bj = 0; bj < 2; ++bj) { const int c = col0 + bj * 128;
                        const v4u g = gq[bj];
                        f32x4 v0 = acc[ai][bj][m][0], v1 = acc[ai][bj][m][1];
                        v0[0] *= bflo(g.x); v0[1] *= bfhi(g.x); v0[2] *= bflo(g.y); v0[3] *= bfhi(g.y); v1[0] *= bflo(g.z); v1[1] *= bfhi(g.z); v1[2] *= bflo(g.w); v1[3] *= bfhi(g.w);
                        { const v4u t = tq[bj];
                            v0[0] += bflo(t.x); v0[1] += bfhi(t.x); v0[2] += bflo(t.y); v0[3] += bfhi(t.y); v1[0] += bflo(t.z); v1[1] += bfhi(t.z); v1[2] += bflo(t.w); v1[3] += bfhi(t.w); }
                        v4u w; w.x = cvt_pk_bf16(v0[0], v0[1]); w.y = cvt_pk_bf16(v0[2], v0[3]); w.z = cvt_pk_bf16(v1[0], v1[1]); w.w = cvt_pk_bf16(v1[2], v1[3]);
                        *(GAS v4u*)(O + r * 1024 + c) = w; } }
        } else if (mode == 2) {
#pragma unroll
            for (int ai = 0; ai < 2; ++ai)
#pragma unroll
                for (int m = 0; m < 4; ++m) { const int r = row0 + ai * 128 + m * 16;
                    if (r >= RTOK && r < REND) { const size_t o = ((size_t)b * SEQ + (r - RTOK)) * D + col0;
                        f32x4 xv[2][2];
#pragma unroll
                        for (int bj = 0; bj < 2; ++bj)
#pragma unroll
                            for (int n = 0; n < 2; ++n) xv[bj][n] = *(const GAS f32x4*)(X + o + bj * 128 + n * 4);
#pragma unroll
                        for (int bj = 0; bj < 2; ++bj)
#pragma unroll
                            for (int n = 0; n < 2; ++n) *(GAS f32x4*)(OF + o + bj * 128 + n * 4) = acc[ai][bj][m][n] + xv[bj][n]; } }
        } else {
#pragma unroll
            for (int ai = 0; ai < 2; ++ai)
#pragma unroll
                for (int m = 0; m < 4; ++m) { float* rowp = OF + (size_t)(row0 + ai * 128 + m * 16) * ldc + col0;
#pragma unroll
                    for (int bj = 0; bj < 2; ++bj)
#pragma unroll
                        for (int n = 0; n < 2; ++n) *(GAS f32x4*)(rowp + bj * 128 + n * 4) = acc[ai][bj][m][n]; }
        }
    }
};

struct MapIdent { __device__ __forceinline__ int operator()(int n) const { return n; } };
struct MapW1 { __device__ __forceinline__ int operator()(int n) const {
    if (n < 3072) return n;
    if (n < 8192) return n + 16;
    if (n < 10240) return n + 48;
    if (n < 10256) return n - 10240 + 3072;
    if (n < 10288) return n - 10256 + 8208;
    return -1; } };
template <class Map>
__device__ __forceinline__ void transpose_item(const float* W, int K, int NS, int N, bf16* WT, LAS float* scr, int item, int lane, const Map& map) {
    const int nblk = N / 32, kb = item / nblk, nb = item % nblk, k0 = 64 * kb, n0 = 32 * nb;
    const int sc = map(n0 + (lane & 31));
#pragma unroll
    for (int i0 = 0; i0 < 32; i0 += 16) { float tv[16];
#pragma unroll
        for (int i = 0; i < 16; ++i) { const int kk = 2 * (i0 + i) + (lane >> 5); tv[i] = sc >= 0 ? *(const GAS float*)(W + (size_t)(k0 + kk) * NS + sc) : 0.f; }
#pragma unroll
        for (int i = 0; i < 16; ++i) { const int kk = 2 * (i0 + i) + (lane >> 5); scr[kk * 33 + (lane & 31)] = tv[i]; } }
    LDS_WAIT(); asm volatile("" ::: "memory");
    const int c = lane & 7;
#pragma unroll
    for (int j = 0; j < 4; ++j) { const int n = (lane >> 3) + 8 * j; const LAS float* s = scr + (8 * c) * 33 + n;
        v4u o; o.x = pk2(s[0 * 33], s[1 * 33]); o.y = pk2(s[2 * 33], s[3 * 33]); o.z = pk2(s[4 * 33], s[5 * 33]); o.w = pk2(s[6 * 33], s[7 * 33]);
        *(GAS v4u*)(WT + (size_t)(n0 + n) * K + k0 + 8 * c) = o; }
    LDS_WAIT(); asm volatile("" ::: "memory");
}
__device__ __forceinline__ void norm_row_bf16(const float* src, const float* w, bf16* dst, int lane) {
    v2u* o8 = (v2u*)dst + lane;
    if (src == nullptr) {
#pragma unroll
        for (int j = 0; j < 4; ++j) o8[64 * j] = (v2u){0u, 0u};
        return; }
    const f32x4* xr = (const f32x4*)src + lane; const f32x4* wr_ = (const f32x4*)w + lane;
    f32x4 v[4]; float s = 0.f;
#pragma unroll
    for (int j = 0; j < 4; ++j) { v[j] = xr[64 * j]; s += (v[j].x * v[j].x + v[j].y * v[j].y) + (v[j].z * v[j].z + v[j].w * v[j].w); }
    const float rs = rsqrtf(wave_sum(s) * (1.f / D) + RMS_EPS);
#pragma unroll
    for (int j = 0; j < 4; ++j) { const f32x4 ww = wr_[64 * j]; v2u o; o.x = pk2(v[j].x * rs * ww.x, v[j].y * rs * ww.y); o.y = pk2(v[j].z * rs * ww.z, v[j].w * rs * ww.w); o8[64 * j] = o; }
}
__device__ __forceinline__ float wave_sum63(float v) {
    v += __builtin_bit_cast(float, __builtin_amdgcn_mov_dpp(__builtin_bit_cast(int, v), 0xB1, 0xf, 0xf, true));
    v += __builtin_bit_cast(float, __builtin_amdgcn_mov_dpp(__builtin_bit_cast(int, v), 0x4E, 0xf, 0xf, true));
    v += __builtin_bit_cast(float, __builtin_amdgcn_mov_dpp(__builtin_bit_cast(int, v), 0x141, 0xf, 0xf, true));
    v += __builtin_bit_cast(float, __builtin_amdgcn_mov_dpp(__builtin_bit_cast(int, v), 0x128, 0xf, 0xf, true));
    v += __builtin_bit_cast(float, __builtin_amdgcn_update_dpp(0, __builtin_bit_cast(int, v), 0x142, 0xa, 0xf, false));
    v += __builtin_bit_cast(float, __builtin_amdgcn_update_dpp(0, __builtin_bit_cast(int, v), 0x143, 0xc, 0xf, false));
    return v;
}
__device__ __forceinline__ void hn_token_rows2(const Ctx& C, int b, int s0, int s1) {
    const int lane = C.lane;
    const f32x4* x0 = (const f32x4*)(C.in[I_X] + ((size_t)b * SEQ + s0) * D) + lane; const f32x4* x1 = (const f32x4*)(C.in[I_X] + ((size_t)b * SEQ + s1) * D) + lane;
    const f32x4* wr_ = (const f32x4*)C.in[I_LNMIX] + lane;
    f32x4 v[4], u[4]; float q0 = 0.f, q1 = 0.f;
#pragma unroll
    for (int j = 0; j < 4; ++j) { v[j] = x0[64 * j]; u[j] = x1[64 * j]; }
#pragma unroll
    for (int j = 0; j < 4; ++j) { q0 += (v[j].x * v[j].x + v[j].y * v[j].y) + (v[j].z * v[j].z + v[j].w * v[j].w); q1 += (u[j].x * u[j].x + u[j].y * u[j].y) + (u[j].z * u[j].z + u[j].w * u[j].w); }
    const float r0 = rsqrtf(wave_sum(q0) * (1.f / D) + RMS_EPS), r1 = rsqrtf(wave_sum(q1) * (1.f / D) + RMS_EPS);
    v2u* o0 = (v2u*)((bf16*)(C.ws + WS_HN) + (size_t)s0 * D) + lane; v2u* o1 = (v2u*)((bf16*)(C.ws + WS_HN) + (size_t)s1 * D) + lane;
#pragma unroll
    for (int j = 0; j < 4; ++j) { const f32x4 ww = wr_[64 * j]; const f32x4 a = v[j] * r0 * ww, bq = u[j] * r1 * ww;
        o0[64 * j] = (v2u){pk2(a.x, a.y), pk2(a.z, a.w)}; o1[64 * j] = (v2u){pk2(bq.x, bq.y), pk2(bq.z, bq.w)}; }
}
__device__ __forceinline__ void hn_batch(const Ctx& C, int b, int first_blk) {
    if (C.bid < first_blk) return;
    const int gw = (C.bid - first_blk) * NWAVES + C.wave, NGW = (C.G - first_blk) * NWAVES;
    for (int s = gw; s < SEQ / 2; s += NGW) hn_token_rows2(C, b, s, s + SEQ / 2);
}
__device__ __forceinline__ void meta_proj(const Ctx& C) {
    const bf16* HNM = (const bf16*)(C.ws + WS_HNM); const bf16* W1T = (const bf16*)(C.ws + WS_W1T);
    bf16* PJ = (bf16*)(C.ws + WS_PJ); float* TL = (float*)(C.ws + WS_TL);
    const int gw = C.bid * NWAVES + C.wave, NGW = C.G * NWAVES, fr = C.lane & 15, fq = C.lane >> 4;
    for (int nt = gw; nt < 643; nt += NGW) {
        f32x4 acc = {0.f, 0.f, 0.f, 0.f};
#pragma unroll 8
        for (int ks = 0; ks < 32; ++ks) acc = mma16(*(const GAS bf16x8*)(HNM + fr * D + 32 * ks + 8 * fq), *(const GAS bf16x8*)(W1T + (size_t)(16 * nt + fr) * D + 32 * ks + 8 * fq), acc);
        const int n = 16 * nt + 4 * fq;
        if (n >= NPJ) { if (n < NPJ + 48) *(GAS f32x4*)(TL + (size_t)(RFRONT + fr) * 48 + (n - NPJ)) = acc; continue; }
        if (n < 512) acc = acc * 0.08838834764831845f;
        else if ((n >= PJ_GO && n < PJ_XBC)) { acc[0] = siluf_(acc[0]); acc[1] = siluf_(acc[1]); acc[2] = siluf_(acc[2]); acc[3] = siluf_(acc[3]); }
        else if (n >= PJ_GA) { acc[0] = sigmoidf_(acc[0]); acc[1] = sigmoidf_(acc[1]); acc[2] = sigmoidf_(acc[2]); acc[3] = sigmoidf_(acc[3]); }
        *(GAS v2u*)(PJ + (size_t)(RFRONT + fr) * NPJ + n) = (v2u){pk2(acc[0], acc[1]), pk2(acc[2], acc[3])};
    }
}
__device__ __forceinline__ void tail_proj(const Ctx& C) {
    int tid_ = C.tid; asm volatile("" : "+v"(tid_));
    const int lane_ = tid_ & 63, wave_ = __builtin_amdgcn_readfirstlane(tid_ >> 6), fr = lane_ & 15, fq = lane_ >> 4;
    const bf16* HN = (const bf16*)(C.ws + WS_HN); const bf16* WT = (const bf16*)(C.ws + WS_W1T) + (size_t)NPJ * D; float* TL = (float*)(C.ws + WS_TL);
    constexpr int PW = 2064;
    ldsp WL = C.lds; LAS f32x4* PR = (LAS f32x4*)(C.lds + 48 * PW);
    { v4u ww[12];
#pragma unroll
      for (int i = 0; i < 12; ++i) { const int e = tid_ + NT * i, row = e >> 7, ch = e & 127; ww[i] = *(const GAS v4u*)(WT + (size_t)row * D + 8 * ch); }
#pragma unroll
      for (int i = 0; i < 12; ++i) { const int e = tid_ + NT * i, row = e >> 7, ch = e & 127; *(LAS v4u*)(WL + row * PW + ch * 16) = ww[i]; } }
    const int rsel = wave_ & 1, kq = wave_ >> 1;
    for (int rp = C.bid; rp < SEQ / 32; rp += C.G) {
        const int rt = 2 * rp + rsel;
        bf16x8 a[8];
#pragma unroll
        for (int i = 0; i < 8; ++i) a[i] = *(const GAS bf16x8*)(HN + (size_t)(16 * rt + fr) * D + 32 * (8 * kq + i) + 8 * fq);
        __syncthreads();
        f32x4 acc[3] = {{0.f, 0.f, 0.f, 0.f}, {0.f, 0.f, 0.f, 0.f}, {0.f, 0.f, 0.f, 0.f}};
#pragma unroll
        for (int i = 0; i < 8; ++i)
#pragma unroll
            for (int n = 0; n < 3; ++n) acc[n] = mma16(a[i], lds_frag(WL + (16 * n + fr) * PW + (32 * (8 * kq + i) + 8 * fq) * 2), acc[n]);
#pragma unroll
        for (int n = 0; n < 3; ++n) PR[(wave_ * 3 + n) * 64 + lane_] = acc[n];
        __syncthreads();
        if (wave_ < 2) {
#pragma unroll
            for (int n = 0; n < 3; ++n) { f32x4 s = PR[((0 * 2 + wave_) * 3 + n) * 64 + lane_] + PR[((1 * 2 + wave_) * 3 + n) * 64 + lane_] + PR[((2 * 2 + wave_) * 3 + n) * 64 + lane_] + PR[((3 * 2 + wave_) * 3 + n) * 64 + lane_];
                *(GAS f32x4*)(TL + (size_t)(RTOK + 16 * (2 * rp + wave_) + fr) * 48 + 16 * n + 4 * fq) = s; }
        }
    }
    __syncthreads();
}
__device__ __forceinline__ void p0b_prologue(const Ctx& C) {
    const int gw = C.bid * NWAVES + C.wave;
    if (gw < NMETA) norm_row_bf16(C.in[I_META] + (size_t)gw * D, C.in[I_LNMIX], (bf16*)(C.ws + WS_HNM) + (size_t)gw * D, C.lane);
    { v4u* z = (v4u*)(C.ws + WS_PJ); const size_t n = (size_t)RFRONT * NPJ * 2 / 16; for (size_t i = (size_t)C.bid * NT + C.tid; i < n; i += (size_t)C.G * NT) z[i] = (v4u){0u, 0u, 0u, 0u}; }
    { v4u* z = (v4u*)(C.ws + WS_TL); const size_t n = (size_t)RFRONT * 48 * 4 / 16; for (size_t i = (size_t)C.bid * NT + C.tid; i < n; i += (size_t)C.G * NT) z[i] = (v4u){0u, 0u, 0u, 0u}; }
    hn_batch(C, 0, 0);
}
__device__ __forceinline__ void weff_unit(const Ctx& C, int unit) {
    int tid_ = C.tid; asm volatile("" : "+v"(tid_));
    const int lane_ = tid_ & 63, wave_ = __builtin_amdgcn_readfirstlane(tid_ >> 6); (void)lane_; (void)wave_;
    const int blk = unit >> 4, d0 = (unit & 15) * 64;
    LAS float* KT = (LAS float*)C.lds;
    LAS float* WQ = (LAS float*)(C.lds + 128 * 132 * 4);
    const float* keys = C.in[I_KEYS] + (size_t)blk * 128 * 128; const float* wq = C.in[I_WQ];
    { f32x4 kv_[8];
#pragma unroll
      for (int i = 0; i < 8; ++i) { const int e = tid_ + NT * i, key = e >> 5, j4 = e & 31; kv_[i] = *(const GAS f32x4*)(keys + key * 128 + 4 * j4); }
#pragma unroll
      for (int i = 0; i < 8; ++i) { const int e = tid_ + NT * i, key = e >> 5, j4 = e & 31; *(LAS f32x4*)(KT + key * 132 + 4 * j4) = kv_[i]; } }
    { f32x4 wv_[4];
#pragma unroll
      for (int i = 0; i < 4; ++i) { const int e = tid_ + NT * i, dd = e >> 5, j4 = e & 31; wv_[i] = *(const GAS f32x4*)(wq + (size_t)(d0 + dd) * 2048 + blk * 128 + 4 * j4); }
#pragma unroll
      for (int i = 0; i < 4; ++i) { const int e = tid_ + NT * i, dd = e >> 5, j4 = e & 31; *(LAS f32x4*)(WQ + dd * 128 + 4 * j4) = wv_[i]; } }
    __syncthreads();
    const int key = tid_ & 127, dg = tid_ >> 7;
    float acc[16];
#pragma unroll
    for (int i = 0; i < 16; ++i) acc[i] = 0.f;
    for (int j4 = 0; j4 < 32; ++j4) {
        const f32x4 kv = *(const LAS f32x4*)(KT + key * 132 + 4 * j4);
#pragma unroll
        for (int i = 0; i < 16; ++i) { const f32x4 wv = *(const LAS f32x4*)(WQ + (dg * 16 + i) * 128 + 4 * j4); acc[i] += kv.x * wv.x + kv.y * wv.y + kv.z * wv.z + kv.w * wv.w; }
    }
    bf16* WET = (bf16*)(C.ws + WS_WET) + (size_t)(blk * 128 + key) * D + d0 + dg * 16;
    v4u o0, o1; o0.x = pk2(acc[0], acc[1]); o0.y = pk2(acc[2], acc[3]); o0.z = pk2(acc[4], acc[5]); o0.w = pk2(acc[6], acc[7]);
    o1.x = pk2(acc[8], acc[9]); o1.y = pk2(acc[10], acc[11]); o1.z = pk2(acc[12], acc[13]); o1.w = pk2(acc[14], acc[15]);
    *(v4u*)WET = o0; *(GAS v4u*)(WET + 8) = o1;
    __syncthreads();
}
__device__ __forceinline__ void p0_prologue(const Ctx& C) {
    LAS float* scr = (LAS float*)(C.lds + C.wave * 16384);
    const int gw = C.bid * NWAVES + C.wave, NGW = C.G * NWAVES;
    constexpr int I_1 = (D / 64) * (N1 / 32), I_A = (1024 / 64) * (1024 / 32), I_B = (2048 / 64) * (1024 / 32), I_O = I_A;
    constexpr int NITEMS = I_1 + I_A + I_B + I_O;
    for (int it = gw; it < NITEMS; it += NGW) {
        int r = it;
        if (r < I_1) { transpose_item(C.in[I_WIN], 1024, 10288, N1, (bf16*)(C.ws + WS_W1T), scr, r, C.lane, MapW1()); continue; } r -= I_1;
        if (r < I_A) { transpose_item(C.in[I_WUG], 1024, 1024, 1024, (bf16*)(C.ws + WS_WAT), scr, r, C.lane, MapIdent()); continue; } r -= I_A;
        if (r < I_B) { transpose_item(C.in[I_WUS], 2048, 1024, 1024, (bf16*)(C.ws + WS_WBT), scr, r, C.lane, MapIdent()); continue; } r -= I_B;
        transpose_item(C.in[I_WOUT], 1024, 1024, 1024, (bf16*)(C.ws + WS_WOT), scr, r, C.lane, MapIdent());
    }
    __syncthreads();
    for (int u = C.bid; u < 256; u += C.G) weff_unit(C, u);
}

__device__ __forceinline__ float softplusf_(float x) { return fmaxf(x, 0.f) + log1pf(__expf(-fabsf(x))); }
__device__ __forceinline__ void conv_batch(const Ctx& C) {
    const bf16* PJ = (const bf16*)(C.ws + WS_PJ); bf16* XC = (bf16*)(C.ws + WS_XC);
    const float* cw = C.in[I_CONVW]; const float* cb = C.in[I_CONVB];
    constexpr int SL = 25, NSEG = (REND + SL - 1) / SL, NITEM = 384 * NSEG;
    for (int id = C.bid * NT + C.tid; id < NITEM; id += C.G * NT) {
        const int ch = id % 384, seg = id / 384, col = 8 * ch, rb = SL * seg;
        v4u xr[SL + 3];
#pragma unroll
        for (int t = 0; t < SL + 3; ++t) { const int r = rb - 3 + t; xr[t] = (r >= 0 && r < REND) ? *(const GAS v4u*)(PJ + (size_t)r * NPJ + PJ_XBC + col) : (v4u){0u, 0u, 0u, 0u}; }
        f32x4 w[4][2], bb[2];
#pragma unroll
        for (int i = 0; i < 4; ++i) { w[i][0] = *(const GAS f32x4*)(cw + i * 3072 + col); w[i][1] = *(const GAS f32x4*)(cw + i * 3072 + col + 4); }
        bb[0] = *(const GAS f32x4*)(cb + col); bb[1] = *(const GAS f32x4*)(cb + col + 4);
#pragma unroll
        for (int t = 0; t < SL; ++t) {
            f32x4 o0 = bb[0], o1 = bb[1];
#pragma unroll
            for (int i = 0; i < 4; ++i) { const v4u x = xr[t + i];
                o0 += w[i][0] * (f32x4){bflo(x.x), bfhi(x.x), bflo(x.y), bfhi(x.y)}; o1 += w[i][1] * (f32x4){bflo(x.z), bfhi(x.z), bflo(x.w), bfhi(x.w)}; }
            v4u o = {pk2(siluf_(o0.x), siluf_(o0.y)), pk2(siluf_(o0.z), siluf_(o0.w)), pk2(siluf_(o1.x), siluf_(o1.y)), pk2(siluf_(o1.z), siluf_(o1.w))};
            if (rb + t < RFRONT) o = (v4u){0u, 0u, 0u, 0u};
            if (rb + t < REND) *(GAS v4u*)(XC + (size_t)(rb + t) * 3072 + col) = o;
        }
    }
}
__device__ __forceinline__ void phaseC_unit(const Ctx& C, int c, int k) {
    int tid_ = C.tid; asm volatile("" : "+v"(tid_));
    const int lane_ = tid_ & 63, wave_ = __builtin_amdgcn_readfirstlane(tid_ >> 6); (void)lane_; (void)wave_;
    const bf16* PJ = (const bf16*)(C.ws + WS_PJ); const float* TL = (const float*)(C.ws + WS_TL);
    bf16* XC = (bf16*)(C.ws + WS_XC); float* GG = (float*)(C.ws + WS_GG); float* DT = (float*)(C.ws + WS_DT); float* AC = (float*)(C.ws + WS_AC);
    const int r0 = 64 * c;
    if (k < 6) {
        const float* cw = C.in[I_CONVW]; const float* cb = C.in[I_CONVB];
        const int col = 512 * k + 2 * (tid_ & 255), rb = r0 + 32 * (tid_ >> 8);
        const f32x2 w0 = *(const GAS f32x2*)(cw + col), w1 = *(const GAS f32x2*)(cw + 3072 + col), w2 = *(const GAS f32x2*)(cw + 2 * 3072 + col), w3 = *(const GAS f32x2*)(cw + 3 * 3072 + col), bb = *(const GAS f32x2*)(cb + col);
        unsigned xr[35];
#pragma unroll
        for (int t = 0; t < 35; ++t) { const int r = rb - 3 + t; xr[t] = (r >= 0) ? *(const GAS unsigned*)(PJ + (size_t)r * NPJ + PJ_XBC + col) : 0u; }
#pragma unroll
        for (int t = 0; t < 32; ++t) {
            const int r = rb + t;
            const f32x2 xm3 = {bflo(xr[t]), bfhi(xr[t])}, xm2 = {bflo(xr[t + 1]), bfhi(xr[t + 1])}, xm1 = {bflo(xr[t + 2]), bfhi(xr[t + 2])}, x0 = {bflo(xr[t + 3]), bfhi(xr[t + 3])};
            f32x2 o = bb + w0 * xm3 + w1 * xm2 + w2 * xm1 + w3 * x0;
            o.x = siluf_(o.x); o.y = siluf_(o.y);
            if (r < RFRONT) { o.x = 0.f; o.y = 0.f; }
            *(GAS unsigned*)(XC + (size_t)r * 3072 + col) = pk2(o.x, o.y);
        }
        return;
    }
    if (k < 10) {
        const int col = 128 * (k - 6) + (tid_ & 127), rq = tid_ >> 7; const float* w2p = C.in[I_WG2]; float w2[16];
        LAS float* PS = (LAS float*)C.lds;
#pragma unroll
        for (int j = 0; j < 16; ++j) w2[j] = w2p[j * 512 + col];
        const float bg = C.in[I_BG][col]; float G = 0.f; float gv[16];
#pragma unroll
        for (int t = 0; t < 16; ++t) {
            const int r = r0 + 16 * rq + t; const float* gl = TL + (size_t)r * 48;
            float z = bg;
#pragma unroll
            for (int j4 = 0; j4 < 4; ++j4) { const f32x4 g = *(const GAS f32x4*)(gl + 4 * j4); z += g.x * w2[4 * j4] + g.y * w2[4 * j4 + 1] + g.z * w2[4 * j4 + 2] + g.w * w2[4 * j4 + 3]; }
            float ls = fminf(z, 0.f) - __logf(1.f + __expf(-fabsf(z)));
            if (r < RFRONT) ls = 0.f;
            G += ls * (1.f / 16.f); gv[t] = G;
        }
        PS[rq * 128 + (tid_ & 127)] = G;
        __syncthreads();
        float base = 0.f;
#pragma unroll
        for (int q = 0; q < 3; ++q) base += (q < rq) ? PS[q * 128 + (tid_ & 127)] : 0.f;
#pragma unroll
        for (int t = 0; t < 16; ++t) GG[(size_t)(r0 + 16 * rq + t) * 512 + col] = gv[t] + base;
        __syncthreads();
        return;
    }
    {
        const int hd = tid_ & 31, rg = tid_ >> 5; const float bias = C.in[I_DTB][hd], A = -__expf(C.in[I_ALOG][hd]);
        LAS float* PS = (LAS float*)C.lds;
        float dtv[4], av[4], acum = 0.f;
#pragma unroll
        for (int t = 0; t < 4; ++t) {
            const int r = r0 + 4 * rg + t; const float x = TL[(size_t)r * 48 + 16 + hd] + bias;
            float dt = fmaxf(x, 0.f) + __logf(1.f + __expf(-fabsf(x)));
            if (r < RFRONT) dt = 0.f;
            acum += A * dt; dtv[t] = dt; av[t] = acum;
        }
        PS[rg * 32 + hd] = acum;
        __syncthreads();
        float base = 0.f;
#pragma unroll
        for (int q = 0; q < 15; ++q) base += (q < rg) ? PS[q * 32 + hd] : 0.f;
#pragma unroll
        for (int t = 0; t < 4; ++t) { const size_t r = (size_t)(r0 + 4 * rg + t); DT[r * 32 + hd] = dtv[t]; AC[r * 32 + hd] = av[t] + base; }
        __syncthreads();
    }
}

constexpr int P136 = 272, P264 = 528, P520 = 1040, P72 = 144;
__device__ __forceinline__ void gla_pass1_unit(const Ctx& C, int c, int h) {
    int tid_ = C.tid; asm volatile("" : "+v"(tid_));
    const int lane_ = tid_ & 63, wave_ = __builtin_amdgcn_readfirstlane(tid_ >> 6); (void)lane_; (void)wave_;
    const bf16* PJ = (const bf16*)(C.ws + WS_PJ); const float* GG = (const float*)(C.ws + WS_GG); bf16* LG = (bf16*)(C.ws + WS_LG);
    ldsp KD = C.lds, VT = C.lds + 64 * P136;
    const int r0 = 64 * c;
    v4u ka_[2], vv[4]; f32x4 a0_[2], a1_[2], l0_[2], l1_[2];
#pragma unroll
    for (int i = 0; i < 2; ++i) { const int e = tid_ + NT * i, s = e >> 4, k0 = (e & 15) * 8; const size_t r = (size_t)(r0 + s);
        ka_[i] = *(const GAS v4u*)(PJ + r * NPJ + PJ_K + 128 * h + k0);
        const float* g = GG + r * 512 + 128 * h + k0; const float* gl = GG + (size_t)(r0 + 63) * 512 + 128 * h + k0;
        a0_[i] = *(const GAS f32x4*)g; a1_[i] = *(const GAS f32x4*)(g + 4); l0_[i] = *(const GAS f32x4*)gl; l1_[i] = *(const GAS f32x4*)(gl + 4); }
#pragma unroll
    for (int i = 0; i < 4; ++i) { const int e = tid_ + NT * i, s = e >> 5, v0 = (e & 31) * 8; vv[i] = *(const GAS v4u*)(PJ + (size_t)(r0 + s) * NPJ + PJ_V + 256 * h + v0); }
#pragma unroll
    for (int i = 0; i < 2; ++i) {
        const int e = tid_ + NT * i, s = e >> 4, k0 = (e & 15) * 8;
        const v4u ka = ka_[i]; const f32x4 a0 = a0_[i], a1 = a1_[i], l0 = l0_[i], l1 = l1_[i];
        v4u o;
        o.x = pk2(bflo(ka.x) * __expf(l0.x - a0.x), bfhi(ka.x) * __expf(l0.y - a0.y)); o.y = pk2(bflo(ka.y) * __expf(l0.z - a0.z), bfhi(ka.y) * __expf(l0.w - a0.w));
        o.z = pk2(bflo(ka.z) * __expf(l1.x - a1.x), bfhi(ka.z) * __expf(l1.y - a1.y)); o.w = pk2(bflo(ka.w) * __expf(l1.z - a1.z), bfhi(ka.w) * __expf(l1.w - a1.w));
        *(LAS v4u*)(KD + s * P136 + k0 * 2) = o;
    }
#pragma unroll
    for (int i = 0; i < 4; ++i) { const int e = tid_ + NT * i, s = e >> 5, v0 = (e & 31) * 8; *(LAS v4u*)(VT + s * P264 + v0 * 2) = vv[i]; }
    __syncthreads();
    const int fr = lane_ & 15, fq = lane_ >> 4, w = wave_;
    f32x4 acc[2][8];
#pragma unroll
    for (int mi = 0; mi < 2; ++mi)
#pragma unroll
        for (int nt = 0; nt < 8; ++nt) acc[mi][nt] = (f32x4){0.f, 0.f, 0.f, 0.f};
#pragma unroll
    for (int ks = 0; ks < 2; ++ks) {
        bf16x8 af[2];
#pragma unroll
        for (int mi = 0; mi < 2; ++mi) af[mi] = tr_frag(VT, P264, 32 * ks, 32 * w + 16 * mi, fr, fq);
#pragma unroll
        for (int nt = 0; nt < 8; ++nt) { const bf16x8 bfm = tr_frag(KD, P136, 32 * ks, 16 * nt, fr, fq);
#pragma unroll
            for (int mi = 0; mi < 2; ++mi) acc[mi][nt] = mma16(af[mi], bfm, acc[mi][nt]); }
    }
    bf16* Lb = LG + ((size_t)(c * 4 + h) * 256) * 128;
#pragma unroll
    for (int mi = 0; mi < 2; ++mi)
#pragma unroll
        for (int nt = 0; nt < 8; ++nt) { const int v = 32 * w + 16 * mi + fr, k = 16 * nt + 4 * fq; const f32x4 a = acc[mi][nt];
            *(GAS v2u*)(Lb + (size_t)v * 128 + k) = (v2u){cvt_pk_bf16(a[0], a[1]), cvt_pk_bf16(a[2], a[3])}; }
    __syncthreads();
}
__device__ __forceinline__ void ssd_pass1_unit(const Ctx& C, int c, int g) {
    int tid_ = C.tid; asm volatile("" : "+v"(tid_));
    const int lane_ = tid_ & 63, wave_ = __builtin_amdgcn_readfirstlane(tid_ >> 6); (void)lane_; (void)wave_;
    const bf16* XC = (const bf16*)(C.ws + WS_XC); const float* DT = (const float*)(C.ws + WS_DT); const float* AC = (const float*)(C.ws + WS_AC); bf16* LS = (bf16*)(C.ws + WS_LS);
    ldsp XW = C.lds, BM = C.lds + 64 * P520;
    const int r0 = 64 * c;
    { const int ch = tid_ & 63, hd = 8 * g + (ch >> 3); const float al = AC[(size_t)(r0 + 63) * 32 + hd];
      v4u xx[8], bb[2]; float dd[8], aa[8];
#pragma unroll
      for (int i = 0; i < 8; ++i) { const size_t r = (size_t)(r0 + (tid_ >> 6) + 8 * i); xx[i] = *(const GAS v4u*)(XC + r * 3072 + 512 * g + 8 * ch); dd[i] = DT[r * 32 + hd]; aa[i] = AC[r * 32 + hd]; }
#pragma unroll
      for (int i = 0; i < 2; ++i) { const int e = tid_ + NT * i, s = e >> 4, c2 = e & 15; bb[i] = *(const GAS v4u*)(XC + (size_t)(r0 + s) * 3072 + 2048 + 128 * g + 8 * c2); }
#pragma unroll
      for (int i = 0; i < 2; ++i) { const int e = tid_ + NT * i, s = e >> 4, c2 = e & 15; *(LAS v4u*)(BM + s * P136 + c2 * 16) = bb[i]; }
#pragma unroll
      for (int i = 0; i < 8; ++i) { const int s = (tid_ >> 6) + 8 * i;
        const float sc = dd[i] * __expf(al - aa[i]); const v4u x = xx[i]; v4u o;
        o.x = pk2(bflo(x.x) * sc, bfhi(x.x) * sc); o.y = pk2(bflo(x.y) * sc, bfhi(x.y) * sc); o.z = pk2(bflo(x.z) * sc, bfhi(x.z) * sc); o.w = pk2(bflo(x.w) * sc, bfhi(x.w) * sc);
        *(LAS v4u*)(XW + s * P520 + ch * 16) = o; } }
    __syncthreads();
    const int fr = lane_ & 15, fq = lane_ >> 4, w = wave_;
    bf16* Lb = LS + ((size_t)(c * 32 + 8 * g + w) * 64) * 128;
#pragma unroll
    for (int nh = 0; nh < 2; ++nh) {
        f32x4 acc[4][4];
#pragma unroll
        for (int mi = 0; mi < 4; ++mi)
#pragma unroll
            for (int nt = 0; nt < 4; ++nt) acc[mi][nt] = (f32x4){0.f, 0.f, 0.f, 0.f};
#pragma unroll
        for (int ks = 0; ks < 2; ++ks) {
            bf16x8 af[4];
#pragma unroll
            for (int mi = 0; mi < 4; ++mi) af[mi] = tr_frag(XW, P520, 32 * ks, 64 * w + 16 * mi, fr, fq);
#pragma unroll
            for (int nt = 0; nt < 4; ++nt) { const bf16x8 bfm = tr_frag(BM, P136, 32 * ks, 64 * nh + 16 * nt, fr, fq);
#pragma unroll
                for (int mi = 0; mi < 4; ++mi) acc[mi][nt] = mma16(af[mi], bfm, acc[mi][nt]); }
        }
#pragma unroll
        for (int mi = 0; mi < 4; ++mi)
#pragma unroll
            for (int nt = 0; nt < 4; ++nt) { const int p = 16 * mi + fr, n = 64 * nh + 16 * nt + 4 * fq; const f32x4 a = acc[mi][nt];
                *(GAS v2u*)(Lb + (size_t)p * 128 + n) = (v2u){cvt_pk_bf16(a[0], a[1]), cvt_pk_bf16(a[2], a[3])}; }
    }
    __syncthreads();
}

__device__ __forceinline__ void phaseE(const Ctx& C) {
    const float* GG = (const float*)(C.ws + WS_GG); const float* AC = (const float*)(C.ws + WS_AC);
    constexpr int NB = 8;
    for (int vb = C.bid; vb < 256; vb += C.G) {
        if (vb < 128) {
            const int e = vb * NT + C.tid, k2 = e & 63, v = (e >> 6) & 255, h = e >> 14;
            GAS unsigned* Lp = (GAS unsigned*)(C.ws + WS_LG) + ((size_t)h * 256 + v) * 64 + k2;
            const GAS float* dp = (const GAS float*)GG + 63 * 512 + 128 * h + 2 * k2;
            float s0 = 0.f, s1 = 0.f;
            unsigned l[2][NB]; f32x2 d[2][NB];
#pragma unroll
            for (int i = 0; i < NB; ++i) { l[0][i] = Lp[(size_t)i * (4 * 256 * 64)]; d[0][i] = *(const GAS f32x2*)(dp + (size_t)i * 64 * 512); }
#pragma unroll 1
            for (int c0 = 0; c0 < NCHUNK; c0 += 2 * NB) {
#pragma unroll
                for (int hb = 0; hb < 2; ++hb) {
                    const int cb = c0 + hb * NB, cn = cb + NB;
#pragma unroll
                    for (int i = 0; i < NB; ++i) if (cn + i < NCHUNK) { l[hb ^ 1][i] = Lp[(size_t)(cn + i) * (4 * 256 * 64)]; d[hb ^ 1][i] = *(const GAS f32x2*)(dp + (size_t)(cn + i) * 64 * 512); }
#pragma unroll
                    for (int i = 0; i < NB; ++i) if (cb + i < NCHUNK) {
                        Lp[(size_t)(cb + i) * (4 * 256 * 64)] = pk2(s0, s1);
                        s0 = s0 * __expf(d[hb][i].x) + bflo(l[hb][i]); s1 = s1 * __expf(d[hb][i].y) + bfhi(l[hb][i]); }
                }
            }
        } else {
            const int e = (vb - 128) * NT + C.tid, n4 = e & 31, p = (e >> 5) & 63, hd = e >> 11;
            GAS v2u* Lp = (GAS v2u*)(C.ws + WS_LS) + ((size_t)hd * 64 + p) * 32 + n4;
            const GAS float* dp = (const GAS float*)AC + 63 * 32 + hd;
            float s0 = 0.f, s1 = 0.f, s2 = 0.f, s3 = 0.f;
            v2u l[2][NB]; float d[2][NB];
#pragma unroll
            for (int i = 0; i < NB; ++i) { l[0][i] = Lp[(size_t)i * (32 * 64 * 32)]; d[0][i] = dp[(size_t)i * 64 * 32]; }
#pragma unroll 1
            for (int c0 = 0; c0 < NCHUNK; c0 += 2 * NB) {
#pragma unroll
                for (int hb = 0; hb < 2; ++hb) {
                    const int cb = c0 + hb * NB, cn = cb + NB;
#pragma unroll
                    for (int i = 0; i < NB; ++i) if (cn + i < NCHUNK) { l[hb ^ 1][i] = Lp[(size_t)(cn + i) * (32 * 64 * 32)]; d[hb ^ 1][i] = dp[(size_t)(cn + i) * 64 * 32]; }
#pragma unroll
                    for (int i = 0; i < NB; ++i) if (cb + i < NCHUNK) {
                        Lp[(size_t)(cb + i) * (32 * 64 * 32)] = (v2u){pk2(s0, s1), pk2(s2, s3)};
                        const float dd = __expf(d[hb][i]);
                        s0 = s0 * dd + bflo(l[hb][i].x); s1 = s1 * dd + bfhi(l[hb][i].x); s2 = s2 * dd + bflo(l[hb][i].y); s3 = s3 * dd + bfhi(l[hb][i].y); }
                }
            }
        }
    }
}

__device__ __forceinline__ void gla_pass3_unit(const Ctx& C, int c, int h) {
    int tid_ = C.tid; asm volatile("" : "+v"(tid_));
    const int lane_ = tid_ & 63, wave_ = __builtin_amdgcn_readfirstlane(tid_ >> 6); (void)lane_; (void)wave_;
    const bf16* PJ = (const bf16*)(C.ws + WS_PJ); const float* GG = (const float*)(C.ws + WS_GG); const bf16* LG = (const bf16*)(C.ws + WS_LG); bf16* OG = (bf16*)(C.ws + WS_OG);
    ldsp QE = C.lds, QN = QE + 64 * P136, KE = QN + 64 * P136, KN = KE + 64 * P136, VT = KN + 64 * P136, ATT = VT + 64 * P264;
    LAS float* RED = (LAS float*)(ATT + 64 * P72);
    const int r0 = 64 * c;
    bf16x8 sfr[4][2];
    { const bf16* Sb = LG + ((size_t)(c * 4 + h) * 256) * 128; const int fr_ = lane_ & 15, fq_ = lane_ >> 4;
#pragma unroll
      for (int ks = 0; ks < 4; ++ks)
#pragma unroll
        for (int nt = 0; nt < 2; ++nt) sfr[ks][nt] = *(const GAS bf16x8*)(Sb + (size_t)(32 * wave_ + 16 * nt + fr_) * 128 + 32 * ks + 8 * fq_); }
    v4u qa_[2], ka_[2]; f32x4 g0_[2], g1_[2];
#pragma unroll
    for (int i = 0; i < 2; ++i) { const int e = tid_ + NT * i, s = e >> 4, k0 = (e & 15) * 8; const size_t r = (size_t)(r0 + s);
        qa_[i] = *(const GAS v4u*)(PJ + r * NPJ + PJ_Q + 128 * h + k0); ka_[i] = *(const GAS v4u*)(PJ + r * NPJ + PJ_K + 128 * h + k0);
        const float* g = GG + r * 512 + 128 * h + k0; g0_[i] = *(const GAS f32x4*)g; g1_[i] = *(const GAS f32x4*)(g + 4); }
#pragma unroll
    for (int i = 0; i < 2; ++i) {
        const int e = tid_ + NT * i, s = e >> 4, k0 = (e & 15) * 8;
        const v4u qa = qa_[i], ka = ka_[i]; const f32x4 g0 = g0_[i], g1 = g1_[i];
        const float gv[8] = {g0.x, g0.y, g0.z, g0.w, g1.x, g1.y, g1.z, g1.w};
        const unsigned qs[4] = {qa.x, qa.y, qa.z, qa.w}, ksr[4] = {ka.x, ka.y, ka.z, ka.w};
        unsigned oqe[4], oqn[4], oke[4], okn[4];
#pragma unroll
        for (int j = 0; j < 4; ++j) { const float e0 = __expf(gv[2 * j]), e1 = __expf(gv[2 * j + 1]), n0 = __expf(-gv[2 * j]), n1 = __expf(-gv[2 * j + 1]);
            const float q0 = bflo(qs[j]), q1 = bfhi(qs[j]), kk0 = bflo(ksr[j]), kk1 = bfhi(ksr[j]);
            oqe[j] = pk2(q0 * e0, q1 * e1); oqn[j] = pk2(q0 * n0, q1 * n1); oke[j] = pk2(kk0 * e0, kk1 * e1); okn[j] = pk2(kk0 * n0, kk1 * n1); }
        const int off = s * P136 + k0 * 2;
        *(LAS v4u*)(QE + off) = (v4u){oqe[0], oqe[1], oqe[2], oqe[3]}; *(LAS v4u*)(QN + off) = (v4u){oqn[0], oqn[1], oqn[2], oqn[3]};
        *(LAS v4u*)(KE + off) = (v4u){oke[0], oke[1], oke[2], oke[3]}; *(LAS v4u*)(KN + off) = (v4u){okn[0], okn[1], okn[2], okn[3]};
    }
    { v4u vv[4];
#pragma unroll
      for (int i = 0; i < 4; ++i) { const int e = tid_ + NT * i, s = e >> 5, v0 = (e & 31) * 8; vv[i] = *(const GAS v4u*)(PJ + (size_t)(r0 + s) * NPJ + PJ_V + 256 * h + v0); }
#pragma unroll
      for (int i = 0; i < 4; ++i) { const int e = tid_ + NT * i, s = e >> 5, v0 = (e & 31) * 8; *(LAS v4u*)(VT + s * P264 + v0 * 2) = vv[i]; } }
    __syncthreads();
    const int fr = lane_ & 15, fq = lane_ >> 4, w = wave_;
#pragma unroll
    for (int ti = 0; ti < 2; ++ti) {
        const int id = 2 * w + ti, tm = id >> 2, sn = id & 3;
        f32x4 ac = {0.f, 0.f, 0.f, 0.f}, aa = {0.f, 0.f, 0.f, 0.f};
#pragma unroll
        for (int ks = 0; ks < 4; ++ks) {
            const int ao = (16 * tm + fr) * P136 + (32 * ks + 8 * fq) * 2, bo = (16 * sn + fr) * P136 + (32 * ks + 8 * fq) * 2;
            ac = mma16(lds_frag(QE + ao), lds_frag(KN + bo), ac);
            aa = mma16(lds_frag(QN + ao), lds_frag(KE + bo), aa);
        }
        const int t = 16 * tm + fr, s0 = 16 * sn + 4 * fq;
        float o[4];
#pragma unroll
        for (int j = 0; j < 4; ++j) o[j] = (s0 + j <= t) ? ac[j] : aa[j];
        *(LAS v2u*)(ATT + t * P72 + s0 * 2) = (v2u){pk2(o[0], o[1]), pk2(o[2], o[3])};
    }
    __syncthreads();
    f32x4 acc[4][2];
#pragma unroll
    for (int tm = 0; tm < 4; ++tm)
#pragma unroll
        for (int nt = 0; nt < 2; ++nt) acc[tm][nt] = (f32x4){0.f, 0.f, 0.f, 0.f};
#pragma unroll
    for (int ks = 0; ks < 4; ++ks) {
#pragma unroll
        for (int tm = 0; tm < 4; ++tm) { const bf16x8 af = lds_frag(QE + (16 * tm + fr) * P136 + (32 * ks + 8 * fq) * 2);
#pragma unroll
            for (int nt = 0; nt < 2; ++nt) acc[tm][nt] = mma16(af, sfr[ks][nt], acc[tm][nt]); }
    }
#pragma unroll
    for (int ks = 0; ks < 2; ++ks) {
        bf16x8 bfm[2];
#pragma unroll
        for (int nt = 0; nt < 2; ++nt) bfm[nt] = tr_frag(VT, P264, 32 * ks, 32 * w + 16 * nt, fr, fq);
#pragma unroll
        for (int tm = 0; tm < 4; ++tm) { const bf16x8 af = lds_frag(ATT + (16 * tm + fr) * P72 + (32 * ks + 8 * fq) * 2);
#pragma unroll
            for (int nt = 0; nt < 2; ++nt) acc[tm][nt] = mma16(af, bfm[nt], acc[tm][nt]); }
    }
    v2u gvp[4][2]; f32x4 wvp[2];
#pragma unroll
    for (int nt = 0; nt < 2; ++nt) { const int v = 32 * w + 16 * nt + 4 * fq; wvp[nt] = *(const GAS f32x4*)(C.in[I_GNW] + v);
#pragma unroll
        for (int tm = 0; tm < 4; ++tm) gvp[tm][nt] = *(const GAS v2u*)(PJ + (size_t)(r0 + 16 * tm + fr) * NPJ + PJ_GO + 256 * h + v); }
#pragma unroll
    for (int tm = 0; tm < 4; ++tm) { float s = 0.f;
#pragma unroll
        for (int nt = 0; nt < 2; ++nt) { const f32x4 a = acc[tm][nt]; s += (a[0] * a[0] + a[1] * a[1]) + (a[2] * a[2] + a[3] * a[3]); }
        s += __shfl_xor(s, 16); s += __shfl_xor(s, 32);
        if (fq == 0) RED[w * 64 + 16 * tm + fr] = s; }
    __syncthreads();
    const float* nw = C.in[I_GNW];
#pragma unroll
    for (int tm = 0; tm < 4; ++tm) { const int t = 16 * tm + fr; float tot = 0.f;
#pragma unroll
        for (int ww = 0; ww < 8; ++ww) tot += RED[ww * 64 + t];
        const float rs = rsqrtf(tot * (1.f / 256.f) + RMS_EPS); const size_t r = (size_t)(r0 + t);
#pragma unroll
        for (int nt = 0; nt < 2; ++nt) { const int v = 32 * w + 16 * nt + 4 * fq; const f32x4 a = acc[tm][nt];
            const f32x4 wv = wvp[nt]; const v2u gv = gvp[tm][nt];
            *(GAS v2u*)(OG + r * 1024 + 256 * h + v) = (v2u){pk2(a[0] * rs * wv.x * bflo(gv.x), a[1] * rs * wv.y * bfhi(gv.x)), pk2(a[2] * rs * wv.z * bflo(gv.y), a[3] * rs * wv.w * bfhi(gv.y))}; } }
    __syncthreads();
}
__device__ __forceinline__ void ssd_pass3_unit(const Ctx& C, int c, int g) {
    int tid_ = C.tid; asm volatile("" : "+v"(tid_));
    const int lane_ = tid_ & 63, wave_ = __builtin_amdgcn_readfirstlane(tid_ >> 6); (void)lane_; (void)wave_;
    const bf16* PJ = (const bf16*)(C.ws + WS_PJ); const bf16* XC = (const bf16*)(C.ws + WS_XC); const float* DT = (const float*)(C.ws + WS_DT); const float* AC = (const float*)(C.ws + WS_AC);
    const bf16* LS = (const bf16*)(C.ws + WS_LS); bf16* YS = (bf16*)(C.ws + WS_YS);
    ldsp XD = C.lds, CM = XD + 64 * P520, BM = CM + 64 * P136, WT = BM + 64 * P136;
    LAS float* ACL = (LAS float*)(WT + 8 * 32 * P72);
    LAS float* DTL = ACL + 8 * 64;
    LAS float* RED = DTL + 8 * 64;
    const int r0 = 64 * c;
    bf16x8 sfr[4][4];
    { const bf16* Sb = LS + ((size_t)(c * 32 + 8 * g + (wave_ >> 1)) * 64) * 128; const int fr_ = lane_ & 15, fq_ = lane_ >> 4;
#pragma unroll
      for (int ks = 0; ks < 2; ++ks)
#pragma unroll
        for (int pn = 0; pn < 4; ++pn) sfr[ks][pn] = *(const GAS bf16x8*)(Sb + (size_t)(16 * pn + fr_) * 128 + 32 * ks + 8 * fq_); }
    { v4u xx[8], bb[2], cc[2]; float a1, d1;
      { const int s = tid_ >> 3, hl = tid_ & 7; const size_t ri = (size_t)(r0 + s) * 32 + 8 * g + hl; a1 = AC[ri]; d1 = DT[ri]; }
#pragma unroll
      for (int i = 0; i < 8; ++i) { const int s = (tid_ >> 6) + 8 * i, ch = tid_ & 63; xx[i] = *(const GAS v4u*)(XC + (size_t)(r0 + s) * 3072 + 512 * g + 8 * ch); }
#pragma unroll
      for (int i = 0; i < 2; ++i) { const int e = tid_ + NT * i, s = e >> 4, ch = e & 15; const size_t r = (size_t)(r0 + s);
        bb[i] = *(const GAS v4u*)(XC + r * 3072 + 2048 + 128 * g + 8 * ch); cc[i] = *(const GAS v4u*)(XC + r * 3072 + 2560 + 128 * g + 8 * ch); }
      { const int s = tid_ >> 3, hl = tid_ & 7; ACL[hl * 64 + s] = a1; DTL[hl * 64 + s] = d1; }
#pragma unroll
      for (int i = 0; i < 8; ++i) { const int s = (tid_ >> 6) + 8 * i, ch = tid_ & 63; *(LAS v4u*)(XD + s * P520 + ch * 16) = xx[i]; }
#pragma unroll
      for (int i = 0; i < 2; ++i) { const int e = tid_ + NT * i, s = e >> 4, ch = e & 15; *(LAS v4u*)(BM + s * P136 + ch * 16) = bb[i]; *(LAS v4u*)(CM + s * P136 + ch * 16) = cc[i]; } }
    __syncthreads();
    const int fr = lane_ & 15, fq = lane_ >> 4, w = wave_, rh = w & 1, hq = w >> 1, t0 = 32 * rh;
    ldsp WW = WT + w * 32 * P72;
    { const bf16* Sb = LS + ((size_t)(c * 32 + 8 * g + hq) * 64) * 128;
#pragma unroll
      for (int ks = 2; ks < 4; ++ks)
#pragma unroll
        for (int pn = 0; pn < 4; ++pn) sfr[ks][pn] = *(const GAS bf16x8*)(Sb + (size_t)(16 * pn + fr) * 128 + 32 * ks + 8 * fq); }
    f32x4 cb[2][4];
#pragma unroll
    for (int tm = 0; tm < 2; ++tm)
#pragma unroll
        for (int sn = 0; sn < 4; ++sn) cb[tm][sn] = (f32x4){0.f, 0.f, 0.f, 0.f};
#pragma unroll
    for (int ks = 0; ks < 4; ++ks) {
        bf16x8 af[2];
#pragma unroll
        for (int tm = 0; tm < 2; ++tm) af[tm] = lds_frag(CM + (t0 + 16 * tm + fr) * P136 + (32 * ks + 8 * fq) * 2);
#pragma unroll
        for (int sn = 0; sn < 4; ++sn) { const bf16x8 bfm = lds_frag(BM + (16 * sn + fr) * P136 + (32 * ks + 8 * fq) * 2);
#pragma unroll
            for (int tm = 0; tm < 2; ++tm) cb[tm][sn] = mma16(af[tm], bfm, cb[tm][sn]); }
    }
    v2u yp[2][2][4];
    float ss[2] = {0.f, 0.f};
    const float* dsk = C.in[I_DSKIP]; const float* nw = C.in[I_SNW];
#pragma unroll
    for (int rd = 0; rd < 2; ++rd) {
        const int hl = hq + 4 * rd, hd = 8 * g + hl;
        float at[2];
#pragma unroll
        for (int tm = 0; tm < 2; ++tm) at[tm] = ACL[hl * 64 + t0 + 16 * tm + fr];
#pragma unroll
        for (int sn = 0; sn < 4; ++sn) { const f32x4 as = *(const LAS f32x4*)(ACL + hl * 64 + 16 * sn + 4 * fq), ds = *(const LAS f32x4*)(DTL + hl * 64 + 16 * sn + 4 * fq);
#pragma unroll
            for (int tm = 0; tm < 2; ++tm) { const f32x4 cv = cb[tm][sn];
                const float w0 = cv[0] * ds.x * __expf(-fabsf(at[tm] - as.x)), w1 = cv[1] * ds.y * __expf(-fabsf(at[tm] - as.y)), w2 = cv[2] * ds.z * __expf(-fabsf(at[tm] - as.z)), w3 = cv[3] * ds.w * __expf(-fabsf(at[tm] - as.w));
                *(LAS v2u*)(WW + (16 * tm + fr) * P72 + (16 * sn + 4 * fq) * 2) = (v2u){pk2(w0, w1), pk2(w2, w3)}; } }
        f32x4 y[2][4];
#pragma unroll
        for (int tm = 0; tm < 2; ++tm)
#pragma unroll
            for (int pn = 0; pn < 4; ++pn) y[tm][pn] = (f32x4){0.f, 0.f, 0.f, 0.f};
#pragma unroll
        for (int ks = 0; ks < 4; ++ks) {
            bf16x8 af[2];
#pragma unroll
            for (int tm = 0; tm < 2; ++tm) af[tm] = lds_frag(CM + (t0 + 16 * tm + fr) * P136 + (32 * ks + 8 * fq) * 2);
#pragma unroll
            for (int pn = 0; pn < 4; ++pn) {
#pragma unroll
                for (int tm = 0; tm < 2; ++tm) y[tm][pn] = mma16(af[tm], sfr[ks][pn], y[tm][pn]); }
        }
        if (rd == 0) {
            const bf16* Sb = LS + ((size_t)(c * 32 + 8 * g + hq + 4) * 64) * 128;
#pragma unroll
            for (int ks = 0; ks < 4; ++ks)
#pragma unroll
                for (int pn = 0; pn < 4; ++pn) sfr[ks][pn] = *(const GAS bf16x8*)(Sb + (size_t)(16 * pn + fr) * 128 + 32 * ks + 8 * fq);
        }
#pragma unroll
        for (int tm = 0; tm < 2; ++tm) { const float ea = __expf(at[tm]);
#pragma unroll
            for (int pn = 0; pn < 4; ++pn) y[tm][pn] = y[tm][pn] * ea; }
        LDS_WAIT(); asm volatile("" ::: "memory");
#pragma unroll
        for (int ks = 0; ks < 2; ++ks) {
            bf16x8 af[2];
#pragma unroll
            for (int tm = 0; tm < 2; ++tm) af[tm] = lds_frag(WW + (16 * tm + fr) * P72 + (32 * ks + 8 * fq) * 2);
#pragma unroll
            for (int pn = 0; pn < 4; ++pn) { const bf16x8 bfm = tr_frag(XD, P520, 32 * ks, 64 * hl + 16 * pn, fr, fq);
#pragma unroll
                for (int tm = 0; tm < 2; ++tm) y[tm][pn] = mma16(af[tm], bfm, y[tm][pn]); }
        }
        LDS_WAIT(); asm volatile("" ::: "memory");
        const float dk = dsk[hd];
#pragma unroll
        for (int tm = 0; tm < 2; ++tm) { const size_t r = (size_t)(r0 + t0 + 16 * tm + fr);
#pragma unroll
            for (int pn = 0; pn < 4; ++pn) { const int col = 64 * hd + 16 * pn + 4 * fq;
                const v2u xv = *(const LAS v2u*)(XD + (t0 + 16 * tm + fr) * P520 + (64 * hl + 16 * pn + 4 * fq) * 2), zv = *(const GAS v2u*)(PJ + r * NPJ + PJ_Z + col);
                f32x4 a = y[tm][pn];
                a[0] = (a[0] + dk * bflo(xv.x)) * bflo(zv.x); a[1] = (a[1] + dk * bfhi(xv.x)) * bfhi(zv.x); a[2] = (a[2] + dk * bflo(xv.y)) * bflo(zv.y); a[3] = (a[3] + dk * bfhi(xv.y)) * bfhi(zv.y);
                ss[tm] += (a[0] * a[0] + a[1] * a[1]) + (a[2] * a[2] + a[3] * a[3]); yp[rd][tm][pn] = (v2u){pk2(a[0], a[1]), pk2(a[2], a[3])}; } }
    }
#pragma unroll
    for (int tm = 0; tm < 2; ++tm) { float s = ss[tm]; s += __shfl_xor(s, 16); s += __shfl_xor(s, 32); if (fq == 0) RED[w * 32 + 16 * tm + fr] = s; }
    __syncthreads();
#pragma unroll
    for (int tm = 0; tm < 2; ++tm) { const int tl = 16 * tm + fr; float tot = 0.f;
#pragma unroll
        for (int q = 0; q < 4; ++q) tot += RED[(2 * q + rh) * 32 + tl];
        const float rs = rsqrtf(tot * (1.f / 512.f) + RMS_EPS); const size_t r = (size_t)(r0 + t0 + tl);
#pragma unroll
        for (int rd = 0; rd < 2; ++rd) { const int hd = 8 * g + hq + 4 * rd;
#pragma unroll
            for (int pn = 0; pn < 4; ++pn) { const int col = 64 * hd + 16 * pn + 4 * fq; const v2u a = yp[rd][tm][pn]; const f32x4 wv = *(const GAS f32x4*)(nw + col);
                *(GAS v2u*)(YS + r * 2048 + col) = (v2u){pk2(bflo(a.x) * rs * wv.x, bfhi(a.x) * rs * wv.y), pk2(bflo(a.y) * rs * wv.z, bfhi(a.y) * rs * wv.w)}; } } }
    __syncthreads();
}

__device__ __forceinline__ void phaseJ(const Ctx& C) {
    const int gw = C.bid * NWAVES + C.wave, NGW = C.G * NWAVES;
    bf16* HN2 = (bf16*)(C.ws + WS_HN2);
    for (int r = gw; r < NTOK / 2; r += NGW) {
        const int r1 = r + NTOK / 2, lane = C.lane;
        const f32x4* x0 = (const f32x4*)(C.out + (size_t)r * D) + lane; const f32x4* x1 = (const f32x4*)(C.out + (size_t)r1 * D) + lane; const f32x4* wr_ = (const f32x4*)C.in[I_LNFFN] + lane;
        f32x4 v[4], u[4]; float q0 = 0.f, q1 = 0.f;
#pragma unroll
        for (int j = 0; j < 4; ++j) { v[j] = *(const GAS f32x4*)(x0 + 64 * j); u[j] = *(const GAS f32x4*)(x1 + 64 * j); }
#pragma unroll
        for (int j = 0; j < 4; ++j) { q0 += (v[j].x * v[j].x + v[j].y * v[j].y) + (v[j].z * v[j].z + v[j].w * v[j].w); q1 += (u[j].x * u[j].x + u[j].y * u[j].y) + (u[j].z * u[j].z + u[j].w * u[j].w); }
        const float s0 = rsqrtf(wave_sum(q0) * (1.f / D) + RMS_EPS), s1 = rsqrtf(wave_sum(q1) * (1.f / D) + RMS_EPS);
        v2u* o0 = (v2u*)(HN2 + (size_t)r * D) + lane; v2u* o1 = (v2u*)(HN2 + (size_t)r1 * D) + lane;
#pragma unroll
        for (int j = 0; j < 4; ++j) { const f32x4 ww = *(const GAS f32x4*)(wr_ + 64 * j); const f32x4 a = v[j] * s0 * ww, bq = u[j] * s1 * ww;
            *(GAS v2u*)(o0 + 64 * j) = (v2u){pk2(a.x, a.y), pk2(a.z, a.w)}; *(GAS v2u*)(o1 + 64 * j) = (v2u){pk2(bq.x, bq.y), pk2(bq.z, bq.w)};
            int w0 = 0, w1 = 0;
            w0 = __builtin_amdgcn_cvt_pk_fp8_f32(a.x * 16.f, a.y * 16.f, w0, false); w0 = __builtin_amdgcn_cvt_pk_fp8_f32(a.z * 16.f, a.w * 16.f, w0, true);
            w1 = __builtin_amdgcn_cvt_pk_fp8_f32(bq.x * 16.f, bq.y * 16.f, w1, false); w1 = __builtin_amdgcn_cvt_pk_fp8_f32(bq.z * 16.f, bq.w * 16.f, w1, true);
            *(GAS unsigned*)(C.ws + WS_HN8 + (size_t)r * D + 4 * lane + 256 * j) = (unsigned)w0; *(GAS unsigned*)(C.ws + WS_HN8 + (size_t)r1 * D + 4 * lane + 256 * j) = (unsigned)w1; }
    }
}
__device__ __forceinline__ void conv_table(const Ctx& C, int tb, int first_blk) {
    if (C.bid < first_blk) return;
    const size_t n16 = (size_t)16384 * 1024 / 16, gt = (size_t)(C.bid - first_blk) * NT + C.tid, GT = (size_t)(C.G - first_blk) * NT;
    const float* src = C.in[tb ? I_PV : I_PU]; unsigned char* dst = C.ws + WS_U8 + (tb ? 1024 : 0); const float gain = tb ? 4.f : 256.f;
    for (size_t i0 = gt; i0 < n16; i0 += 4 * GT) { f32x4 a[4][4];
#pragma unroll
        for (int p = 0; p < 4; ++p) { const size_t i = i0 + p * GT;
#pragma unroll
            for (int q = 0; q < 4; ++q) a[p][q] = (i < n16) ? *(const GAS f32x4*)(src + 16 * i + 4 * q) : (f32x4){0.f, 0.f, 0.f, 0.f}; }
#pragma unroll
        for (int p = 0; p < 4; ++p) { const size_t i = i0 + p * GT;
            if (tb == 0) { v4u o;
#pragma unroll
                for (int q = 0; q < 4; ++q) { int w = 0; w = __builtin_amdgcn_cvt_pk_fp8_f32(a[p][q].x * gain, a[p][q].y * gain, w, false); w = __builtin_amdgcn_cvt_pk_fp8_f32(a[p][q].z * gain, a[p][q].w * gain, w, true); o[q] = (unsigned)w; }
                if (i < n16) *(GAS v4u*)(dst + (i >> 6) * 2048 + (i & 63) * 16) = o;
            } else { v2u o;
#pragma unroll
                for (int h = 0; h < 2; ++h) { unsigned w = 0;
                    w = __builtin_amdgcn_cvt_scalef32_pk_fp4_f32(w, a[p][2 * h].x * gain, a[p][2 * h].y * gain, 1.0f, 0); w = __builtin_amdgcn_cvt_scalef32_pk_fp4_f32(w, a[p][2 * h].z * gain, a[p][2 * h].w * gain, 1.0f, 1);
                    w = __builtin_amdgcn_cvt_scalef32_pk_fp4_f32(w, a[p][2 * h + 1].x * gain, a[p][2 * h + 1].y * gain, 1.0f, 2); w = __builtin_amdgcn_cvt_scalef32_pk_fp4_f32(w, a[p][2 * h + 1].z * gain, a[p][2 * h + 1].w * gain, 1.0f, 3); o[h] = w; }
                if (i < n16) *(GAS v2u*)(dst + (i >> 6) * 2048 + (i & 63) * 8) = o;
            } } }
}

__device__ __forceinline__ float gelu_tanh(float x) {
    const float y = 0.7978845608028654f * (x + 0.044715f * x * x * x);
    const float e = __expf(2.f * y);
    const float th = 1.f - 2.f * fast_rcp(e + 1.f);
    return 0.5f * x * (1.f + th);
}
typedef _Float16 h16x2 __attribute__((ext_vector_type(2)));
template <int CTRL> __device__ __forceinline__ unsigned dppu(unsigned x) { return (unsigned)__builtin_amdgcn_mov_dpp((int)x, CTRL, 0xf, 0xf, true); }
template <int CTRL> __device__ __forceinline__ float dppf(float x) { return __builtin_bit_cast(float, __builtin_amdgcn_mov_dpp(__builtin_bit_cast(int, x), CTRL, 0xf, 0xf, true)); }
__device__ __forceinline__ unsigned row_max_u(unsigned m) { m = max(m, dppu<0xB1>(m)); m = max(m, dppu<0x4E>(m)); m = max(m, dppu<0x141>(m)); m = max(m, dppu<0x128>(m)); return m; }
__device__ __forceinline__ float row_sum_f(float v) { v += dppf<0xB1>(v); v += dppf<0x4E>(v); v += dppf<0x141>(v); v += dppf<0x128>(v); return v; }
__device__ __forceinline__ unsigned mono(float f) { const unsigned b = __builtin_bit_cast(unsigned, f); return b ^ ((unsigned)((int)b >> 31) | 0x80000000u); }
__device__ __forceinline__ float unmono(unsigned u) { const unsigned b = (u & 0x80000000u) ? (u ^ 0x80000000u) : ~u; return __builtin_bit_cast(float, b); }
__device__ __forceinline__ void cand_ij(int c, int& ci, int& cj) {
    if (c < 16) { ci = 0; cj = c; } else if (c < 24) { ci = 1; cj = c - 16; } else if (c < 29) { ci = 2; cj = c - 24; } else if (c < 33) { ci = 3; cj = c - 29; }
    else if (c < 36) { ci = 4; cj = c - 33; } else if (c < 38) { ci = 5; cj = c - 36; } else if (c < 40) { ci = 6; cj = c - 38; } else if (c < 42) { ci = 7; cj = c - 40; }
    else if (c < 50) { ci = c - 34; cj = 0; } else { ci = 0; cj = 0; }
}
constexpr int PEER_LDS_PER_WAVE = 3072;
__device__ __forceinline__ void peer_token(const Ctx& C, int t, bool dry = false) {
    const int lane = C.lane, g = lane >> 4, j = lane & 15;
    const float* SC = (const float*)(C.ws + WS_SC) + (size_t)t * 2048;
    const bf16* HN2 = (const bf16*)(C.ws + WS_HN2) + (size_t)t * D;
    ldsp LST = C.lds + C.wave * PEER_LDS_PER_WAVE; ldsp EL = LST + 2048;
#pragma unroll 1
    for (int P = 0; P < 2; ++P) {
        const float* spa = SC + (4 * P + g) * 128 + 8 * j; const float* spb = SC + (4 * (P + 2) + g) * 128 + 8 * j;
        const f32x4 s0 = *(const GAS f32x4*)spa, s1 = *(const GAS f32x4*)(spa + 4), s2 = *(const GAS f32x4*)spb, s3 = *(const GAS f32x4*)(spb + 4);
        unsigned k[8], kb[8];
        const float sa[8] = {s0.x, s0.y, s0.z, s0.w, s1.x, s1.y, s1.z, s1.w}, sb[8] = {s2.x, s2.y, s2.z, s2.w, s3.x, s3.y, s3.z, s3.w};
#pragma unroll
        for (int q = 0; q < 8; ++q) { k[q] = (mono(sa[q]) & ~127u) | (unsigned)(127 - (8 * j + q)); kb[q] = (mono(sb[q]) & ~127u) | (unsigned)(127 - (8 * j + q)); }
        unsigned res = 0u, resb = 0u;
#pragma unroll 4
        for (int it = 0; it < 16; ++it) {
            unsigned m = max(max(max(k[0], k[1]), max(k[2], k[3])), max(max(k[4], k[5]), max(k[6], k[7])));
            unsigned mb = max(max(max(kb[0], kb[1]), max(kb[2], kb[3])), max(max(kb[4], kb[5]), max(kb[6], kb[7])));
            m = max(m, dppu<0xB1>(m)); mb = max(mb, dppu<0xB1>(mb)); m = max(m, dppu<0x4E>(m)); mb = max(mb, dppu<0x4E>(mb));
            m = max(m, dppu<0x141>(m)); mb = max(mb, dppu<0x141>(mb)); m = max(m, dppu<0x128>(m)); mb = max(mb, dppu<0x128>(mb));
#pragma unroll
            for (int q = 0; q < 8; ++q) { k[q] = (k[q] == m) ? 0u : k[q]; kb[q] = (kb[q] == mb) ? 0u : kb[q]; }
            res = (j == it) ? m : res; resb = (j == it) ? mb : resb;
        }
        *(LAS v2u*)(LST + ((4 * P + g) * 16 + j) * 8) = (v2u){__builtin_bit_cast(unsigned, unmono(res & ~127u)), 127u - (res & 127u)};
        *(LAS v2u*)(LST + ((4 * (P + 2) + g) * 16 + j) * 8) = (v2u){__builtin_bit_cast(unsigned, unmono(resb & ~127u)), 127u - (resb & 127u)};
    }
    LDS_WAIT(); asm volatile("" ::: "memory");
    int eA = 0, eB = 0; float wA = 0.f, wB = 0.f;
#pragma unroll
    for (int Q = 0; Q < 2; ++Q) {
        const int h = 4 * Q + g;
        unsigned k[4];
#pragma unroll
        for (int m = 0; m < 4; ++m) {
            const int c = j + 16 * m; int ci, cj; cand_ij(c, ci, cj);
            const v2u a = *(const LAS v2u*)(LST + ((2 * h) * 16 + ci) * 8), b = *(const LAS v2u*)(LST + ((2 * h + 1) * 16 + cj) * 8);
            const float val = __builtin_bit_cast(float, a.x) + __builtin_bit_cast(float, b.x);
            k[m] = (c < 50) ? ((mono(val) & ~63u) | (unsigned)(63 - c)) : 0u;
            *(LAS unsigned*)(EL + (g * 64 + c) * 4) = a.y * 128u + b.y;
        }
        unsigned res = 0u, mtop = 0u;
#pragma unroll 4
        for (int it = 0; it < 16; ++it) {
            unsigned m = max(max(k[0], k[1]), max(k[2], k[3]));
            m = row_max_u(m);
            if (it == 0) mtop = m;
#pragma unroll
            for (int q = 0; q < 4; ++q) k[q] = (k[q] == m) ? 0u : k[q];
            res = (j == it) ? m : res;
        }
        LDS_WAIT(); asm volatile("" ::: "memory");
        const int cw = 63 - (int)(res & 63u);
        const int e = (int)*(const LAS unsigned*)(EL + (g * 64 + cw) * 4);
        const float ex = __expf(unmono(res & ~63u) - unmono(mtop & ~63u));
        const float wgt = ex / row_sum_f(ex);
        if (Q == 0) { eA = e; wA = wgt; } else { eB = e; wB = wgt; }
        LDS_WAIT(); asm volatile("" ::: "memory");
    }
#ifdef DRY_TOPK_ONLY
    if (dry) { ((float*)(C.ws + WS_T1))[(size_t)t * 64 + lane] = (float)(eA + eB) + wA + wB; return; }
#endif
    const unsigned char* U8 = C.ws + WS_U8; const unsigned char* V8 = C.ws + WS_U8 + 1024;
    const int li = lane & 15, lg = lane >> 4;
    v4u hb[16];
    { const unsigned char* H8 = C.ws + WS_HN8 + (size_t)t * D + 16 * lg;
#pragma unroll
      for (int s = 0; s < 16; ++s) hb[s] = *(const GAS v4u*)(H8 + 64 * s); }
    f32x2 acc[8];
#pragma unroll
    for (int i = 0; i < 8; ++i) acc[i] = (f32x2){0.f, 0.f};
#pragma unroll 1
    for (int gi = 0; gi < 8; ++gi) {
        const int ev = gi < 4 ? eA : eB; const float wv = gi < 4 ? wA : wB; const int lb = 16 * (gi & 3);
        const int ei = __shfl(ev, lb + li);
        const unsigned char* up = U8 + (size_t)ei * 2048 + 16 * lg;
        v4u uq[16];
#pragma unroll
        for (int s = 0; s < 16; ++s) uq[s] = *(const GAS v4u*)(up + 64 * s);
        v2u vq[8];
#pragma unroll
        for (int q = 0; q < 8; ++q) vq[q] = *(const GAS v2u*)(V8 + (size_t)__builtin_amdgcn_readlane(ev, lb + q) * 2048 + 8 * lane);
        float wr[4];
#pragma unroll
        for (int r = 0; r < 4; ++r) wr[r] = __shfl(wv, lb + 4 * lg + r);
        f32x4 dots = {0.f, 0.f, 0.f, 0.f};
#pragma unroll
        for (int s = 0; s < 16; ++s) {
            dots = __builtin_amdgcn_mfma_f32_16x16x32_fp8_fp8(__builtin_bit_cast(long, (v2u){uq[s].x, uq[s].y}), __builtin_bit_cast(long, (v2u){hb[s].x, hb[s].y}), dots, 0, 0, 0);
            dots = __builtin_amdgcn_mfma_f32_16x16x32_fp8_fp8(__builtin_bit_cast(long, (v2u){uq[s].z, uq[s].w}), __builtin_bit_cast(long, (v2u){hb[s].z, hb[s].w}), dots, 0, 0, 0);
        }
        float cfr[4];
#pragma unroll
        for (int r = 0; r < 4; ++r) cfr[r] = wr[r] * gelu_tanh(dots[r] * (1.f / 4096.f)) * 0.25f;
#pragma unroll
        for (int hf = 0; hf < 2; ++hf) {
            if (hf == 1) {
#pragma unroll
                for (int q = 0; q < 8; ++q) vq[q] = *(const GAS v2u*)(V8 + (size_t)__builtin_amdgcn_readlane(ev, lb + 8 + q) * 2048 + 8 * lane);
            }
#pragma unroll
            for (int q = 0; q < 8; ++q) { const int pl = 8 * hf + q;
                const float cf = __builtin_bit_cast(float, __builtin_amdgcn_readlane(__builtin_bit_cast(int, cfr[pl & 3]), 16 * (pl >> 2)));
#pragma unroll
                for (int w2 = 0; w2 < 2; ++w2) { acc[4 * w2 + 0] = __builtin_amdgcn_cvt_scalef32_pk_f32_fp4(vq[q][w2], 1.0f, 0) * cf + acc[4 * w2 + 0]; acc[4 * w2 + 1] = __builtin_amdgcn_cvt_scalef32_pk_f32_fp4(vq[q][w2], 1.0f, 1) * cf + acc[4 * w2 + 1];
                    acc[4 * w2 + 2] = __builtin_amdgcn_cvt_scalef32_pk_f32_fp4(vq[q][w2], 1.0f, 2) * cf + acc[4 * w2 + 2]; acc[4 * w2 + 3] = __builtin_amdgcn_cvt_scalef32_pk_f32_fp4(vq[q][w2], 1.0f, 3) * cf + acc[4 * w2 + 3]; }
            }
        }
    }
    float* orow = C.out + (size_t)t * D + 16 * lane; const float* lw = C.in[I_LNF] + 16 * lane;
    f32x4 hv[4]; float s = 0.f;
#pragma unroll
    for (int i = 0; i < 4; ++i) { hv[i] = *(const GAS f32x4*)(orow + 4 * i); hv[i].x += acc[2 * i].x; hv[i].y += acc[2 * i].y; hv[i].z += acc[2 * i + 1].x; hv[i].w += acc[2 * i + 1].y;
        s += (hv[i].x * hv[i].x + hv[i].y * hv[i].y) + (hv[i].z * hv[i].z + hv[i].w * hv[i].w); }
    const float rs = rsqrtf(wave_sum(s) * (1.f / D) + RMS_EPS);
    if (dry) return;
#pragma unroll
    for (int i = 0; i < 4; ++i) { const f32x4 w4 = *(const GAS f32x4*)(lw + 4 * i); *(GAS f32x4*)(orow + 4 * i) = hv[i] * rs * w4; }
}

constexpr int NSTEPS = 37;
#ifndef PH_MASK
#define PH_MASK 0xFF
#endif
#define PH_ON(k) (((PH_MASK) >> (k)) & 1)
struct Args { const float* in[22]; float* out; unsigned char* ws; int ph_lo, ph_hi; };
typedef const __attribute__((address_space(4))) Args* kargp;
__device__ __forceinline__ void ctx_init(Ctx& C, unsigned char* smem) {
    kargp ap = (kargp)__builtin_amdgcn_kernarg_segment_ptr();
    asm volatile("" : "+s"(ap));
    int tid_ = threadIdx.x; asm volatile("" : "+v"(tid_));
    C.lds = (ldsp)smem; C.tid = tid_; C.lane = C.tid & 63; C.wave = __builtin_amdgcn_readfirstlane(C.tid >> 6); C.G = gridDim.x; C.bid = blockIdx.x;
#pragma unroll
    for (int i = 0; i < 22; ++i) C.in[i] = ap->in[i];
    C.out = ap->out; C.ws = ap->ws;
}
__global__ void __launch_bounds__(NT, 2) hyb_fwd(Args args) {
    extern __shared__ __attribute__((aligned(16))) unsigned char smem[];
    volatile LAS unsigned* MISC = (volatile LAS unsigned*)((ldsp)smem + LDSCTL_OFF);
    for (int u = threadIdx.x; u < (LDS_BYTES - LDSCTL_OFF) / 4; u += NT) MISC[u] = 0u;
    __syncthreads();
    const int lo = args.ph_lo, hi = args.ph_hi;
    unsigned* barw = (unsigned*)(args.ws + WS_CTL) + CW_BAR;
    XcdBarrier bar; bar.bar = barw; bar.x = 0; bar.st = MISC + 8;
    if (hi - lo > 1) bar = xcd_barrier_post(barw, MISC + 8);
#pragma unroll 1
    for (int step = lo; step < hi; ++step) {
        int kind, b = 0, gk = 0;
        if (step == 0) kind = 0;
        else if (step == 1) kind = 8;
        else if (step <= 33) { b = (step - 2) >> 3; const int k = (step - 2) & 7; gk = k; kind = (k == 0 || k >= 5) ? 1 : k + 1; }
        else if (step == 34) kind = 6;
        else if (step == 35) { kind = 1; gk = 8; }
        else kind = 7;
#ifdef REP_KIND
#ifndef REP_GK
#define REP_GK -1
#endif
        for (int rep = ((kind == REP_KIND && (REP_GK < 0 || gk == REP_GK)) ? 0 : 1); rep < 2; ++rep) {
        const bool dry = (rep == 0);
#else
        const bool dry = false; {
#endif
        Ctx C; ctx_init(C, smem);
        if (kind == 0 && PH_ON(0)) p0_prologue(C);
        else if (kind == 8) p0b_prologue(C);
        else if (kind == 1 && PH_ON(1)) {
            pg8::Gemm g; EpiAny E; E.P.PJ = (bf16*)(C.ws + WS_PJ); E.P.TL = (float*)(C.ws + WS_TL); E.PJ = (const bf16*)(C.ws + WS_PJ); E.T = nullptr; E.O = nullptr; E.gcol = 0; E.X = C.in[I_X]; E.OF = C.out; E.b = b; E.ldc = 2048;
            if (gk == 0)      { g = pg8::Gemm{(const bf16*)(C.ws + WS_HN), (const bf16*)(C.ws + WS_W1T), SEQ, NPJ, 1024}; E.mode = 0; if (b == 0) meta_proj(C); tail_proj(C); }
            else if (gk == 5) { g = pg8::Gemm{(const bf16*)(C.ws + WS_OG), (const bf16*)(C.ws + WS_WAT), RPB, 1024, 1024}; E.mode = 1; E.O = (bf16*)(C.ws + WS_T1); E.gcol = PJ_GA; }
            else if (gk == 6) { g = pg8::Gemm{(const bf16*)(C.ws + WS_YS), (const bf16*)(C.ws + WS_WBT), RPB, 1024, 2048}; E.mode = 1; E.O = (bf16*)(C.ws + WS_MX); E.gcol = PJ_GB; E.T = (const bf16*)(C.ws + WS_T1); }
            else if (gk == 7) { g = pg8::Gemm{(const bf16*)(C.ws + WS_MX), (const bf16*)(C.ws + WS_WOT), RPB, 1024, 1024}; E.mode = 2; }
            else              { g = pg8::Gemm{(const bf16*)(C.ws + WS_HN2), (const bf16*)(C.ws + WS_WET), NTOK, 2048, 1024}; E.mode = 3; E.OF = (float*)(C.ws + WS_SC); }
            pg8::StaticOrder S; S.init(g.M, g.N, C.G, C.bid);
#ifdef REP_TAIL_ONLY
            if (!dry)
#endif
            pg8::gemm_phase<EpiAny, pg8::StaticOrder, true, true>(C.lds, g, S, E);
            if (b == 0 && (gk == 5 || gk == 6)) conv_table(C, gk - 5, (S.nwg < C.G) ? S.nwg : 0);
            if (gk == 7 && b + 1 < BATCH) hn_batch(C, b + 1, (S.nwg < C.G) ? S.nwg : 0);
        }
        else if (kind == 2 && PH_ON(2)) {
#ifdef DRYC
            if (!dry || DRYC == 1) conv_batch(C);
            if (!dry || DRYC == 2) for (int u = C.bid; u < NCHUNK * 5; u += C.G) phaseC_unit(C, u / 5, 6 + u % 5);
#else
            conv_batch(C); for (int u = C.bid; u < NCHUNK * 5; u += C.G) phaseC_unit(C, u / 5, 6 + u % 5);
#endif
 }
        else if ((kind == 3 && PH_ON(3)) || (kind == 5 && PH_ON(5))) {
            unsigned* qc = (unsigned*)(C.ws + WS_CTL) + CW_QUEUE + 2 * step + (dry ? 1 : 0);
            for (;;) {
                if (C.tid == 0) MISC[16] = atomicAdd(qc, 1u);
                __syncthreads();
                const int u = (int)MISC[16];
                __syncthreads();
                if (u >= NCHUNK * 8) break;
                const bool ssd = u < NCHUNK * 4; const int v = ssd ? u : u - NCHUNK * 4, c = v >> 2, k = v & 3;
#ifdef DRYF
                if (dry && ssd != (DRYF == 2)) continue;
#endif
                if (kind == 3) { if (ssd) ssd_pass1_unit(C, c, k); else gla_pass1_unit(C, c, k); }
                else           { if (ssd) ssd_pass3_unit(C, c, k); else gla_pass3_unit(C, c, k); }
            }
        }
        else if (kind == 4 && PH_ON(4)) phaseE(C);
        else if (kind == 6 && PH_ON(6)) phaseJ(C);
        else if (kind == 7 && PH_ON(7)) { const int gw = C.bid * NWAVES + C.wave, NGW = C.G * NWAVES; for (int t = gw; t < NTOK; t += NGW) peer_token(C, t, dry); }
#ifdef REP_KIND
        if (rep == 0) xcd_barrier(bar);
#endif
        }
        if (step + 1 < hi && !(kind == 1 && gk == 5)) xcd_barrier(bar);
    }
}

#ifdef DBG_STOP
__global__ void dbg_digest(const unsigned* w, size_t nwords, float* out, size_t nout) {
    for (size_t i = (size_t)blockIdx.x * blockDim.x + threadIdx.x; i < nout; i += (size_t)gridDim.x * blockDim.x) {
        unsigned h = 0; for (size_t j = i; j < nwords; j += nout) h ^= w[j] * 2654435761u + (unsigned)(j / nout);
        out[i] = (float)(h & 0xFFFFFFu);
    }
}
#endif
#ifndef HYB_N_LAUNCHES
#define HYB_N_LAUNCHES 1
#endif
extern "C" void kernel_launch(void* const* d_in, const int* in_sizes, int n_in, void* d_out, int out_size, void* d_ws, size_t ws_size, hipStream_t stream) {
    static int grid = 0;
    if (grid == 0) {
        if (n_in != 22 || out_size != NTOK * D || ws_size < WS_END) { fprintf(stderr, "kernel_launch: unexpected shapes: n_in %d out %d ws %zu (need %zu)\n", n_in, out_size, ws_size, (size_t)WS_END); grid = -1; return; }
        int dev = 0, cus = 0, per_cu = 0;
        if (hipGetDevice(&dev) != hipSuccess || hipDeviceGetAttribute(&cus, hipDeviceAttributeMultiprocessorCount, dev) != hipSuccess) { grid = -1; return; }
        if (hipFuncSetAttribute((const void*)hyb_fwd, hipFuncAttributeMaxDynamicSharedMemorySize, LDS_BYTES) != hipSuccess) { fprintf(stderr, "kernel_launch: hipFuncSetAttribute failed\n"); grid = -1; return; }
        if (hipOccupancyMaxActiveBlocksPerMultiprocessor(&per_cu, (const void*)hyb_fwd, NT, LDS_BYTES) != hipSuccess || per_cu < 1) { fprintf(stderr, "kernel_launch: occupancy query says %d blocks per CU\n", per_cu); per_cu = 1; }
        (void)hipGetLastError();
        grid = cus;
    }
    if (grid < 0) return;
    (void)hipMemsetAsync((char*)d_ws + WS_CTL, 0, CTL_ZERO_BYTES, stream);
    Args a{};
    for (int i = 0; i < 22; ++i) a.in[i] = (const float*)d_in[i];
    a.out = (float*)d_out; a.ws = (unsigned char*)d_ws;
    if (HYB_N_LAUNCHES == 1) { a.ph_lo = 0; a.ph_hi = NSTEPS; hipLaunchKernelGGL(hyb_fwd, dim3(grid), dim3(NT), LDS_BYTES, stream, a); }
    else {
#ifdef DBG_STOP
        for (int s = 0; s <= DBG_STOP; ++s) { a.ph_lo = s; a.ph_hi = s + 1; hipLaunchKernelGGL(hyb_fwd, dim3(grid), dim3(NT), LDS_BYTES, stream, a); }
        hipLaunchKernelGGL(dbg_digest, dim3(2048), dim3(256), 0, stream, (const unsigned*)((char*)d_ws + (size_t)(DBG_OFF)), (size_t)(DBG_LEN) / 4, (float*)d_out, (size_t)NTOK * D);
#else
        for (int s = 0; s < NSTEPS; ++s) { a.ph_lo = s; a.ph_hi = s + 1; hipLaunchKernelGGL(hyb_fwd, dim3(grid), dim3(NT), LDS_BYTES, stream, a); }
#endif
    }
}
```

```cpp
#include <hip/hip_runtime.h>
#include <cstdio>
#include <cstdint>
namespace pg8 {
#define PG8_LAS __attribute__((address_space(3)))
typedef unsigned short bf16_t;
typedef short bf16x8 __attribute__((ext_vector_type(8)));
typedef float f32x4 __attribute__((ext_vector_type(4)));
typedef unsigned u32x4 __attribute__((ext_vector_type(4)));
constexpr int BM = 256, BK = 64, HALF = 128, HTB = HALF * BK * 2  , STAGE_BYTES = 8 * HTB, NXCD = 8, WGM = 8;

__host__ __device__ __forceinline__ int lds_byte(int r, int c) { const int st = (r >> 4) * 2 + (c >> 5), rr = r & 15, cc = c & 31, ob = rr * 64 + cc * 2; return st * 1024 + (ob ^ (((ob >> 9) & 1) << 5)); }
__host__ __device__ __forceinline__ void stage_rc(int b, int& R, int& C) { const int st = b / 1024, sb = b % 1024, swz = sb ^ (((sb >> 9) & 1) << 5); R = (st >> 1) * 16 + swz / 64; C = (st & 1) * 32 + (swz % 64) / 2; }
__host__ __device__ __forceinline__ int perm32(int rho) { const int n = rho >> 4, i = rho & 15; return 8 * (i >> 2) + 4 * n + (i & 3); }

struct Unit { int pm, pn; };
struct Gemm { const bf16_t* A; const bf16_t* Bt; int M, N, K; };

struct StaticOrder {
    int nM, nN, nwg, G, c;
    __host__ __device__ void init(int M, int N, int G_, int c_) { nM = M / BM; nN = N / BM; nwg = nM * nN; G = G_; c = c_; }
    __host__ __device__ bool next(int i, Unit& u) const {
        const long L = (long)i * G + c; if (L >= nwg) return false;
        int wgid = (int)L; { const int q = nwg / NXCD, r = nwg % NXCD, xcd = wgid % NXCD, off = wgid / NXCD; wgid = (xcd < r ? xcd * (q + 1) : r * (q + 1) + (xcd - r) * q) + off; }
        const int nig = WGM * nN, gid = wgid / nig, fm = gid * WGM, gsz = (nM - fm) < WGM ? (nM - fm) : WGM;
        u.pm = fm + ((wgid % nig) % gsz); u.pn = (wgid % nig) / gsz; return true;
    }
    __device__ __forceinline__ void a_ready(const Unit&) const {}
    __device__ __forceinline__ void done(const Unit&) const {}
};

typedef float f32x2_t __attribute__((ext_vector_type(2))); typedef __bf16 bf16x2_t __attribute__((ext_vector_type(2)));
__device__ __forceinline__ unsigned cvt_pk_bf16(float lo, float hi) { f32x2_t v = {lo, hi}; bf16x2_t b = __builtin_convertvector(v, bf16x2_t); return __builtin_bit_cast(unsigned, b); }
template <class Epi, class Sched, bool ALIGN_EPI = false, bool SP2 = false>
__device__ __forceinline__ void gemm_phase(PG8_LAS unsigned char* lds, const Gemm g, const Sched& S, const Epi& E) {
    int tid_ = threadIdx.x; asm volatile("" : "+v"(tid_));
    const int tid = tid_, wid = __builtin_amdgcn_readfirstlane(tid >> 6), lane = tid & 63, wr = wid >> 2, wc = wid & 3, fr = lane & 15, fq = lane >> 4;
    const int K = g.K, nt = K / BK;
    unsigned voffA[2], voffB[2];
#pragma unroll
    for (int i = 0; i < 2; ++i) { int R, C; stage_rc(tid * 16 + i * 8192, R, C); const int Rb = Epi::PERM ? ((R & ~31) + perm32(R & 31)) : R;
        voffA[i] = (unsigned)(R * K + C) * 2u; voffB[i] = (unsigned)(Rb * K + C) * 2u; }
    const size_t kstep = (size_t)(BK * 2);
    const size_t hstep = (size_t)HALF * K * 2;
    const size_t tstep = 2 * hstep;
    const unsigned ldsw = (unsigned)wid * 1024u;
    const int aoff = lds_byte(wr * 64 + fr, fq * 8), boff = lds_byte(wc * 32 + fr, fq * 8);
#define PG8_SA(b, h) (((b) * 2 + (h)) * HTB)
#define PG8_SB(b, h) ((4 + (b) * 2 + (h)) * HTB)
#define PG8_STAGE(bufoff, gbase, voff) do { _Pragma("unroll") for (int _i = 0; _i < 2; ++_i) \
        __builtin_amdgcn_global_load_lds((const unsigned*)((const char*)(gbase) + (voff)[_i]), (PG8_LAS unsigned*)(lds + (bufoff) + ldsw + _i * 8192), 16, 0, 0); } while (0)
#define PG8_LDA(dst, b, h) do { _Pragma("unroll") for (int m = 0; m < 4; ++m) _Pragma("unroll") for (int k = 0; k < 2; ++k) dst[m][k] = *(const PG8_LAS bf16x8*)(lds + PG8_SA(b, h) + aoff + m * 2048 + k * 1024); } while (0)
#define PG8_LDB(dst, b, h) do { _Pragma("unroll") for (int n = 0; n < 2; ++n) _Pragma("unroll") for (int k = 0; k < 2; ++k) dst[n][k] = *(const PG8_LAS bf16x8*)(lds + PG8_SB(b, h) + boff + n * 2048 + k * 1024); } while (0)
#define PG8_MMA(ai, bj, At, Bt) do { __builtin_amdgcn_s_setprio(1); _Pragma("unroll") for (int m = 0; m < 4; ++m) _Pragma("unroll") for (int n = 0; n < 2; ++n) _Pragma("unroll") for (int k = 0; k < 2; ++k) \
        acc[ai][bj][m][n] = __builtin_amdgcn_mfma_f32_16x16x32_bf16(Bt[n][k], At[m][k], acc[ai][bj][m][n], 0, 0, 0); __builtin_amdgcn_s_setprio(0); } while (0)
#define PG8_WAIT_V(n) asm volatile("s_waitcnt vmcnt(" #n ")" ::: "memory")
#define PG8_WAIT_L(n) asm volatile("s_waitcnt lgkmcnt(" #n ")" ::: "memory")
#define PG8_BAR __builtin_amdgcn_s_barrier()
#define PG8_SCHED __builtin_amdgcn_sched_barrier(0)
    Unit cur, nxt; int ui = 0;
    if (!S.next(0, cur)) return;
    f32x4 acc[2][2][4][2];
#pragma unroll
    for (int a = 0; a < 2; ++a)
#pragma unroll
        for (int b = 0; b < 2; ++b)
#pragma unroll
            for (int m = 0; m < 4; ++m)
#pragma unroll
                for (int n = 0; n < 2; ++n) acc[a][b][m][n] = (f32x4){0.f, 0.f, 0.f, 0.f};
    bf16x8 At[4][2], B0[2][2], B1[2][2];
    const char* cA = (const char*)g.A + (size_t)cur.pm * tstep; const char* cB = (const char*)g.Bt + (size_t)cur.pn * tstep;
    S.a_ready(cur);
    if constexpr (SP2) {
        PG8_STAGE(PG8_SB(0, 0), cB, voffB); PG8_STAGE(PG8_SB(0, 1), cB + hstep, voffB); PG8_STAGE(PG8_SA(0, 0), cA, voffA); PG8_STAGE(PG8_SA(0, 1), cA + hstep, voffA);
        if (wr == 1) PG8_BAR;
        PG8_WAIT_V(2); PG8_BAR;
        PG8_STAGE(PG8_SB(1, 0), cB + kstep, voffB); PG8_STAGE(PG8_SA(1, 0), cA + kstep, voffA); PG8_STAGE(PG8_SB(1, 1), cB + hstep + kstep, voffB);
        PG8_WAIT_V(6); PG8_BAR;
    } else {
        PG8_STAGE(PG8_SB(0, 0), cB, voffB); PG8_STAGE(PG8_SA(0, 0), cA, voffA); PG8_STAGE(PG8_SB(0, 1), cB + hstep, voffB); PG8_STAGE(PG8_SA(0, 1), cA + hstep, voffA);
        if (wr == 1) PG8_BAR;
        PG8_WAIT_V(4); PG8_BAR;
        PG8_STAGE(PG8_SB(1, 0), cB + kstep, voffB); PG8_STAGE(PG8_SA(1, 0), cA + kstep, voffA); PG8_STAGE(PG8_SB(1, 1), cB + hstep + kstep, voffB);
        PG8_WAIT_V(6); PG8_BAR;
    }
    for (;;) {
        const bool has_next = S.next(ui + 1, nxt);
        const char* nA = has_next ? (const char*)g.A + (size_t)nxt.pm * tstep : cA; const char* nB = has_next ? (const char*)g.Bt + (size_t)nxt.pn * tstep : cB;
        for (int t = 0; t < nt; t += 2) {
            const bool last = (t == nt - 2);
            const char* a1 = cA + (size_t)(t + 1) * kstep;
            const char* a2 = last ? nA : cA + (size_t)(t + 2) * kstep; const char* b2 = last ? nB : cB + (size_t)(t + 2) * kstep;
            const char* a3 = a2 + kstep; const char* b3 = b2 + kstep;
            if (last && has_next) S.a_ready(nxt);
            if constexpr (SP2) {
            PG8_LDB(B0, 0, 0); PG8_LDB(B1, 0, 1); PG8_SCHED; PG8_LDA(At, 0, 0); PG8_STAGE(PG8_SA(1, 1), a1 + hstep, voffA);
            PG8_WAIT_V(8); PG8_WAIT_L(0); PG8_BAR; PG8_MMA(0, 0, At, B0); PG8_MMA(0, 1, At, B1); PG8_BAR; PG8_SCHED;
            PG8_LDA(At, 0, 1); PG8_STAGE(PG8_SB(0, 0), b2, voffB); PG8_STAGE(PG8_SB(0, 1), b2 + hstep, voffB); PG8_STAGE(PG8_SA(0, 0), a2, voffA);
            PG8_WAIT_V(8); PG8_WAIT_L(0); PG8_BAR; PG8_MMA(1, 0, At, B0); PG8_MMA(1, 1, At, B1); PG8_BAR; PG8_SCHED;
            PG8_LDB(B0, 1, 0); PG8_LDB(B1, 1, 1); PG8_SCHED; PG8_LDA(At, 1, 0); PG8_STAGE(PG8_SA(0, 1), a2 + hstep, voffA);
            PG8_WAIT_V(8); PG8_WAIT_L(0); PG8_BAR; PG8_MMA(0, 0, At, B0); PG8_MMA(0, 1, At, B1); PG8_BAR; PG8_SCHED;
            PG8_LDA(At, 1, 1); PG8_STAGE(PG8_SB(1, 0), b3, voffB); PG8_STAGE(PG8_SB(1, 1), b3 + hstep, voffB); PG8_STAGE(PG8_SA(1, 0), a3, voffA);
            PG8_WAIT_V(8); PG8_WAIT_L(0); PG8_BAR; PG8_MMA(1, 0, At, B0); PG8_MMA(1, 1, At, B1); PG8_BAR; PG8_SCHED;
            } else {
            PG8_LDB(B0, 0, 0); PG8_SCHED; PG8_LDA(At, 0, 0); PG8_STAGE(PG8_SA(1, 1), a1 + hstep, voffA);
            PG8_WAIT_L(8); PG8_BAR; PG8_WAIT_L(0); PG8_MMA(0, 0, At, B0); PG8_BAR; PG8_SCHED;
            PG8_LDB(B1, 0, 1); PG8_STAGE(PG8_SB(0, 0), b2, voffB);
            PG8_BAR; PG8_WAIT_L(0); PG8_MMA(0, 1, At, B1); PG8_BAR;
            PG8_LDA(At, 0, 1); PG8_STAGE(PG8_SA(0, 0), a2, voffA);
            PG8_BAR; PG8_WAIT_L(0); PG8_MMA(1, 0, At, B0); PG8_BAR; PG8_SCHED;
            PG8_STAGE(PG8_SB(0, 1), b2 + hstep, voffB);
            PG8_WAIT_V(6); PG8_BAR; PG8_MMA(1, 1, At, B1); PG8_BAR;
            PG8_LDB(B0, 1, 0); PG8_SCHED; PG8_LDA(At, 1, 0); PG8_STAGE(PG8_SA(0, 1), a2 + hstep, voffA);
            PG8_WAIT_L(8); PG8_BAR; PG8_WAIT_L(0); PG8_MMA(0, 0, At, B0); PG8_BAR; PG8_SCHED;
            PG8_LDB(B1, 1, 1); PG8_STAGE(PG8_SB(1, 0), b3, voffB);
            PG8_BAR; PG8_WAIT_L(0); PG8_MMA(0, 1, At, B1); PG8_BAR;
            PG8_LDA(At, 1, 1); PG8_STAGE(PG8_SA(1, 0), a3, voffA);
            PG8_BAR; PG8_WAIT_L(0); PG8_MMA(1, 0, At, B0); PG8_BAR; PG8_SCHED;
            PG8_STAGE(PG8_SB(1, 1), b3 + hstep, voffB);
            PG8_WAIT_V(6); PG8_BAR; PG8_MMA(1, 1, At, B1); PG8_BAR;
            }
        }
        if constexpr (ALIGN_EPI) { if (wr == 0) PG8_BAR; }
        if constexpr (!Epi::AFTER_DRAIN) { E(acc, cur, wr, wc, fr, fq); S.done(cur); }
        if (!has_next) break;
#pragma unroll
        for (int a = 0; a < 2; ++a)
#pragma unroll
            for (int b = 0; b < 2; ++b)
#pragma unroll
                for (int m = 0; m < 4; ++m)
#pragma unroll
                    for (int n = 0; n < 2; ++n) acc[a][b][m][n] = (f32x4){0.f, 0.f, 0.f, 0.f};
        cur = nxt; cA = nA; cB = nB; ++ui;
        if constexpr (ALIGN_EPI) { if (wr == 1) PG8_BAR; }
    }
    PG8_WAIT_V(0);
    if constexpr (!ALIGN_EPI) { if (wr == 0) PG8_BAR; }
    PG8_BAR;
    if constexpr (Epi::AFTER_DRAIN) { E.fused(acc, cur, wr, wc, fr, fq, lds, wid, lane); S.done(cur); }
#undef PG8_SA
#undef PG8_SB
#undef PG8_STAGE
#undef PG8_LDA
#undef PG8_LDB
#undef PG8_MMA
#undef PG8_WAIT_V
#undef PG8_WAIT_L
#undef PG8_BAR
#undef PG8_SCHED
}
}

constexpr int NWAVES = 8, NT = 512;
constexpr int D = 1024, BATCH = 4, SEQ = 8192, NMETA = 16;
constexpr int RPB = 8448;
constexpr int RFRONT = 48, RTOK = 64, REND = 8256;
constexpr int NCHUNK = 129;
constexpr int NPJ = 10240;
constexpr int N1 = 10496;
constexpr int PJ_Q = 0, PJ_K = 512, PJ_V = 1024, PJ_GO = 2048, PJ_Z = 3072, PJ_XBC = 5120, PJ_GA = 8192, PJ_GB = 9216;
constexpr int NTOK = BATCH * SEQ;
constexpr float RMS_EPS = 1e-6f;

constexpr size_t MiB = 1u << 20;
constexpr size_t WS_CTL = 0, CTL_ZERO_BYTES = 1 * MiB;
constexpr size_t WS_W1T = 2 * MiB;
constexpr size_t WS_WAT = 23 * MiB;
constexpr size_t WS_WBT = 25 * MiB;
constexpr size_t WS_WOT = 29 * MiB;
constexpr size_t WS_WET = 31 * MiB;
constexpr size_t WS_HNM = 35 * MiB;
constexpr size_t WS_HN = 36 * MiB;
constexpr size_t WS_PJ = 53 * MiB;
constexpr size_t WS_TL = 218 * MiB;
constexpr size_t WS_XC = 220 * MiB;
constexpr size_t WS_GG = 270 * MiB;
constexpr size_t WS_DT = 287 * MiB;
constexpr size_t WS_AC = 289 * MiB;
constexpr size_t WS_LG = 291 * MiB;
constexpr size_t WS_LS = 324 * MiB;
constexpr size_t WS_OG = 389 * MiB;
constexpr size_t WS_YS = 406 * MiB;
constexpr size_t WS_T1 = 439 * MiB;
constexpr size_t WS_MX = 456 * MiB;
constexpr size_t WS_MIX_END = 473 * MiB;
constexpr size_t WS_HN2 = 36 * MiB;
constexpr size_t WS_SC = 100 * MiB;
constexpr size_t WS_HN8 = 356 * MiB;
constexpr size_t WS_U8 = 474 * MiB;
constexpr size_t WS_END = 506 * MiB;
constexpr int CW_BAR = 4096, CW_QUEUE = 64;

constexpr int LDS_WORK = 147456;
constexpr int LDSCTL_OFF = LDS_WORK;
constexpr int LDS_BYTES = LDS_WORK + 512;

#define GAS __attribute__((address_space(1)))
#define LAS __attribute__((address_space(3)))
typedef unsigned short bf16;
typedef unsigned v4u __attribute__((ext_vector_type(4)));
typedef unsigned v2u __attribute__((ext_vector_type(2)));
typedef float f32x4 __attribute__((ext_vector_type(4)));
typedef float f32x2 __attribute__((ext_vector_type(2)));
typedef short bf16x8 __attribute__((ext_vector_type(8)));
typedef short s16x4 __attribute__((ext_vector_type(4)));
typedef short v4i16_t __attribute__((ext_vector_type(4)));
typedef LAS unsigned char* ldsp;
#define RLX_AGENT __ATOMIC_RELAXED, __HIP_MEMORY_SCOPE_AGENT
#define LDS_WAIT() asm volatile("s_waitcnt lgkmcnt(0)" ::: "memory")

__device__ __forceinline__ unsigned pk2(float lo, float hi) { return pg8::cvt_pk_bf16(lo, hi); }
__device__ __forceinline__ float bflo(unsigned u) { return __builtin_bit_cast(float, u << 16); }
__device__ __forceinline__ float bfhi(unsigned u) { return __builtin_bit_cast(float, u & 0xffff0000u); }
__device__ __forceinline__ float fast_rcp(float x) { return __builtin_amdgcn_rcpf(x); }
__device__ __forceinline__ float sigmoidf_(float x) { return fast_rcp(1.f + __expf(-x)); }
__device__ __forceinline__ float siluf_(float x) { return x * sigmoidf_(x); }
__device__ __forceinline__ float wave_sum(float v) {
#pragma unroll
    for (int o = 1; o < 64; o <<= 1) v += __shfl_xor(v, o);
    return v;
}
__device__ __forceinline__ float wave_max(float v) {
#pragma unroll
    for (int o = 1; o < 64; o <<= 1) v = fmaxf(v, __shfl_xor(v, o));
    return v;
}
__device__ __forceinline__ f32x4 mma16(bf16x8 a, bf16x8 b, f32x4 c) { return __builtin_amdgcn_mfma_f32_16x16x32_bf16(b, a, c, 0, 0, 0); }
__device__ __forceinline__ bf16x8 lds_frag(ldsp p) { return *(const LAS bf16x8*)p; }
__device__ __forceinline__ s16x4 lds_tr(ldsp p) { return __builtin_bit_cast(s16x4, __builtin_amdgcn_ds_read_tr16_b64_v4i16((LAS v4i16_t*)p)); }
__device__ __forceinline__ bf16x8 tr_frag(ldsp tile, int pitch, int k0, int n0, int fr, int fq) {
#ifdef TR_SLOW
    bf16x8 r;
#pragma unroll
    for (int e = 0; e < 8; ++e) r[e] = *(const LAS short*)(tile + (k0 + 8 * fq + e) * pitch + (n0 + fr) * 2);
    return r;
#else
    ldsp p = tile + (k0 + 8 * fq + (fr >> 2)) * pitch + (n0 + 4 * (fr & 3)) * 2;
    const s16x4 lo = lds_tr(p), hi = lds_tr(p + 4 * pitch);
    bf16x8 r; r[0] = lo[0]; r[1] = lo[1]; r[2] = lo[2]; r[3] = lo[3]; r[4] = hi[0]; r[5] = hi[1]; r[6] = hi[2]; r[7] = hi[3];
    return r;
#endif
}

#define XB_TMO      128
#define XB_XCNT(j)  (256  + 64 * (j))
#define XB_XSUB(j)  (1280 + 64 * (j))
#define XB_XGEN(j)  (2304 + 64 * (j))
#define XB_TOP      3328
#define XB_TOPGEN   3392
#define XCD_BAR_WORDS 3456
#define XB_SPIN_CAP (1u << 22)
__device__ __forceinline__ unsigned xb_ld(unsigned* p)              { return __hip_atomic_load(p, __ATOMIC_RELAXED, __HIP_MEMORY_SCOPE_AGENT); }
__device__ __forceinline__ unsigned xb_add(unsigned* p, unsigned v) { return __hip_atomic_fetch_add(p, v, __ATOMIC_RELAXED, __HIP_MEMORY_SCOPE_AGENT); }
__device__ __forceinline__ unsigned xb_xcc_id() { return (unsigned)__builtin_amdgcn_s_getreg((3 << 11) | 20) & 0xFu; }
#define XB_SPIN(cond, bar) do { unsigned _sp = 0; while (cond) { __builtin_amdgcn_s_sleep(1); \
    if ((++_sp & 255u) == 0u) { if (xb_ld(&(bar)[XB_TMO])) break; if (_sp > XB_SPIN_CAP) { atomicAdd(&(bar)[XB_TMO], 1u); break; } } } } while (0)
struct XcdBarrier { unsigned* bar; unsigned x; volatile LAS unsigned* st; };
__device__ __forceinline__ XcdBarrier xcd_barrier_post(unsigned* bar, volatile LAS unsigned* st) {
    XcdBarrier b; b.bar = bar; b.x = xb_xcc_id(); b.st = st;
    if (threadIdx.x == 0) (void)xb_add(&bar[XB_XCNT(b.x)], 1u);
    return b;
}
__device__ __forceinline__ void xcd_barrier_complete(unsigned* bar, unsigned x, unsigned& nloc, unsigned& nx) {
    const unsigned G = gridDim.x * gridDim.y * gridDim.z;
    unsigned sum, cnt, mine, sp = 0u;
    for (;;) {
        sum = 0u; cnt = 0u; mine = 0u;
#pragma unroll
        for (unsigned j = 0; j < 16; ++j) { const unsigned c = xb_ld(&bar[XB_XCNT(j)]); sum += c; cnt += (c > 0u) ? 1u : 0u; mine = (j == x) ? c : mine; }
        if (sum == G) break;
        __builtin_amdgcn_s_sleep(1);
        if ((++sp & 255u) == 0u) { if (xb_ld(&bar[XB_TMO])) break; if (sp > XB_SPIN_CAP) { atomicAdd(&bar[XB_TMO], 1u); break; } }
    }
    nloc = mine > 0u ? mine : 1u; nx = cnt > 0u ? cnt : 1u;
}
__device__ __forceinline__ void xcd_barrier(const XcdBarrier& b) {
    asm volatile("s_waitcnt vmcnt(0)" ::: "memory");
    __syncthreads();
    if (threadIdx.x == 0) {
        unsigned* bar = b.bar;
        __builtin_amdgcn_s_waitcnt(0);
        unsigned nloc = b.st[0], nx = b.st[1];
        if (nloc == 0u) { xcd_barrier_complete(bar, b.x, nloc, nx); b.st[0] = nloc; b.st[1] = nx; }
        const unsigned old = xb_add(&bar[XB_XSUB(b.x)], 1u);
        const unsigned gen = old / nloc;
        if (old + 1u == (gen + 1u) * nloc) {
            __builtin_amdgcn_fence(__ATOMIC_RELEASE, "agent");
            asm volatile("s_waitcnt vmcnt(0)" ::: "memory");
            const unsigned og = xb_add(&bar[XB_TOP], 1u);
            const unsigned tg = og / nx;
            if (og + 1u == (tg + 1u) * nx) xb_add(&bar[XB_TOPGEN], 1u);
            else XB_SPIN(xb_ld(&bar[XB_TOPGEN]) == tg, bar);
            __builtin_amdgcn_fence(__ATOMIC_ACQUIRE, "agent");
            xb_add(&bar[XB_XGEN(b.x)], 1u);
            asm volatile("s_waitcnt vmcnt(0)" ::: "memory");
        } else {
            XB_SPIN(xb_ld(&bar[XB_XGEN(b.x)]) == gen, bar);
            __builtin_amdgcn_fence(__ATOMIC_ACQUIRE, "agent");
            asm volatile("s_waitcnt vmcnt(0)" ::: "memory");
        }
    }
    __syncthreads();
}

struct Ctx {
    ldsp lds; int tid, lane, wave, G, bid;
    const float* in[22]; float* out; unsigned char* ws;
};
enum { I_X = 0, I_META, I_LNMIX, I_WIN, I_WG2, I_BG, I_GNW, I_CONVW, I_CONVB, I_DTB, I_ALOG, I_DSKIP, I_SNW, I_WUG, I_WUS, I_WOUT, I_LNFFN, I_WQ, I_KEYS, I_PU, I_PV, I_LNF };

using pg8::Unit; using pg8::cvt_pk_bf16;
struct EpiProj {
    static constexpr bool PERM = true, AFTER_DRAIN = false;
    bf16* PJ; float* TL;
    __device__ __forceinline__ void operator()(const f32x4 (&acc)[2][2][4][2], const Unit& u, int wr, int wc, int fr, int fq) const {
        const int row0 = RTOK + u.pm * 256 + wr * 64 + fr; const int pn = u.pn;
        const int mode = pn < 2 ? 1 : (pn < 8 ? 0 : (pn < 20 ? 2 : (pn < 32 ? 0 : 3)));
        const int col0 = pn * 256 + wc * 32 + 8 * fq;
#pragma unroll
        for (int ai = 0; ai < 2; ++ai)
#pragma unroll
            for (int m = 0; m < 4; ++m) { bf16* rowp = PJ + (size_t)(row0 + ai * 128 + m * 16) * NPJ + col0;
#pragma unroll
                for (int bj = 0; bj < 2; ++bj) { f32x4 v0 = acc[ai][bj][m][0], v1 = acc[ai][bj][m][1];
                    if (mode == 1) { v0 = v0 * 0.08838834764831845f; v1 = v1 * 0.08838834764831845f; }
                    else if (mode == 2) {
#pragma unroll
                        for (int j = 0; j < 4; ++j) { v0[j] = siluf_(v0[j]); v1[j] = siluf_(v1[j]); } }
                    else if (mode == 3) {
#pragma unroll
                        for (int j = 0; j < 4; ++j) { v0[j] = sigmoidf_(v0[j]); v1[j] = sigmoidf_(v1[j]); } }
                    v4u w; w.x = cvt_pk_bf16(v0[0], v0[1]); w.y = cvt_pk_bf16(v0[2], v0[3]); w.z = cvt_pk_bf16(v1[0], v1[1]); w.w = cvt_pk_bf16(v1[2], v1[3]);
                    *(GAS v4u*)(rowp + bj * 128) = w; } }
    }
};
struct EpiAny {
    static constexpr bool PERM = true, AFTER_DRAIN = false;
    int mode;
    EpiProj P; bf16* O; const bf16* PJ; const bf16* T; int gcol; const float* X; float* OF; int b; int ldc;
    __device__ __forceinline__ void operator()(const f32x4 (&acc)[2][2][4][2], const Unit& u, int wr, int wc, int fr, int fq) const {
        if (mode == 0) { P(acc, u, wr, wc, fr, fq); return; }
        const int row0 = u.pm * 256 + wr * 64 + fr; const int col0 = u.pn * 256 + wc * 32 + 8 * fq;
        if (mode == 1) {
#pragma unroll
            for (int ai = 0; ai < 2; ++ai)
#pragma unroll
                for (int m = 0; m < 4; ++m) { const size_t r = (size_t)(row0 + ai * 128 + m * 16);
                    v4u gq[2], tq[2];
#pragma unroll
                    for (int bj = 0; bj < 2; ++bj) { gq[bj] = *(const GAS v4u*)(PJ + r * NPJ + gcol + col0 + bj * 128); tq[bj] = T ? *(const GAS v4u*)(T + r * 1024 + col0 + bj * 128) : (v4u){0u, 0u, 0u, 0u}; }
#pragma unroll
                    for (int bj = 0; bj < 2; ++bj) { const int c = col0 + bj * 128;
                        const v4u g = gq[bj];
                        f32x4 v0 = acc[ai][bj][m][0], v1 = acc[ai][bj][m][1];
                        v0[0] *= bflo(g.x); v0[1] *= bfhi(g.x); v0[2] *= bflo(g.y); v0[3] *= bfhi(g.y); v1[0] *= bflo(g.z); v1[1] *= bfhi(g.z); v1[2] *= bflo(g.w); v1[3] *= bfhi(g.w);
                        { const v4u t = tq[bj];
                            v0[0] += bflo(t.x); v0[1] += bfhi(t.x); v0[2] += bflo(t.y); v0[3] += bfhi(t.y); v1[0] += bflo(t.z); v1[1] += bfhi(t.z); v1[2] += bflo(t.w); v1[3] += bfhi(t.w); }
                        v4u w; w.x = cvt_pk_bf16(v0[0], v0[1]); w.y = cvt_pk_bf16(v0[2], v0[3]); w.z = cvt_pk_bf16(v1[0], v1[1]); w.w = cvt_pk_bf16(v1[2], v1[3]);
                        *(GAS v4u*)(O + r * 1024 + c) = w; } }
        } else if (mode == 2) {
#pragma unroll
            for (int ai = 0; ai < 2; ++ai)
#pragma unroll
                for (int m = 0; m < 4; ++m) { const int r = row0 + ai * 128 + m * 16;
                    if (r >= RTOK && r < REND) { const size_t o = ((size_t)b * SEQ + (r - RTOK)) * D + col0;
                        f32x4 xv[2][2];
#pragma unroll
                        for (int bj = 0; bj < 2; ++bj)
#pragma unroll
                            for (int n = 0; n < 2; ++n) xv[bj][n] = *(const GAS f32x4*)(X + o + bj * 128 + n * 4);
#pragma unroll
                        for (int bj = 0; bj < 2; ++bj)
#pragma unroll
                            for (int n = 0; n < 2; ++n) *(GAS f32x4*)(OF + o + bj * 128 + n * 4) = acc[ai][bj][m][n] + xv[bj][n]; } }
        } else {
#pragma unroll
            for (int ai = 0; ai < 2; ++ai)
#pragma unroll
                for (int m = 0; m < 4; ++m) { float* rowp = OF + (size_t)(row0 + ai * 128 + m * 16) * ldc + col0;
#pragma unroll
                    for (int bj = 0; bj < 2; ++bj)
#pragma unroll
                        for (int n = 0; n < 2; ++n) *(GAS f32x4*)(rowp + bj * 128 + n * 4) = acc[ai][bj][m][n]; }
        }
    }
};

struct MapIdent { __device__ __forceinline__ int operator()(int n) const { return n; } };
struct MapW1 { __device__ __forceinline__ int operator()(int n) const {
    if (n < 3072) return n;
    if (n < 8192) return n + 16;
    if (n < 10240) return n + 48;
    if (n < 10256) return n - 10240 + 3072;
    if (n < 10288) return n - 10256 + 8208;
    return -1; } };
template <class Map>
__device__ __forceinline__ void transpose_item(const float* W, int K, int NS, int N, bf16* WT, LAS float* scr, int item, int lane, const Map& map) {
    const int nblk = N / 32, kb = item / nblk, nb = item % nblk, k0 = 64 * kb, n0 = 32 * nb;
    const int sc = map(n0 + (lane & 31));
#pragma unroll
    for (int i0 = 0; i0 < 32; i0 += 16) { float tv[16];
#pragma unroll
        for (int i = 0; i < 16; ++i) { const int kk = 2 * (i0 + i) + (lane >> 5); tv[i] = sc >= 0 ? *(const GAS float*)(W + (size_t)(k0 + kk) * NS + sc) : 0.f; }
#pragma unroll
        for (int i = 0; i < 16; ++i) { const int kk = 2 * (i0 + i) + (lane >> 5); scr[kk * 33 + (lane & 31)] = tv[i]; } }
    LDS_WAIT(); asm volatile("" ::: "memory");
    const int c = lane & 7;
#pragma unroll
    for (int j = 0; j < 4; ++j) { const int n = (lane >> 3) + 8 * j; const LAS float* s = scr + (8 * c) * 33 + n;
        v4u o; o.x = pk2(s[0 * 33], s[1 * 33]); o.y = pk2(s[2 * 33], s[3 * 33]); o.z = pk2(s[4 * 33], s[5 * 33]); o.w = pk2(s[6 * 33], s[7 * 33]);
        *(GAS v4u*)(WT + (size_t)(n0 + n) * K + k0 + 8 * c) = o; }
    LDS_WAIT(); asm volatile("" ::: "memory");
}
__device__ __forceinline__ void norm_row_bf16(const float* src, const float* w, bf16* dst, int lane) {
    v2u* o8 = (v2u*)dst + lane;
    if (src == nullptr) {
#pragma unroll
        for (int j = 0; j < 4; ++j) o8[64 * j] = (v2u){0u, 0u};
        return; }
    const f32x4* xr = (const f32x4*)src + lane; const f32x4* wr_ = (const f32x4*)w + lane;
    f32x4 v[4]; float s = 0.f;
#pragma unroll
    for (int j = 0; j < 4; ++j) { v[j] = xr[64 * j]; s += (v[j].x * v[j].x + v[j].y * v[j].y) + (v[j].z * v[j].z + v[j].w * v[j].w); }
    const float rs = rsqrtf(wave_sum(s) * (1.f / D) + RMS_EPS);
#pragma unroll
    for (int j = 0; j < 4; ++j) { const f32x4 ww = wr_[64 * j]; v2u o; o.x = pk2(v[j].x * rs * ww.x, v[j].y * rs * ww.y); o.y = pk2(v[j].z * rs * ww.z, v[j].w * rs * ww.w); o8[64 * j] = o; }
}
__device__ __forceinline__ float wave_sum63(float v) {
    v += __builtin_bit_cast(float, __builtin_amdgcn_mov_dpp(__builtin_bit_cast(int, v), 0xB1, 0xf, 0xf, true));
    v += __builtin_bit_cast(float, __builtin_amdgcn_mov_dpp(__builtin_bit_cast(int, v), 0x4E, 0xf, 0xf, true));
    v += __builtin_bit_cast(float, __builtin_amdgcn_mov_dpp(__builtin_bit_cast(int, v), 0x141, 0xf, 0xf, true));
    v += __builtin_bit_cast(float, __builtin_amdgcn_mov_dpp(__builtin_bit_cast(int, v), 0x128, 0xf, 0xf, true));
    v += __builtin_bit_cast(float, __builtin_amdgcn_update_dpp(0, __builtin_bit_cast(int, v), 0x142, 0xa, 0xf, false));
    v += __builtin_bit_cast(float, __builtin_amdgcn_update_dpp(0, __builtin_bit_cast(int, v), 0x143, 0xc, 0xf, false));
    return v;
}
__device__ __forceinline__ void hn_token_rows2(const Ctx& C, int b, int s0, int s1) {
    const int lane = C.lane;
    const f32x4* x0 = (const f32x4*)(C.in[I_X] + ((size_t)b * SEQ + s0) * D) + lane; const f32x4* x1 = (const f32x4*)(C.in[I_X] + ((size_t)b * SEQ + s1) * D) + lane;
    const f32x4* wr_ = (const f32x4*)C.in[I_LNMIX] + lane;
    f32x4 v[4], u[4]; float q0 = 0.f, q1 = 0.f;
#pragma unroll
    for (int j = 0; j < 4; ++j) { v[j] = x0[64 * j]; u[j] = x1[64 * j]; }
#pragma unroll
    for (int j = 0; j < 4; ++j) { q0 += (v[j].x * v[j].x + v[j].y * v[j].y) + (v[j].z * v[j].z + v[j].w * v[j].w); q1 += (u[j].x * u[j].x + u[j].y * u[j].y) + (u[j].z * u[j].z + u[j].w * u[j].w); }
    const float r0 = rsqrtf(wave_sum(q0) * (1.f / D) + RMS_EPS), r1 = rsqrtf(wave_sum(q1) * (1.f / D) + RMS_EPS);
    v2u* o0 = (v2u*)((bf16*)(C.ws + WS_HN) + (size_t)s0 * D) + lane; v2u* o1 = (v2u*)((bf16*)(C.ws + WS_HN) + (size_t)s1 * D) + lane;
#pragma unroll
    for (int j = 0; j < 4; ++j) { const f32x4 ww = wr_[64 * j]; const f32x4 a = v[j] * r0 * ww, bq = u[j] * r1 * ww;
        o0[64 * j] = (v2u){pk2(a.x, a.y), pk2(a.z, a.w)}; o1[64 * j] = (v2u){pk2(bq.x, bq.y), pk2(bq.z, bq.w)}; }
}
__device__ __forceinline__ void hn_batch(const Ctx& C, int b, int first_blk) {
    if (C.bid < first_blk) return;
    const int gw = (C.bid - first_blk) * NWAVES + C.wave, NGW = (C.G - first_blk) * NWAVES;
    for (int s = gw; s < SEQ / 2; s += NGW) hn_token_rows2(C, b, s, s + SEQ / 2);
}
__device__ __forceinline__ void meta_proj(const Ctx& C) {
    const bf16* HNM = (const bf16*)(C.ws + WS_HNM); const bf16* W1T = (const bf16*)(C.ws + WS_W1T);
    bf16* PJ = (bf16*)(C.ws + WS_PJ); float* TL = (float*)(C.ws + WS_TL);
    const int gw = C.bid * NWAVES + C.wave, NGW = C.G * NWAVES, fr = C.lane & 15, fq = C.lane >> 4;
    for (int nt = gw; nt < 643; nt += NGW) {
        f32x4 acc = {0.f, 0.f, 0.f, 0.f};
#pragma unroll 8
        for (int ks = 0; ks < 32; ++ks) acc = mma16(*(const GAS bf16x8*)(HNM + fr * D + 32 * ks + 8 * fq), *(const GAS bf16x8*)(W1T + (size_t)(16 * nt + fr) * D + 32 * ks + 8 * fq), acc);
        const int n = 16 * nt + 4 * fq;
        if (n >= NPJ) { if (n < NPJ + 48) *(GAS f32x4*)(TL + (size_t)(RFRONT + fr) * 48 + (n - NPJ)) = acc; continue; }
        if (n < 512) acc = acc * 0.08838834764831845f;
        else if ((n >= PJ_GO && n < PJ_XBC)) { acc[0] = siluf_(acc[0]); acc[1] = siluf_(acc[1]); acc[2] = siluf_(acc[2]); acc[3] = siluf_(acc[3]); }
        else if (n >= PJ_GA) { acc[0] = sigmoidf_(acc[0]); acc[1] = sigmoidf_(acc[1]); acc[2] = sigmoidf_(acc[2]); acc[3] = sigmoidf_(acc[3]); }
        *(GAS v2u*)(PJ + (size_t)(RFRONT + fr) * NPJ + n) = (v2u){pk2(acc[0], acc[1]), pk2(acc[2], acc[3])};
    }
}
__device__ __forceinline__ void tail_proj(const Ctx& C) {
    int tid_ = C.tid; asm volatile("" : "+v"(tid_));
    const int lane_ = tid_ & 63, wave_ = __builtin_amdgcn_readfirstlane(tid_ >> 6), fr = lane_ & 15, fq = lane_ >> 4;
    const bf16* HN = (const bf16*)(C.ws + WS_HN); const bf16* WT = (const bf16*)(C.ws + WS_W1T) + (size_t)NPJ * D; float* TL = (float*)(C.ws + WS_TL);
    constexpr int PW = 2064;
    ldsp WL = C.lds; LAS f32x4* PR = (LAS f32x4*)(C.lds + 48 * PW);
    { v4u ww[12];
#pragma unroll
      for (int i = 0; i < 12; ++i) { const int e = tid_ + NT * i, row = e >> 7, ch = e & 127; ww[i] = *(const GAS v4u*)(WT + (size_t)row * D + 8 * ch); }
#pragma unroll
      for (int i = 0; i < 12; ++i) { const int e = tid_ + NT * i, row = e >> 7, ch = e & 127; *(LAS v4u*)(WL + row * PW + ch * 16) = ww[i]; } }
    const int rsel = wave_ & 1, kq = wave_ >> 1;
    for (int rp = C.bid; rp < SEQ / 32; rp += C.G) {
        const int rt = 2 * rp + rsel;
        bf16x8 a[8];
#pragma unroll
        for (int i = 0; i < 8; ++i) a[i] = *(const GAS bf16x8*)(HN + (size_t)(16 * rt + fr) * D + 32 * (8 * kq + i) + 8 * fq);
        __syncthreads();
        f32x4 acc[3] = {{0.f, 0.f, 0.f, 0.f}, {0.f, 0.f, 0.f, 0.f}, {0.f, 0.f, 0.f, 0.f}};
#pragma unroll
        for (int i = 0; i < 8; ++i)
#pragma unroll
            for (int n = 0; n < 3; ++n) acc[n] = mma16(a[i], lds_frag(WL + (16 * n + fr) * PW + (32 * (8 * kq + i) + 8 * fq) * 2), acc[n]);
#pragma unroll
        for (int n = 0; n < 3; ++n) PR[(wave_ * 3 + n) * 64 + lane_] = acc[n];
        __syncthreads();
        if (wave_ < 2) {
#pragma unroll
            for (int n = 0; n < 3; ++n) { f32x4 s = PR[((0 * 2 + wave_) * 3 + n) * 64 + lane_] + PR[((1 * 2 + wave_) * 3 + n) * 64 + lane_] + PR[((2 * 2 + wave_) * 3 + n) * 64 + lane_] + PR[((3 * 2 + wave_) * 3 + n) * 64 + lane_];
                *(GAS f32x4*)(TL + (size_t)(RTOK + 16 * (2 * rp + wave_) + fr) * 48 + 16 * n + 4 * fq) = s; }
        }
    }
    __syncthreads();
}
__device__ __forceinline__ void p0b_prologue(const Ctx& C) {
    const int gw = C.bid * NWAVES + C.wave;
    if (gw < NMETA) norm_row_bf16(C.in[I_META] + (size_t)gw * D, C.in[I_LNMIX], (bf16*)(C.ws + WS_HNM) + (size_t)gw * D, C.lane);
    { v4u* z = (v4u*)(C.ws + WS_PJ); const size_t n = (size_t)RFRONT * NPJ * 2 / 16; for (size_t i = (size_t)C.bid * NT + C.tid; i < n; i += (size_t)C.G * NT) z[i] = (v4u){0u, 0u, 0u, 0u}; }
    { v4u* z = (v4u*)(C.ws + WS_TL); const size_t n = (size_t)RFRONT * 48 * 4 / 16; for (size_t i = (size_t)C.bid * NT + C.tid; i < n; i += (size_t)C.G * NT) z[i] = (v4u){0u, 0u, 0u, 0u}; }
    hn_batch(C, 0, 0);
}
__device__ __forceinline__ void weff_unit(const Ctx& C, int unit) {
    int tid_ = C.tid; asm volatile("" : "+v"(tid_));
    const int lane_ = tid_ & 63, wave_ = __builtin_amdgcn_readfirstlane(tid_ >> 6); (void)lane_; (void)wave_;
    const int blk = unit >> 4, d0 = (unit & 15) * 64;
    LAS float* KT = (LAS float*)C.lds;
    LAS float* WQ = (LAS float*)(C.lds + 128 * 132 * 4);
    const float* keys = C.in[I_KEYS] + (size_t)blk * 128 * 128; const float* wq = C.in[I_WQ];
    { f32x4 kv_[8];
#pragma unroll
      for (int i = 0; i < 8; ++i) { const int e = tid_ + NT * i, key = e >> 5, j4 = e & 31; kv_[i] = *(const GAS f32x4*)(keys + key * 128 + 4 * j4); }
#pragma unroll
      for (int i = 0; i < 8; ++i) { const int e = tid_ + NT * i, key = e >> 5, j4 = e & 31; *(LAS f32x4*)(KT + key * 132 + 4 * j4) = kv_[i]; } }
    { f32x4 wv_[4];
#pragma unroll
      for (int i = 0; i < 4; ++i) { const int e = tid_ + NT * i, dd = e >> 5, j4 = e & 31; wv_[i] = *(const GAS f32x4*)(wq + (size_t)(d0 + dd) * 2048 + blk * 128 + 4 * j4); }
#pragma unroll
      for (int i = 0; i < 4; ++i) { const int e = tid_ + NT * i, dd = e >> 5, j4 = e & 31; *(LAS f32x4*)(WQ + dd * 128 + 4 * j4) = wv_[i]; } }
    __syncthreads();
    const int key = tid_ & 127, dg = tid_ >> 7;
    float acc[16];
#pragma unroll
    for (int i = 0; i < 16; ++i) acc[i] = 0.f;
    for (int j4 = 0; j4 < 32; ++j4) {
        const f32x4 kv = *(const LAS f32x4*)(KT + key * 132 + 4 * j4);
#pragma unroll
        for (int i = 0; i < 16; ++i) { const f32x4 wv = *(const LAS f32x4*)(WQ + (dg * 16 + i) * 128 + 4 * j4); acc[i] += kv.x * wv.x + kv.y * wv.y + kv.z * wv.z + kv.w * wv.w; }
    }
    bf16* WET = (bf16*)(C.ws + WS_WET) + (size_t)(blk * 128 + key) * D + d0 + dg * 16;
    v4u o0, o1; o0.x = pk2(acc[0], acc[1]); o0.y = pk2(acc[2], acc[3]); o0.z = pk2(acc[4], acc[5]); o0.w = pk2(acc[6], acc[7]);
    o1.x = pk2(acc[8], acc[9]); o1.y = pk2(acc[10], acc[11]); o1.z = pk2(acc[12], acc[13]); o1.w = pk2(acc[14], acc[15]);
    *(v4u*)WET = o0; *(GAS v4u*)(WET + 8) = o1;
    __syncthreads();
}
__device__ __forceinline__ void p0_prologue(const Ctx& C) {
    LAS float* scr = (LAS float*)(C.lds + C.wave * 16384);
    const int gw = C.bid * NWAVES + C.wave, NGW = C.G * NWAVES;
    constexpr int I_1 = (D / 64) * (N1 / 32), I_A = (1024 / 64) * (1024 / 32), I_B = (2048 / 64) * (1024 / 32), I_O = I_A;
    constexpr int NITEMS = I_1 + I_A + I_B + I_O;
    for (int it = gw; it < NITEMS; it += NGW) {
        int r = it;
        if (r < I_1) { transpose_item(C.in[I_WIN], 1024, 10288, N1, (bf16*)(C.ws + WS_W1T), scr, r, C.lane, MapW1()); continue; } r -= I_1;
        if (r < I_A) { transpose_item(C.in[I_WUG], 1024, 1024, 1024, (bf16*)(C.ws + WS_WAT), scr, r, C.lane, MapIdent()); continue; } r -= I_A;
        if (r < I_B) { transpose_item(C.in[I_WUS], 2048, 1024, 1024, (bf16*)(C.ws + WS_WBT), scr, r, C.lane, MapIdent()); continue; } r -= I_B;
        transpose_item(C.in[I_WOUT], 1024, 1024, 1024, (bf16*)(C.ws + WS_WOT), scr, r, C.lane, MapIdent());
    }
    __syncthreads();
    for (int u = C.bid; u < 256; u += C.G) weff_unit(C, u);
}

__device__ __forceinline__ float softplusf_(float x) { return fmaxf(x, 0.f) + log1pf(__expf(-fabsf(x))); }
__device__ __forceinline__ void conv_batch(const Ctx& C) {
    const bf16* PJ = (const bf16*)(C.ws + WS_PJ); bf16* XC = (bf16*)(C.ws + WS_XC);
    const float* cw = C.in[I_CONVW]; const float* cb = C.in[I_CONVB];
    constexpr int SL = 25, NSEG = (REND + SL - 1) / SL, NITEM = 384 * NSEG;
    for (int id = C.bid * NT + C.tid; id < NITEM; id += C.G * NT) {
        const int ch = id % 384, seg = id / 384, col = 8 * ch, rb = SL * seg;
        v4u xr[SL + 3];
#pragma unroll
        for (int t = 0; t < SL + 3; ++t) { const int r = rb - 3 + t; xr[t] = (r >= 0 && r < REND) ? *(const GAS v4u*)(PJ + (size_t)r * NPJ + PJ_XBC + col) : (v4u){0u, 0u, 0u, 0u}; }
        f32x4 w[4][2], bb[2];
#pragma unroll
        for (int i = 0; i < 4; ++i) { w[i][0] = *(const GAS f32x4*)(cw + i * 3072 + col); w[i][1] = *(const GAS f32x4*)(cw + i * 3072 + col + 4); }
        bb[0] = *(const GAS f32x4*)(cb + col); bb[1] = *(const GAS f32x4*)(cb + col + 4);
#pragma unroll
        for (int t = 0; t < SL; ++t) {
            f32x4 o0 = bb[0], o1 = bb[1];
#pragma unroll
            for (int i = 0; i < 4; ++i) { const v4u x = xr[t + i];
                o0 += w[i][0] * (f32x4){bflo(x.x), bfhi(x.x), bflo(x.y), bfhi(x.y)}; o1 += w[i][1] * (f32x4){bflo(x.z), bfhi(x.z), bflo(x.w), bfhi(x.w)}; }
            v4u o = {pk2(siluf_(o0.x), siluf_(o0.y)), pk2(siluf_(o0.z), siluf_(o0.w)), pk2(siluf_(o1.x), siluf_(o1.y)), pk2(siluf_(o1.z), siluf_(o1.w))};
            if (rb + t < RFRONT) o = (v4u){0u, 0u, 0u, 0u};
            if (rb + t < REND) *(GAS v4u*)(XC + (size_t)(rb + t) * 3072 + col) = o;
        }
    }
}
__device__ __forceinline__ void phaseC_unit(const Ctx& C, int c, int k) {
    int tid_ = C.tid; asm volatile("" : "+v"(tid_));
    const int lane_ = tid_ & 63, wave_ = __builtin_amdgcn_readfirstlane(tid_ >> 6); (void)lane_; (void)wave_;
    const bf16* PJ = (const bf16*)(C.ws + WS_PJ); const float* TL = (const float*)(C.ws + WS_TL);
    bf16* XC = (bf16*)(C.ws + WS_XC); float* GG = (float*)(C.ws + WS_GG); float* DT = (float*)(C.ws + WS_DT); float* AC = (float*)(C.ws + WS_AC);
    const int r0 = 64 * c;
    if (k < 6) {
        const float* cw = C.in[I_CONVW]; const float* cb = C.in[I_CONVB];
        const int col = 512 * k + 2 * (tid_ & 255), rb = r0 + 32 * (tid_ >> 8);
        const f32x2 w0 = *(const GAS f32x2*)(cw + col), w1 = *(const GAS f32x2*)(cw + 3072 + col), w2 = *(const GAS f32x2*)(cw + 2 * 3072 + col), w3 = *(const GAS f32x2*)(cw + 3 * 3072 + col), bb = *(const GAS f32x2*)(cb + col);
        unsigned xr[35];
#pragma unroll
        for (int t = 0; t < 35; ++t) { const int r = rb - 3 + t; xr[t] = (r >= 0) ? *(const GAS unsigned*)(PJ + (size_t)r * NPJ + PJ_XBC + col) : 0u; }
#pragma unroll
        for (int t = 0; t < 32; ++t) {
            const int r = rb + t;
            const f32x2 xm3 = {bflo(xr[t]), bfhi(xr[t])}, xm2 = {bflo(xr[t + 1]), bfhi(xr[t + 1])}, xm1 = {bflo(xr[t + 2]), bfhi(xr[t + 2])}, x0 = {bflo(xr[t + 3]), bfhi(xr[t + 3])};
            f32x2 o = bb + w0 * xm3 + w1 * xm2 + w2 * xm1 + w3 * x0;
            o.x = siluf_(o.x); o.y = siluf_(o.y);
            if (r < RFRONT) { o.x = 0.f; o.y = 0.f; }
            *(GAS unsigned*)(XC + (size_t)r * 3072 + col) = pk2(o.x, o.y);
        }
        return;
    }
    if (k < 10) {
        const int col = 128 * (k - 6) + (tid_ & 127), rq = tid_ >> 7; const float* w2p = C.in[I_WG2]; float w2[16];
        LAS float* PS = (LAS float*)C.lds;
#pragma unroll
        for (int j = 0; j < 16; ++j) w2[j] = w2p[j * 512 + col];
        const float bg = C.in[I_BG][col]; float G = 0.f; float gv[16];
#pragma unroll
        for (int t = 0; t < 16; ++t) {
            const int r = r0 + 16 * rq + t; const float* gl = TL + (size_t)r * 48;
            float z = bg;
#pragma unroll
            for (int j4 = 0; j4 < 4; ++j4) { const f32x4 g = *(const GAS f32x4*)(gl + 4 * j4); z += g.x * w2[4 * j4] + g.y * w2[4 * j4 + 1] + g.z * w2[4 * j4 + 2] + g.w * w2[4 * j4 + 3]; }
            float ls = fminf(z, 0.f) - __logf(1.f + __expf(-fabsf(z)));
            if (r < RFRONT) ls = 0.f;
            G += ls * (1.f / 16.f); gv[t] = G;
        }
        PS[rq * 128 + (tid_ & 127)] = G;
        __syncthreads();
        float base = 0.f;
#pragma unroll
        for (int q = 0; q < 3; ++q) base += (q < rq) ? PS[q * 128 + (tid_ & 127)] : 0.f;
#pragma unroll
        for (int t = 0; t < 16; ++t) GG[(size_t)(r0 + 16 * rq + t) * 512 + col] = gv[t] + base;
        __syncthreads();
        return;
    }
    {
        const int hd = tid_ & 31, rg = tid_ >> 5; const float bias = C.in[I_DTB][hd], A = -__expf(C.in[I_ALOG][hd]);
        LAS float* PS = (LAS float*)C.lds;
        float dtv[4], av[4], acum = 0.f;
#pragma unroll
        for (int t = 0; t < 4; ++t) {
            const int r = r0 + 4 * rg + t; const float x = TL[(size_t)r * 48 + 16 + hd] + bias;
            float dt = fmaxf(x, 0.f) + __logf(1.f + __expf(-fabsf(x)));
            if (r < RFRONT) dt = 0.f;
            acum += A * dt; dtv[t] = dt; av[t] = acum;
        }
        PS[rg * 32 + hd] = acum;
        __syncthreads();
        float base = 0.f;
#pragma unroll
        for (int q = 0; q < 15; ++q) base += (q < rg) ? PS[q * 32 + hd] : 0.f;
#pragma unroll
        for (int t = 0; t < 4; ++t) { const size_t r = (size_t)(r0 + 4 * rg + t); DT[r * 32 + hd] = dtv[t]; AC[r * 32 + hd] = av[t] + base; }
        __syncthreads();
    }
}

constexpr int P136 = 272, P264 = 528, P520 = 1040, P72 = 144;
__device__ __forceinline__ void gla_pass1_unit(const Ctx& C, int c, int h) {
    int tid_ = C.tid; asm volatile("" : "+v"(tid_));
    const int lane_ = tid_ & 63, wave_ = __builtin_amdgcn_readfirstlane(tid_ >> 6); (void)lane_; (void)wave_;
    const bf16* PJ = (const bf16*)(C.ws + WS_PJ); const float* GG = (const float*)(C.ws + WS_GG); bf16* LG = (bf16*)(C.ws + WS_LG);
    ldsp KD = C.lds, VT = C.lds + 64 * P136;
    const int r0 = 64 * c;
    v4u ka_[2], vv[4]; f32x4 a0_[2], a1_[2], l0_[2], l1_[2];
#pragma unroll
    for (int i = 0; i < 2; ++i) { const int e = tid_ + NT * i, s = e >> 4, k0 = (e & 15) * 8; const size_t r = (size_t)(r0 + s);
        ka_[i] = *(const GAS v4u*)(PJ + r * NPJ + PJ_K + 128 * h + k0);
        const float* g = GG + r * 512 + 128 * h + k0; const float* gl = GG + (size_t)(r0 + 63) * 512 + 128 * h + k0;
        a0_[i] = *(const GAS f32x4*)g; a1_[i] = *(const GAS f32x4*)(g + 4); l0_[i] = *(const GAS f32x4*)gl; l1_[i] = *(const GAS f32x4*)(gl + 4); }
#pragma unroll
    for (int i = 0; i < 4; ++i) { const int e = tid_ + NT * i, s = e >> 5, v0 = (e & 31) * 8; vv[i] = *(const GAS v4u*)(PJ + (size_t)(r0 + s) * NPJ + PJ_V + 256 * h + v0); }
#pragma unroll
    for (int i = 0; i < 2; ++i) {
        const int e = tid_ + NT * i, s = e >> 4, k0 = (e & 15) * 8;
        const v4u ka = ka_[i]; const f32x4 a0 = a0_[i], a1 = a1_[i], l0 = l0_[i], l1 = l1_[i];
        v4u o;
        o.x = pk2(bflo(ka.x) * __expf(l0.x - a0.x), bfhi(ka.x) * __expf(l0.y - a0.y)); o.y = pk2(bflo(ka.y) * __expf(l0.z - a0.z), bfhi(ka.y) * __expf(l0.w - a0.w));
        o.z = pk2(bflo(ka.z) * __expf(l1.x - a1.x), bfhi(ka.z) * __expf(l1.y - a1.y)); o.w = pk2(bflo(ka.w) * __expf(l1.z - a1.z), bfhi(ka.w) * __expf(l1.w - a1.w));
        *(LAS v4u*)(KD + s * P136 + k0 * 2) = o;
    }
#pragma unroll
    for (int i = 0; i < 4; ++i) { const int e = tid_ + NT * i, s = e >> 5, v0 = (e & 31) * 8; *(LAS v4u*)(VT + s * P264 + v0 * 2) = vv[i]; }
    __syncthreads();
    const int fr = lane_ & 15, fq = lane_ >> 4, w = wave_;
    f32x4 acc[2][8];
#pragma unroll
    for (int mi = 0; mi < 2; ++mi)
#pragma unroll
        for (int nt = 0; nt < 8; ++nt) acc[mi][nt] = (f32x4){0.f, 0.f, 0.f, 0.f};
#pragma unroll
    for (int ks = 0; ks < 2; ++ks) {
        bf16x8 af[2];
#pragma unroll
        for (int mi = 0; mi < 2; ++mi) af[mi] = tr_frag(VT, P264, 32 * ks, 32 * w + 16 * mi, fr, fq);
#pragma unroll
        for (int nt = 0; nt < 8; ++nt) { const bf16x8 bfm = tr_frag(KD, P136, 32 * ks, 16 * nt, fr, fq);
#pragma unroll
            for (int mi = 0; mi < 2; ++mi) acc[mi][nt] = mma16(af[mi], bfm, acc[mi][nt]); }
    }
    bf16* Lb = LG + ((size_t)(c * 4 + h) * 256) * 128;
#pragma unroll
    for (int mi = 0; mi < 2; ++mi)
#pragma unroll
        for (int nt = 0; nt < 8; ++nt) { const int v = 32 * w + 16 * mi + fr, k = 16 * nt + 4 * fq; const f32x4 a = acc[mi][nt];
            *(GAS v2u*)(Lb + (size_t)v * 128 + k) = (v2u){cvt_pk_bf16(a[0], a[1]), cvt_pk_bf16(a[2], a[3])}; }
    __syncthreads();
}
__device__ __forceinline__ void ssd_pass1_unit(const Ctx& C, int c, int g) {
    int tid_ = C.tid; asm volatile("" : "+v"(tid_));
    const int lane_ = tid_ & 63, wave_ = __builtin_amdgcn_readfirstlane(tid_ >> 6); (void)lane_; (void)wave_;
    const bf16* XC = (const bf16*)(C.ws + WS_XC); const float* DT = (const float*)(C.ws + WS_DT); const float* AC = (const float*)(C.ws + WS_AC); bf16* LS = (bf16*)(C.ws + WS_LS);
    ldsp XW = C.lds, BM = C.lds + 64 * P520;
    const int r0 = 64 * c;
    { const int ch = tid_ & 63, hd = 8 * g + (ch >> 3); const float al = AC[(size_t)(r0 + 63) * 32 + hd];
      v4u xx[8], bb[2]; float dd[8], aa[8];
#pragma unroll
      for (int i = 0; i < 8; ++i) { const size_t r = (size_t)(r0 + (tid_ >> 6) + 8 * i); xx[i] = *(const GAS v4u*)(XC + r * 3072 + 512 * g + 8 * ch); dd[i] = DT[r * 32 + hd]; aa[i] = AC[r * 32 + hd]; }
#pragma unroll
      for (int i = 0; i < 2; ++i) { const int e = tid_ + NT * i, s = e >> 4, c2 = e & 15; bb[i] = *(const GAS v4u*)(XC + (size_t)(r0 + s) * 3072 + 2048 + 128 * g + 8 * c2); }
#pragma unroll
      for (int i = 0; i < 2; ++i) { const int e = tid_ + NT * i, s = e >> 4, c2 = e & 15; *(LAS v4u*)(BM + s * P136 + c2 * 16) = bb[i]; }
#pragma unroll
      for (int i = 0; i < 8; ++i) { const int s = (tid_ >> 6) + 8 * i;
        const float sc = dd[i] * __expf(al - aa[i]); const v4u x = xx[i]; v4u o;
        o.x = pk2(bflo(x.x) * sc, bfhi(x.x) * sc); o.y = pk2(bflo(x.y) * sc, bfhi(x.y) * sc); o.z = pk2(bflo(x.z) * sc, bfhi(x.z) * sc); o.w = pk2(bflo(x.w) * sc, bfhi(x.w) * sc);
        *(LAS v4u*)(XW + s * P520 + ch * 16) = o; } }
    __syncthreads();
    const int fr = lane_ & 15, fq = lane_ >> 4, w = wave_;
    bf16* Lb = LS + ((size_t)(c * 32 + 8 * g + w) * 64) * 128;
#pragma unroll
    for (int nh = 0; nh < 2; ++nh) {
        f32x4 acc[4][4];
#pragma unroll
        for (int mi = 0; mi < 4; ++mi)
#pragma unroll
            for (int nt = 0; nt < 4; ++nt) acc[mi][nt] = (f32x4){0.f, 0.f, 0.f, 0.f};
#pragma unroll
        for (int ks = 0; ks < 2; ++ks) {
            bf16x8 af[4];
#pragma unroll
            for (int mi = 0; mi < 4; ++mi) af[mi] = tr_frag(XW, P520, 32 * ks, 64 * w + 16 * mi, fr, fq);
#pragma unroll
            for (int nt = 0; nt < 4; ++nt) { const bf16x8 bfm = tr_frag(BM, P136, 32 * ks, 64 * nh + 16 * nt, fr, fq);
#pragma unroll
                for (int mi = 0; mi < 4; ++mi) acc[mi][nt] = mma16(af[mi], bfm, acc[mi][nt]); }
        }
#pragma unroll
        for (int mi = 0; mi < 4; ++mi)
#pragma unroll
            for (int nt = 0; nt < 4; ++nt) { const int p = 16 * mi + fr, n = 64 * nh + 16 * nt + 4 * fq; const f32x4 a = acc[mi][nt];
                *(GAS v2u*)(Lb + (size_t)p * 128 + n) = (v2u){cvt_pk_bf16(a[0], a[1]), cvt_pk_bf16(a[2], a[3])}; }
    }
    __syncthreads();
}

__device__ __forceinline__ void phaseE(const Ctx& C) {
    const float* GG = (const float*)(C.ws + WS_GG); const float* AC = (const float*)(C.ws + WS_AC);
    constexpr int NB = 8;
    for (int vb = C.bid; vb < 256; vb += C.G) {
        if (vb < 128) {
            const int e = vb * NT + C.tid, k2 = e & 63, v = (e >> 6) & 255, h = e >> 14;
            GAS unsigned* Lp = (GAS unsigned*)(C.ws + WS_LG) + ((size_t)h * 256 + v) * 64 + k2;
            const GAS float* dp = (const GAS float*)GG + 63 * 512 + 128 * h + 2 * k2;
            float s0 = 0.f, s1 = 0.f;
            unsigned l[2][NB]; f32x2 d[2][NB];
#pragma unroll
            for (int i = 0; i < NB; ++i) { l[0][i] = Lp[(size_t)i * (4 * 256 * 64)]; d[0][i] = *(const GAS f32x2*)(dp + (size_t)i * 64 * 512); }
#pragma unroll 1
            for (int c0 = 0; c0 < NCHUNK; c0 += 2 * NB) {
#pragma unroll
                for (int hb = 0; hb < 2; ++hb) {
                    const int cb = c0 + hb * NB, cn = cb + NB;
#pragma unroll
                    for (int i = 0; i < NB; ++i) if (cn + i < NCHUNK) { l[hb ^ 1][i] = Lp[(size_t)(cn + i) * (4 * 256 * 64)]; d[hb ^ 1][i] = *(const GAS f32x2*)(dp + (size_t)(cn + i) * 64 * 512); }
#pragma unroll
                    for (int i = 0; i < NB; ++i) if (cb + i < NCHUNK) {
                        Lp[(size_t)(cb + i) * (4 * 256 * 64)] = pk2(s0, s1);
                        s0 = s0 * __expf(d[hb][i].x) + bflo(l[hb][i]); s1 = s1 * __expf(d[hb][i].y) + bfhi(l[hb][i]); }
                }
            }
        } else {
            const int e = (vb - 128) * NT + C.tid, n4 = e & 31, p = (e >> 5) & 63, hd = e >> 11;
            GAS v2u* Lp = (GAS v2u*)(C.ws + WS_LS) + ((size_t)hd * 64 + p) * 32 + n4;
            const GAS float* dp = (const GAS float*)AC + 63 * 32 + hd;
            float s0 = 0.f, s1 = 0.f, s2 = 0.f, s3 = 0.f;
            v2u l[2][NB]; float d[2][NB];
#pragma unroll
            for (int i = 0; i < NB; ++i) { l[0][i] = Lp[(size_t)i * (32 * 64 * 32)]; d[0][i] = dp[(size_t)i * 64 * 32]; }
#pragma unroll 1
            for (int c0 = 0; c0 < NCHUNK; c0 += 2 * NB) {
#pragma unroll
                for (int hb = 0; hb < 2; ++hb) {
                    const int cb = c0 + hb * NB, cn = cb + NB;
#pragma unroll
                    for (int i = 0; i < NB; ++i) if (cn + i < NCHUNK) { l[hb ^ 1][i] = Lp[(size_t)(cn + i) * (32 * 64 * 32)]; d[hb ^ 1][i] = dp[(size_t)(cn + i) * 64 * 32]; }
#pragma unroll
                    for (int i = 0; i < NB; ++i) if (cb + i < NCHUNK) {
                        Lp[(size_t)(cb + i) * (32 * 64 * 32)] = (v2u){pk2(s0, s1), pk2(s2, s3)};
                        const float dd = __expf(d[hb][i]);
                        s0 = s0 * dd + bflo(l[hb][i].x); s1 = s1 * dd + bfhi(l[hb][i].x); s2 = s2 * dd + bflo(l[hb][i].y); s3 = s3 * dd + bfhi(l[hb][i].y); }
                }
            }
        }
    }
}

__device__ __forceinline__ void gla_pass3_unit(const Ctx& C, int c, int h) {
    int tid_ = C.tid; asm volatile("" : "+v"(tid_));
    const int lane_ = tid_ & 63, wave_ = __builtin_amdgcn_readfirstlane(tid_ >> 6); (void)lane_; (void)wave_;
    const bf16* PJ = (const bf16*)(C.ws + WS_PJ); const float* GG = (const float*)(C.ws + WS_GG); const bf16* LG = (const bf16*)(C.ws + WS_LG); bf16* OG = (bf16*)(C.ws + WS_OG);
    ldsp QE = C.lds, QN = QE + 64 * P136, KE = QN + 64 * P136, KN = KE + 64 * P136, VT = KN + 64 * P136, ATT = VT + 64 * P264;
    LAS float* RED = (LAS float*)(ATT + 64 * P72);
    const int r0 = 64 * c;
    bf16x8 sfr[4][2];
    { const bf16* Sb = LG + ((size_t)(c * 4 + h) * 256) * 128; const int fr_ = lane_ & 15, fq_ = lane_ >> 4;
#pragma unroll
      for (int ks = 0; ks < 4; ++ks)
#pragma unroll
        for (int nt = 0; nt < 2; ++nt) sfr[ks][nt] = *(const GAS bf16x8*)(Sb + (size_t)(32 * wave_ + 16 * nt + fr_) * 128 + 32 * ks + 8 * fq_); }
    v4u qa_[2], ka_[2]; f32x4 g0_[2], g1_[2];
#pragma unroll
    for (int i = 0; i < 2; ++i) { const int e = tid_ + NT * i, s = e >> 4, k0 = (e & 15) * 8; const size_t r = (size_t)(r0 + s);
        qa_[i] = *(const GAS v4u*)(PJ + r * NPJ + PJ_Q + 128 * h + k0); ka_[i] = *(const GAS v4u*)(PJ + r * NPJ + PJ_K + 128 * h + k0);
        const float* g = GG + r * 512 + 128 * h + k0; g0_[i] = *(const GAS f32x4*)g; g1_[i] = *(const GAS f32x4*)(g + 4); }
#pragma unroll
    for (int i = 0; i < 2; ++i) {
        const int e = tid_ + NT * i, s = e >> 4, k0 = (e & 15) * 8;
        const v4u qa = qa_[i], ka = ka_[i]; const f32x4 g0 = g0_[i], g1 = g1_[i];
        const float gv[8] = {g0.x, g0.y, g0.z, g0.w, g1.x, g1.y, g1.z, g1.w};
        const unsigned qs[4] = {qa.x, qa.y, qa.z, qa.w}, ksr[4] = {ka.x, ka.y, ka.z, ka.w};
        unsigned oqe[4], oqn[4], oke[4], okn[4];
#pragma unroll
        for (int j = 0; j < 4; ++j) { const float e0 = __expf(gv[2 * j]), e1 = __expf(gv[2 * j + 1]), n0 = __expf(-gv[2 * j]), n1 = __expf(-gv[2 * j + 1]);
            const float q0 = bflo(qs[j]), q1 = bfhi(qs[j]), kk0 = bflo(ksr[j]), kk1 = bfhi(ksr[j]);
            oqe[j] = pk2(q0 * e0, q1 * e1); oqn[j] = pk2(q0 * n0, q1 * n1); oke[j] = pk2(kk0 * e0, kk1 * e1); okn[j] = pk2(kk0 * n0, kk1 * n1); }
        const int off = s * P136 + k0 * 2;
        *(LAS v4u*)(QE + off) = (v4u){oqe[0], oqe[1], oqe[2], oqe[3]}; *(LAS v4u*)(QN + off) = (v4u){oqn[0], oqn[1], oqn[2], oqn[3]};
        *(LAS v4u*)(KE + off) = (v4u){oke[0], oke[1], oke[2], oke[3]}; *(LAS v4u*)(KN + off) = (v4u){okn[0], okn[1], okn[2], okn[3]};
    }
    { v4u vv[4];
#pragma unroll
      for (int i = 0; i < 4; ++i) { const int e = tid_ + NT * i, s = e >> 5, v0 = (e & 31) * 8; vv[i] = *(const GAS v4u*)(PJ + (size_t)(r0 + s) * NPJ + PJ_V + 256 * h + v0); }
#pragma unroll
      for (int i = 0; i < 4; ++i) { const int e = tid_ + NT * i, s = e >> 5, v0 = (e & 31) * 8; *(LAS v4u*)(VT + s * P264 + v0 * 2) = vv[i]; } }
    __syncthreads();
    const int fr = lane_ & 15, fq = lane_ >> 4, w = wave_;
#pragma unroll
    for (int ti = 0; ti < 2; ++ti) {
        const int id = 2 * w + ti, tm = id >> 2, sn = id & 3;
        f32x4 ac = {0.f, 0.f, 0.f, 0.f}, aa = {0.f, 0.f, 0.f, 0.f};
#pragma unroll
        for (int ks = 0; ks < 4; ++ks) {
            const int ao = (16 * tm + fr) * P136 + (32 * ks + 8 * fq) * 2, bo = (16 * sn + fr) * P136 + (32 * ks + 8 * fq) * 2;
            ac = mma16(lds_frag(QE + ao), lds_frag(KN + bo), ac);
            aa = mma16(lds_frag(QN + ao), lds_frag(KE + bo), aa);
        }
        const int t = 16 * tm + fr, s0 = 16 * sn + 4 * fq;
        float o[4];
#pragma unroll
        for (int j = 0; j < 4; ++j) o[j] = (s0 + j <= t) ? ac[j] : aa[j];
        *(LAS v2u*)(ATT + t * P72 + s0 * 2) = (v2u){pk2(o[0], o[1]), pk2(o[2], o[3])};
    }
    __syncthreads();
    f32x4 acc[4][2];
#pragma unroll
    for (int tm = 0; tm < 4; ++tm)
#pragma unroll
        for (int nt = 0; nt < 2; ++nt) acc[tm][nt] = (f32x4){0.f, 0.f, 0.f, 0.f};
#pragma unroll
    for (int ks = 0; ks < 4; ++ks) {
#pragma unroll
        for (int tm = 0; tm < 4; ++tm) { const bf16x8 af = lds_frag(QE + (16 * tm + fr) * P136 + (32 * ks + 8 * fq) * 2);
#pragma unroll
            for (int nt = 0; nt < 2; ++nt) acc[tm][nt] = mma16(af, sfr[ks][nt], acc[tm][nt]); }
    }
#pragma unroll
    for (int ks = 0; ks < 2; ++ks) {
        bf16x8 bfm[2];
#pragma unroll
        for (int nt = 0; nt < 2; ++nt) bfm[nt] = tr_frag(VT, P264, 32 * ks, 32 * w + 16 * nt, fr, fq);
#pragma unroll
        for (int tm = 0; tm < 4; ++tm) { const bf16x8 af = lds_frag(ATT + (16 * tm + fr) * P72 + (32 * ks + 8 * fq) * 2);
#pragma unroll
            for (int nt = 0; nt < 2; ++nt) acc[tm][nt] = mma16(af, bfm[nt], acc[tm][nt]); }
    }
    v2u gvp[4][2]; f32x4 wvp[2];
#pragma unroll
    for (int nt = 0; nt < 2; ++nt) { const int v = 32 * w + 16 * nt + 4 * fq; wvp[nt] = *(const GAS f32x4*)(C.in[I_GNW] + v);
#pragma unroll
        for (int tm = 0; tm < 4; ++tm) gvp[tm][nt] = *(const GAS v2u*)(PJ + (size_t)(r0 + 16 * tm + fr) * NPJ + PJ_GO + 256 * h + v); }
#pragma unroll
    for (int tm = 0; tm < 4; ++tm) { float s = 0.f;
#pragma unroll
        for (int nt = 0; nt < 2; ++nt) { const f32x4 a = acc[tm][nt]; s += (a[0] * a[0] + a[1] * a[1]) + (a[2] * a[2] + a[3] * a[3]); }
        s += __shfl_xor(s, 16); s += __shfl_xor(s, 32);
        if (fq == 0) RED[w * 64 + 16 * tm + fr] = s; }
    __syncthreads();
    const float* nw = C.in[I_GNW];
#pragma unroll
    for (int tm = 0; tm < 4; ++tm) { const int t = 16 * tm + fr; float tot = 0.f;
#pragma unroll
        for (int ww = 0; ww < 8; ++ww) tot += RED[ww * 64 + t];
        const float rs = rsqrtf(tot * (1.f / 256.f) + RMS_EPS); const size_t r = (size_t)(r0 + t);
#pragma unroll
        for (int nt = 0; nt < 2; ++nt) { const int v = 32 * w + 16 * nt + 4 * fq; const f32x4 a = acc[tm][nt];
            const f32x4 wv = wvp[nt]; const v2u gv = gvp[tm][nt];
            *(GAS v2u*)(OG + r * 1024 + 256 * h + v) = (v2u){pk2(a[0] * rs * wv.x * bflo(gv.x), a[1] * rs * wv.y * bfhi(gv.x)), pk2(a[2] * rs * wv.z * bflo(gv.y), a[3] * rs * wv.w * bfhi(gv.y))}; } }
    __syncthreads();
}
__device__ __forceinline__ void ssd_pass3_unit(const Ctx& C, int c, int g) {
    int tid_ = C.tid; asm volatile("" : "+v"(tid_));
    const int lane_ = tid_ & 63, wave_ = __builtin_amdgcn_readfirstlane(tid_ >> 6); (void)lane_; (void)wave_;
    const bf16* PJ = (const bf16*)(C.ws + WS_PJ); const bf16* XC = (const bf16*)(C.ws + WS_XC); const float* DT = (const float*)(C.ws + WS_DT); const float* AC = (const float*)(C.ws + WS_AC);
    const bf16* LS = (const bf16*)(C.ws + WS_LS); bf16* YS = (bf16*)(C.ws + WS_YS);
    ldsp XD = C.lds, CM = XD + 64 * P520, BM = CM + 64 * P136, WT = BM + 64 * P136;
    LAS float* ACL = (LAS float*)(WT + 8 * 32 * P72);
    LAS float* DTL = ACL + 8 * 64;
    LAS float* RED = DTL + 8 * 64;
    const int r0 = 64 * c;
    bf16x8 sfr[4][4];
    { const bf16* Sb = LS + ((size_t)(c * 32 + 8 * g + (wave_ >> 1)) * 64) * 128; const int fr_ = lane_ & 15, fq_ = lane_ >> 4;
#pragma unroll
      for (int ks = 0; ks < 2; ++ks)
#pragma unroll
        for (int pn = 0; pn < 4; ++pn) sfr[ks][pn] = *(const GAS bf16x8*)(Sb + (size_t)(16 * pn + fr_) * 128 + 32 * ks + 8 * fq_); }
    { v4u xx[8], bb[2], cc[2]; float a1, d1;
      { const int s = tid_ >> 3, hl = tid_ & 7; const size_t ri = (size_t)(r0 + s) * 32 + 8 * g + hl; a1 = AC[ri]; d1 = DT[ri]; }
#pragma unroll
      for (int i = 0; i < 8; ++i) { const int s = (tid_ >> 6) + 8 * i, ch = tid_ & 63; xx[i] = *(const GAS v4u*)(XC + (size_t)(r0 + s) * 3072 + 512 * g + 8 * ch); }
#pragma unroll
      for (int i = 0; i < 2; ++i) { const int e = tid_ + NT * i, s = e >> 4, ch = e & 15; const size_t r = (size_t)(r0 + s);
        bb[i] = *(const GAS v4u*)(XC + r * 3072 + 2048 + 128 * g + 8 * ch); cc[i] = *(const GAS v4u*)(XC + r * 3072 + 2560 + 128 * g + 8 * ch); }
      { const int s = tid_ >> 3, hl = tid_ & 7; ACL[hl * 64 + s] = a1; DTL[hl * 64 + s] = d1; }
#pragma unroll
      for (int i = 0; i < 8; ++i) { const int s = (tid_ >> 6) + 8 * i, ch = tid_ & 63; *(LAS v4u*)(XD + s * P520 + ch * 16) = xx[i]; }
#pragma unroll
      for (int i = 0; i < 2; ++i) { const int e = tid_ + NT * i, s = e >> 4, ch = e & 15; *(LAS v4u*)(BM + s * P136 + ch * 16) = bb[i]; *(LAS v4u*)(CM + s * P136 + ch * 16) = cc[i]; } }
    __syncthreads();
    const int fr = lane_ & 15, fq = lane_ >> 4, w = wave_, rh = w & 1, hq = w >> 1, t0 = 32 * rh;
    ldsp WW = WT + w * 32 * P72;
    { const bf16* Sb = LS + ((size_t)(c * 32 + 8 * g + hq) * 64) * 128;
#pragma unroll
      for (int ks = 2; ks < 4; ++ks)
#pragma unroll
        for (int pn = 0; pn < 4; ++pn) sfr[ks][pn] = *(const GAS bf16x8*)(Sb + (size_t)(16 * pn + fr) * 128 + 32 * ks + 8 * fq); }
    f32x4 cb[2][4];
#pragma unroll
    for (int tm = 0; tm < 2; ++tm)
#pragma unroll
        for (int sn = 0; sn < 4; ++sn) cb[tm][sn] = (f32x4){0.f, 0.f, 0.f, 0.f};
#pragma unroll
    for (int ks = 0; ks < 4; ++ks) {
        bf16x8 af[2];
#pragma unroll
        for (int tm = 0; tm < 2; ++tm) af[tm] = lds_frag(CM + (t0 + 16 * tm + fr) * P136 + (32 * ks + 8 * fq) * 2);
#pragma unroll
        for (int sn = 0; sn < 4; ++sn) { const bf16x8 bfm = lds_frag(BM + (16 * sn + fr) * P136 + (32 * ks + 8 * fq) * 2);
#pragma unroll
            for (int tm = 0; tm < 2; ++tm) cb[tm][sn] = mma16(af[tm], bfm, cb[tm][sn]); }
    }
    v2u yp[2][2][4];
    float ss[2] = {0.f, 0.f};
    const float* dsk = C.in[I_DSKIP]; const float* nw = C.in[I_SNW];
#pragma unroll
    for (int rd = 0; rd < 2; ++rd) {
        const int hl = hq + 4 * rd, hd = 8 * g + hl;
        float at[2];
#pragma unroll
        for (int tm = 0; tm < 2; ++tm) at[tm] = ACL[hl * 64 + t0 + 16 * tm + fr];
#pragma unroll
        for (int sn = 0; sn < 4; ++sn) { const f32x4 as = *(const LAS f32x4*)(ACL + hl * 64 + 16 * sn + 4 * fq), ds = *(const LAS f32x4*)(DTL + hl * 64 + 16 * sn + 4 * fq);
#pragma unroll
            for (int tm = 0; tm < 2; ++tm) { const f32x4 cv = cb[tm][sn];
                const float w0 = cv[0] * ds.x * __expf(-fabsf(at[tm] - as.x)), w1 = cv[1] * ds.y * __expf(-fabsf(at[tm] - as.y)), w2 = cv[2] * ds.z * __expf(-fabsf(at[tm] - as.z)), w3 = cv[3] * ds.w * __expf(-fabsf(at[tm] - as.w));
                *(LAS v2u*)(WW + (16 * tm + fr) * P72 + (16 * sn + 4 * fq) * 2) = (v2u){pk2(w0, w1), pk2(w2, w3)}; } }
        f32x4 y[2][4];
#pragma unroll
        for (int tm = 0; tm < 2; ++tm)
#pragma unroll
            for (int pn = 0; pn < 4; ++pn) y[tm][pn] = (f32x4){0.f, 0.f, 0.f, 0.f};
#pragma unroll
        for (int ks = 0; ks < 4; ++ks) {
            bf16x8 af[2];
#pragma unroll
            for (int tm = 0; tm < 2; ++tm) af[tm] = lds_frag(CM + (t0 + 16 * tm + fr) * P136 + (32 * ks + 8 * fq) * 2);
#pragma unroll
            for (int pn = 0; pn < 4; ++pn) {
#pragma unroll
                for (int tm = 0; tm < 2; ++tm) y[tm][pn] = mma16(af[tm], sfr[ks][pn], y[tm][pn]); }
        }
        if (rd == 0) {
            const bf16* Sb = LS + ((size_t)(c * 32 + 8 * g + hq + 4) * 64) * 128;
#pragma unroll
            for (int ks = 0; ks < 4; ++ks)
#pragma unroll
                for (int pn = 0; pn < 4; ++pn) sfr[ks][pn] = *(const GAS bf16x8*)(Sb + (size_t)(16 * pn + fr) * 128 + 32 * ks + 8 * fq);
        }
#pragma unroll
        for (int tm = 0; tm < 2; ++tm) { const float ea = __expf(at[tm]);
#pragma unroll
            for (int pn = 0; pn < 4; ++pn) y[tm][pn] = y[tm][pn] * ea; }
        LDS_WAIT(); asm volatile("" ::: "memory");
#pragma unroll
        for (int ks = 0; ks < 2; ++ks) {
            bf16x8 af[2];
#pragma unroll
            for (int tm = 0; tm < 2; ++tm) af[tm] = lds_frag(WW + (16 * tm + fr) * P72 + (32 * ks + 8 * fq) * 2);
#pragma unroll
            for (int pn = 0; pn < 4; ++pn) { const bf16x8 bfm = tr_frag(XD, P520, 32 * ks, 64 * hl + 16 * pn, fr, fq);
#pragma unroll
                for (int tm = 0; tm < 2; ++tm) y[tm][pn] = mma16(af[tm], bfm, y[tm][pn]); }
        }
        LDS_WAIT(); asm volatile("" ::: "memory");
        const float dk = dsk[hd];
#pragma unroll
        for (int tm = 0; tm < 2; ++tm) { const size_t r = (size_t)(r0 + t0 + 16 * tm + fr);
#pragma unroll
            for (int pn = 0; pn < 4; ++pn) { const int col = 64 * hd + 16 * pn + 4 * fq;
                const v2u xv = *(const LAS v2u*)(XD + (t0 + 16 * tm + fr) * P520 + (64 * hl + 16 * pn + 4 * fq) * 2), zv = *(const GAS v2u*)(PJ + r * NPJ + PJ_Z + col);
                f32x4 a = y[tm][pn];
                a[0] = (a[0] + dk * bflo(xv.x)) * bflo(zv.x); a[1] = (a[1] + dk * bfhi(xv.x)) * bfhi(zv.x); a[2] = (a[2] + dk * bflo(xv.y)) * bflo(zv.y); a[3] = (a[3] + dk * bfhi(xv.y)) * bfhi(zv.y);
                ss[tm] += (a[0] * a[0] + a[1] * a[1]) + (a[2] * a[2] + a[3] * a[3]); yp[rd][tm][pn] = (v2u){pk2(a[0], a[1]), pk2(a[2], a[3])}; } }
    }
#pragma unroll
    for (int tm = 0; tm < 2; ++tm) { float s = ss[tm]; s += __shfl_xor(s, 16); s += __shfl_xor(s, 32); if (fq == 0) RED[w * 32 + 16 * tm + fr] = s; }
    __syncthreads();
#pragma unroll
    for (int tm = 0; tm < 2; ++tm) { const int tl = 16 * tm + fr; float tot = 0.f;
#pragma unroll
        for (int q = 0; q < 4; ++q) tot += RED[(2 * q + rh) * 32 + tl];
        const float rs = rsqrtf(tot * (1.f / 512.f) + RMS_EPS); const size_t r = (size_t)(r0 + t0 + tl);
#pragma unroll
        for (int rd = 0; rd < 2; ++rd) { const int hd = 8 * g + hq + 4 * rd;
#pragma unroll
            for (int pn = 0; pn < 4; ++pn) { const int col = 64 * hd + 16 * pn + 4 * fq; const v2u a = yp[rd][tm][pn]; const f32x4 wv = *(const GAS f32x4*)(nw + col);
                *(GAS v2u*)(YS + r * 2048 + col) = (v2u){pk2(bflo(a.x) * rs * wv.x, bfhi(a.x) * rs * wv.y), pk2(bflo(a.y) * rs * wv.z, bfhi(a.y) * rs * wv.w)}; } } }
    __syncthreads();
}

__device__ __forceinline__ void phaseJ(const Ctx& C) {
    const int gw = C.bid * NWAVES + C.wave, NGW = C.G * NWAVES;
    bf16* HN2 = (bf16*)(C.ws + WS_HN2);
    for (int r = gw; r < NTOK / 2; r += NGW) {
        const int r1 = r + NTOK / 2, lane = C.lane;
        const f32x4* x0 = (const f32x4*)(C.out + (size_t)r * D) + lane; const f32x4* x1 = (const f32x4*)(C.out + (size_t)r1 * D) + lane; const f32x4* wr_ = (const f32x4*)C.in[I_LNFFN] + lane;
        f32x4 v[4], u[4]; float q0 = 0.f, q1 = 0.f;
#pragma unroll
        for (int j = 0; j < 4; ++j) { v[j] = *(const GAS f32x4*)(x0 + 64 * j); u[j] = *(const GAS f32x4*)(x1 + 64 * j); }
#pragma unroll
        for (int j = 0; j < 4; ++j) { q0 += (v[j].x * v[j].x + v[j].y * v[j].y) + (v[j].z * v[j].z + v[j].w * v[j].w); q1 += (u[j].x * u[j].x + u[j].y * u[j].y) + (u[j].z * u[j].z + u[j].w * u[j].w); }
        const float s0 = rsqrtf(wave_sum(q0) * (1.f / D) + RMS_EPS), s1 = rsqrtf(wave_sum(q1) * (1.f / D) + RMS_EPS);
        v2u* o0 = (v2u*)(HN2 + (size_t)r * D) + lane; v2u* o1 = (v2u*)(HN2 + (size_t)r1 * D) + lane;
#pragma unroll
        for (int j = 0; j < 4; ++j) { const f32x4 ww = *(const GAS f32x4*)(wr_ + 64 * j); const f32x4 a = v[j] * s0 * ww, bq = u[j] * s1 * ww;
            *(GAS v2u*)(o0 + 64 * j) = (v2u){pk2(a.x, a.y), pk2(a.z, a.w)}; *(GAS v2u*)(o1 + 64 * j) = (v2u){pk2(bq.x, bq.y), pk2(bq.z, bq.w)};
            int w0 = 0, w1 = 0;
            w0 = __builtin_amdgcn_cvt_pk_fp8_f32(a.x * 16.f, a.y * 16.f, w0, false); w0 = __builtin_amdgcn_cvt_pk_fp8_f32(a.z * 16.f, a.w * 16.f, w0, true);
            w1 = __builtin_amdgcn_cvt_pk_fp8_f32(bq.x * 16.f, bq.y * 16.f, w1, false); w1 = __builtin_amdgcn_cvt_pk_fp8_f32(bq.z * 16.f, bq.w * 16.f, w1, true);
            *(GAS unsigned*)(C.ws + WS_HN8 + (size_t)r * D + 4 * lane + 256 * j) = (unsigned)w0; *(GAS unsigned*)(C.ws + WS_HN8 + (size_t)r1 * D + 4 * lane + 256 * j) = (unsigned)w1; }
    }
}
#ifndef PEER_SWAP_NIBBLES
#define PEER_SWAP_NIBBLES 0
#endif
__device__ __forceinline__ void conv_table(const Ctx& C, int tb, int first_blk) {
    if (C.bid < first_blk) return;
    const size_t n16 = (size_t)16384 * 1024 / 16, gt = (size_t)(C.bid - first_blk) * NT + C.tid, GT = (size_t)(C.G - first_blk) * NT;
    const float* src = C.in[tb ? I_PV : I_PU]; unsigned char* dst = C.ws + WS_U8 + (tb ? 512 : 0); const float gain = tb ? 5.656854249f : 64.f;
    for (size_t i0 = gt; i0 < n16; i0 += 4 * GT) { f32x4 a[4][4];
#pragma unroll
        for (int p = 0; p < 4; ++p) { const size_t i = i0 + p * GT;
#pragma unroll
            for (int q = 0; q < 4; ++q) a[p][q] = (i < n16) ? *(const GAS f32x4*)(src + 16 * i + 4 * q) : (f32x4){0.f, 0.f, 0.f, 0.f}; }
#pragma unroll
        for (int p = 0; p < 4; ++p) { const size_t i = i0 + p * GT; v2u o;
#pragma unroll
            for (int h = 0; h < 2; ++h) { unsigned w = 0;
                if (tb == 0 && PEER_SWAP_NIBBLES) {
                w = __builtin_amdgcn_cvt_scalef32_pk_fp4_f32(w, a[p][2 * h].y * gain, a[p][2 * h].x * gain, 1.0f, 0); w = __builtin_amdgcn_cvt_scalef32_pk_fp4_f32(w, a[p][2 * h].w * gain, a[p][2 * h].z * gain, 1.0f, 1);
                w = __builtin_amdgcn_cvt_scalef32_pk_fp4_f32(w, a[p][2 * h + 1].y * gain, a[p][2 * h + 1].x * gain, 1.0f, 2); w = __builtin_amdgcn_cvt_scalef32_pk_fp4_f32(w, a[p][2 * h + 1].w * gain, a[p][2 * h + 1].z * gain, 1.0f, 3); } else {
                w = __builtin_amdgcn_cvt_scalef32_pk_fp4_f32(w, a[p][2 * h].x * gain, a[p][2 * h].y * gain, 1.0f, 0); w = __builtin_amdgcn_cvt_scalef32_pk_fp4_f32(w, a[p][2 * h].z * gain, a[p][2 * h].w * gain, 1.0f, 1);
                w = __builtin_amdgcn_cvt_scalef32_pk_fp4_f32(w, a[p][2 * h + 1].x * gain, a[p][2 * h + 1].y * gain, 1.0f, 2); w = __builtin_amdgcn_cvt_scalef32_pk_fp4_f32(w, a[p][2 * h + 1].z * gain, a[p][2 * h + 1].w * gain, 1.0f, 3); }
                o[h] = w; }
            if (i < n16) *(GAS v2u*)(dst + (i >> 6) * 1024 + (i & 63) * 8) = o; } }
}

__device__ __forceinline__ float gelu_tanh(float x) {
    const float y = 0.7978845608028654f * (x + 0.044715f * x * x * x);
    const float e = __expf(2.f * y);
    const float th = 1.f - 2.f * fast_rcp(e + 1.f);
    return 0.5f * x * (1.f + th);
}
typedef _Float16 h16x2 __attribute__((ext_vector_type(2)));
typedef int v8i __attribute__((ext_vector_type(8)));

template <int CTRL> __device__ __forceinline__ unsigned dppu(unsigned x) { return (unsigned)__builtin_amdgcn_mov_dpp((int)x, CTRL, 0xf, 0xf, true); }
template <int CTRL> __device__ __forceinline__ float dppf(float x) { return __builtin_bit_cast(float, __builtin_amdgcn_mov_dpp(__builtin_bit_cast(int, x), CTRL, 0xf, 0xf, true)); }
__device__ __forceinline__ unsigned row_max_u(unsigned m) { m = max(m, dppu<0xB1>(m)); m = max(m, dppu<0x4E>(m)); m = max(m, dppu<0x141>(m)); m = max(m, dppu<0x128>(m)); return m; }
__device__ __forceinline__ float row_sum_f(float v) { v += dppf<0xB1>(v); v += dppf<0x4E>(v); v += dppf<0x141>(v); v += dppf<0x128>(v); return v; }
__device__ __forceinline__ unsigned mono(float f) { const unsigned b = __builtin_bit_cast(unsigned, f); return b ^ ((unsigned)((int)b >> 31) | 0x80000000u); }
__device__ __forceinline__ float unmono(unsigned u) { const unsigned b = (u & 0x80000000u) ? (u ^ 0x80000000u) : ~u; return __builtin_bit_cast(float, b); }
__device__ __forceinline__ void cand_ij(int c, int& ci, int& cj) {
    if (c < 16) { ci = 0; cj = c; } else if (c < 24) { ci = 1; cj = c - 16; } else if (c < 29) { ci = 2; cj = c - 24; } else if (c < 33) { ci = 3; cj = c - 29; }
    else if (c < 36) { ci = 4; cj = c - 33; } else if (c < 38) { ci = 5; cj = c - 36; } else if (c < 40) { ci = 6; cj = c - 38; } else if (c < 42) { ci = 7; cj = c - 40; }
    else if (c < 50) { ci = c - 34; cj = 0; } else { ci = 0; cj = 0; }
}
constexpr int PEER_LDS_PER_WAVE = 3072;
__device__ __forceinline__ void peer_token(const Ctx& C, int t, bool dry = false) {
    const int lane = C.lane, g = lane >> 4, j = lane & 15;
    const float* SC = (const float*)(C.ws + WS_SC) + (size_t)t * 2048;
    const bf16* HN2 = (const bf16*)(C.ws + WS_HN2) + (size_t)t * D;
    ldsp LST = C.lds + C.wave * PEER_LDS_PER_WAVE; ldsp EL = LST + 2048;
#pragma unroll 1
    for (int P = 0; P < 2; ++P) {
        const float* spa = SC + (4 * P + g) * 128 + 8 * j; const float* spb = SC + (4 * (P + 2) + g) * 128 + 8 * j;
        const f32x4 s0 = *(const GAS f32x4*)spa, s1 = *(const GAS f32x4*)(spa + 4), s2 = *(const GAS f32x4*)spb, s3 = *(const GAS f32x4*)(spb + 4);
        unsigned k[8], kb[8];
        const float sa[8] = {s0.x, s0.y, s0.z, s0.w, s1.x, s1.y, s1.z, s1.w}, sb[8] = {s2.x, s2.y, s2.z, s2.w, s3.x, s3.y, s3.z, s3.w};
#pragma unroll
        for (int q = 0; q < 8; ++q) { k[q] = (mono(sa[q]) & ~127u) | (unsigned)(127 - (8 * j + q)); kb[q] = (mono(sb[q]) & ~127u) | (unsigned)(127 - (8 * j + q)); }
        unsigned res = 0u, resb = 0u;
#pragma unroll 4
        for (int it = 0; it < 16; ++it) {
            unsigned m = max(max(max(k[0], k[1]), max(k[2], k[3])), max(max(k[4], k[5]), max(k[6], k[7])));
            unsigned mb = max(max(max(kb[0], kb[1]), max(kb[2], kb[3])), max(max(kb[4], kb[5]), max(kb[6], kb[7])));
            m = max(m, dppu<0xB1>(m)); mb = max(mb, dppu<0xB1>(mb)); m = max(m, dppu<0x4E>(m)); mb = max(mb, dppu<0x4E>(mb));
            m = max(m, dppu<0x141>(m)); mb = max(mb, dppu<0x141>(mb)); m = max(m, dppu<0x128>(m)); mb = max(mb, dppu<0x128>(mb));
#pragma unroll
            for (int q = 0; q < 8; ++q) { k[q] = (k[q] == m) ? 0u : k[q]; kb[q] = (kb[q] == mb) ? 0u : kb[q]; }
            res = (j == it) ? m : res; resb = (j == it) ? mb : resb;
        }
        *(LAS v2u*)(LST + ((4 * P + g) * 16 + j) * 8) = (v2u){__builtin_bit_cast(unsigned, unmono(res & ~127u)), 127u - (res & 127u)};
        *(LAS v2u*)(LST + ((4 * (P + 2) + g) * 16 + j) * 8) = (v2u){__builtin_bit_cast(unsigned, unmono(resb & ~127u)), 127u - (resb & 127u)};
    }
    LDS_WAIT(); asm volatile("" ::: "memory");
    int eA = 0, eB = 0; float wA = 0.f, wB = 0.f;
#pragma unroll
    for (int Q = 0; Q < 2; ++Q) {
        const int h = 4 * Q + g;
        unsigned k[4];
#pragma unroll
        for (int m = 0; m < 4; ++m) {
            const int c = j + 16 * m; int ci, cj; cand_ij(c, ci, cj);
            const v2u a = *(const LAS v2u*)(LST + ((2 * h) * 16 + ci) * 8), b = *(const LAS v2u*)(LST + ((2 * h + 1) * 16 + cj) * 8);
            const float val = __builtin_bit_cast(float, a.x) + __builtin_bit_cast(float, b.x);
            k[m] = (c < 50) ? ((mono(val) & ~63u) | (unsigned)(63 - c)) : 0u;
            *(LAS unsigned*)(EL + (g * 64 + c) * 4) = a.y * 128u + b.y;
        }
        unsigned res = 0u, mtop = 0u;
#pragma unroll 4
        for (int it = 0; it < 16; ++it) {
            unsigned m = max(max(k[0], k[1]), max(k[2], k[3]));
            m = row_max_u(m);
            if (it == 0) mtop = m;
#pragma unroll
            for (int q = 0; q < 4; ++q) k[q] = (k[q] == m) ? 0u : k[q];
            res = (j == it) ? m : res;
        }
        LDS_WAIT(); asm volatile("" ::: "memory");
        const int cw = 63 - (int)(res & 63u);
        const int e = (int)*(const LAS unsigned*)(EL + (g * 64 + cw) * 4);
        const float ex = __expf(unmono(res & ~63u) - unmono(mtop & ~63u));
        const float wgt = ex / row_sum_f(ex);
        if (Q == 0) { eA = e; wA = wgt; } else { eB = e; wB = wgt; }
        LDS_WAIT(); asm volatile("" ::: "memory");
    }
#ifdef DRY_TOPK_ONLY
    if (dry) { ((float*)(C.ws + WS_T1))[(size_t)t * 64 + lane] = (float)(eA + eB) + wA + wB; return; }
#endif
    const unsigned char* U8 = C.ws + WS_U8; const unsigned char* V8 = C.ws + WS_U8 + 512;
    const int li = lane & 15, lg = lane >> 4;
    v4u hb[16];
    { const unsigned char* H8 = C.ws + WS_HN8 + (size_t)t * D + 16 * lg;
#pragma unroll
      for (int m = 0; m < 8; ++m) { hb[2 * m] = *(const GAS v4u*)(H8 + 128 * m); hb[2 * m + 1] = *(const GAS v4u*)(H8 + 128 * m + 64); } }
    f32x2 acc[8];
#pragma unroll
    for (int i = 0; i < 8; ++i) acc[i] = (f32x2){0.f, 0.f};
#pragma unroll 1
    for (int gi = 0; gi < 8; ++gi) {
        const int ev = gi < 4 ? eA : eB; const float wv = gi < 4 ? wA : wB; const int lb = 16 * (gi & 3);
        const int ei = __shfl(ev, lb + li);
        const unsigned char* up = U8 + (size_t)ei * 1024 + 16 * lg;
        v4u uq[8];
#pragma unroll
        for (int m = 0; m < 8; ++m) uq[m] = *(const GAS v4u*)(up + 64 * m);
        v2u vq[8];
#pragma unroll
        for (int q = 0; q < 8; ++q) vq[q] = *(const GAS v2u*)(V8 + (size_t)__builtin_amdgcn_readlane(ev, lb + q) * 1024 + 8 * lane);
        float wr[4];
#pragma unroll
        for (int r = 0; r < 4; ++r) wr[r] = __shfl(wv, lb + 4 * lg + r);
        f32x4 dots = {0.f, 0.f, 0.f, 0.f};
#pragma unroll
        for (int m = 0; m < 8; ++m) {
            const v8i av = {(int)uq[m].x, (int)uq[m].y, (int)uq[m].z, (int)uq[m].w, 0, 0, 0, 0};
            const v8i bv = {(int)hb[2 * m].x, (int)hb[2 * m].y, (int)hb[2 * m].z, (int)hb[2 * m].w, (int)hb[2 * m + 1].x, (int)hb[2 * m + 1].y, (int)hb[2 * m + 1].z, (int)hb[2 * m + 1].w};
            dots = __builtin_amdgcn_mfma_scale_f32_16x16x128_f8f6f4(av, bv, dots, 4, 0, 0, 0x7f7f7f7f, 0, 0x7f7f7f7f);
        }
        float cfr[4];
#pragma unroll
        for (int r = 0; r < 4; ++r) cfr[r] = wr[r] * gelu_tanh(dots[r] * (1.f / 1024.f)) * 0.1767766953f;
#pragma unroll
        for (int hf = 0; hf < 2; ++hf) {
            if (hf == 1) {
#pragma unroll
                for (int q = 0; q < 8; ++q) vq[q] = *(const GAS v2u*)(V8 + (size_t)__builtin_amdgcn_readlane(ev, lb + 8 + q) * 1024 + 8 * lane);
            }
#pragma unroll
            for (int q = 0; q < 8; ++q) { const int pl = 8 * hf + q;
                const float cf = __builtin_bit_cast(float, __builtin_amdgcn_readlane(__builtin_bit_cast(int, cfr[pl & 3]), 16 * (pl >> 2)));
#pragma unroll
                for (int w2 = 0; w2 < 2; ++w2) { acc[4 * w2 + 0] = __builtin_amdgcn_cvt_scalef32_pk_f32_fp4(vq[q][w2], 1.0f, 0) * cf + acc[4 * w2 + 0]; acc[4 * w2 + 1] = __builtin_amdgcn_cvt_scalef32_pk_f32_fp4(vq[q][w2], 1.0f, 1) * cf + acc[4 * w2 + 1];
                    acc[4 * w2 + 2] = __builtin_amdgcn_cvt_scalef32_pk_f32_fp4(vq[q][w2], 1.0f, 2) * cf + acc[4 * w2 + 2]; acc[4 * w2 + 3] = __builtin_amdgcn_cvt_scalef32_pk_f32_fp4(vq[q][w2], 1.0f, 3) * cf + acc[4 * w2 + 3]; }
            }
        }
    }
    float* orow = C.out + (size_t)t * D + 16 * lane; const float* lw = C.in[I_LNF] + 16 * lane;
    f32x4 hv[4]; float s = 0.f;
#pragma unroll
    for (int i = 0; i < 4; ++i) { hv[i] = *(const GAS f32x4*)(orow + 4 * i); hv[i].x += acc[2 * i].x; hv[i].y += acc[2 * i].y; hv[i].z += acc[2 * i + 1].x; hv[i].w += acc[2 * i + 1].y;
        s += (hv[i].x * hv[i].x + hv[i].y * hv[i].y) + (hv[i].z * hv[i].z + hv[i].w * hv[i].w); }
    const float rs = rsqrtf(wave_sum(s) * (1.f / D) + RMS_EPS);
    if (dry) return;
#pragma unroll
    for (int i = 0; i < 4; ++i) { const f32x4 w4 = *(const GAS f32x4*)(lw + 4 * i); *(GAS f32x4*)(orow + 4 * i) = hv[i] * rs * w4; }
}

constexpr int NSTEPS = 37;
#ifndef PH_MASK
#define PH_MASK 0xFF
#endif
#define PH_ON(k) (((PH_MASK) >> (k)) & 1)
struct Args { const float* in[22]; float* out; unsigned char* ws; int ph_lo, ph_hi; };
typedef const __attribute__((address_space(4))) Args* kargp;
__device__ __forceinline__ void ctx_init(Ctx& C, unsigned char* smem) {
    kargp ap = (kargp)__builtin_amdgcn_kernarg_segment_ptr();
    asm volatile("" : "+s"(ap));
    int tid_ = threadIdx.x; asm volatile("" : "+v"(tid_));
    C.lds = (ldsp)smem; C.tid = tid_; C.lane = C.tid & 63; C.wave = __builtin_amdgcn_readfirstlane(C.tid >> 6); C.G = gridDim.x; C.bid = blockIdx.x;
#pragma unroll
    for (int i = 0; i < 22; ++i) C.in[i] = ap->in[i];
    C.out = ap->out; C.ws = ap->ws;
}
__global__ void __launch_bounds__(NT, 2) hyb_fwd(Args args) {
    extern __shared__ __attribute__((aligned(16))) unsigned char smem[];
    volatile LAS unsigned* MISC = (volatile LAS unsigned*)((ldsp)smem + LDSCTL_OFF);
    for (int u = threadIdx.x; u < (LDS_BYTES - LDSCTL_OFF) / 4; u += NT) MISC[u] = 0u;
    __syncthreads();
    const int lo = args.ph_lo, hi = args.ph_hi;
    unsigned* barw = (unsigned*)(args.ws + WS_CTL) + CW_BAR;
    XcdBarrier bar; bar.bar = barw; bar.x = 0; bar.st = MISC + 8;
    if (hi - lo > 1) bar = xcd_barrier_post(barw, MISC + 8);
#pragma unroll 1
    for (int step = lo; step < hi; ++step) {
        int kind, b = 0, gk = 0;
        if (step == 0) kind = 0;
        else if (step == 1) kind = 8;
        else if (step <= 33) { b = (step - 2) >> 3; const int k = (step - 2) & 7; gk = k; kind = (k == 0 || k >= 5) ? 1 : k + 1; }
        else if (step == 34) kind = 6;
        else if (step == 35) { kind = 1; gk = 8; }
        else kind = 7;
#ifdef REP_KIND
#ifndef REP_GK
#define REP_GK -1
#endif
        for (int rep = ((kind == REP_KIND && (REP_GK < 0 || gk == REP_GK)) ? 0 : 1); rep < 2; ++rep) {
        const bool dry = (rep == 0);
#else
        const bool dry = false; {
#endif
        Ctx C; ctx_init(C, smem);
        if (kind == 0 && PH_ON(0)) p0_prologue(C);
        else if (kind == 8) p0b_prologue(C);
        else if (kind == 1 && PH_ON(1)) {
            pg8::Gemm g; EpiAny E; E.P.PJ = (bf16*)(C.ws + WS_PJ); E.P.TL = (float*)(C.ws + WS_TL); E.PJ = (const bf16*)(C.ws + WS_PJ); E.T = nullptr; E.O = nullptr; E.gcol = 0; E.X = C.in[I_X]; E.OF = C.out; E.b = b; E.ldc = 2048;
            if (gk == 0)      { g = pg8::Gemm{(const bf16*)(C.ws + WS_HN), (const bf16*)(C.ws + WS_W1T), SEQ, NPJ, 1024}; E.mode = 0; if (b == 0) meta_proj(C); tail_proj(C); }
            else if (gk == 5) { g = pg8::Gemm{(const bf16*)(C.ws + WS_OG), (const bf16*)(C.ws + WS_WAT), RPB, 1024, 1024}; E.mode = 1; E.O = (bf16*)(C.ws + WS_T1); E.gcol = PJ_GA; }
            else if (gk == 6) { g = pg8::Gemm{(const bf16*)(C.ws + WS_YS), (const bf16*)(C.ws + WS_WBT), RPB, 1024, 2048}; E.mode = 1; E.O = (bf16*)(C.ws + WS_MX); E.gcol = PJ_GB; E.T = (const bf16*)(C.ws + WS_T1); }
            else if (gk == 7) { g = pg8::Gemm{(const bf16*)(C.ws + WS_MX), (const bf16*)(C.ws + WS_WOT), RPB, 1024, 1024}; E.mode = 2; }
            else              { g = pg8::Gemm{(const bf16*)(C.ws + WS_HN2), (const bf16*)(C.ws + WS_WET), NTOK, 2048, 1024}; E.mode = 3; E.OF = (float*)(C.ws + WS_SC); }
            pg8::StaticOrder S; S.init(g.M, g.N, C.G, C.bid);
#ifdef REP_TAIL_ONLY
            if (!dry)
#endif
            pg8::gemm_phase<EpiAny, pg8::StaticOrder, true, true>(C.lds, g, S, E);
            if (b == 0 && (gk == 5 || gk == 6)) conv_table(C, gk - 5, (S.nwg < C.G) ? S.nwg : 0);
            if (gk == 7 && b + 1 < BATCH) hn_batch(C, b + 1, (S.nwg < C.G) ? S.nwg : 0);
        }
        else if (kind == 2 && PH_ON(2)) {
#ifdef DRYC
            if (!dry || DRYC == 1) conv_batch(C);
            if (!dry || DRYC == 2) for (int u = C.bid; u < NCHUNK * 5; u += C.G) phaseC_unit(C, u / 5, 6 + u % 5);
#else
            conv_batch(C); for (int u = C.bid; u < NCHUNK * 5; u += C.G) phaseC_unit(C, u / 5, 6 + u % 5);
#endif
 }
        else if ((kind == 3 && PH_ON(3)) || (kind == 5 && PH_ON(5))) {
            unsigned* qc = (unsigned*)(C.ws + WS_CTL) + CW_QUEUE + 2 * step + (dry ? 1 : 0);
            for (;;) {
                if (C.tid == 0) MISC[16] = atomicAdd(qc, 1u);
                __syncthreads();
                const int u = (int)MISC[16];
                __syncthreads();
                if (u >= NCHUNK * 8) break;
                const bool ssd = u < NCHUNK * 4; const int v = ssd ? u : u - NCHUNK * 4, c = v >> 2, k = v & 3;
#ifdef DRYF
                if (dry && ssd != (DRYF == 2)) continue;
#endif
                if (kind == 3) { if (ssd) ssd_pass1_unit(C, c, k); else gla_pass1_unit(C, c, k); }
                else           { if (ssd) ssd_pass3_unit(C, c, k); else gla_pass3_unit(C, c, k); }
            }
        }
        else if (kind == 4 && PH_ON(4)) phaseE(C);
        else if (kind == 6 && PH_ON(6)) phaseJ(C);
        else if (kind == 7 && PH_ON(7)) { const int gw = C.bid * NWAVES + C.wave, NGW = C.G * NWAVES; for (int t = gw; t < NTOK; t += NGW) peer_token(C, t, dry); }
#ifdef REP_KIND
        if (rep == 0) xcd_barrier(bar);
#endif
        }
        if (step + 1 < hi && !(kind == 1 && gk == 5)) xcd_barrier(bar);
    }
}

#ifdef DBG_STOP
__global__ void dbg_digest(const unsigned* w, size_t nwords, float* out, size_t nout) {
    for (size_t i = (size_t)blockIdx.x * blockDim.x + threadIdx.x; i < nout; i += (size_t)gridDim.x * blockDim.x) {
        unsigned h = 0; for (size_t j = i; j < nwords; j += nout) h ^= w[j] * 2654435761u + (unsigned)(j / nout);
        out[i] = (float)(h & 0xFFFFFFu);
    }
}
#endif
#ifndef HYB_N_LAUNCHES
#define HYB_N_LAUNCHES 1
#endif
extern "C" void kernel_launch(void* const* d_in, const int* in_sizes, int n_in, void* d_out, int out_size, void* d_ws, size_t ws_size, hipStream_t stream) {
    static int grid = 0;
    if (grid == 0) {
        if (n_in != 22 || out_size != NTOK * D || ws_size < WS_END) { fprintf(stderr, "kernel_launch: unexpected shapes: n_in %d out %d ws %zu (need %zu)\n", n_in, out_size, ws_size, (size_t)WS_END); grid = -1; return; }
        int dev = 0, cus = 0, per_cu = 0;
        if (hipGetDevice(&dev) != hipSuccess || hipDeviceGetAttribute(&cus, hipDeviceAttributeMultiprocessorCount, dev) != hipSuccess) { grid = -1; return; }
        if (hipFuncSetAttribute((const void*)hyb_fwd, hipFuncAttributeMaxDynamicSharedMemorySize, LDS_BYTES) != hipSuccess) { fprintf(stderr, "kernel_launch: hipFuncSetAttribute failed\n"); grid = -1; return; }
        if (hipOccupancyMaxActiveBlocksPerMultiprocessor(&per_cu, (const void*)hyb_fwd, NT, LDS_BYTES) != hipSuccess || per_cu < 1) { fprintf(stderr, "kernel_launch: occupancy query says %d blocks per CU\n", per_cu); per_cu = 1; }
        (void)hipGetLastError();
        grid = cus;
    }
    if (grid < 0) return;
    (void)hipMemsetAsync((char*)d_ws + WS_CTL, 0, CTL_ZERO_BYTES, stream);
    Args a{};
    for (int i = 0; i < 22; ++i) a.in[i] = (const float*)d_in[i];
    a.out = (float*)d_out; a.ws = (unsigned char*)d_ws;
    if (HYB_N_LAUNCHES == 1) { a.ph_lo = 0; a.ph_hi = NSTEPS; hipLaunchKernelGGL(hyb_fwd, dim3(grid), dim3(NT), LDS_BYTES, stream, a); }
    else {
#ifdef DBG_STOP
        for (int s = 0; s <= DBG_STOP; ++s) { a.ph_lo = s; a.ph_hi = s + 1; hipLaunchKernelGGL(hyb_fwd, dim3(grid), dim3(NT), LDS_BYTES, stream, a); }
        hipLaunchKernelGGL(dbg_digest, dim3(2048), dim3(256), 0, stream, (const unsigned*)((char*)d_ws + (size_t)(DBG_OFF)), (size_t)(DBG_LEN) / 4, (float*)d_out, (size_t)NTOK * D);
#else
        for (int s = 0; s < NSTEPS; ++s) { a.ph_lo = s; a.ph_hi = s + 1; hipLaunchKernelGGL(hyb_fwd, dim3(grid), dim3(NT), LDS_BYTES, stream, a); }
#endif
    }
}
```

```cpp
#include <hip/hip_runtime.h>
#include <cstdio>
#include <cstdint>
namespace pg8 {
#define PG8_LAS __attribute__((address_space(3)))
typedef unsigned short bf16_t;
typedef short bf16x8 __attribute__((ext_vector_type(8)));
typedef float f32x4 __attribute__((ext_vector_type(4)));
typedef unsigned u32x4 __attribute__((ext_vector_type(4)));
constexpr int BM = 256, BK = 64, HALF = 128, HTB = HALF * BK * 2  , STAGE_BYTES = 8 * HTB, NXCD = 8, WGM = 8;

__host__ __device__ __forceinline__ int lds_byte(int r, int c) { const int st = (r >> 4) * 2 + (c >> 5), rr = r & 15, cc = c & 31, ob = rr * 64 + cc * 2; return st * 1024 + (ob ^ (((ob >> 9) & 1) << 5)); }
__host__ __device__ __forceinline__ void stage_rc(int b, int& R, int& C) { const int st = b / 1024, sb = b % 1024, swz = sb ^ (((sb >> 9) & 1) << 5); R = (st >> 1) * 16 + swz / 64; C = (st & 1) * 32 + (swz % 64) / 2; }
__host__ __device__ __forceinline__ int perm32(int rho) { const int n = rho >> 4, i = rho & 15; return 8 * (i >> 2) + 4 * n + (i & 3); }

struct Unit { int pm, pn; };
struct Gemm { const bf16_t* A; const bf16_t* Bt; int M, N, K; };

struct StaticOrder {
    int nM, nN, nwg, G, c;
    __host__ __device__ void init(int M, int N, int G_, int c_) { nM = M / BM; nN = N / BM; nwg = nM * nN; G = G_; c = c_; }
    __host__ __device__ bool next(int i, Unit& u) const {
        const long L = (long)i * G + c; if (L >= nwg) return false;
        int wgid = (int)L; { const int q = nwg / NXCD, r = nwg % NXCD, xcd = wgid % NXCD, off = wgid / NXCD; wgid = (xcd < r ? xcd * (q + 1) : r * (q + 1) + (xcd - r) * q) + off; }
        const int nig = WGM * nN, gid = wgid / nig, fm = gid * WGM, gsz = (nM - fm) < WGM ? (nM - fm) : WGM;
        u.pm = fm + ((wgid % nig) % gsz); u.pn = (wgid % nig) / gsz; return true;
    }
    __device__ __forceinline__ void a_ready(const Unit&) const {}
    __device__ __forceinline__ void done(const Unit&) const {}
};

typedef float f32x2_t __attribute__((ext_vector_type(2))); typedef __bf16 bf16x2_t __attribute__((ext_vector_type(2)));
__device__ __forceinline__ unsigned cvt_pk_bf16(float lo, float hi) { f32x2_t v = {lo, hi}; bf16x2_t b = __builtin_convertvector(v, bf16x2_t); return __builtin_bit_cast(unsigned, b); }
template <class Epi, class Sched, bool ALIGN_EPI = false, bool SP2 = false>
__device__ __forceinline__ void gemm_phase(PG8_LAS unsigned char* lds, const Gemm g, const Sched& S, const Epi& E) {
    int tid_ = threadIdx.x; asm volatile("" : "+v"(tid_));
    const int tid = tid_, wid = __builtin_amdgcn_readfirstlane(tid >> 6), lane = tid & 63, wr = wid >> 2, wc = wid & 3, fr = lane & 15, fq = lane >> 4;
    const int K = g.K, nt = K / BK;
    unsigned voffA[2], voffB[2];
#pragma unroll
    for (int i = 0; i < 2; ++i) { int R, C; stage_rc(tid * 16 + i * 8192, R, C); const int Rb = Epi::PERM ? ((R & ~31) + perm32(R & 31)) : R;
        voffA[i] = (unsigned)(R * K + C) * 2u; voffB[i] = (unsigned)(Rb * K + C) * 2u; }
    const size_t kstep = (size_t)(BK * 2);
    const size_t hstep = (size_t)HALF * K * 2;
    const size_t tstep = 2 * hstep;
    const unsigned ldsw = (unsigned)wid * 1024u;
    const int aoff = lds_byte(wr * 64 + fr, fq * 8), boff = lds_byte(wc * 32 + fr, fq * 8);
#define PG8_SA(b, h) (((b) * 2 + (h)) * HTB)
#define PG8_SB(b, h) ((4 + (b) * 2 + (h)) * HTB)
#define PG8_STAGE(bufoff, gbase, voff) do { _Pragma("unroll") for (int _i = 0; _i < 2; ++_i) \
        __builtin_amdgcn_global_load_lds((const unsigned*)((const char*)(gbase) + (voff)[_i]), (PG8_LAS unsigned*)(lds + (bufoff) + ldsw + _i * 8192), 16, 0, 0); } while (0)
#define PG8_LDA(dst, b, h) do { _Pragma("unroll") for (int m = 0; m < 4; ++m) _Pragma("unroll") for (int k = 0; k < 2; ++k) dst[m][k] = *(const PG8_LAS bf16x8*)(lds + PG8_SA(b, h) + aoff + m * 2048 + k * 1024); } while (0)
#define PG8_LDB(dst, b, h) do { _Pragma("unroll") for (int n = 0; n < 2; ++n) _Pragma("unroll") for (int k = 0; k < 2; ++k) dst[n][k] = *(const PG8_LAS bf16x8*)(lds + PG8_SB(b, h) + boff + n * 2048 + k * 1024); } while (0)
#define PG8_MMA(ai, bj, At, Bt) do { __builtin_amdgcn_s_setprio(1); _Pragma("unroll") for (int m = 0; m < 4; ++m) _Pragma("unroll") for (int n = 0; n < 2; ++n) _Pragma("unroll") for (int k = 0; k < 2; ++k) \
        acc[ai][bj][m][n] = __builtin_amdgcn_mfma_f32_16x16x32_bf16(Bt[n][k], At[m][k], acc[ai][bj][m][n], 0, 0, 0); __builtin_amdgcn_s_setprio(0); } while (0)
#define PG8_WAIT_V(n) asm volatile("s_waitcnt vmcnt(" #n ")" ::: "memory")
#define PG8_WAIT_L(n) asm volatile("s_waitcnt lgkmcnt(" #n ")" ::: "memory")
#define PG8_BAR __builtin_amdgcn_s_barrier()
#define PG8_SCHED __builtin_amdgcn_sched_barrier(0)
    Unit cur, nxt; int ui = 0;
    if (!S.next(0, cur)) return;
    f32x4 acc[2][2][4][2];
#pragma unroll
    for (int a = 0; a < 2; ++a)
#pragma unroll
        for (int b = 0; b < 2; ++b)
#pragma unroll
            for (int m = 0; m < 4; ++m)
#pragma unroll
                for (int n = 0; n < 2; ++n) acc[a][b][m][n] = (f32x4){0.f, 0.f, 0.f, 0.f};
    bf16x8 At[4][2], B0[2][2], B1[2][2];
    const char* cA = (const char*)g.A + (size_t)cur.pm * tstep; const char* cB = (const char*)g.Bt + (size_t)cur.pn * tstep;
    S.a_ready(cur);
    if constexpr (SP2) {
        PG8_STAGE(PG8_SB(0, 0), cB, voffB); PG8_STAGE(PG8_SB(0, 1), cB + hstep, voffB); PG8_STAGE(PG8_SA(0, 0), cA, voffA); PG8_STAGE(PG8_SA(0, 1), cA + hstep, voffA);
        if (wr == 1) PG8_BAR;
        PG8_WAIT_V(2); PG8_BAR;
        PG8_STAGE(PG8_SB(1, 0), cB + kstep, voffB); PG8_STAGE(PG8_SA(1, 0), cA + kstep, voffA); PG8_STAGE(PG8_SB(1, 1), cB + hstep + kstep, voffB);
        PG8_WAIT_V(6); PG8_BAR;
    } else {
        PG8_STAGE(PG8_SB(0, 0), cB, voffB); PG8_STAGE(PG8_SA(0, 0), cA, voffA); PG8_STAGE(PG8_SB(0, 1), cB + hstep, voffB); PG8_STAGE(PG8_SA(0, 1), cA + hstep, voffA);
        if (wr == 1) PG8_BAR;
        PG8_WAIT_V(4); PG8_BAR;
        PG8_STAGE(PG8_SB(1, 0), cB + kstep, voffB); PG8_STAGE(PG8_SA(1, 0), cA + kstep, voffA); PG8_STAGE(PG8_SB(1, 1), cB + hstep + kstep, voffB);
        PG8_WAIT_V(6); PG8_BAR;
    }
    for (;;) {
        const bool has_next = S.next(ui + 1, nxt);
        const char* nA = has_next ? (const char*)g.A + (size_t)nxt.pm * tstep : cA; const char* nB = has_next ? (const char*)g.Bt + (size_t)nxt.pn * tstep : cB;
        for (int t = 0; t < nt; t += 2) {
            const bool last = (t == nt - 2);
            const char* a1 = cA + (size_t)(t + 1) * kstep;
            const char* a2 = last ? nA : cA + (size_t)(t + 2) * kstep; const char* b2 = last ? nB : cB + (size_t)(t + 2) * kstep;
            const char* a3 = a2 + kstep; const char* b3 = b2 + kstep;
            if (last && has_next) S.a_ready(nxt);
            if constexpr (SP2) {
            PG8_LDB(B0, 0, 0); PG8_LDB(B1, 0, 1); PG8_SCHED; PG8_LDA(At, 0, 0); PG8_STAGE(PG8_SA(1, 1), a1 + hstep, voffA);
            PG8_WAIT_V(8); PG8_WAIT_L(0); PG8_BAR; PG8_MMA(0, 0, At, B0); PG8_MMA(0, 1, At, B1); PG8_BAR; PG8_SCHED;
            PG8_LDA(At, 0, 1); PG8_STAGE(PG8_SB(0, 0), b2, voffB); PG8_STAGE(PG8_SB(0, 1), b2 + hstep, voffB); PG8_STAGE(PG8_SA(0, 0), a2, voffA);
            PG8_WAIT_V(8); PG8_WAIT_L(0); PG8_BAR; PG8_MMA(1, 0, At, B0); PG8_MMA(1, 1, At, B1); PG8_BAR; PG8_SCHED;
            PG8_LDB(B0, 1, 0); PG8_LDB(B1, 1, 1); PG8_SCHED; PG8_LDA(At, 1, 0); PG8_STAGE(PG8_SA(0, 1), a2 + hstep, voffA);
            PG8_WAIT_V(8); PG8_WAIT_L(0); PG8_BAR; PG8_MMA(0, 0, At, B0); PG8_MMA(0, 1, At, B1); PG8_BAR; PG8_SCHED;
            PG8_LDA(At, 1, 1); PG8_STAGE(PG8_SB(1, 0), b3, voffB); PG8_STAGE(PG8_SB(1, 1), b3 + hstep, voffB); PG8_STAGE(PG8_SA(1, 0), a3, voffA);
            PG8_WAIT_V(8); PG8_WAIT_L(0); PG8_BAR; PG8_MMA(1, 0, At, B0); PG8_MMA(1, 1, At, B1); PG8_BAR; PG8_SCHED;
            } else {
            PG8_LDB(B0, 0, 0); PG8_SCHED; PG8_LDA(At, 0, 0); PG8_STAGE(PG8_SA(1, 1), a1 + hstep, voffA);
            PG8_WAIT_L(8); PG8_BAR; PG8_WAIT_L(0); PG8_MMA(0, 0, At, B0); PG8_BAR; PG8_SCHED;
            PG8_LDB(B1, 0, 1); PG8_STAGE(PG8_SB(0, 0), b2, voffB);
            PG8_BAR; PG8_WAIT_L(0); PG8_MMA(0, 1, At, B1); PG8_BAR;
            PG8_LDA(At, 0, 1); PG8_STAGE(PG8_SA(0, 0), a2, voffA);
            PG8_BAR; PG8_WAIT_L(0); PG8_MMA(1, 0, At, B0); PG8_BAR; PG8_SCHED;
            PG8_STAGE(PG8_SB(0, 1), b2 + hstep, voffB);
            PG8_WAIT_V(6); PG8_BAR; PG8_MMA(1, 1, At, B1); PG8_BAR;
            PG8_LDB(B0, 1, 0); PG8_SCHED; PG8_LDA(At, 1, 0); PG8_STAGE(PG8_SA(0, 1), a2 + hstep, voffA);
            PG8_WAIT_L(8); PG8_BAR; PG8_WAIT_L(0); PG8_MMA(0, 0, At, B0); PG8_BAR; PG8_SCHED;
            PG8_LDB(B1, 1, 1); PG8_STAGE(PG8_SB(1, 0), b3, voffB);
            PG8_BAR; PG8_WAIT_L(0); PG8_MMA(0, 1, At, B1); PG8_BAR;
            PG8_LDA(At, 1, 1); PG8_STAGE(PG8_SA(1, 0), a3, voffA);
            PG8_BAR; PG8_WAIT_L(0); PG8_MMA(1, 0, At, B0); PG8_BAR; PG8_SCHED;
            PG8_STAGE(PG8_SB(1, 1), b3 + hstep, voffB);
            PG8_WAIT_V(6); PG8_BAR; PG8_MMA(1, 1, At, B1); PG8_BAR;
            }
        }
        if constexpr (ALIGN_EPI) { if (wr == 0) PG8_BAR; }
        if constexpr (!Epi::AFTER_DRAIN) { E(acc, cur, wr, wc, fr, fq); S.done(cur); }
        if (!has_next) break;
#pragma unroll
        for (int a = 0; a < 2; ++a)
#pragma unroll
            for (int b = 0; b < 2; ++b)
#pragma unroll
                for (int m = 0; m < 4; ++m)
#pragma unroll
                    for (int n = 0; n < 2; ++n) acc[a][b][m][n] = (f32x4){0.f, 0.f, 0.f, 0.f};
        cur = nxt; cA = nA; cB = nB; ++ui;
        if constexpr (ALIGN_EPI) { if (wr == 1) PG8_BAR; }
    }
    PG8_WAIT_V(0);
    if constexpr (!ALIGN_EPI) { if (wr == 0) PG8_BAR; }
    PG8_BAR;
    if constexpr (Epi::AFTER_DRAIN) { E.fused(acc, cur, wr, wc, fr, fq, lds, wid, lane); S.done(cur); }
#undef PG8_SA
#undef PG8_SB
#undef PG8_STAGE
#undef PG8_LDA
#undef PG8_LDB
#undef PG8_MMA
#undef PG8_WAIT_V
#undef PG8_WAIT_L
#undef PG8_BAR
#undef PG8_SCHED
}
}

constexpr int NWAVES = 8, NT = 512;
constexpr int D = 1024, BATCH = 4, SEQ = 8192, NMETA = 16;
constexpr int RPB = 8448;
constexpr int RFRONT = 48, RTOK = 64, REND = 8256;
constexpr int NCHUNK = 129;
constexpr int NPJ = 10240;
constexpr int N1 = 10496;
constexpr int PJ_Q = 0, PJ_K = 512, PJ_V = 1024, PJ_GO = 2048, PJ_Z = 3072, PJ_XBC = 5120, PJ_GA = 8192, PJ_GB = 9216;
constexpr int NTOK = BATCH * SEQ;
constexpr float RMS_EPS = 1e-6f;

constexpr size_t MiB = 1u << 20;
constexpr size_t WS_CTL = 0, CTL_ZERO_BYTES = 1 * MiB;
constexpr size_t WS_W1T = 2 * MiB;
constexpr size_t WS_WAT = 23 * MiB;
constexpr size_t WS_WBT = 25 * MiB;
constexpr size_t WS_WOT = 29 * MiB;
constexpr size_t WS_WET = 31 * MiB;
constexpr size_t WS_HNM = 35 * MiB;
constexpr size_t WS_HN = 36 * MiB;
constexpr size_t WS_PJ = 53 * MiB;
constexpr size_t WS_TL = 218 * MiB;
constexpr size_t WS_XC = 220 * MiB;
constexpr size_t WS_GG = 270 * MiB;
constexpr size_t WS_DT = 287 * MiB;
constexpr size_t WS_AC = 289 * MiB;
constexpr size_t WS_LG = 291 * MiB;
constexpr size_t WS_LS = 324 * MiB;
constexpr size_t WS_OG = 389 * MiB;
constexpr size_t WS_YS = 406 * MiB;
constexpr size_t WS_T1 = 439 * MiB;
constexpr size_t WS_MX = 456 * MiB;
constexpr size_t WS_MIX_END = 473 * MiB;
constexpr size_t WS_HN2 = 36 * MiB;
constexpr size_t WS_SC = 100 * MiB;
constexpr size_t WS_HN8 = 356 * MiB;
constexpr size_t WS_U8 = 474 * MiB;
constexpr size_t WS_END = 506 * MiB;
constexpr int CW_BAR = 4096, CW_QUEUE = 64;

constexpr int LDS_WORK = 147456;
constexpr int LDSCTL_OFF = LDS_WORK;
constexpr int LDS_BYTES = LDS_WORK + 512;

#define GAS __attribute__((address_space(1)))
#define LAS __attribute__((address_space(3)))
typedef unsigned short bf16;
typedef unsigned v4u __attribute__((ext_vector_type(4)));
typedef unsigned v2u __attribute__((ext_vector_type(2)));
typedef float f32x4 __attribute__((ext_vector_type(4)));
typedef float f32x2 __attribute__((ext_vector_type(2)));
typedef short bf16x8 __attribute__((ext_vector_type(8)));
typedef short s16x4 __attribute__((ext_vector_type(4)));
typedef short v4i16_t __attribute__((ext_vector_type(4)));
typedef LAS unsigned char* ldsp;
#define RLX_AGENT __ATOMIC_RELAXED, __HIP_MEMORY_SCOPE_AGENT
#define LDS_WAIT() asm volatile("s_waitcnt lgkmcnt(0)" ::: "memory")

__device__ __forceinline__ unsigned pk2(float lo, float hi) { return pg8::cvt_pk_bf16(lo, hi); }
__device__ __forceinline__ float bflo(unsigned u) { return __builtin_bit_cast(float, u << 16); }
__device__ __forceinline__ float bfhi(unsigned u) { return __builtin_bit_cast(float, u & 0xffff0000u); }
__device__ __forceinline__ float fast_rcp(float x) { return __builtin_amdgcn_rcpf(x); }
__device__ __forceinline__ float sigmoidf_(float x) { return fast_rcp(1.f + __expf(-x)); }
__device__ __forceinline__ float siluf_(float x) { return x * sigmoidf_(x); }
__device__ __forceinline__ float wave_sum(float v) {
#pragma unroll
    for (int o = 1; o < 64; o <<= 1) v += __shfl_xor(v, o);
    return v;
}
__device__ __forceinline__ float wave_max(float v) {
#pragma unroll
    for (int o = 1; o < 64; o <<= 1) v = fmaxf(v, __shfl_xor(v, o));
    return v;
}
__device__ __forceinline__ f32x4 mma16(bf16x8 a, bf16x8 b, f32x4 c) { return __builtin_amdgcn_mfma_f32_16x16x32_bf16(b, a, c, 0, 0, 0); }
__device__ __forceinline__ bf16x8 lds_frag(ldsp p) { return *(const LAS bf16x8*)p; }
__device__ __forceinline__ s16x4 lds_tr(ldsp p) { return __builtin_bit_cast(s16x4, __builtin_amdgcn_ds_read_tr16_b64_v4i16((LAS v4i16_t*)p)); }
__device__ __forceinline__ bf16x8 tr_frag(ldsp tile, int pitch, int k0, int n0, int fr, int fq) {
#ifdef TR_SLOW
    bf16x8 r;
#pragma unroll
    for (int e = 0; e < 8; ++e) r[e] = *(const LAS short*)(tile + (k0 + 8 * fq + e) * pitch + (n0 + fr) * 2);
    return r;
#else
    ldsp p = tile + (k0 + 8 * fq + (fr >> 2)) * pitch + (n0 + 4 * (fr & 3)) * 2;
    const s16x4 lo = lds_tr(p), hi = lds_tr(p + 4 * pitch);
    bf16x8 r; r[0] = lo[0]; r[1] = lo[1]; r[2] = lo[2]; r[3] = lo[3]; r[4] = hi[0]; r[5] = hi[1]; r[6] = hi[2]; r[7] = hi[3];
    return r;
#endif
}

#define XB_TMO      128
#define XB_XCNT(j)  (256  + 64 * (j))
#define XB_XSUB(j)  (1280 + 64 * (j))
#define XB_XGEN(j)  (2304 + 64 * (j))
#define XB_TOP      3328
#define XB_TOPGEN   3392
#define XCD_BAR_WORDS 3456
#define XB_SPIN_CAP (1u << 22)
__device__ __forceinline__ unsigned xb_ld(unsigned* p)              { return __hip_atomic_load(p, __ATOMIC_RELAXED, __HIP_MEMORY_SCOPE_AGENT); }
__device__ __forceinline__ unsigned xb_add(unsigned* p, unsigned v) { return __hip_atomic_fetch_add(p, v, __ATOMIC_RELAXED, __HIP_MEMORY_SCOPE_AGENT); }
__device__ __forceinline__ unsigned xb_xcc_id() { return (unsigned)__builtin_amdgcn_s_getreg((3 << 11) | 20) & 0xFu; }
#define XB_SPIN(cond, bar) do { unsigned _sp = 0; while (cond) { __builtin_amdgcn_s_sleep(1); \
    if ((++_sp & 255u) == 0u) { if (xb_ld(&(bar)[XB_TMO])) break; if (_sp > XB_SPIN_CAP) { atomicAdd(&(bar)[XB_TMO], 1u); break; } } } } while (0)
struct XcdBarrier { unsigned* bar; unsigned x; volatile LAS unsigned* st; };
__device__ __forceinline__ XcdBarrier xcd_barrier_post(unsigned* bar, volatile LAS unsigned* st) {
    XcdBarrier b; b.bar = bar; b.x = xb_xcc_id(); b.st = st;
    if (threadIdx.x == 0) (void)xb_add(&bar[XB_XCNT(b.x)], 1u);
    return b;
}
__device__ __forceinline__ void xcd_barrier_complete(unsigned* bar, unsigned x, unsigned& nloc, unsigned& nx) {
    const unsigned G = gridDim.x * gridDim.y * gridDim.z;
    unsigned sum, cnt, mine, sp = 0u;
    for (;;) {
        sum = 0u; cnt = 0u; mine = 0u;
#pragma unroll
        for (unsigned j = 0; j < 16; ++j) { const unsigned c = xb_ld(&bar[XB_XCNT(j)]); sum += c; cnt += (c > 0u) ? 1u : 0u; mine = (j == x) ? c : mine; }
        if (sum == G) break;
        __builtin_amdgcn_s_sleep(1);
        if ((++sp & 255u) == 0u) { if (xb_ld(&bar[XB_TMO])) break; if (sp > XB_SPIN_CAP) { atomicAdd(&bar[XB_TMO], 1u); break; } }
    }
    nloc = mine > 0u ? mine : 1u; nx = cnt > 0u ? cnt : 1u;
}
__device__ __forceinline__ void xcd_barrier(const XcdBarrier& b) {
    asm volatile("s_waitcnt vmcnt(0)" ::: "memory");
    __syncthreads();
    if (threadIdx.x == 0) {
        unsigned* bar = b.bar;
        __builtin_amdgcn_s_waitcnt(0);
        unsigned nloc = b.st[0], nx = b.st[1];
        if (nloc == 0u) { xcd_barrier_complete(bar, b.x, nloc, nx); b.st[0] = nloc; b.st[1] = nx; }
        const unsigned old = xb_add(&bar[XB_XSUB(b.x)], 1u);
        const unsigned gen = old / nloc;
        if (old + 1u == (gen + 1u) * nloc) {
            __builtin_amdgcn_fence(__ATOMIC_RELEASE, "agent");
            asm volatile("s_waitcnt vmcnt(0)" ::: "memory");
            const unsigned og = xb_add(&bar[XB_TOP], 1u);
            const unsigned tg = og / nx;
            if (og + 1u == (tg + 1u) * nx) xb_add(&bar[XB_TOPGEN], 1u);
            else XB_SPIN(xb_ld(&bar[XB_TOPGEN]) == tg, bar);
            __builtin_amdgcn_fence(__ATOMIC_ACQUIRE, "agent");
            xb_add(&bar[XB_XGEN(b.x)], 1u);
            asm volatile("s_waitcnt vmcnt(0)" ::: "memory");
        } else {
            XB_SPIN(xb_ld(&bar[XB_XGEN(b.x)]) == gen, bar);
            __builtin_amdgcn_fence(__ATOMIC_ACQUIRE, "agent");
            asm volatile("s_waitcnt vmcnt(0)" ::: "memory");
        }
    }
    __syncthreads();
}

struct Ctx {
    ldsp lds; int tid, lane, wave, G, bid;
    const float* in[22]; float* out; unsigned char* ws;
};
enum { I_X = 0, I_META, I_LNMIX, I_WIN, I_WG2, I_BG, I_GNW, I_CONVW, I_CONVB, I_DTB, I_ALOG, I_DSKIP, I_SNW, I_WUG, I_WUS, I_WOUT, I_LNFFN, I_WQ, I_KEYS, I_PU, I_PV, I_LNF };

using pg8::Unit; using pg8::cvt_pk_bf16;
struct EpiProj {
    static constexpr bool PERM = true, AFTER_DRAIN = false;
    bf16* PJ; float* TL;
    __device__ __forceinline__ void operator()(const f32x4 (&acc)[2][2][4][2], const Unit& u, int wr, int wc, int fr, int fq) const {
        const int row0 = RTOK + u.pm * 256 + wr * 64 + fr; const int pn = u.pn;
        const int mode = pn < 2 ? 1 : (pn < 8 ? 0 : (pn < 20 ? 2 : (pn < 32 ? 0 : 3)));
        const int col0 = pn * 256 + wc * 32 + 8 * fq;
#pragma unroll
        for (int ai = 0; ai < 2; ++ai)
#pragma unroll
            for (int m = 0; m < 4; ++m) { bf16* rowp = PJ + (size_t)(row0 + ai * 128 + m * 16) * NPJ + col0;
#pragma unroll
                for (int bj = 0; bj < 2; ++bj) { f32x4 v0 = acc[ai][bj][m][0], v1 = acc[ai][bj][m][1];
                    if (mode == 1) { v0 = v0 * 0.08838834764831845f; v1 = v1 * 0.08838834764831845f; }
                    else if (mode == 2) {
#pragma unroll
                        for (int j = 0; j < 4; ++j) { v0[j] = siluf_(v0[j]); v1[j] = siluf_(v1[j]); } }
                    else if (mode == 3) {
#pragma unroll
                        for (int j = 0; j < 4; ++j) { v0[j] = sigmoidf_(v0[j]); v1[j] = sigmoidf_(v1[j]); } }
                    v4u w; w.x = cvt_pk_bf16(v0[0], v0[1]); w.y = cvt_pk_bf16(v0[2], v0[3]); w.z = cvt_pk_bf16(v1[0], v1[1]); w.w = cvt_pk_bf16(v1[2], v1[3]);
                    *(GAS v4u*)(rowp + bj * 128) = w; } }
    }
};
struct EpiAny {
    static constexpr bool PERM = true, AFTER_DRAIN = false;
    int mode;
    EpiProj P; bf16* O; const bf16* PJ; const bf16* T; int gcol; const float* X; float* OF; int b; int ldc;
    __device__ __forceinline__ void operator()(const f32x4 (&acc)[2][2][4][2], const Unit& u, int wr, int wc, int fr, int fq) const {
        if (mode == 0) { P(acc, u, wr, wc, fr, fq); return; }
        const int row0 = u.pm * 256 + wr * 64 + fr; const int col0 = u.pn * 256 + wc * 32 + 8 * fq;
        if (mode == 1) {
#pragma unroll
            for (int ai = 0; ai < 2; ++ai)
#pragma unroll
                for (int m = 0; m < 4; ++m) { const size_t r = (size_t)(row0 + ai * 128 + m * 16);
                    v4u gq[2], tq[2];
#pragma unroll
                    for (int bj = 0; bj < 2; ++bj) { gq[bj] = *(const GAS v4u*)(PJ + r * NPJ + gcol + col0 + bj * 128); tq[bj] = T ? *(const GAS v4u*)(T + r * 1024 + col0 + bj * 128) : (v4u){0u, 0u, 0u, 0u}; }
#pragma unroll
                    for (int bj = 0; bj < 2; ++bj) { const int c = col0 + bj * 128;
                        const v4u g = gq[bj];
                        f32x4 v0 = acc[ai][bj][m][0], v1 = acc[ai][bj][m][1];
                        v0[0] *= bflo(g.x); v0[1] *= bfhi(g.x); v0[2] *= bflo(g.y); v0[3] *= bfhi(g.y); v1[0] *= bflo(g.z); v1[1] *= bfhi(g.z); v1[2] *= bflo(g.w); v1[3] *= bfhi(g.w);
                        { const v4u t = tq[bj];
                            v0[0] += bflo(t.x); v0[1] += bfhi(t.x); v0[2] += bflo(t.y); v0[3] += bfhi(t.y); v1[0] += bflo(t.z); v1[1] += bfhi(t.z); v1[2] += bflo(t.w); v1[3] += bfhi(t.w); }
                        v4u w; w.x = cvt_pk_bf16(v0[0], v0[1]); w.y = cvt_pk_bf16(v0[2], v0[3]); w.z = cvt_pk_bf16(v1[0], v1[1]); w.w = cvt_pk_bf16(v1[2], v1[3]);
                        *(GAS v4u*)(O + r * 1024 + c) = w; } }
        } else if (mode == 2) {
#pragma unroll
            for (int ai = 0; ai < 2; ++ai)
#pragma unroll
                for (int m = 0; m < 4; ++m) { const int r = row0 + ai * 128 + m * 16;
                    if (r >= RTOK && r < REND) { const size_t o = ((size_t)b * SEQ + (r - RTOK)) * D + col0;
                        f32x4 xv[2][2];
#pragma unroll
                        for (int bj = 0; bj < 2; ++bj)
#pragma unroll
                            for (int n = 0; n < 2; ++n) xv[bj][n] = *(const GAS f32x4*)(X + o + bj * 128 + n * 4);
#pragma unroll
                        for (int bj = 0; bj < 2; ++bj)
#pragma unroll
                            for (int n = 0; n < 2; ++n) *(GAS f32x4*)(OF + o + bj * 128 + n * 4) = acc[ai][bj][m][n] + xv[bj][n]; } }
        } else {
#pragma unroll
            for (int ai = 0; ai < 2; ++ai)
#pragma unroll
                for (int m = 0; m < 4; ++m) { _Float16* rowp = (_Float16*)OF + (size_t)(row0 + ai * 128 + m * 16) * ldc + col0;
#pragma unroll
                    for (int bj = 0; bj < 2; ++bj) { const f32x4 v0 = acc[ai][bj][m][0], v1 = acc[ai][bj][m][1];
                        typedef _Float16 h2 __attribute__((ext_vector_type(2)));
                        const h2 p0 = {(_Float16)v0[0], (_Float16)v0[1]}, p1 = {(_Float16)v0[2], (_Float16)v0[3]}, p2 = {(_Float16)v1[0], (_Float16)v1[1]}, p3 = {(_Float16)v1[2], (_Float16)v1[3]};
                        *(GAS v4u*)(rowp + bj * 128) = (v4u){__builtin_bit_cast(unsigned, p0), __builtin_bit_cast(unsigned, p1), __builtin_bit_cast(unsigned, p2), __builtin_bit_cast(unsigned, p3)}; } }
        }
    }
};

struct MapIdent { __device__ __forceinline__ int operator()(int n) const { return n; } };
struct MapW1 { __device__ __forceinline__ int operator()(int n) const {
    if (n < 3072) return n;
    if (n < 8192) return n + 16;
    if (n < 10240) return n + 48;
    if (n < 10256) return n - 10240 + 3072;
    if (n < 10288) return n - 10256 + 8208;
    return -1; } };
template <class Map>
__device__ __forceinline__ void transpose_item(const float* W, int K, int NS, int N, bf16* WT, LAS float* scr, int item, int lane, const Map& map) {
    const int nblk = N / 32, kb = item / nblk, nb = item % nblk, k0 = 64 * kb, n0 = 32 * nb;
    const int sc = map(n0 + (lane & 31));
#pragma unroll
    for (int i0 = 0; i0 < 32; i0 += 16) { float tv[16];
#pragma unroll
        for (int i = 0; i < 16; ++i) { const int kk = 2 * (i0 + i) + (lane >> 5); tv[i] = sc >= 0 ? *(const GAS float*)(W + (size_t)(k0 + kk) * NS + sc) : 0.f; }
#pragma unroll
        for (int i = 0; i < 16; ++i) { const int kk = 2 * (i0 + i) + (lane >> 5); scr[kk * 33 + (lane & 31)] = tv[i]; } }
    LDS_WAIT(); asm volatile("" ::: "memory");
    const int c = lane & 7;
#pragma unroll
    for (int j = 0; j < 4; ++j) { const int n = (lane >> 3) + 8 * j; const LAS float* s = scr + (8 * c) * 33 + n;
        v4u o; o.x = pk2(s[0 * 33], s[1 * 33]); o.y = pk2(s[2 * 33], s[3 * 33]); o.z = pk2(s[4 * 33], s[5 * 33]); o.w = pk2(s[6 * 33], s[7 * 33]);
        *(GAS v4u*)(WT + (size_t)(n0 + n) * K + k0 + 8 * c) = o; }
    LDS_WAIT(); asm volatile("" ::: "memory");
}
__device__ __forceinline__ void norm_row_bf16(const float* src, const float* w, bf16* dst, int lane) {
    v2u* o8 = (v2u*)dst + lane;
    if (src == nullptr) {
#pragma unroll
        for (int j = 0; j < 4; ++j) o8[64 * j] = (v2u){0u, 0u};
        return; }
    const f32x4* xr = (const f32x4*)src + lane; const f32x4* wr_ = (const f32x4*)w + lane;
    f32x4 v[4]; float s = 0.f;
#pragma unroll
    for (int j = 0; j < 4; ++j) { v[j] = xr[64 * j]; s += (v[j].x * v[j].x + v[j].y * v[j].y) + (v[j].z * v[j].z + v[j].w * v[j].w); }
    const float rs = rsqrtf(wave_sum(s) * (1.f / D) + RMS_EPS);
#pragma unroll
    for (int j = 0; j < 4; ++j) { const f32x4 ww = wr_[64 * j]; v2u o; o.x = pk2(v[j].x * rs * ww.x, v[j].y * rs * ww.y); o.y = pk2(v[j].z * rs * ww.z, v[j].w * rs * ww.w); o8[64 * j] = o; }
}
__device__ __forceinline__ float wave_sum63(float v) {
    v += __builtin_bit_cast(float, __builtin_amdgcn_mov_dpp(__builtin_bit_cast(int, v), 0xB1, 0xf, 0xf, true));
    v += __builtin_bit_cast(float, __builtin_amdgcn_mov_dpp(__builtin_bit_cast(int, v), 0x4E, 0xf, 0xf, true));
    v += __builtin_bit_cast(float, __builtin_amdgcn_mov_dpp(__builtin_bit_cast(int, v), 0x141, 0xf, 0xf, true));
    v += __builtin_bit_cast(float, __builtin_amdgcn_mov_dpp(__builtin_bit_cast(int, v), 0x128, 0xf, 0xf, true));
    v += __builtin_bit_cast(float, __builtin_amdgcn_update_dpp(0, __builtin_bit_cast(int, v), 0x142, 0xa, 0xf, false));
    v += __builtin_bit_cast(float, __builtin_amdgcn_update_dpp(0, __builtin_bit_cast(int, v), 0x143, 0xc, 0xf, false));
    return v;
}
__device__ __forceinline__ void hn_token_rows2(const Ctx& C, int b, int s0, int s1) {
    const int lane = C.lane;
    const f32x4* x0 = (const f32x4*)(C.in[I_X] + ((size_t)b * SEQ + s0) * D) + lane; const f32x4* x1 = (const f32x4*)(C.in[I_X] + ((size_t)b * SEQ + s1) * D) + lane;
    const f32x4* wr_ = (const f32x4*)C.in[I_LNMIX] + lane;
    f32x4 v[4], u[4]; float q0 = 0.f, q1 = 0.f;
#pragma unroll
    for (int j = 0; j < 4; ++j) { v[j] = x0[64 * j]; u[j] = x1[64 * j]; }
#pragma unroll
    for (int j = 0; j < 4; ++j) { q0 += (v[j].x * v[j].x + v[j].y * v[j].y) + (v[j].z * v[j].z + v[j].w * v[j].w); q1 += (u[j].x * u[j].x + u[j].y * u[j].y) + (u[j].z * u[j].z + u[j].w * u[j].w); }
    const float r0 = rsqrtf(wave_sum(q0) * (1.f / D) + RMS_EPS), r1 = rsqrtf(wave_sum(q1) * (1.f / D) + RMS_EPS);
    v2u* o0 = (v2u*)((bf16*)(C.ws + WS_HN) + (size_t)s0 * D) + lane; v2u* o1 = (v2u*)((bf16*)(C.ws + WS_HN) + (size_t)s1 * D) + lane;
#pragma unroll
    for (int j = 0; j < 4; ++j) { const f32x4 ww = wr_[64 * j]; const f32x4 a = v[j] * r0 * ww, bq = u[j] * r1 * ww;
        o0[64 * j] = (v2u){pk2(a.x, a.y), pk2(a.z, a.w)}; o1[64 * j] = (v2u){pk2(bq.x, bq.y), pk2(bq.z, bq.w)}; }
}
__device__ __forceinline__ void hn_batch(const Ctx& C, int b, int first_blk) {
    if (C.bid < first_blk) return;
    const int gw = (C.bid - first_blk) * NWAVES + C.wave, NGW = (C.G - first_blk) * NWAVES;
    for (int s = gw; s < SEQ / 2; s += NGW) hn_token_rows2(C, b, s, s + SEQ / 2);
}
__device__ __forceinline__ void meta_proj(const Ctx& C) {
    const bf16* HNM = (const bf16*)(C.ws + WS_HNM); const bf16* W1T = (const bf16*)(C.ws + WS_W1T);
    bf16* PJ = (bf16*)(C.ws + WS_PJ); float* TL = (float*)(C.ws + WS_TL);
    const int gw = C.bid * NWAVES + C.wave, NGW = C.G * NWAVES, fr = C.lane & 15, fq = C.lane >> 4;
    for (int nt = gw; nt < 643; nt += NGW) {
        f32x4 acc = {0.f, 0.f, 0.f, 0.f};
#pragma unroll 8
        for (int ks = 0; ks < 32; ++ks) acc = mma16(*(const GAS bf16x8*)(HNM + fr * D + 32 * ks + 8 * fq), *(const GAS bf16x8*)(W1T + (size_t)(16 * nt + fr) * D + 32 * ks + 8 * fq), acc);
        const int n = 16 * nt + 4 * fq;
        if (n >= NPJ) { if (n < NPJ + 48) *(GAS f32x4*)(TL + (size_t)(RFRONT + fr) * 48 + (n - NPJ)) = acc; continue; }
        if (n < 512) acc = acc * 0.08838834764831845f;
        else if ((n >= PJ_GO && n < PJ_XBC)) { acc[0] = siluf_(acc[0]); acc[1] = siluf_(acc[1]); acc[2] = siluf_(acc[2]); acc[3] = siluf_(acc[3]); }
        else if (n >= PJ_GA) { acc[0] = sigmoidf_(acc[0]); acc[1] = sigmoidf_(acc[1]); acc[2] = sigmoidf_(acc[2]); acc[3] = sigmoidf_(acc[3]); }
        *(GAS v2u*)(PJ + (size_t)(RFRONT + fr) * NPJ + n) = (v2u){pk2(acc[0], acc[1]), pk2(acc[2], acc[3])};
    }
}
__device__ __forceinline__ void tail_proj(const Ctx& C) {
    int tid_ = C.tid; asm volatile("" : "+v"(tid_));
    const int lane_ = tid_ & 63, wave_ = __builtin_amdgcn_readfirstlane(tid_ >> 6), fr = lane_ & 15, fq = lane_ >> 4;
    const bf16* HN = (const bf16*)(C.ws + WS_HN); const bf16* WT = (const bf16*)(C.ws + WS_W1T) + (size_t)NPJ * D; float* TL = (float*)(C.ws + WS_TL);
    constexpr int PW = 2064;
    ldsp WL = C.lds; LAS f32x4* PR = (LAS f32x4*)(C.lds + 48 * PW);
    { v4u ww[12];
#pragma unroll
      for (int i = 0; i < 12; ++i) { const int e = tid_ + NT * i, row = e >> 7, ch = e & 127; ww[i] = *(const GAS v4u*)(WT + (size_t)row * D + 8 * ch); }
#pragma unroll
      for (int i = 0; i < 12; ++i) { const int e = tid_ + NT * i, row = e >> 7, ch = e & 127; *(LAS v4u*)(WL + row * PW + ch * 16) = ww[i]; } }
    const int rsel = wave_ & 1, kq = wave_ >> 1;
    for (int rp = C.bid; rp < SEQ / 32; rp += C.G) {
        const int rt = 2 * rp + rsel;
        bf16x8 a[8];
#pragma unroll
        for (int i = 0; i < 8; ++i) a[i] = *(const GAS bf16x8*)(HN + (size_t)(16 * rt + fr) * D + 32 * (8 * kq + i) + 8 * fq);
        __syncthreads();
        f32x4 acc[3] = {{0.f, 0.f, 0.f, 0.f}, {0.f, 0.f, 0.f, 0.f}, {0.f, 0.f, 0.f, 0.f}};
#pragma unroll
        for (int i = 0; i < 8; ++i)
#pragma unroll
            for (int n = 0; n < 3; ++n) acc[n] = mma16(a[i], lds_frag(WL + (16 * n + fr) * PW + (32 * (8 * kq + i) + 8 * fq) * 2), acc[n]);
#pragma unroll
        for (int n = 0; n < 3; ++n) PR[(wave_ * 3 + n) * 64 + lane_] = acc[n];
        __syncthreads();
        if (wave_ < 2) {
#pragma unroll
            for (int n = 0; n < 3; ++n) { f32x4 s = PR[((0 * 2 + wave_) * 3 + n) * 64 + lane_] + PR[((1 * 2 + wave_) * 3 + n) * 64 + lane_] + PR[((2 * 2 + wave_) * 3 + n) * 64 + lane_] + PR[((3 * 2 + wave_) * 3 + n) * 64 + lane_];
                *(GAS f32x4*)(TL + (size_t)(RTOK + 16 * (2 * rp + wave_) + fr) * 48 + 16 * n + 4 * fq) = s; }
        }
    }
    __syncthreads();
}
__device__ __forceinline__ void p0b_prologue(const Ctx& C) {
    const int gw = C.bid * NWAVES + C.wave;
    if (gw < NMETA) norm_row_bf16(C.in[I_META] + (size_t)gw * D, C.in[I_LNMIX], (bf16*)(C.ws + WS_HNM) + (size_t)gw * D, C.lane);
    { v4u* z = (v4u*)(C.ws + WS_PJ); const size_t n = (size_t)RFRONT * NPJ * 2 / 16; for (size_t i = (size_t)C.bid * NT + C.tid; i < n; i += (size_t)C.G * NT) z[i] = (v4u){0u, 0u, 0u, 0u}; }
    { v4u* z = (v4u*)(C.ws + WS_TL); const size_t n = (size_t)RFRONT * 48 * 4 / 16; for (size_t i = (size_t)C.bid * NT + C.tid; i < n; i += (size_t)C.G * NT) z[i] = (v4u){0u, 0u, 0u, 0u}; }
    hn_batch(C, 0, 0);
}
__device__ __forceinline__ void weff_unit(const Ctx& C, int unit) {
    int tid_ = C.tid; asm volatile("" : "+v"(tid_));
    const int lane_ = tid_ & 63, wave_ = __builtin_amdgcn_readfirstlane(tid_ >> 6); (void)lane_; (void)wave_;
    const int blk = unit >> 4, d0 = (unit & 15) * 64;
    LAS float* KT = (LAS float*)C.lds;
    LAS float* WQ = (LAS float*)(C.lds + 128 * 132 * 4);
    const float* keys = C.in[I_KEYS] + (size_t)blk * 128 * 128; const float* wq = C.in[I_WQ];
    { f32x4 kv_[8];
#pragma unroll
      for (int i = 0; i < 8; ++i) { const int e = tid_ + NT * i, key = e >> 5, j4 = e & 31; kv_[i] = *(const GAS f32x4*)(keys + key * 128 + 4 * j4); }
#pragma unroll
      for (int i = 0; i < 8; ++i) { const int e = tid_ + NT * i, key = e >> 5, j4 = e & 31; *(LAS f32x4*)(KT + key * 132 + 4 * j4) = kv_[i]; } }
    { f32x4 wv_[4];
#pragma unroll
      for (int i = 0; i < 4; ++i) { const int e = tid_ + NT * i, dd = e >> 5, j4 = e & 31; wv_[i] = *(const GAS f32x4*)(wq + (size_t)(d0 + dd) * 2048 + blk * 128 + 4 * j4); }
#pragma unroll
      for (int i = 0; i < 4; ++i) { const int e = tid_ + NT * i, dd = e >> 5, j4 = e & 31; *(LAS f32x4*)(WQ + dd * 128 + 4 * j4) = wv_[i]; } }
    __syncthreads();
    const int key = tid_ & 127, dg = tid_ >> 7;
    float acc[16];
#pragma unroll
    for (int i = 0; i < 16; ++i) acc[i] = 0.f;
    for (int j4 = 0; j4 < 32; ++j4) {
        const f32x4 kv = *(const LAS f32x4*)(KT + key * 132 + 4 * j4);
#pragma unroll
        for (int i = 0; i < 16; ++i) { const f32x4 wv = *(const LAS f32x4*)(WQ + (dg * 16 + i) * 128 + 4 * j4); acc[i] += kv.x * wv.x + kv.y * wv.y + kv.z * wv.z + kv.w * wv.w; }
    }
    bf16* WET = (bf16*)(C.ws + WS_WET) + (size_t)(blk * 128 + key) * D + d0 + dg * 16;
    v4u o0, o1; o0.x = pk2(acc[0], acc[1]); o0.y = pk2(acc[2], acc[3]); o0.z = pk2(acc[4], acc[5]); o0.w = pk2(acc[6], acc[7]);
    o1.x = pk2(acc[8], acc[9]); o1.y = pk2(acc[10], acc[11]); o1.z = pk2(acc[12], acc[13]); o1.w = pk2(acc[14], acc[15]);
    *(v4u*)WET = o0; *(GAS v4u*)(WET + 8) = o1;
    __syncthreads();
}
__device__ __forceinline__ void p0_prologue(const Ctx& C) {
    LAS float* scr = (LAS float*)(C.lds + C.wave * 16384);
    const int gw = C.bid * NWAVES + C.wave, NGW = C.G * NWAVES;
    constexpr int I_1 = (D / 64) * (N1 / 32), I_A = (1024 / 64) * (1024 / 32), I_B = (2048 / 64) * (1024 / 32), I_O = I_A;
    constexpr int NITEMS = I_1 + I_A + I_B + I_O;
    for (int it = gw; it < NITEMS; it += NGW) {
        int r = it;
        if (r < I_1) { transpose_item(C.in[I_WIN], 1024, 10288, N1, (bf16*)(C.ws + WS_W1T), scr, r, C.lane, MapW1()); continue; } r -= I_1;
        if (r < I_A) { transpose_item(C.in[I_WUG], 1024, 1024, 1024, (bf16*)(C.ws + WS_WAT), scr, r, C.lane, MapIdent()); continue; } r -= I_A;
        if (r < I_B) { transpose_item(C.in[I_WUS], 2048, 1024, 1024, (bf16*)(C.ws + WS_WBT), scr, r, C.lane, MapIdent()); continue; } r -= I_B;
        transpose_item(C.in[I_WOUT], 1024, 1024, 1024, (bf16*)(C.ws + WS_WOT), scr, r, C.lane, MapIdent());
    }
    __syncthreads();
    for (int u = C.bid; u < 256; u += C.G) weff_unit(C, u);
}

__device__ __forceinline__ float softplusf_(float x) { return fmaxf(x, 0.f) + log1pf(__expf(-fabsf(x))); }
__device__ __forceinline__ void conv_batch(const Ctx& C) {
    const bf16* PJ = (const bf16*)(C.ws + WS_PJ); bf16* XC = (bf16*)(C.ws + WS_XC);
    const float* cw = C.in[I_CONVW]; const float* cb = C.in[I_CONVB];
    constexpr int SL = 25, NSEG = (REND + SL - 1) / SL, NITEM = 384 * NSEG;
    for (int id = C.bid * NT + C.tid; id < NITEM; id += C.G * NT) {
        const int ch = id % 384, seg = id / 384, col = 8 * ch, rb = SL * seg;
        v4u xr[SL + 3];
#pragma unroll
        for (int t = 0; t < SL + 3; ++t) { const int r = rb - 3 + t; xr[t] = (r >= 0 && r < REND) ? *(const GAS v4u*)(PJ + (size_t)r * NPJ + PJ_XBC + col) : (v4u){0u, 0u, 0u, 0u}; }
        f32x4 w[4][2], bb[2];
#pragma unroll
        for (int i = 0; i < 4; ++i) { w[i][0] = *(const GAS f32x4*)(cw + i * 3072 + col); w[i][1] = *(const GAS f32x4*)(cw + i * 3072 + col + 4); }
        bb[0] = *(const GAS f32x4*)(cb + col); bb[1] = *(const GAS f32x4*)(cb + col + 4);
#pragma unroll
        for (int t = 0; t < SL; ++t) {
            f32x4 o0 = bb[0], o1 = bb[1];
#pragma unroll
            for (int i = 0; i < 4; ++i) { const v4u x = xr[t + i];
                o0 += w[i][0] * (f32x4){bflo(x.x), bfhi(x.x), bflo(x.y), bfhi(x.y)}; o1 += w[i][1] * (f32x4){bflo(x.z), bfhi(x.z), bflo(x.w), bfhi(x.w)}; }
            v4u o = {pk2(siluf_(o0.x), siluf_(o0.y)), pk2(siluf_(o0.z), siluf_(o0.w)), pk2(siluf_(o1.x), siluf_(o1.y)), pk2(siluf_(o1.z), siluf_(o1.w))};
            if (rb + t < RFRONT) o = (v4u){0u, 0u, 0u, 0u};
            if (rb + t < REND) *(GAS v4u*)(XC + (size_t)(rb + t) * 3072 + col) = o;
        }
    }
}
__device__ __forceinline__ void phaseC_unit(const Ctx& C, int c, int k) {
    int tid_ = C.tid; asm volatile("" : "+v"(tid_));
    const int lane_ = tid_ & 63, wave_ = __builtin_amdgcn_readfirstlane(tid_ >> 6); (void)lane_; (void)wave_;
    const bf16* PJ = (const bf16*)(C.ws + WS_PJ); const float* TL = (const float*)(C.ws + WS_TL);
    bf16* XC = (bf16*)(C.ws + WS_XC); float* GG = (float*)(C.ws + WS_GG); float* DT = (float*)(C.ws + WS_DT); float* AC = (float*)(C.ws + WS_AC);
    const int r0 = 64 * c;
    if (k < 6) {
        const float* cw = C.in[I_CONVW]; const float* cb = C.in[I_CONVB];
        const int col = 512 * k + 2 * (tid_ & 255), rb = r0 + 32 * (tid_ >> 8);
        const f32x2 w0 = *(const GAS f32x2*)(cw + col), w1 = *(const GAS f32x2*)(cw + 3072 + col), w2 = *(const GAS f32x2*)(cw + 2 * 3072 + col), w3 = *(const GAS f32x2*)(cw + 3 * 3072 + col), bb = *(const GAS f32x2*)(cb + col);
        unsigned xr[35];
#pragma unroll
        for (int t = 0; t < 35; ++t) { const int r = rb - 3 + t; xr[t] = (r >= 0) ? *(const GAS unsigned*)(PJ + (size_t)r * NPJ + PJ_XBC + col) : 0u; }
#pragma unroll
        for (int t = 0; t < 32; ++t) {
            const int r = rb + t;
            const f32x2 xm3 = {bflo(xr[t]), bfhi(xr[t])}, xm2 = {bflo(xr[t + 1]), bfhi(xr[t + 1])}, xm1 = {bflo(xr[t + 2]), bfhi(xr[t + 2])}, x0 = {bflo(xr[t + 3]), bfhi(xr[t + 3])};
            f32x2 o = bb + w0 * xm3 + w1 * xm2 + w2 * xm1 + w3 * x0;
            o.x = siluf_(o.x); o.y = siluf_(o.y);
            if (r < RFRONT) { o.x = 0.f; o.y = 0.f; }
            *(GAS unsigned*)(XC + (size_t)r * 3072 + col) = pk2(o.x, o.y);
        }
        return;
    }
    if (k < 10) {
        const int col = 128 * (k - 6) + (tid_ & 127), rq = tid_ >> 7; const float* w2p = C.in[I_WG2]; float w2[16];
        LAS float* PS = (LAS float*)C.lds;
#pragma unroll
        for (int j = 0; j < 16; ++j) w2[j] = w2p[j * 512 + col];
        const float bg = C.in[I_BG][col]; float G = 0.f; float gv[16];
#pragma unroll
        for (int t = 0; t < 16; ++t) {
            const int r = r0 + 16 * rq + t; const float* gl = TL + (size_t)r * 48;
            float z = bg;
#pragma unroll
            for (int j4 = 0; j4 < 4; ++j4) { const f32x4 g = *(const GAS f32x4*)(gl + 4 * j4); z += g.x * w2[4 * j4] + g.y * w2[4 * j4 + 1] + g.z * w2[4 * j4 + 2] + g.w * w2[4 * j4 + 3]; }
            float ls = fminf(z, 0.f) - __logf(1.f + __expf(-fabsf(z)));
            if (r < RFRONT) ls = 0.f;
            G += ls * (1.f / 16.f); gv[t] = G;
        }
        PS[rq * 128 + (tid_ & 127)] = G;
        __syncthreads();
        float base = 0.f;
#pragma unroll
        for (int q = 0; q < 3; ++q) base += (q < rq) ? PS[q * 128 + (tid_ & 127)] : 0.f;
#pragma unroll
        for (int t = 0; t < 16; ++t) GG[(size_t)(r0 + 16 * rq + t) * 512 + col] = gv[t] + base;
        __syncthreads();
        return;
    }
    {
        const int hd = tid_ & 31, rg = tid_ >> 5; const float bias = C.in[I_DTB][hd], A = -__expf(C.in[I_ALOG][hd]);
        LAS float* PS = (LAS float*)C.lds;
        float dtv[4], av[4], acum = 0.f;
#pragma unroll
        for (int t = 0; t < 4; ++t) {
            const int r = r0 + 4 * rg + t; const float x = TL[(size_t)r * 48 + 16 + hd] + bias;
            float dt = fmaxf(x, 0.f) + __logf(1.f + __expf(-fabsf(x)));
            if (r < RFRONT) dt = 0.f;
            acum += A * dt; dtv[t] = dt; av[t] = acum;
        }
        PS[rg * 32 + hd] = acum;
        __syncthreads();
        float base = 0.f;
#pragma unroll
        for (int q = 0; q < 15; ++q) base += (q < rg) ? PS[q * 32 + hd] : 0.f;
#pragma unroll
        for (int t = 0; t < 4; ++t) { const size_t r = (size_t)(r0 + 4 * rg + t); DT[r * 32 + hd] = dtv[t]; AC[r * 32 + hd] = av[t] + base; }
        __syncthreads();
    }
}

constexpr int P136 = 272, P264 = 528, P520 = 1040, P72 = 144;
__device__ __forceinline__ void gla_pass1_unit(const Ctx& C, int c, int h) {
    int tid_ = C.tid; asm volatile("" : "+v"(tid_));
    const int lane_ = tid_ & 63, wave_ = __builtin_amdgcn_readfirstlane(tid_ >> 6); (void)lane_; (void)wave_;
    const bf16* PJ = (const bf16*)(C.ws + WS_PJ); const float* GG = (const float*)(C.ws + WS_GG); bf16* LG = (bf16*)(C.ws + WS_LG);
    ldsp KD = C.lds, VT = C.lds + 64 * P136;
    const int r0 = 64 * c;
    v4u ka_[2], vv[4]; f32x4 a0_[2], a1_[2], l0_[2], l1_[2];
#pragma unroll
    for (int i = 0; i < 2; ++i) { const int e = tid_ + NT * i, s = e >> 4, k0 = (e & 15) * 8; const size_t r = (size_t)(r0 + s);
        ka_[i] = *(const GAS v4u*)(PJ + r * NPJ + PJ_K + 128 * h + k0);
        const float* g = GG + r * 512 + 128 * h + k0; const float* gl = GG + (size_t)(r0 + 63) * 512 + 128 * h + k0;
        a0_[i] = *(const GAS f32x4*)g; a1_[i] = *(const GAS f32x4*)(g + 4); l0_[i] = *(const GAS f32x4*)gl; l1_[i] = *(const GAS f32x4*)(gl + 4); }
#pragma unroll
    for (int i = 0; i < 4; ++i) { const int e = tid_ + NT * i, s = e >> 5, v0 = (e & 31) * 8; vv[i] = *(const GAS v4u*)(PJ + (size_t)(r0 + s) * NPJ + PJ_V + 256 * h + v0); }
#pragma unroll
    for (int i = 0; i < 2; ++i) {
        const int e = tid_ + NT * i, s = e >> 4, k0 = (e & 15) * 8;
        const v4u ka = ka_[i]; const f32x4 a0 = a0_[i], a1 = a1_[i], l0 = l0_[i], l1 = l1_[i];
        v4u o;
        o.x = pk2(bflo(ka.x) * __expf(l0.x - a0.x), bfhi(ka.x) * __expf(l0.y - a0.y)); o.y = pk2(bflo(ka.y) * __expf(l0.z - a0.z), bfhi(ka.y) * __expf(l0.w - a0.w));
        o.z = pk2(bflo(ka.z) * __expf(l1.x - a1.x), bfhi(ka.z) * __expf(l1.y - a1.y)); o.w = pk2(bflo(ka.w) * __expf(l1.z - a1.z), bfhi(ka.w) * __expf(l1.w - a1.w));
        *(LAS v4u*)(KD + s * P136 + k0 * 2) = o;
    }
#pragma unroll
    for (int i = 0; i < 4; ++i) { const int e = tid_ + NT * i, s = e >> 5, v0 = (e & 31) * 8; *(LAS v4u*)(VT + s * P264 + v0 * 2) = vv[i]; }
    __syncthreads();
    const int fr = lane_ & 15, fq = lane_ >> 4, w = wave_;
    f32x4 acc[2][8];
#pragma unroll
    for (int mi = 0; mi < 2; ++mi)
#pragma unroll
        for (int nt = 0; nt < 8; ++nt) acc[mi][nt] = (f32x4){0.f, 0.f, 0.f, 0.f};
#pragma unroll
    for (int ks = 0; ks < 2; ++ks) {
        bf16x8 af[2];
#pragma unroll
        for (int mi = 0; mi < 2; ++mi) af[mi] = tr_frag(VT, P264, 32 * ks, 32 * w + 16 * mi, fr, fq);
#pragma unroll
        for (int nt = 0; nt < 8; ++nt) { const bf16x8 bfm = tr_frag(KD, P136, 32 * ks, 16 * nt, fr, fq);
#pragma unroll
            for (int mi = 0; mi < 2; ++mi) acc[mi][nt] = mma16(af[mi], bfm, acc[mi][nt]); }
    }
    bf16* Lb = LG + ((size_t)(c * 4 + h) * 256) * 128;
#pragma unroll
    for (int mi = 0; mi < 2; ++mi)
#pragma unroll
        for (int nt = 0; nt < 8; ++nt) { const int v = 32 * w + 16 * mi + fr, k = 16 * nt + 4 * fq; const f32x4 a = acc[mi][nt];
            *(GAS v2u*)(Lb + (size_t)v * 128 + k) = (v2u){cvt_pk_bf16(a[0], a[1]), cvt_pk_bf16(a[2], a[3])}; }
    __syncthreads();
}
__device__ __forceinline__ void ssd_pass1_unit(const Ctx& C, int c, int g) {
    int tid_ = C.tid; asm volatile("" : "+v"(tid_));
    const int lane_ = tid_ & 63, wave_ = __builtin_amdgcn_readfirstlane(tid_ >> 6); (void)lane_; (void)wave_;
    const bf16* XC = (const bf16*)(C.ws + WS_XC); const float* DT = (const float*)(C.ws + WS_DT); const float* AC = (const float*)(C.ws + WS_AC); bf16* LS = (bf16*)(C.ws + WS_LS);
    ldsp XW = C.lds, BM = C.lds + 64 * P520;
    const int r0 = 64 * c;
    { const int ch = tid_ & 63, hd = 8 * g + (ch >> 3); const float al = AC[(size_t)(r0 + 63) * 32 + hd];
      v4u xx[8], bb[2]; float dd[8], aa[8];
#pragma unroll
      for (int i = 0; i < 8; ++i) { const size_t r = (size_t)(r0 + (tid_ >> 6) + 8 * i); xx[i] = *(const GAS v4u*)(XC + r * 3072 + 512 * g + 8 * ch); dd[i] = DT[r * 32 + hd]; aa[i] = AC[r * 32 + hd]; }
#pragma unroll
      for (int i = 0; i < 2; ++i) { const int e = tid_ + NT * i, s = e >> 4, c2 = e & 15; bb[i] = *(const GAS v4u*)(XC + (size_t)(r0 + s) * 3072 + 2048 + 128 * g + 8 * c2); }
#pragma unroll
      for (int i = 0; i < 2; ++i) { const int e = tid_ + NT * i, s = e >> 4, c2 = e & 15; *(LAS v4u*)(BM + s * P136 + c2 * 16) = bb[i]; }
#pragma unroll
      for (int i = 0; i < 8; ++i) { const int s = (tid_ >> 6) + 8 * i;
        const float sc = dd[i] * __expf(al - aa[i]); const v4u x = xx[i]; v4u o;
        o.x = pk2(bflo(x.x) * sc, bfhi(x.x) * sc); o.y = pk2(bflo(x.y) * sc, bfhi(x.y) * sc); o.z = pk2(bflo(x.z) * sc, bfhi(x.z) * sc); o.w = pk2(bflo(x.w) * sc, bfhi(x.w) * sc);
        *(LAS v4u*)(XW + s * P520 + ch * 16) = o; } }
    __syncthreads();
    const int fr = lane_ & 15, fq = lane_ >> 4, w = wave_;
    bf16* Lb = LS + ((size_t)(c * 32 + 8 * g + w) * 64) * 128;
#pragma unroll
    for (int nh = 0; nh < 2; ++nh) {
        f32x4 acc[4][4];
#pragma unroll
        for (int mi = 0; mi < 4; ++mi)
#pragma unroll
            for (int nt = 0; nt < 4; ++nt) acc[mi][nt] = (f32x4){0.f, 0.f, 0.f, 0.f};
#pragma unroll
        for (int ks = 0; ks < 2; ++ks) {
            bf16x8 af[4];
#pragma unroll
            for (int mi = 0; mi < 4; ++mi) af[mi] = tr_frag(XW, P520, 32 * ks, 64 * w + 16 * mi, fr, fq);
#pragma unroll
            for (int nt = 0; nt < 4; ++nt) { const bf16x8 bfm = tr_frag(BM, P136, 32 * ks, 64 * nh + 16 * nt, fr, fq);
#pragma unroll
                for (int mi = 0; mi < 4; ++mi) acc[mi][nt] = mma16(af[mi], bfm, acc[mi][nt]); }
        }
#pragma unroll
        for (int mi = 0; mi < 4; ++mi)
#pragma unroll
            for (int nt = 0; nt < 4; ++nt) { const int p = 16 * mi + fr, n = 64 * nh + 16 * nt + 4 * fq; const f32x4 a = acc[mi][nt];
                *(GAS v2u*)(Lb + (size_t)p * 128 + n) = (v2u){cvt_pk_bf16(a[0], a[1]), cvt_pk_bf16(a[2], a[3])}; }
    }
    __syncthreads();
}

__device__ __forceinline__ void phaseE(const Ctx& C) {
    const float* GG = (const float*)(C.ws + WS_GG); const float* AC = (const float*)(C.ws + WS_AC);
    constexpr int NB = 8;
    for (int vb = C.bid; vb < 256; vb += C.G) {
        if (vb < 128) {
            const int e = vb * NT + C.tid, k2 = e & 63, v = (e >> 6) & 255, h = e >> 14;
            GAS unsigned* Lp = (GAS unsigned*)(C.ws + WS_LG) + ((size_t)h * 256 + v) * 64 + k2;
            const GAS float* dp = (const GAS float*)GG + 63 * 512 + 128 * h + 2 * k2;
            float s0 = 0.f, s1 = 0.f;
            unsigned l[2][NB]; f32x2 d[2][NB];
#pragma unroll
            for (int i = 0; i < NB; ++i) { l[0][i] = Lp[(size_t)i * (4 * 256 * 64)]; d[0][i] = *(const GAS f32x2*)(dp + (size_t)i * 64 * 512); }
#pragma unroll 1
            for (int c0 = 0; c0 < NCHUNK; c0 += 2 * NB) {
#pragma unroll
                for (int hb = 0; hb < 2; ++hb) {
                    const int cb = c0 + hb * NB, cn = cb + NB;
#pragma unroll
                    for (int i = 0; i < NB; ++i) if (cn + i < NCHUNK) { l[hb ^ 1][i] = Lp[(size_t)(cn + i) * (4 * 256 * 64)]; d[hb ^ 1][i] = *(const GAS f32x2*)(dp + (size_t)(cn + i) * 64 * 512); }
#pragma unroll
                    for (int i = 0; i < NB; ++i) if (cb + i < NCHUNK) {
                        Lp[(size_t)(cb + i) * (4 * 256 * 64)] = pk2(s0, s1);
                        s0 = s0 * __expf(d[hb][i].x) + bflo(l[hb][i]); s1 = s1 * __expf(d[hb][i].y) + bfhi(l[hb][i]); }
                }
            }
        } else {
            const int e = (vb - 128) * NT + C.tid, n4 = e & 31, p = (e >> 5) & 63, hd = e >> 11;
            GAS v2u* Lp = (GAS v2u*)(C.ws + WS_LS) + ((size_t)hd * 64 + p) * 32 + n4;
            const GAS float* dp = (const GAS float*)AC + 63 * 32 + hd;
            float s0 = 0.f, s1 = 0.f, s2 = 0.f, s3 = 0.f;
            v2u l[2][NB]; float d[2][NB];
#pragma unroll
            for (int i = 0; i < NB; ++i) { l[0][i] = Lp[(size_t)i * (32 * 64 * 32)]; d[0][i] = dp[(size_t)i * 64 * 32]; }
#pragma unroll 1
            for (int c0 = 0; c0 < NCHUNK; c0 += 2 * NB) {
#pragma unroll
                for (int hb = 0; hb < 2; ++hb) {
                    const int cb = c0 + hb * NB, cn = cb + NB;
#pragma unroll
                    for (int i = 0; i < NB; ++i) if (cn + i < NCHUNK) { l[hb ^ 1][i] = Lp[(size_t)(cn + i) * (32 * 64 * 32)]; d[hb ^ 1][i] = dp[(size_t)(cn + i) * 64 * 32]; }
#pragma unroll
                    for (int i = 0; i < NB; ++i) if (cb + i < NCHUNK) {
                        Lp[(size_t)(cb + i) * (32 * 64 * 32)] = (v2u){pk2(s0, s1), pk2(s2, s3)};
                        const float dd = __expf(d[hb][i]);
                        s0 = s0 * dd + bflo(l[hb][i].x); s1 = s1 * dd + bfhi(l[hb][i].x); s2 = s2 * dd + bflo(l[hb][i].y); s3 = s3 * dd + bfhi(l[hb][i].y); }
                }
            }
        }
    }
}

__device__ __forceinline__ void gla_pass3_unit(const Ctx& C, int c, int h) {
    int tid_ = C.tid; asm volatile("" : "+v"(tid_));
    const int lane_ = tid_ & 63, wave_ = __builtin_amdgcn_readfirstlane(tid_ >> 6); (void)lane_; (void)wave_;
    const bf16* PJ = (const bf16*)(C.ws + WS_PJ); const float* GG = (const float*)(C.ws + WS_GG); const bf16* LG = (const bf16*)(C.ws + WS_LG); bf16* OG = (bf16*)(C.ws + WS_OG);
    ldsp QE = C.lds, QN = QE + 64 * P136, KE = QN + 64 * P136, KN = KE + 64 * P136, VT = KN + 64 * P136, ATT = VT + 64 * P264;
    LAS float* RED = (LAS float*)(ATT + 64 * P72);
    const int r0 = 64 * c;
    bf16x8 sfr[4][2];
    { const bf16* Sb = LG + ((size_t)(c * 4 + h) * 256) * 128; const int fr_ = lane_ & 15, fq_ = lane_ >> 4;
#pragma unroll
      for (int ks = 0; ks < 4; ++ks)
#pragma unroll
        for (int nt = 0; nt < 2; ++nt) sfr[ks][nt] = *(const GAS bf16x8*)(Sb + (size_t)(32 * wave_ + 16 * nt + fr_) * 128 + 32 * ks + 8 * fq_); }
    v4u qa_[2], ka_[2]; f32x4 g0_[2], g1_[2];
#pragma unroll
    for (int i = 0; i < 2; ++i) { const int e = tid_ + NT * i, s = e >> 4, k0 = (e & 15) * 8; const size_t r = (size_t)(r0 + s);
        qa_[i] = *(const GAS v4u*)(PJ + r * NPJ + PJ_Q + 128 * h + k0); ka_[i] = *(const GAS v4u*)(PJ + r * NPJ + PJ_K + 128 * h + k0);
        const float* g = GG + r * 512 + 128 * h + k0; g0_[i] = *(const GAS f32x4*)g; g1_[i] = *(const GAS f32x4*)(g + 4); }
#pragma unroll
    for (int i = 0; i < 2; ++i) {
        const int e = tid_ + NT * i, s = e >> 4, k0 = (e & 15) * 8;
        const v4u qa = qa_[i], ka = ka_[i]; const f32x4 g0 = g0_[i], g1 = g1_[i];
        const float gv[8] = {g0.x, g0.y, g0.z, g0.w, g1.x, g1.y, g1.z, g1.w};
        const unsigned qs[4] = {qa.x, qa.y, qa.z, qa.w}, ksr[4] = {ka.x, ka.y, ka.z, ka.w};
        unsigned oqe[4], oqn[4], oke[4], okn[4];
#pragma unroll
        for (int j = 0; j < 4; ++j) { const float e0 = __expf(gv[2 * j]), e1 = __expf(gv[2 * j + 1]), n0 = __expf(-gv[2 * j]), n1 = __expf(-gv[2 * j + 1]);
            const float q0 = bflo(qs[j]), q1 = bfhi(qs[j]), kk0 = bflo(ksr[j]), kk1 = bfhi(ksr[j]);
            oqe[j] = pk2(q0 * e0, q1 * e1); oqn[j] = pk2(q0 * n0, q1 * n1); oke[j] = pk2(kk0 * e0, kk1 * e1); okn[j] = pk2(kk0 * n0, kk1 * n1); }
        const int off = s * P136 + k0 * 2;
        *(LAS v4u*)(QE + off) = (v4u){oqe[0], oqe[1], oqe[2], oqe[3]}; *(LAS v4u*)(QN + off) = (v4u){oqn[0], oqn[1], oqn[2], oqn[3]};
        *(LAS v4u*)(KE + off) = (v4u){oke[0], oke[1], oke[2], oke[3]}; *(LAS v4u*)(KN + off) = (v4u){okn[0], okn[1], okn[2], okn[3]};
    }
    { v4u vv[4];
#pragma unroll
      for (int i = 0; i < 4; ++i) { const int e = tid_ + NT * i, s = e >> 5, v0 = (e & 31) * 8; vv[i] = *(const GAS v4u*)(PJ + (size_t)(r0 + s) * NPJ + PJ_V + 256 * h + v0); }
#pragma unroll
      for (int i = 0; i < 4; ++i) { const int e = tid_ + NT * i, s = e >> 5, v0 = (e & 31) * 8; *(LAS v4u*)(VT + s * P264 + v0 * 2) = vv[i]; } }
    __syncthreads();
    const int fr = lane_ & 15, fq = lane_ >> 4, w = wave_;
#pragma unroll
    for (int ti = 0; ti < 2; ++ti) {
        const int id = 2 * w + ti, tm = id >> 2, sn = id & 3;
        f32x4 ac = {0.f, 0.f, 0.f, 0.f}, aa = {0.f, 0.f, 0.f, 0.f};
#pragma unroll
        for (int ks = 0; ks < 4; ++ks) {
            const int ao = (16 * tm + fr) * P136 + (32 * ks + 8 * fq) * 2, bo = (16 * sn + fr) * P136 + (32 * ks + 8 * fq) * 2;
            ac = mma16(lds_frag(QE + ao), lds_frag(KN + bo), ac);
            aa = mma16(lds_frag(QN + ao), lds_frag(KE + bo), aa);
        }
        const int t = 16 * tm + fr, s0 = 16 * sn + 4 * fq;
        float o[4];
#pragma unroll
        for (int j = 0; j < 4; ++j) o[j] = (s0 + j <= t) ? ac[j] : aa[j];
        *(LAS v2u*)(ATT + t * P72 + s0 * 2) = (v2u){pk2(o[0], o[1]), pk2(o[2], o[3])};
    }
    __syncthreads();
    f32x4 acc[4][2];
#pragma unroll
    for (int tm = 0; tm < 4; ++tm)
#pragma unroll
        for (int nt = 0; nt < 2; ++nt) acc[tm][nt] = (f32x4){0.f, 0.f, 0.f, 0.f};
#pragma unroll
    for (int ks = 0; ks < 4; ++ks) {
#pragma unroll
        for (int tm = 0; tm < 4; ++tm) { const bf16x8 af = lds_frag(QE + (16 * tm + fr) * P136 + (32 * ks + 8 * fq) * 2);
#pragma unroll
            for (int nt = 0; nt < 2; ++nt) acc[tm][nt] = mma16(af, sfr[ks][nt], acc[tm][nt]); }
    }
#pragma unroll
    for (int ks = 0; ks < 2; ++ks) {
        bf16x8 bfm[2];
#pragma unroll
        for (int nt = 0; nt < 2; ++nt) bfm[nt] = tr_frag(VT, P264, 32 * ks, 32 * w + 16 * nt, fr, fq);
#pragma unroll
        for (int tm = 0; tm < 4; ++tm) { const bf16x8 af = lds_frag(ATT + (16 * tm + fr) * P72 + (32 * ks + 8 * fq) * 2);
#pragma unroll
            for (int nt = 0; nt < 2; ++nt) acc[tm][nt] = mma16(af, bfm[nt], acc[tm][nt]); }
    }
    v2u gvp[4][2]; f32x4 wvp[2];
#pragma unroll
    for (int nt = 0; nt < 2; ++nt) { const int v = 32 * w + 16 * nt + 4 * fq; wvp[nt] = *(const GAS f32x4*)(C.in[I_GNW] + v);
#pragma unroll
        for (int tm = 0; tm < 4; ++tm) gvp[tm][nt] = *(const GAS v2u*)(PJ + (size_t)(r0 + 16 * tm + fr) * NPJ + PJ_GO + 256 * h + v); }
#pragma unroll
    for (int tm = 0; tm < 4; ++tm) { float s = 0.f;
#pragma unroll
        for (int nt = 0; nt < 2; ++nt) { const f32x4 a = acc[tm][nt]; s += (a[0] * a[0] + a[1] * a[1]) + (a[2] * a[2] + a[3] * a[3]); }
        s += __shfl_xor(s, 16); s += __shfl_xor(s, 32);
        if (fq == 0) RED[w * 64 + 16 * tm + fr] = s; }
    __syncthreads();
    const float* nw = C.in[I_GNW];
#pragma unroll
    for (int tm = 0; tm < 4; ++tm) { const int t = 16 * tm + fr; float tot = 0.f;
#pragma unroll
        for (int ww = 0; ww < 8; ++ww) tot += RED[ww * 64 + t];
        const float rs = rsqrtf(tot * (1.f / 256.f) + RMS_EPS); const size_t r = (size_t)(r0 + t);
#pragma unroll
        for (int nt = 0; nt < 2; ++nt) { const int v = 32 * w + 16 * nt + 4 * fq; const f32x4 a = acc[tm][nt];
            const f32x4 wv = wvp[nt]; const v2u gv = gvp[tm][nt];
            *(GAS v2u*)(OG + r * 1024 + 256 * h + v) = (v2u){pk2(a[0] * rs * wv.x * bflo(gv.x), a[1] * rs * wv.y * bfhi(gv.x)), pk2(a[2] * rs * wv.z * bflo(gv.y), a[3] * rs * wv.w * bfhi(gv.y))}; } }
    __syncthreads();
}
__device__ __forceinline__ void ssd_pass3_unit(const Ctx& C, int c, int g) {
    int tid_ = C.tid; asm volatile("" : "+v"(tid_));
    const int lane_ = tid_ & 63, wave_ = __builtin_amdgcn_readfirstlane(tid_ >> 6); (void)lane_; (void)wave_;
    const bf16* PJ = (const bf16*)(C.ws + WS_PJ); const bf16* XC = (const bf16*)(C.ws + WS_XC); const float* DT = (const float*)(C.ws + WS_DT); const float* AC = (const float*)(C.ws + WS_AC);
    const bf16* LS = (const bf16*)(C.ws + WS_LS); bf16* YS = (bf16*)(C.ws + WS_YS);
    ldsp XD = C.lds, CM = XD + 64 * P520, BM = CM + 64 * P136, WT = BM + 64 * P136;
    LAS float* ACL = (LAS float*)(WT + 8 * 32 * P72);
    LAS float* DTL = ACL + 8 * 64;
    LAS float* RED = DTL + 8 * 64;
    const int r0 = 64 * c;
    bf16x8 sfr[4][4];
    { const bf16* Sb = LS + ((size_t)(c * 32 + 8 * g + (wave_ >> 1)) * 64) * 128; const int fr_ = lane_ & 15, fq_ = lane_ >> 4;
#pragma unroll
      for (int ks = 0; ks < 2; ++ks)
#pragma unroll
        for (int pn = 0; pn < 4; ++pn) sfr[ks][pn] = *(const GAS bf16x8*)(Sb + (size_t)(16 * pn + fr_) * 128 + 32 * ks + 8 * fq_); }
    { v4u xx[8], bb[2], cc[2]; float a1, d1;
      { const int s = tid_ >> 3, hl = tid_ & 7; const size_t ri = (size_t)(r0 + s) * 32 + 8 * g + hl; a1 = AC[ri]; d1 = DT[ri]; }
#pragma unroll
      for (int i = 0; i < 8; ++i) { const int s = (tid_ >> 6) + 8 * i, ch = tid_ & 63; xx[i] = *(const GAS v4u*)(XC + (size_t)(r0 + s) * 3072 + 512 * g + 8 * ch); }
#pragma unroll
      for (int i = 0; i < 2; ++i) { const int e = tid_ + NT * i, s = e >> 4, ch = e & 15; const size_t r = (size_t)(r0 + s);
        bb[i] = *(const GAS v4u*)(XC + r * 3072 + 2048 + 128 * g + 8 * ch); cc[i] = *(const GAS v4u*)(XC + r * 3072 + 2560 + 128 * g + 8 * ch); }
      { const int s = tid_ >> 3, hl = tid_ & 7; ACL[hl * 64 + s] = a1; DTL[hl * 64 + s] = d1; }
#pragma unroll
      for (int i = 0; i < 8; ++i) { const int s = (tid_ >> 6) + 8 * i, ch = tid_ & 63; *(LAS v4u*)(XD + s * P520 + ch * 16) = xx[i]; }
#pragma unroll
      for (int i = 0; i < 2; ++i) { const int e = tid_ + NT * i, s = e >> 4, ch = e & 15; *(LAS v4u*)(BM + s * P136 + ch * 16) = bb[i]; *(LAS v4u*)(CM + s * P136 + ch * 16) = cc[i]; } }
    __syncthreads();
    const int fr = lane_ & 15, fq = lane_ >> 4, w = wave_, rh = w & 1, hq = w >> 1, t0 = 32 * rh;
    ldsp WW = WT + w * 32 * P72;
    { const bf16* Sb = LS + ((size_t)(c * 32 + 8 * g + hq) * 64) * 128;
#pragma unroll
      for (int ks = 2; ks < 4; ++ks)
#pragma unroll
        for (int pn = 0; pn < 4; ++pn) sfr[ks][pn] = *(const GAS bf16x8*)(Sb + (size_t)(16 * pn + fr) * 128 + 32 * ks + 8 * fq); }
    f32x4 cb[2][4];
#pragma unroll
    for (int tm = 0; tm < 2; ++tm)
#pragma unroll
        for (int sn = 0; sn < 4; ++sn) cb[tm][sn] = (f32x4){0.f, 0.f, 0.f, 0.f};
#pragma unroll
    for (int ks = 0; ks < 4; ++ks) {
        bf16x8 af[2];
#pragma unroll
        for (int tm = 0; tm < 2; ++tm) af[tm] = lds_frag(CM + (t0 + 16 * tm + fr) * P136 + (32 * ks + 8 * fq) * 2);
#pragma unroll
        for (int sn = 0; sn < 4; ++sn) { const bf16x8 bfm = lds_frag(BM + (16 * sn + fr) * P136 + (32 * ks + 8 * fq) * 2);
#pragma unroll
            for (int tm = 0; tm < 2; ++tm) cb[tm][sn] = mma16(af[tm], bfm, cb[tm][sn]); }
    }
    v2u yp[2][2][4];
    float ss[2] = {0.f, 0.f};
    const float* dsk = C.in[I_DSKIP]; const float* nw = C.in[I_SNW];
#pragma unroll
    for (int rd = 0; rd < 2; ++rd) {
        const int hl = hq + 4 * rd, hd = 8 * g + hl;
        float at[2];
#pragma unroll
        for (int tm = 0; tm < 2; ++tm) at[tm] = ACL[hl * 64 + t0 + 16 * tm + fr];
#pragma unroll
        for (int sn = 0; sn < 4; ++sn) { const f32x4 as = *(const LAS f32x4*)(ACL + hl * 64 + 16 * sn + 4 * fq), ds = *(const LAS f32x4*)(DTL + hl * 64 + 16 * sn + 4 * fq);
#pragma unroll
            for (int tm = 0; tm < 2; ++tm) { const f32x4 cv = cb[tm][sn];
                const float w0 = cv[0] * ds.x * __expf(-fabsf(at[tm] - as.x)), w1 = cv[1] * ds.y * __expf(-fabsf(at[tm] - as.y)), w2 = cv[2] * ds.z * __expf(-fabsf(at[tm] - as.z)), w3 = cv[3] * ds.w * __expf(-fabsf(at[tm] - as.w));
                *(LAS v2u*)(WW + (16 * tm + fr) * P72 + (16 * sn + 4 * fq) * 2) = (v2u){pk2(w0, w1), pk2(w2, w3)}; } }
        f32x4 y[2][4];
#pragma unroll
        for (int tm = 0; tm < 2; ++tm)
#pragma unroll
            for (int pn = 0; pn < 4; ++pn) y[tm][pn] = (f32x4){0.f, 0.f, 0.f, 0.f};
#pragma unroll
        for (int ks = 0; ks < 4; ++ks) {
            bf16x8 af[2];
#pragma unroll
            for (int tm = 0; tm < 2; ++tm) af[tm] = lds_frag(CM + (t0 + 16 * tm + fr) * P136 + (32 * ks + 8 * fq) * 2);
#pragma unroll
            for (int pn = 0; pn < 4; ++pn) {
#pragma unroll
                for (int tm = 0; tm < 2; ++tm) y[tm][pn] = mma16(af[tm], sfr[ks][pn], y[tm][pn]); }
        }
        if (rd == 0) {
            const bf16* Sb = LS + ((size_t)(c * 32 + 8 * g + hq + 4) * 64) * 128;
#pragma unroll
            for (int ks = 0; ks < 4; ++ks)
#pragma unroll
                for (int pn = 0; pn < 4; ++pn) sfr[ks][pn] = *(const GAS bf16x8*)(Sb + (size_t)(16 * pn + fr) * 128 + 32 * ks + 8 * fq);
        }
#pragma unroll
        for (int tm = 0; tm < 2; ++tm) { const float ea = __expf(at[tm]);
#pragma unroll
            for (int pn = 0; pn < 4; ++pn) y[tm][pn] = y[tm][pn] * ea; }
        LDS_WAIT(); asm volatile("" ::: "memory");
#pragma unroll
        for (int ks = 0; ks < 2; ++ks) {
            bf16x8 af[2];
#pragma unroll
            for (int tm = 0; tm < 2; ++tm) af[tm] = lds_frag(WW + (16 * tm + fr) * P72 + (32 * ks + 8 * fq) * 2);
#pragma unroll
            for (int pn = 0; pn < 4; ++pn) { const bf16x8 bfm = tr_frag(XD, P520, 32 * ks, 64 * hl + 16 * pn, fr, fq);
#pragma unroll
                for (int tm = 0; tm < 2; ++tm) y[tm][pn] = mma16(af[tm], bfm, y[tm][pn]); }
        }
        LDS_WAIT(); asm volatile("" ::: "memory");
        const float dk = dsk[hd];
#pragma unroll
        for (int tm = 0; tm < 2; ++tm) { const size_t r = (size_t)(r0 + t0 + 16 * tm + fr);
#pragma unroll
            for (int pn = 0; pn < 4; ++pn) { const int col = 64 * hd + 16 * pn + 4 * fq;
                const v2u xv = *(const LAS v2u*)(XD + (t0 + 16 * tm + fr) * P520 + (64 * hl + 16 * pn + 4 * fq) * 2), zv = *(const GAS v2u*)(PJ + r * NPJ + PJ_Z + col);
                f32x4 a = y[tm][pn];
                a[0] = (a[0] + dk * bflo(xv.x)) * bflo(zv.x); a[1] = (a[1] + dk * bfhi(xv.x)) * bfhi(zv.x); a[2] = (a[2] + dk * bflo(xv.y)) * bflo(zv.y); a[3] = (a[3] + dk * bfhi(xv.y)) * bfhi(zv.y);
                ss[tm] += (a[0] * a[0] + a[1] * a[1]) + (a[2] * a[2] + a[3] * a[3]); yp[rd][tm][pn] = (v2u){pk2(a[0], a[1]), pk2(a[2], a[3])}; } }
    }
#pragma unroll
    for (int tm = 0; tm < 2; ++tm) { float s = ss[tm]; s += __shfl_xor(s, 16); s += __shfl_xor(s, 32); if (fq == 0) RED[w * 32 + 16 * tm + fr] = s; }
    __syncthreads();
#pragma unroll
    for (int tm = 0; tm < 2; ++tm) { const int tl = 16 * tm + fr; float tot = 0.f;
#pragma unroll
        for (int q = 0; q < 4; ++q) tot += RED[(2 * q + rh) * 32 + tl];
        const float rs = rsqrtf(tot * (1.f / 512.f) + RMS_EPS); const size_t r = (size_t)(r0 + t0 + tl);
#pragma unroll
        for (int rd = 0; rd < 2; ++rd) { const int hd = 8 * g + hq + 4 * rd;
#pragma unroll
            for (int pn = 0; pn < 4; ++pn) { const int col = 64 * hd + 16 * pn + 4 * fq; const v2u a = yp[rd][tm][pn]; const f32x4 wv = *(const GAS f32x4*)(nw + col);
                *(GAS v2u*)(YS + r * 2048 + col) = (v2u){pk2(bflo(a.x) * rs * wv.x, bfhi(a.x) * rs * wv.y), pk2(bflo(a.y) * rs * wv.z, bfhi(a.y) * rs * wv.w)}; } } }
    __syncthreads();
}

__device__ __forceinline__ void phaseJ(const Ctx& C) {
    const int gw = C.bid * NWAVES + C.wave, NGW = C.G * NWAVES;
    bf16* HN2 = (bf16*)(C.ws + WS_HN2);
    for (int r = gw; r < NTOK / 2; r += NGW) {
        const int r1 = r + NTOK / 2, lane = C.lane;
        const f32x4* x0 = (const f32x4*)(C.out + (size_t)r * D) + lane; const f32x4* x1 = (const f32x4*)(C.out + (size_t)r1 * D) + lane; const f32x4* wr_ = (const f32x4*)C.in[I_LNFFN] + lane;
        f32x4 v[4], u[4]; float q0 = 0.f, q1 = 0.f;
#pragma unroll
        for (int j = 0; j < 4; ++j) { v[j] = *(const GAS f32x4*)(x0 + 64 * j); u[j] = *(const GAS f32x4*)(x1 + 64 * j); }
#pragma unroll
        for (int j = 0; j < 4; ++j) { q0 += (v[j].x * v[j].x + v[j].y * v[j].y) + (v[j].z * v[j].z + v[j].w * v[j].w); q1 += (u[j].x * u[j].x + u[j].y * u[j].y) + (u[j].z * u[j].z + u[j].w * u[j].w); }
        const float s0 = rsqrtf(wave_sum(q0) * (1.f / D) + RMS_EPS), s1 = rsqrtf(wave_sum(q1) * (1.f / D) + RMS_EPS);
        v2u* o0 = (v2u*)(HN2 + (size_t)r * D) + lane; v2u* o1 = (v2u*)(HN2 + (size_t)r1 * D) + lane;
#pragma unroll
        for (int j = 0; j < 4; ++j) { const f32x4 ww = *(const GAS f32x4*)(wr_ + 64 * j); const f32x4 a = v[j] * s0 * ww, bq = u[j] * s1 * ww;
            *(GAS v2u*)(o0 + 64 * j) = (v2u){pk2(a.x, a.y), pk2(a.z, a.w)}; *(GAS v2u*)(o1 + 64 * j) = (v2u){pk2(bq.x, bq.y), pk2(bq.z, bq.w)};
            int w0 = 0, w1 = 0;
            w0 = __builtin_amdgcn_cvt_pk_fp8_f32(a.x * 16.f, a.y * 16.f, w0, false); w0 = __builtin_amdgcn_cvt_pk_fp8_f32(a.z * 16.f, a.w * 16.f, w0, true);
            w1 = __builtin_amdgcn_cvt_pk_fp8_f32(bq.x * 16.f, bq.y * 16.f, w1, false); w1 = __builtin_amdgcn_cvt_pk_fp8_f32(bq.z * 16.f, bq.w * 16.f, w1, true);
            *(GAS unsigned*)(C.ws + WS_HN8 + (size_t)r * D + 4 * lane + 256 * j) = (unsigned)w0; *(GAS unsigned*)(C.ws + WS_HN8 + (size_t)r1 * D + 4 * lane + 256 * j) = (unsigned)w1; }
    }
}
#ifndef PEER_SWAP_NIBBLES
#define PEER_SWAP_NIBBLES 0
#endif
__device__ __forceinline__ void conv_table(const Ctx& C, int tb, int first_blk) {
    if (C.bid < first_blk) return;
    const size_t n16 = (size_t)16384 * 1024 / 16, gt = (size_t)(C.bid - first_blk) * NT + C.tid, GT = (size_t)(C.G - first_blk) * NT;
    const float* src = C.in[tb ? I_PV : I_PU]; unsigned char* dst = C.ws + WS_U8 + (tb ? 512 : 0); const float gain = tb ? 5.656854249f : 64.f;
    for (size_t i0 = gt; i0 < n16; i0 += 4 * GT) { f32x4 a[4][4];
#pragma unroll
        for (int p = 0; p < 4; ++p) { const size_t i = i0 + p * GT;
#pragma unroll
            for (int q = 0; q < 4; ++q) a[p][q] = (i < n16) ? *(const GAS f32x4*)(src + 16 * i + 4 * q) : (f32x4){0.f, 0.f, 0.f, 0.f}; }
#pragma unroll
        for (int p = 0; p < 4; ++p) { const size_t i = i0 + p * GT; v2u o;
#pragma unroll
            for (int h = 0; h < 2; ++h) { unsigned w = 0;
                if (tb == 0 && PEER_SWAP_NIBBLES) {
                w = __builtin_amdgcn_cvt_scalef32_pk_fp4_f32(w, a[p][2 * h].y * gain, a[p][2 * h].x * gain, 1.0f, 0); w = __builtin_amdgcn_cvt_scalef32_pk_fp4_f32(w, a[p][2 * h].w * gain, a[p][2 * h].z * gain, 1.0f, 1);
                w = __builtin_amdgcn_cvt_scalef32_pk_fp4_f32(w, a[p][2 * h + 1].y * gain, a[p][2 * h + 1].x * gain, 1.0f, 2); w = __builtin_amdgcn_cvt_scalef32_pk_fp4_f32(w, a[p][2 * h + 1].w * gain, a[p][2 * h + 1].z * gain, 1.0f, 3); } else {
                w = __builtin_amdgcn_cvt_scalef32_pk_fp4_f32(w, a[p][2 * h].x * gain, a[p][2 * h].y * gain, 1.0f, 0); w = __builtin_amdgcn_cvt_scalef32_pk_fp4_f32(w, a[p][2 * h].z * gain, a[p][2 * h].w * gain, 1.0f, 1);
                w = __builtin_amdgcn_cvt_scalef32_pk_fp4_f32(w, a[p][2 * h + 1].x * gain, a[p][2 * h + 1].y * gain, 1.0f, 2); w = __builtin_amdgcn_cvt_scalef32_pk_fp4_f32(w, a[p][2 * h + 1].z * gain, a[p][2 * h + 1].w * gain, 1.0f, 3); }
                o[h] = w; }
            if (i < n16) *(GAS v2u*)(dst + (i >> 6) * 1024 + (i & 63) * 8) = o; } }
}

__device__ __forceinline__ float gelu_tanh(float x) {
    const float y = 0.7978845608028654f * (x + 0.044715f * x * x * x);
    const float e = __expf(2.f * y);
    const float th = 1.f - 2.f * fast_rcp(e + 1.f);
    return 0.5f * x * (1.f + th);
}
typedef _Float16 h16x2 __attribute__((ext_vector_type(2)));
typedef int v8i __attribute__((ext_vector_type(8)));

template <int CTRL> __device__ __forceinline__ unsigned dppu(unsigned x) { return (unsigned)__builtin_amdgcn_mov_dpp((int)x, CTRL, 0xf, 0xf, true); }
template <int CTRL> __device__ __forceinline__ float dppf(float x) { return __builtin_bit_cast(float, __builtin_amdgcn_mov_dpp(__builtin_bit_cast(int, x), CTRL, 0xf, 0xf, true)); }
__device__ __forceinline__ unsigned row_max_u(unsigned m) { m = max(m, dppu<0xB1>(m)); m = max(m, dppu<0x4E>(m)); m = max(m, dppu<0x141>(m)); m = max(m, dppu<0x128>(m)); return m; }
__device__ __forceinline__ float row_sum_f(float v) { v += dppf<0xB1>(v); v += dppf<0x4E>(v); v += dppf<0x141>(v); v += dppf<0x128>(v); return v; }
__device__ __forceinline__ unsigned mono(float f) { const unsigned b = __builtin_bit_cast(unsigned, f); return b ^ ((unsigned)((int)b >> 31) | 0x80000000u); }
__device__ __forceinline__ float unmono(unsigned u) { const unsigned b = (u & 0x80000000u) ? (u ^ 0x80000000u) : ~u; return __builtin_bit_cast(float, b); }
__device__ __forceinline__ void cand_ij(int c, int& ci, int& cj) {
    if (c < 16) { ci = 0; cj = c; } else if (c < 24) { ci = 1; cj = c - 16; } else if (c < 29) { ci = 2; cj = c - 24; } else if (c < 33) { ci = 3; cj = c - 29; }
    else if (c < 36) { ci = 4; cj = c - 33; } else if (c < 38) { ci = 5; cj = c - 36; } else if (c < 40) { ci = 6; cj = c - 38; } else if (c < 42) { ci = 7; cj = c - 40; }
    else if (c < 50) { ci = c - 34; cj = 0; } else { ci = 0; cj = 0; }
}
constexpr int PEER_LDS_PER_WAVE = 3072;
__device__ __forceinline__ void peer_token(const Ctx& C, int t, bool dry = false) {
    const int lane = C.lane, g = lane >> 4, j = lane & 15;
    const _Float16* SC = (const _Float16*)(C.ws + WS_SC) + (size_t)t * 2048;
    const bf16* HN2 = (const bf16*)(C.ws + WS_HN2) + (size_t)t * D;
    ldsp LST = C.lds + C.wave * PEER_LDS_PER_WAVE; ldsp EL = LST + 2048;
#pragma unroll 1
    for (int P = 0; P < 2; ++P) {
        typedef _Float16 h8 __attribute__((ext_vector_type(8)));
        const h8 ha8 = *(const GAS h8*)(SC + (4 * P + g) * 128 + 8 * j), hb8 = *(const GAS h8*)(SC + (4 * (P + 2) + g) * 128 + 8 * j);
        unsigned k[8], kb[8];
        float sa[8], sb[8];
#pragma unroll
        for (int q = 0; q < 8; ++q) { sa[q] = (float)ha8[q]; sb[q] = (float)hb8[q]; }
#pragma unroll
        for (int q = 0; q < 8; ++q) { k[q] = (mono(sa[q]) & ~127u) | (unsigned)(127 - (8 * j + q)); kb[q] = (mono(sb[q]) & ~127u) | (unsigned)(127 - (8 * j + q)); }
#define CEX(A, B) do { const unsigned hi_ = max(A, B), lo_ = min(A, B); A = hi_; B = lo_; } while (0)
#define SORT8(K) do { CEX(K[0], K[1]); CEX(K[2], K[3]); CEX(K[4], K[5]); CEX(K[6], K[7]); CEX(K[0], K[2]); CEX(K[1], K[3]); CEX(K[4], K[6]); CEX(K[5], K[7]); \
        CEX(K[1], K[2]); CEX(K[5], K[6]); CEX(K[0], K[4]); CEX(K[3], K[7]); CEX(K[1], K[5]); CEX(K[2], K[6]); CEX(K[1], K[4]); CEX(K[3], K[6]); CEX(K[2], K[4]); CEX(K[3], K[5]); CEX(K[3], K[4]); } while (0)
        SORT8(k); SORT8(kb);
#undef SORT8
#undef CEX
        unsigned res = 0u, resb = 0u;
#pragma unroll 4
        for (int it = 0; it < 16; ++it) {
            unsigned m = k[0], mb = kb[0];
            m = max(m, dppu<0xB1>(m)); mb = max(mb, dppu<0xB1>(mb)); m = max(m, dppu<0x4E>(m)); mb = max(mb, dppu<0x4E>(mb));
            m = max(m, dppu<0x141>(m)); mb = max(mb, dppu<0x141>(mb)); m = max(m, dppu<0x128>(m)); mb = max(mb, dppu<0x128>(mb));
            const bool pa = (k[0] == m), pb = (kb[0] == mb);
#pragma unroll
            for (int q = 0; q < 7; ++q) { k[q] = pa ? k[q + 1] : k[q]; kb[q] = pb ? kb[q + 1] : kb[q]; }
            k[7] = pa ? 0u : k[7]; kb[7] = pb ? 0u : kb[7];
            res = (j == it) ? m : res; resb = (j == it) ? mb : resb;
        }
        *(LAS v2u*)(LST + ((4 * P + g) * 16 + j) * 8) = (v2u){__builtin_bit_cast(unsigned, unmono(res & ~127u)), 127u - (res & 127u)};
        *(LAS v2u*)(LST + ((4 * (P + 2) + g) * 16 + j) * 8) = (v2u){__builtin_bit_cast(unsigned, unmono(resb & ~127u)), 127u - (resb & 127u)};
    }
    LDS_WAIT(); asm volatile("" ::: "memory");
    int eA = 0, eB = 0; float wA = 0.f, wB = 0.f;
#pragma unroll
    for (int Q = 0; Q < 2; ++Q) {
        const int h = 4 * Q + g;
        unsigned k[4];
#pragma unroll
        for (int m = 0; m < 4; ++m) {
            const int c = j + 16 * m; int ci, cj; cand_ij(c, ci, cj);
            const v2u a = *(const LAS v2u*)(LST + ((2 * h) * 16 + ci) * 8), b = *(const LAS v2u*)(LST + ((2 * h + 1) * 16 + cj) * 8);
            const float val = __builtin_bit_cast(float, a.x) + __builtin_bit_cast(float, b.x);
            k[m] = (c < 50) ? ((mono(val) & ~63u) | (unsigned)(63 - c)) : 0u;
            *(LAS unsigned*)(EL + (g * 64 + c) * 4) = a.y * 128u + b.y;
        }
        { unsigned h_, l_;
#define CEX(A, B) do { h_ = max(A, B); l_ = min(A, B); A = h_; B = l_; } while (0)
          CEX(k[0], k[1]); CEX(k[2], k[3]); CEX(k[0], k[2]); CEX(k[1], k[3]); CEX(k[1], k[2]);
#undef CEX
        }
        unsigned res = 0u, mtop = 0u;
#pragma unroll 4
        for (int it = 0; it < 16; ++it) {
            const unsigned m = row_max_u(k[0]);
            if (it == 0) mtop = m;
            const bool pa = (k[0] == m);
            k[0] = pa ? k[1] : k[0]; k[1] = pa ? k[2] : k[1]; k[2] = pa ? k[3] : k[2]; k[3] = pa ? 0u : k[3];
            res = (j == it) ? m : res;
        }
        LDS_WAIT(); asm volatile("" ::: "memory");
        const int cw = 63 - (int)(res & 63u);
        const int e = (int)*(const LAS unsigned*)(EL + (g * 64 + cw) * 4);
        const float ex = __expf(unmono(res & ~63u) - unmono(mtop & ~63u));
        const float wgt = ex / row_sum_f(ex);
        if (Q == 0) { eA = e; wA = wgt; } else { eB = e; wB = wgt; }
        LDS_WAIT(); asm volatile("" ::: "memory");
    }
#ifdef DRY_TOPK_ONLY
    if (dry) { ((float*)(C.ws + WS_T1))[(size_t)t * 64 + lane] = (float)(eA + eB) + wA + wB; return; }
#endif
    const unsigned char* U8 = C.ws + WS_U8; const unsigned char* V8 = C.ws + WS_U8 + 512;
    const int li = lane & 15, lg = lane >> 4;
    v4u hb[16];
    { const unsigned char* H8 = C.ws + WS_HN8 + (size_t)t * D + 16 * lg;
#pragma unroll
      for (int m = 0; m < 8; ++m) { hb[2 * m] = *(const GAS v4u*)(H8 + 128 * m); hb[2 * m + 1] = *(const GAS v4u*)(H8 + 128 * m + 64); } }
    f32x2 acc[8];
#pragma unroll
    for (int i = 0; i < 8; ++i) acc[i] = (f32x2){0.f, 0.f};
#pragma unroll 1
    for (int gi = 0; gi < 8; ++gi) {
        const int ev = gi < 4 ? eA : eB; const float wv = gi < 4 ? wA : wB; const int lb = 16 * (gi & 3);
        const int ei = __shfl(ev, lb + li);
        const unsigned char* up = U8 + (size_t)ei * 1024 + 16 * lg;
        v4u uq[8];
#pragma unroll
        for (int m = 0; m < 8; ++m) uq[m] = *(const GAS v4u*)(up + 64 * m);
        v2u vq[8];
#pragma unroll
        for (int q = 0; q < 8; ++q) vq[q] = *(const GAS v2u*)(V8 + (size_t)__builtin_amdgcn_readlane(ev, lb + q) * 1024 + 8 * lane);
        float wr[4];
#pragma unroll
        for (int r = 0; r < 4; ++r) wr[r] = __shfl(wv, lb + 4 * lg + r);
        f32x4 dots = {0.f, 0.f, 0.f, 0.f};
#pragma unroll
        for (int m = 0; m < 8; ++m) {
            const v8i av = {(int)uq[m].x, (int)uq[m].y, (int)uq[m].z, (int)uq[m].w, 0, 0, 0, 0};
            const v8i bv = {(int)hb[2 * m].x, (int)hb[2 * m].y, (int)hb[2 * m].z, (int)hb[2 * m].w, (int)hb[2 * m + 1].x, (int)hb[2 * m + 1].y, (int)hb[2 * m + 1].z, (int)hb[2 * m + 1].w};
            dots = __builtin_amdgcn_mfma_scale_f32_16x16x128_f8f6f4(av, bv, dots, 4, 0, 0, 0x7f7f7f7f, 0, 0x7f7f7f7f);
        }
        float cfr[4];
#pragma unroll
        for (int r = 0; r < 4; ++r) cfr[r] = wr[r] * gelu_tanh(dots[r] * (1.f / 1024.f)) * 0.1767766953f;
#pragma unroll
        for (int hf = 0; hf < 2; ++hf) {
            if (hf == 1) {
#pragma unroll
                for (int q = 0; q < 8; ++q) vq[q] = *(const GAS v2u*)(V8 + (size_t)__builtin_amdgcn_readlane(ev, lb + 8 + q) * 1024 + 8 * lane);
            }
#pragma unroll
            for (int q = 0; q < 8; ++q) { const int pl = 8 * hf + q;
                const float cf = __builtin_bit_cast(float, __builtin_amdgcn_readlane(__builtin_bit_cast(int, cfr[pl & 3]), 16 * (pl >> 2)));
#pragma unroll
                for (int w2 = 0; w2 < 2; ++w2) { acc[4 * w2 + 0] = __builtin_amdgcn_cvt_scalef32_pk_f32_fp4(vq[q][w2], 1.0f, 0) * cf + acc[4 * w2 + 0]; acc[4 * w2 + 1] = __builtin_amdgcn_cvt_scalef32_pk_f32_fp4(vq[q][w2], 1.0f, 1) * cf + acc[4 * w2 + 1];
                    acc[4 * w2 + 2] = __builtin_amdgcn_cvt_scalef32_pk_f32_fp4(vq[q][w2], 1.0f, 2) * cf + acc[4 * w2 + 2]; acc[4 * w2 + 3] = __builtin_amdgcn_cvt_scalef32_pk_f32_fp4(vq[q][w2], 1.0f, 3) * cf + acc[4 * w2 + 3]; }
            }
        }
    }
    float* orow = C.out + (size_t)t * D + 16 * lane; const float* lw = C.in[I_LNF] + 16 * lane;
    f32x4 hv[4]; float s = 0.f;
#pragma unroll
    for (int i = 0; i < 4; ++i) { hv[i] = *(const GAS f32x4*)(orow + 4 * i); hv[i].x += acc[2 * i].x; hv[i].y += acc[2 * i].y; hv[i].z += acc[2 * i + 1].x; hv[i].w += acc[2 * i + 1].y;
        s += (hv[i].x * hv[i].x + hv[i].y * hv[i].y) + (hv[i].z * hv[i].z + hv[i].w * hv[i].w); }
    const float rs = rsqrtf(wave_sum(s) * (1.f / D) + RMS_EPS);
    if (dry) return;
#pragma unroll
    for (int i = 0; i < 4; ++i) { const f32x4 w4 = *(const GAS f32x4*)(lw + 4 * i); *(GAS f32x4*)(orow + 4 * i) = hv[i] * rs * w4; }
}

constexpr int NSTEPS = 36;
#ifndef PH_MASK
#define PH_MASK 0xFF
#endif
#define PH_ON(k) (((PH_MASK) >> (k)) & 1)
struct Args { const float* in[22]; float* out; unsigned char* ws; int ph_lo, ph_hi; };
typedef const __attribute__((address_space(4))) Args* kargp;
__device__ __forceinline__ void ctx_init(Ctx& C, unsigned char* smem) {
    kargp ap = (kargp)__builtin_amdgcn_kernarg_segment_ptr();
    asm volatile("" : "+s"(ap));
    int tid_ = threadIdx.x; asm volatile("" : "+v"(tid_));
    C.lds = (ldsp)smem; C.tid = tid_; C.lane = C.tid & 63; C.wave = __builtin_amdgcn_readfirstlane(C.tid >> 6); C.G = gridDim.x; C.bid = blockIdx.x;
#pragma unroll
    for (int i = 0; i < 22; ++i) C.in[i] = ap->in[i];
    C.out = ap->out; C.ws = ap->ws;
}
__global__ void __launch_bounds__(NT, 2) hyb_fwd(Args args) {
    extern __shared__ __attribute__((aligned(16))) unsigned char smem[];
    volatile LAS unsigned* MISC = (volatile LAS unsigned*)((ldsp)smem + LDSCTL_OFF);
    for (int u = threadIdx.x; u < (LDS_BYTES - LDSCTL_OFF) / 4; u += NT) MISC[u] = 0u;
    __syncthreads();
    const int lo = args.ph_lo, hi = args.ph_hi;
    unsigned* barw = (unsigned*)(args.ws + WS_CTL) + CW_BAR;
    XcdBarrier bar; bar.bar = barw; bar.x = 0; bar.st = MISC + 8;
    if (hi - lo > 1) bar = xcd_barrier_post(barw, MISC + 8);
#pragma unroll 1
    for (int step = lo; step < hi; ++step) {
        int kind, b = 0, gk = 0;
        if (step == 0) kind = 0;
        else if (step <= 32) { b = (step - 1) >> 3; const int k = (step - 1) & 7; gk = k; kind = (k == 0 || k >= 5) ? 1 : k + 1; }
        else if (step == 33) kind = 6;
        else if (step == 34) { kind = 1; gk = 8; }
        else kind = 7;
#ifdef REP_KIND
#ifndef REP_GK
#define REP_GK -1
#endif
        for (int rep = ((kind == REP_KIND && (REP_GK < 0 || gk == REP_GK)) ? 0 : 1); rep < 2; ++rep) {
        const bool dry = (rep == 0);
#else
        const bool dry = false; {
#endif
        Ctx C; ctx_init(C, smem);
        if (kind == 0 && PH_ON(0)) { p0_prologue(C); p0b_prologue(C); }
        else if (kind == 1 && PH_ON(1)) {
            pg8::Gemm g; EpiAny E; E.P.PJ = (bf16*)(C.ws + WS_PJ); E.P.TL = (float*)(C.ws + WS_TL); E.PJ = (const bf16*)(C.ws + WS_PJ); E.T = nullptr; E.O = nullptr; E.gcol = 0; E.X = C.in[I_X]; E.OF = C.out; E.b = b; E.ldc = 2048;
            if (gk == 0)      { g = pg8::Gemm{(const bf16*)(C.ws + WS_HN), (const bf16*)(C.ws + WS_W1T), SEQ, NPJ, 1024}; E.mode = 0; if (b == 0) meta_proj(C); tail_proj(C); }
            else if (gk == 5) { g = pg8::Gemm{(const bf16*)(C.ws + WS_OG), (const bf16*)(C.ws + WS_WAT), RPB, 1024, 1024}; E.mode = 1; E.O = (bf16*)(C.ws + WS_T1); E.gcol = PJ_GA; }
            else if (gk == 6) { g = pg8::Gemm{(const bf16*)(C.ws + WS_YS), (const bf16*)(C.ws + WS_WBT), RPB, 1024, 2048}; E.mode = 1; E.O = (bf16*)(C.ws + WS_MX); E.gcol = PJ_GB; E.T = (const bf16*)(C.ws + WS_T1); }
            else if (gk == 7) { g = pg8::Gemm{(const bf16*)(C.ws + WS_MX), (const bf16*)(C.ws + WS_WOT), RPB, 1024, 1024}; E.mode = 2; }
            else              { g = pg8::Gemm{(const bf16*)(C.ws + WS_HN2), (const bf16*)(C.ws + WS_WET), NTOK, 2048, 1024}; E.mode = 3; E.OF = (float*)(C.ws + WS_SC); }
            pg8::StaticOrder S; S.init(g.M, g.N, C.G, C.bid);
#ifdef REP_TAIL_ONLY
            if (!dry)
#endif
            pg8::gemm_phase<EpiAny, pg8::StaticOrder, true, true>(C.lds, g, S, E);
            if (b == 0 && (gk == 5 || gk == 6)) conv_table(C, gk - 5, (S.nwg < C.G) ? S.nwg : 0);
            if (gk == 7 && b + 1 < BATCH) hn_batch(C, b + 1, (S.nwg < C.G) ? S.nwg : 0);
        }
        else if (kind == 2 && PH_ON(2)) {
#ifdef DRYC
            if (!dry || DRYC == 1) conv_batch(C);
            if (!dry || DRYC == 2) for (int u = C.bid; u < NCHUNK * 5; u += C.G) phaseC_unit(C, u / 5, 6 + u % 5);
#else
            conv_batch(C); for (int u = C.bid; u < NCHUNK * 5; u += C.G) phaseC_unit(C, u / 5, 6 + u % 5);
#endif
 }
        else if ((kind == 3 && PH_ON(3)) || (kind == 5 && PH_ON(5))) {
            unsigned* qc = (unsigned*)(C.ws + WS_CTL) + CW_QUEUE + 2 * step + (dry ? 1 : 0);
            for (;;) {
                if (C.tid == 0) MISC[16] = atomicAdd(qc, 1u);
                __syncthreads();
                const int u = (int)MISC[16];
                __syncthreads();
                if (u >= NCHUNK * 8) break;
                const bool ssd = u < NCHUNK * 4; const int v = ssd ? u : u - NCHUNK * 4, c = v >> 2, k = v & 3;
#ifdef DRYF
                if (dry && ssd != (DRYF == 2)) continue;
#endif
                if (kind == 3) { if (ssd) ssd_pass1_unit(C, c, k); else gla_pass1_unit(C, c, k); }
                else           { if (ssd) ssd_pass3_unit(C, c, k); else gla_pass3_unit(C, c, k); }
            }
        }
        else if (kind == 4 && PH_ON(4)) phaseE(C);
        else if (kind == 6 && PH_ON(6)) phaseJ(C);
        else if (kind == 7 && PH_ON(7)) { const int gw = C.bid * NWAVES + C.wave, NGW = C.G * NWAVES; for (int t = gw; t < NTOK; t += NGW) peer_token(C, t, dry); }
#ifdef REP_KIND
        if (rep == 0) xcd_barrier(bar);
#endif
        }
        if (step + 1 < hi && !(kind == 1 && gk == 5)) xcd_barrier(bar);
    }
}

#ifdef DBG_STOP
__global__ void dbg_digest(const unsigned* w, size_t nwords, float* out, size_t nout) {
    for (size_t i = (size_t)blockIdx.x * blockDim.x + threadIdx.x; i < nout; i += (size_t)gridDim.x * blockDim.x) {
        unsigned h = 0; for (size_t j = i; j < nwords; j += nout) h ^= w[j] * 2654435761u + (unsigned)(j / nout);
        out[i] = (float)(h & 0xFFFFFFu);
    }
}
#endif
#ifndef HYB_N_LAUNCHES
#define HYB_N_LAUNCHES 1
#endif
extern "C" void kernel_launch(void* const* d_in, const int* in_sizes, int n_in, void* d_out, int out_size, void* d_ws, size_t ws_size, hipStream_t stream) {
    static int grid = 0;
    if (grid == 0) {
        if (n_in != 22 || out_size != NTOK * D || ws_size < WS_END) { fprintf(stderr, "kernel_launch: unexpected shapes: n_in %d out %d ws %zu (need %zu)\n", n_in, out_size, ws_size, (size_t)WS_END); grid = -1; return; }
        int dev = 0, cus = 0, per_cu = 0;
        if (hipGetDevice(&dev) != hipSuccess || hipDeviceGetAttribute(&cus, hipDeviceAttributeMultiprocessorCount, dev) != hipSuccess) { grid = -1; return; }
        if (hipFuncSetAttribute((const void*)hyb_fwd, hipFuncAttributeMaxDynamicSharedMemorySize, LDS_BYTES) != hipSuccess) { fprintf(stderr, "kernel_launch: hipFuncSetAttribute failed\n"); grid = -1; return; }
        if (hipOccupancyMaxActiveBlocksPerMultiprocessor(&per_cu, (const void*)hyb_fwd, NT, LDS_BYTES) != hipSuccess || per_cu < 1) { fprintf(stderr, "kernel_launch: occupancy query says %d blocks per CU\n", per_cu); per_cu = 1; }
        (void)hipGetLastError();
        grid = cus;
    }
    if (grid < 0) return;
    (void)hipMemsetAsync((char*)d_ws + WS_CTL, 0, CTL_ZERO_BYTES, stream);
    Args a{};
    for (int i = 0; i < 22; ++i) a.in[i] = (const float*)d_in[i];
    a.out = (float*)d_out; a.ws = (unsigned char*)d_ws;
    if (HYB_N_LAUNCHES == 1) { a.ph_lo = 0; a.ph_hi = NSTEPS; hipLaunchKernelGGL(hyb_fwd, dim3(grid), dim3(NT), LDS_BYTES, stream, a); }
    else {
#ifdef DBG_STOP
        for (int s = 0; s <= DBG_STOP; ++s) { a.ph_lo = s; a.ph_hi = s + 1; hipLaunchKernelGGL(hyb_fwd, dim3(grid), dim3(NT), LDS_BYTES, stream, a); }
        hipLaunchKernelGGL(dbg_digest, dim3(2048), dim3(256), 0, stream, (const unsigned*)((char*)d_ws + (size_t)(DBG_OFF)), (size_t)(DBG_LEN) / 4, (float*)d_out, (size_t)NTOK * D);
#else
        for (int s = 0; s < NSTEPS; ++s) { a.ph_lo = s; a.ph_hi = s + 1; hipLaunchKernelGGL(hyb_fwd, dim3(grid), dim3(NT), LDS_BYTES, stream, a); }
#endif
    }
}
```

```cpp
#include <hip/hip_runtime.h>
#include <cstdio>
#include <cstdint>
namespace pg8 {
#define PG8_LAS __attribute__((address_space(3)))
typedef unsigned short bf16_t;
typedef short bf16x8 __attribute__((ext_vector_type(8)));
typedef float f32x4 __attribute__((ext_vector_type(4)));
typedef unsigned u32x4 __attribute__((ext_vector_type(4)));
constexpr int BM = 256, BK = 64, HALF = 128, HTB = HALF * BK * 2  , STAGE_BYTES = 8 * HTB, NXCD = 8, WGM = 8;

__host__ __device__ __forceinline__ int lds_byte(int r, int c) { const int st = (r >> 4) * 2 + (c >> 5), rr = r & 15, cc = c & 31, ob = rr * 64 + cc * 2; return st * 1024 + (ob ^ (((ob >> 9) & 1) << 5)); }
__host__ __device__ __forceinline__ void stage_rc(int b, int& R, int& C) { const int st = b / 1024, sb = b % 1024, swz = sb ^ (((sb >> 9) & 1) << 5); R = (st >> 1) * 16 + swz / 64; C = (st & 1) * 32 + (swz % 64) / 2; }
__host__ __device__ __forceinline__ int perm32(int rho) { const int n = rho >> 4, i = rho & 15; return 8 * (i >> 2) + 4 * n + (i & 3); }

struct Unit { int pm, pn; };
struct Gemm { const bf16_t* A; const bf16_t* Bt; int M, N, K; };

struct StaticOrder {
    int nM, nN, nwg, G, c;
    __host__ __device__ void init(int M, int N, int G_, int c_) { nM = M / BM; nN = N / BM; nwg = nM * nN; G = G_; c = c_; }
    __host__ __device__ bool next(int i, Unit& u) const {
        const long L = (long)i * G + c; if (L >= nwg) return false;
        int wgid = (int)L; { const int q = nwg / NXCD, r = nwg % NXCD, xcd = wgid % NXCD, off = wgid / NXCD; wgid = (xcd < r ? xcd * (q + 1) : r * (q + 1) + (xcd - r) * q) + off; }
        const int nig = WGM * nN, gid = wgid / nig, fm = gid * WGM, gsz = (nM - fm) < WGM ? (nM - fm) : WGM;
        u.pm = fm + ((wgid % nig) % gsz); u.pn = (wgid % nig) / gsz; return true;
    }
    __device__ __forceinline__ void a_ready(const Unit&) const {}
    __device__ __forceinline__ void done(const Unit&) const {}
};

typedef float f32x2_t __attribute__((ext_vector_type(2))); typedef __bf16 bf16x2_t __attribute__((ext_vector_type(2)));
__device__ __forceinline__ unsigned cvt_pk_bf16(float lo, float hi) { f32x2_t v = {lo, hi}; bf16x2_t b = __builtin_convertvector(v, bf16x2_t); return __builtin_bit_cast(unsigned, b); }
template <class Epi, class Sched, bool ALIGN_EPI = false, bool SP2 = false>
__device__ __forceinline__ void gemm_phase(PG8_LAS unsigned char* lds, const Gemm g, const Sched& S, const Epi& E) {
    int tid_ = threadIdx.x; asm volatile("" : "+v"(tid_));
    const int tid = tid_, wid = __builtin_amdgcn_readfirstlane(tid >> 6), lane = tid & 63, wr = wid >> 2, wc = wid & 3, fr = lane & 15, fq = lane >> 4;
    const int K = g.K, nt = K / BK;
    unsigned voffA[2], voffB[2];
#pragma unroll
    for (int i = 0; i < 2; ++i) { int R, C; stage_rc(tid * 16 + i * 8192, R, C); const int Rb = Epi::PERM ? ((R & ~31) + perm32(R & 31)) : R;
        voffA[i] = (unsigned)(R * K + C) * 2u; voffB[i] = (unsigned)(Rb * K + C) * 2u; }
    const size_t kstep = (size_t)(BK * 2);
    const size_t hstep = (size_t)HALF * K * 2;
    const size_t tstep = 2 * hstep;
    const unsigned ldsw = (unsigned)wid * 1024u;
    const int aoff = lds_byte(wr * 64 + fr, fq * 8), boff = lds_byte(wc * 32 + fr, fq * 8);
#define PG8_SA(b, h) (((b) * 2 + (h)) * HTB)
#define PG8_SB(b, h) ((4 + (b) * 2 + (h)) * HTB)
#define PG8_STAGE(bufoff, gbase, voff) do { _Pragma("unroll") for (int _i = 0; _i < 2; ++_i) \
        __builtin_amdgcn_global_load_lds((const unsigned*)((const char*)(gbase) + (voff)[_i]), (PG8_LAS unsigned*)(lds + (bufoff) + ldsw + _i * 8192), 16, 0, 0); } while (0)
#define PG8_LDA(dst, b, h) do { _Pragma("unroll") for (int m = 0; m < 4; ++m) _Pragma("unroll") for (int k = 0; k < 2; ++k) dst[m][k] = *(const PG8_LAS bf16x8*)(lds + PG8_SA(b, h) + aoff + m * 2048 + k * 1024); } while (0)
#define PG8_LDB(dst, b, h) do { _Pragma("unroll") for (int n = 0; n < 2; ++n) _Pragma("unroll") for (int k = 0; k < 2; ++k) dst[n][k] = *(const PG8_LAS bf16x8*)(lds + PG8_SB(b, h) + boff + n * 2048 + k * 1024); } while (0)
#define PG8_MMA(ai, bj, At, Bt) do { __builtin_amdgcn_s_setprio(1); _Pragma("unroll") for (int m = 0; m < 4; ++m) _Pragma("unroll") for (int n = 0; n < 2; ++n) _Pragma("unroll") for (int k = 0; k < 2; ++k) \
        acc[ai][bj][m][n] = __builtin_amdgcn_mfma_f32_16x16x32_bf16(Bt[n][k], At[m][k], acc[ai][bj][m][n], 0, 0, 0); __builtin_amdgcn_s_setprio(0); } while (0)
#define PG8_WAIT_V(n) asm volatile("s_waitcnt vmcnt(" #n ")" ::: "memory")
#define PG8_WAIT_L(n) asm volatile("s_waitcnt lgkmcnt(" #n ")" ::: "memory")
#define PG8_BAR __builtin_amdgcn_s_barrier()
#define PG8_SCHED __builtin_amdgcn_sched_barrier(0)
    Unit cur, nxt; int ui = 0;
    if (!S.next(0, cur)) return;
    f32x4 acc[2][2][4][2];
#pragma unroll
    for (int a = 0; a < 2; ++a)
#pragma unroll
        for (int b = 0; b < 2; ++b)
#pragma unroll
            for (int m = 0; m < 4; ++m)
#pragma unroll
                for (int n = 0; n < 2; ++n) acc[a][b][m][n] = (f32x4){0.f, 0.f, 0.f, 0.f};
    bf16x8 At[4][2], B0[2][2], B1[2][2];
    const char* cA = (const char*)g.A + (size_t)cur.pm * tstep; const char* cB = (const char*)g.Bt + (size_t)cur.pn * tstep;
    S.a_ready(cur);
    if constexpr (SP2) {
        PG8_STAGE(PG8_SB(0, 0), cB, voffB); PG8_STAGE(PG8_SB(0, 1), cB + hstep, voffB); PG8_STAGE(PG8_SA(0, 0), cA, voffA); PG8_STAGE(PG8_SA(0, 1), cA + hstep, voffA);
        if (wr == 1) PG8_BAR;
        PG8_WAIT_V(2); PG8_BAR;
        PG8_STAGE(PG8_SB(1, 0), cB + kstep, voffB); PG8_STAGE(PG8_SA(1, 0), cA + kstep, voffA); PG8_STAGE(PG8_SB(1, 1), cB + hstep + kstep, voffB);
        PG8_WAIT_V(6); PG8_BAR;
    } else {
        PG8_STAGE(PG8_SB(0, 0), cB, voffB); PG8_STAGE(PG8_SA(0, 0), cA, voffA); PG8_STAGE(PG8_SB(0, 1), cB + hstep, voffB); PG8_STAGE(PG8_SA(0, 1), cA + hstep, voffA);
        if (wr == 1) PG8_BAR;
        PG8_WAIT_V(4); PG8_BAR;
        PG8_STAGE(PG8_SB(1, 0), cB + kstep, voffB); PG8_STAGE(PG8_SA(1, 0), cA + kstep, voffA); PG8_STAGE(PG8_SB(1, 1), cB + hstep + kstep, voffB);
        PG8_WAIT_V(6); PG8_BAR;
    }
    for (;;) {
        const bool has_next = S.next(ui + 1, nxt);
        const char* nA = has_next ? (const char*)g.A + (size_t)nxt.pm * tstep : cA; const char* nB = has_next ? (const char*)g.Bt + (size_t)nxt.pn * tstep : cB;
        for (int t = 0; t < nt; t += 2) {
            const bool last = (t == nt - 2);
            const char* a1 = cA + (size_t)(t + 1) * kstep;
            const char* a2 = last ? nA : cA + (size_t)(t + 2) * kstep; const char* b2 = last ? nB : cB + (size_t)(t + 2) * kstep;
            const char* a3 = a2 + kstep; const char* b3 = b2 + kstep;
            if (last && has_next) S.a_ready(nxt);
            if constexpr (SP2) {
            PG8_LDB(B0, 0, 0); PG8_LDB(B1, 0, 1); PG8_SCHED; PG8_LDA(At, 0, 0); PG8_STAGE(PG8_SA(1, 1), a1 + hstep, voffA);
            PG8_WAIT_V(8); PG8_WAIT_L(0); PG8_BAR; PG8_MMA(0, 0, At, B0); PG8_MMA(0, 1, At, B1); PG8_BAR; PG8_SCHED;
            PG8_LDA(At, 0, 1); PG8_STAGE(PG8_SB(0, 0), b2, voffB); PG8_STAGE(PG8_SB(0, 1), b2 + hstep, voffB); PG8_STAGE(PG8_SA(0, 0), a2, voffA);
            PG8_WAIT_V(8); PG8_WAIT_L(0); PG8_BAR; PG8_MMA(1, 0, At, B0); PG8_MMA(1, 1, At, B1); PG8_BAR; PG8_SCHED;
            PG8_LDB(B0, 1, 0); PG8_LDB(B1, 1, 1); PG8_SCHED; PG8_LDA(At, 1, 0); PG8_STAGE(PG8_SA(0, 1), a2 + hstep, voffA);
            PG8_WAIT_V(8); PG8_WAIT_L(0); PG8_BAR; PG8_MMA(0, 0, At, B0); PG8_MMA(0, 1, At, B1); PG8_BAR; PG8_SCHED;
            PG8_LDA(At, 1, 1); PG8_STAGE(PG8_SB(1, 0), b3, voffB); PG8_STAGE(PG8_SB(1, 1), b3 + hstep, voffB); PG8_STAGE(PG8_SA(1, 0), a3, voffA);
            PG8_WAIT_V(8); PG8_WAIT_L(0); PG8_BAR; PG8_MMA(1, 0, At, B0); PG8_MMA(1, 1, At, B1); PG8_BAR; PG8_SCHED;
            } else {
            PG8_LDB(B0, 0, 0); PG8_SCHED; PG8_LDA(At, 0, 0); PG8_STAGE(PG8_SA(1, 1), a1 + hstep, voffA);
            PG8_WAIT_L(8); PG8_BAR; PG8_WAIT_L(0); PG8_MMA(0, 0, At, B0); PG8_BAR; PG8_SCHED;
            PG8_LDB(B1, 0, 1); PG8_STAGE(PG8_SB(0, 0), b2, voffB);
            PG8_BAR; PG8_WAIT_L(0); PG8_MMA(0, 1, At, B1); PG8_BAR;
            PG8_LDA(At, 0, 1); PG8_STAGE(PG8_SA(0, 0), a2, voffA);
            PG8_BAR; PG8_WAIT_L(0); PG8_MMA(1, 0, At, B0); PG8_BAR; PG8_SCHED;
            PG8_STAGE(PG8_SB(0, 1), b2 + hstep, voffB);
            PG8_WAIT_V(6); PG8_BAR; PG8_MMA(1, 1, At, B1); PG8_BAR;
            PG8_LDB(B0, 1, 0); PG8_SCHED; PG8_LDA(At, 1, 0); PG8_STAGE(PG8_SA(0, 1), a2 + hstep, voffA);
            PG8_WAIT_L(8); PG8_BAR; PG8_WAIT_L(0); PG8_MMA(0, 0, At, B0); PG8_BAR; PG8_SCHED;
            PG8_LDB(B1, 1, 1); PG8_STAGE(PG8_SB(1, 0), b3, voffB);
            PG8_BAR; PG8_WAIT_L(0); PG8_MMA(0, 1, At, B1); PG8_BAR;
            PG8_LDA(At, 1, 1); PG8_STAGE(PG8_SA(1, 0), a3, voffA);
            PG8_BAR; PG8_WAIT_L(0); PG8_MMA(1, 0, At, B0); PG8_BAR; PG8_SCHED;
            PG8_STAGE(PG8_SB(1, 1), b3 + hstep, voffB);
            PG8_WAIT_V(6); PG8_BAR; PG8_MMA(1, 1, At, B1); PG8_BAR;
            }
        }
        if constexpr (ALIGN_EPI) { if (wr == 0) PG8_BAR; }
        if constexpr (!Epi::AFTER_DRAIN) { E(acc, cur, wr, wc, fr, fq); S.done(cur); }
        if (!has_next) break;
#pragma unroll
        for (int a = 0; a < 2; ++a)
#pragma unroll
            for (int b = 0; b < 2; ++b)
#pragma unroll
                for (int m = 0; m < 4; ++m)
#pragma unroll
                    for (int n = 0; n < 2; ++n) acc[a][b][m][n] = (f32x4){0.f, 0.f, 0.f, 0.f};
        cur = nxt; cA = nA; cB = nB; ++ui;
        if constexpr (ALIGN_EPI) { if (wr == 1) PG8_BAR; }
    }
    PG8_WAIT_V(0);
    if constexpr (!ALIGN_EPI) { if (wr == 0) PG8_BAR; }
    PG8_BAR;
    if constexpr (Epi::AFTER_DRAIN) { E.fused(acc, cur, wr, wc, fr, fq, lds, wid, lane); S.done(cur); }
#undef PG8_SA
#undef PG8_SB
#undef PG8_STAGE
#undef PG8_LDA
#undef PG8_LDB
#undef PG8_MMA
#undef PG8_WAIT_V
#undef PG8_WAIT_L
#undef PG8_BAR
#undef PG8_SCHED
}
}

constexpr int NWAVES = 8, NT = 512;
constexpr int D = 1024, BATCH = 4, SEQ = 8192, NMETA = 16;
constexpr int RPB = 8448;
constexpr int RFRONT = 48, RTOK = 64, REND = 8256;
constexpr int NCHUNK = 129;
constexpr int NPJ = 10240;
constexpr int N1 = 10496;
constexpr int PJ_Q = 0, PJ_K = 512, PJ_V = 1024, PJ_GO = 2048, PJ_Z = 3072, PJ_XBC = 5120, PJ_GA = 8192, PJ_GB = 9216;
constexpr int NTOK = BATCH * SEQ;
constexpr float RMS_EPS = 1e-6f;

constexpr size_t MiB = 1u << 20;
constexpr size_t WS_CTL = 0, CTL_ZERO_BYTES = 1 * MiB;
constexpr size_t WS_W1T = 2 * MiB;
constexpr size_t WS_WAT = 23 * MiB;
constexpr size_t WS_WBT = 25 * MiB;
constexpr size_t WS_WOT = 29 * MiB;
constexpr size_t WS_WET = 31 * MiB;
constexpr size_t WS_HNM = 35 * MiB;
constexpr size_t WS_HN = 36 * MiB;
constexpr size_t WS_PJ = 53 * MiB;
constexpr size_t WS_TL = 218 * MiB;
constexpr size_t WS_XC = 220 * MiB;
constexpr size_t WS_GG = 270 * MiB;
constexpr size_t WS_DT = 287 * MiB;
constexpr size_t WS_AC = 289 * MiB;
constexpr size_t WS_LG = 291 * MiB;
constexpr size_t WS_LS = 308 * MiB;
constexpr size_t WS_OG = 341 * MiB;
constexpr size_t WS_YS = 373 * MiB;
constexpr size_t WS_GT = 437 * MiB;
constexpr size_t WS_T1 = 291 * MiB;
constexpr size_t WS_MX = 220 * MiB;
constexpr size_t WS_MIX_END = 473 * MiB;
constexpr size_t WS_HN2 = 36 * MiB;
constexpr size_t WS_SC = 100 * MiB;
constexpr size_t WS_HN8 = 356 * MiB;
constexpr size_t WS_U8 = 474 * MiB;
constexpr size_t WS_END = 506 * MiB;
constexpr int CW_BAR = 4096, CW_QUEUE = 64;

constexpr int LDS_WORK = 147456;
constexpr int LDSCTL_OFF = LDS_WORK;
constexpr int LDS_BYTES = LDS_WORK + 512;

#define GAS __attribute__((address_space(1)))
#define LAS __attribute__((address_space(3)))
typedef unsigned short bf16;
typedef unsigned v4u __attribute__((ext_vector_type(4)));
typedef unsigned v2u __attribute__((ext_vector_type(2)));
typedef float f32x4 __attribute__((ext_vector_type(4)));
typedef float f32x2 __attribute__((ext_vector_type(2)));
typedef short bf16x8 __attribute__((ext_vector_type(8)));
typedef short s16x4 __attribute__((ext_vector_type(4)));
typedef short v4i16_t __attribute__((ext_vector_type(4)));
typedef LAS unsigned char* ldsp;
#define RLX_AGENT __ATOMIC_RELAXED, __HIP_MEMORY_SCOPE_AGENT
#define LDS_WAIT() asm volatile("s_waitcnt lgkmcnt(0)" ::: "memory")

__device__ __forceinline__ unsigned pk2(float lo, float hi) { return pg8::cvt_pk_bf16(lo, hi); }
__device__ __forceinline__ float bflo(unsigned u) { return __builtin_bit_cast(float, u << 16); }
__device__ __forceinline__ float bfhi(unsigned u) { return __builtin_bit_cast(float, u & 0xffff0000u); }
__device__ __forceinline__ float fast_rcp(float x) { return __builtin_amdgcn_rcpf(x); }
__device__ __forceinline__ float sigmoidf_(float x) { return fast_rcp(1.f + __expf(-x)); }
__device__ __forceinline__ float siluf_(float x) { return x * sigmoidf_(x); }
__device__ __forceinline__ float wave_sum(float v) {
#pragma unroll
    for (int o = 1; o < 64; o <<= 1) v += __shfl_xor(v, o);
    return v;
}
__device__ __forceinline__ float wave_max(float v) {
#pragma unroll
    for (int o = 1; o < 64; o <<= 1) v = fmaxf(v, __shfl_xor(v, o));
    return v;
}
__device__ __forceinline__ f32x4 mma16(bf16x8 a, bf16x8 b, f32x4 c) { return __builtin_amdgcn_mfma_f32_16x16x32_bf16(b, a, c, 0, 0, 0); }
__device__ __forceinline__ bf16x8 lds_frag(ldsp p) { return *(const LAS bf16x8*)p; }
__device__ __forceinline__ s16x4 lds_tr(ldsp p) { return __builtin_bit_cast(s16x4, __builtin_amdgcn_ds_read_tr16_b64_v4i16((LAS v4i16_t*)p)); }
__device__ __forceinline__ bf16x8 tr_frag(ldsp tile, int pitch, int k0, int n0, int fr, int fq) {
#ifdef TR_SLOW
    bf16x8 r;
#pragma unroll
    for (int e = 0; e < 8; ++e) r[e] = *(const LAS short*)(tile + (k0 + 8 * fq + e) * pitch + (n0 + fr) * 2);
    return r;
#else
    ldsp p = tile + (k0 + 8 * fq + (fr >> 2)) * pitch + (n0 + 4 * (fr & 3)) * 2;
    const s16x4 lo = lds_tr(p), hi = lds_tr(p + 4 * pitch);
    bf16x8 r; r[0] = lo[0]; r[1] = lo[1]; r[2] = lo[2]; r[3] = lo[3]; r[4] = hi[0]; r[5] = hi[1]; r[6] = hi[2]; r[7] = hi[3];
    return r;
#endif
}

__device__ __forceinline__ float sat448(float x) { return __builtin_amdgcn_fmed3f(x, -448.f, 448.f); }
__device__ __forceinline__ unsigned pack4_fp8(float a, float b, float c2, float d2) { int w = 0; w = __builtin_amdgcn_cvt_pk_fp8_f32(sat448(a), sat448(b), w, false); w = __builtin_amdgcn_cvt_pk_fp8_f32(sat448(c2), sat448(d2), w, true); return (unsigned)w; }
__device__ __forceinline__ bf16x8 fp8x8_to_bf16(unsigned a, unsigned b) {
    const f32x2 p0 = __builtin_amdgcn_cvt_pk_f32_fp8((int)a, false), p1 = __builtin_amdgcn_cvt_pk_f32_fp8((int)a, true), p2 = __builtin_amdgcn_cvt_pk_f32_fp8((int)b, false), p3 = __builtin_amdgcn_cvt_pk_f32_fp8((int)b, true);
    const v4u r = {pk2(p0.x, p0.y), pk2(p1.x, p1.y), pk2(p2.x, p2.y), pk2(p3.x, p3.y)};
    return __builtin_bit_cast(bf16x8, r);
}
__device__ __forceinline__ float ssd_gain(const float* dt_bias, int hd) { const float b = dt_bias[hd]; const float dt0 = fmaxf(b, 0.f) + __logf(1.f + __expf(-fabsf(b))); return exp2f(floorf(__log2f(1.f / dt0))); }

#define XB_TMO      128
#define XB_XCNT(j)  (256  + 64 * (j))
#define XB_XSUB(j)  (1280 + 64 * (j))
#define XB_XGEN(j)  (2304 + 64 * (j))
#define XB_TOP      3328
#define XB_TOPGEN   3392
#define XCD_BAR_WORDS 3456
#define XB_SPIN_CAP (1u << 22)
__device__ __forceinline__ unsigned xb_ld(unsigned* p)              { return __hip_atomic_load(p, __ATOMIC_RELAXED, __HIP_MEMORY_SCOPE_AGENT); }
__device__ __forceinline__ unsigned xb_add(unsigned* p, unsigned v) { return __hip_atomic_fetch_add(p, v, __ATOMIC_RELAXED, __HIP_MEMORY_SCOPE_AGENT); }
__device__ __forceinline__ unsigned xb_xcc_id() { return (unsigned)__builtin_amdgcn_s_getreg((3 << 11) | 20) & 0xFu; }
#define XB_SPIN(cond, bar) do { unsigned _sp = 0; while (cond) { __builtin_amdgcn_s_sleep(1); \
    if ((++_sp & 255u) == 0u) { if (xb_ld(&(bar)[XB_TMO])) break; if (_sp > XB_SPIN_CAP) { atomicAdd(&(bar)[XB_TMO], 1u); break; } } } } while (0)
struct XcdBarrier { unsigned* bar; unsigned x; volatile LAS unsigned* st; };
__device__ __forceinline__ XcdBarrier xcd_barrier_post(unsigned* bar, volatile LAS unsigned* st) {
    XcdBarrier b; b.bar = bar; b.x = xb_xcc_id(); b.st = st;
    if (threadIdx.x == 0) (void)xb_add(&bar[XB_XCNT(b.x)], 1u);
    return b;
}
__device__ __forceinline__ void xcd_barrier_complete(unsigned* bar, unsigned x, unsigned& nloc, unsigned& nx) {
    const unsigned G = gridDim.x * gridDim.y * gridDim.z;
    unsigned sum, cnt, mine, sp = 0u;
    for (;;) {
        sum = 0u; cnt = 0u; mine = 0u;
#pragma unroll
        for (unsigned j = 0; j < 16; ++j) { const unsigned c = xb_ld(&bar[XB_XCNT(j)]); sum += c; cnt += (c > 0u) ? 1u : 0u; mine = (j == x) ? c : mine; }
        if (sum == G) break;
        __builtin_amdgcn_s_sleep(1);
        if ((++sp & 255u) == 0u) { if (xb_ld(&bar[XB_TMO])) break; if (sp > XB_SPIN_CAP) { atomicAdd(&bar[XB_TMO], 1u); break; } }
    }
    nloc = mine > 0u ? mine : 1u; nx = cnt > 0u ? cnt : 1u;
}
__device__ __forceinline__ void xcd_barrier(const XcdBarrier& b) {
    asm volatile("s_waitcnt vmcnt(0)" ::: "memory");
    __syncthreads();
    if (threadIdx.x == 0) {
        unsigned* bar = b.bar;
        __builtin_amdgcn_s_waitcnt(0);
        unsigned nloc = b.st[0], nx = b.st[1];
        if (nloc == 0u) { xcd_barrier_complete(bar, b.x, nloc, nx); b.st[0] = nloc; b.st[1] = nx; }
        const unsigned old = xb_add(&bar[XB_XSUB(b.x)], 1u);
        const unsigned gen = old / nloc;
        if (old + 1u == (gen + 1u) * nloc) {
            __builtin_amdgcn_fence(__ATOMIC_RELEASE, "agent");
            asm volatile("s_waitcnt vmcnt(0)" ::: "memory");
            const unsigned og = xb_add(&bar[XB_TOP], 1u);
            const unsigned tg = og / nx;
            if (og + 1u == (tg + 1u) * nx) xb_add(&bar[XB_TOPGEN], 1u);
            else XB_SPIN(xb_ld(&bar[XB_TOPGEN]) == tg, bar);
            __builtin_amdgcn_fence(__ATOMIC_ACQUIRE, "agent");
            xb_add(&bar[XB_XGEN(b.x)], 1u);
            asm volatile("s_waitcnt vmcnt(0)" ::: "memory");
        } else {
            XB_SPIN(xb_ld(&bar[XB_XGEN(b.x)]) == gen, bar);
            __builtin_amdgcn_fence(__ATOMIC_ACQUIRE, "agent");
            asm volatile("s_waitcnt vmcnt(0)" ::: "memory");
        }
    }
    __syncthreads();
}

struct Ctx {
    ldsp lds; int tid, lane, wave, G, bid;
    const float* in[22]; float* out; unsigned char* ws;
};
enum { I_X = 0, I_META, I_LNMIX, I_WIN, I_WG2, I_BG, I_GNW, I_CONVW, I_CONVB, I_DTB, I_ALOG, I_DSKIP, I_SNW, I_WUG, I_WUS, I_WOUT, I_LNFFN, I_WQ, I_KEYS, I_PU, I_PV, I_LNF };

using pg8::Unit; using pg8::cvt_pk_bf16;
struct EpiProj {
    static constexpr bool PERM = true, AFTER_DRAIN = false;
    bf16* PJ; float* TL; bf16* GT;
    __device__ __forceinline__ void operator()(const f32x4 (&acc)[2][2][4][2], const Unit& u, int wr, int wc, int fr, int fq) const {
        const int row0 = RTOK + u.pm * 256 + wr * 64 + fr; const int pn = u.pn;
        const int mode = pn < 2 ? 1 : (pn < 8 ? 0 : (pn < 20 ? 2 : (pn < 32 ? 0 : 3)));
        const int col0 = pn * 256 + wc * 32 + 8 * fq;
#pragma unroll
        for (int ai = 0; ai < 2; ++ai)
#pragma unroll
            for (int m = 0; m < 4; ++m) { bf16* rowp = (GT && pn >= 32) ? GT + (size_t)(row0 - RTOK + ai * 128 + m * 16) * 2048 + (col0 - PJ_GA) : PJ + (size_t)(row0 + ai * 128 + m * 16) * NPJ + col0;
#pragma unroll
                for (int bj = 0; bj < 2; ++bj) { f32x4 v0 = acc[ai][bj][m][0], v1 = acc[ai][bj][m][1];
                    if (mode == 1) { v0 = v0 * 0.08838834764831845f; v1 = v1 * 0.08838834764831845f; }
                    else if (mode == 2) {
#pragma unroll
                        for (int j = 0; j < 4; ++j) { v0[j] = siluf_(v0[j]); v1[j] = siluf_(v1[j]); } }
                    else if (mode == 3) {
#pragma unroll
                        for (int j = 0; j < 4; ++j) { v0[j] = sigmoidf_(v0[j]); v1[j] = sigmoidf_(v1[j]); } }
                    v4u w; w.x = cvt_pk_bf16(v0[0], v0[1]); w.y = cvt_pk_bf16(v0[2], v0[3]); w.z = cvt_pk_bf16(v1[0], v1[1]); w.w = cvt_pk_bf16(v1[2], v1[3]);
                    *(GAS v4u*)(rowp + bj * 128) = w; } }
    }
};
struct EpiAny {
    static constexpr bool PERM = true, AFTER_DRAIN = false;
    int mode;
    EpiProj P; bf16* O; const bf16* PJ; const bf16* GT; const bf16* T; int gsel; const float* X; float* OF; int pair; int ldc;
    __device__ __forceinline__ void operator()(const f32x4 (&acc)[2][2][4][2], const Unit& u, int wr, int wc, int fr, int fq) const {
        if (mode == 0) { P(acc, u, wr, wc, fr, fq); return; }
        const int row0 = u.pm * 256 + wr * 64 + fr; const int col0 = u.pn * 256 + wc * 32 + 8 * fq;
        if (mode == 1) {
#pragma unroll
            for (int ai = 0; ai < 2; ++ai)
#pragma unroll
                for (int m = 0; m < 4; ++m) { const size_t r = (size_t)(row0 + ai * 128 + m * 16);
                    v4u gq[2], tq[2];
                    const bf16* gp = (r < SEQ) ? GT + r * 2048 + gsel * 1024 + col0 : PJ + (r - SEQ + RTOK) * NPJ + PJ_GA + gsel * 1024 + col0;
#pragma unroll
                    for (int bj = 0; bj < 2; ++bj) { gq[bj] = *(const GAS v4u*)(gp + bj * 128); tq[bj] = T ? *(const GAS v4u*)(T + r * 1024 + col0 + bj * 128) : (v4u){0u, 0u, 0u, 0u}; }
#pragma unroll
                    for (int bj = 0; bj < 2; ++bj) { const int c = col0 + bj * 128;
                        const v4u g = gq[bj];
                        f32x4 v0 = acc[ai][bj][m][0], v1 = acc[ai][bj][m][1];
                        v0[0] *= bflo(g.x); v0[1] *= bfhi(g.x); v0[2] *= bflo(g.y); v0[3] *= bfhi(g.y); v1[0] *= bflo(g.z); v1[1] *= bfhi(g.z); v1[2] *= bflo(g.w); v1[3] *= bfhi(g.w);
                        { const v4u t = tq[bj];
                            v0[0] += bflo(t.x); v0[1] += bfhi(t.x); v0[2] += bflo(t.y); v0[3] += bfhi(t.y); v1[0] += bflo(t.z); v1[1] += bfhi(t.z); v1[2] += bflo(t.w); v1[3] += bfhi(t.w); }
                        v4u w; w.x = cvt_pk_bf16(v0[0], v0[1]); w.y = cvt_pk_bf16(v0[2], v0[3]); w.z = cvt_pk_bf16(v1[0], v1[1]); w.w = cvt_pk_bf16(v1[2], v1[3]);
                        *(GAS v4u*)(O + r * 1024 + c) = w; } }
        } else if (mode == 2) {
#pragma unroll
            for (int ai = 0; ai < 2; ++ai)
#pragma unroll
                for (int m = 0; m < 4; ++m) { const int r = row0 + ai * 128 + m * 16;
                    { const size_t o = ((size_t)pair * 2 * SEQ + r) * D + col0;
                        f32x4 xv[2][2];
#pragma unroll
                        for (int bj = 0; bj < 2; ++bj)
#pragma unroll
                            for (int n = 0; n < 2; ++n) xv[bj][n] = *(const GAS f32x4*)(X + o + bj * 128 + n * 4);
#pragma unroll
                        for (int bj = 0; bj < 2; ++bj)
#pragma unroll
                            for (int n = 0; n < 2; ++n) *(GAS f32x4*)(OF + o + bj * 128 + n * 4) = acc[ai][bj][m][n] + xv[bj][n]; } }
        } else {
#pragma unroll
            for (int ai = 0; ai < 2; ++ai)
#pragma unroll
                for (int m = 0; m < 4; ++m) { _Float16* rowp = (_Float16*)OF + (size_t)(row0 + ai * 128 + m * 16) * ldc + col0;
#pragma unroll
                    for (int bj = 0; bj < 2; ++bj) { const f32x4 v0 = acc[ai][bj][m][0], v1 = acc[ai][bj][m][1];
                        typedef _Float16 h2 __attribute__((ext_vector_type(2)));
                        const h2 p0 = {(_Float16)v0[0], (_Float16)v0[1]}, p1 = {(_Float16)v0[2], (_Float16)v0[3]}, p2 = {(_Float16)v1[0], (_Float16)v1[1]}, p3 = {(_Float16)v1[2], (_Float16)v1[3]};
                        *(GAS v4u*)(rowp + bj * 128) = (v4u){__builtin_bit_cast(unsigned, p0), __builtin_bit_cast(unsigned, p1), __builtin_bit_cast(unsigned, p2), __builtin_bit_cast(unsigned, p3)}; } }
        }
    }
};

struct MapIdent { __device__ __forceinline__ int operator()(int n) const { return n; } };
struct MapW1 { __device__ __forceinline__ int operator()(int n) const {
    if (n < 3072) return n;
    if (n < 8192) return n + 16;
    if (n < 10240) return n + 48;
    if (n < 10256) return n - 10240 + 3072;
    if (n < 10288) return n - 10256 + 8208;
    return -1; } };
template <class Map>
__device__ __forceinline__ void transpose_item(const float* W, int K, int NS, int N, bf16* WT, LAS float* scr, int item, int lane, const Map& map) {
    const int nblk = N / 32, kb = item / nblk, nb = item % nblk, k0 = 64 * kb, n0 = 32 * nb;
    const int sc = map(n0 + (lane & 31));
#pragma unroll
    for (int i0 = 0; i0 < 32; i0 += 16) { float tv[16];
#pragma unroll
        for (int i = 0; i < 16; ++i) { const int kk = 2 * (i0 + i) + (lane >> 5); tv[i] = sc >= 0 ? *(const GAS float*)(W + (size_t)(k0 + kk) * NS + sc) : 0.f; }
#pragma unroll
        for (int i = 0; i < 16; ++i) { const int kk = 2 * (i0 + i) + (lane >> 5); scr[kk * 33 + (lane & 31)] = tv[i]; } }
    LDS_WAIT(); asm volatile("" ::: "memory");
    const int c = lane & 7;
#pragma unroll
    for (int j = 0; j < 4; ++j) { const int n = (lane >> 3) + 8 * j; const LAS float* s = scr + (8 * c) * 33 + n;
        v4u o; o.x = pk2(s[0 * 33], s[1 * 33]); o.y = pk2(s[2 * 33], s[3 * 33]); o.z = pk2(s[4 * 33], s[5 * 33]); o.w = pk2(s[6 * 33], s[7 * 33]);
        *(GAS v4u*)(WT + (size_t)(n0 + n) * K + k0 + 8 * c) = o; }
    LDS_WAIT(); asm volatile("" ::: "memory");
}
__device__ __forceinline__ void norm_row_bf16(const float* src, const float* w, bf16* dst, int lane) {
    v2u* o8 = (v2u*)dst + lane;
    if (src == nullptr) {
#pragma unroll
        for (int j = 0; j < 4; ++j) o8[64 * j] = (v2u){0u, 0u};
        return; }
    const f32x4* xr = (const f32x4*)src + lane; const f32x4* wr_ = (const f32x4*)w + lane;
    f32x4 v[4]; float s = 0.f;
#pragma unroll
    for (int j = 0; j < 4; ++j) { v[j] = xr[64 * j]; s += (v[j].x * v[j].x + v[j].y * v[j].y) + (v[j].z * v[j].z + v[j].w * v[j].w); }
    const float rs = rsqrtf(wave_sum(s) * (1.f / D) + RMS_EPS);
#pragma unroll
    for (int j = 0; j < 4; ++j) { const f32x4 ww = wr_[64 * j]; v2u o; o.x = pk2(v[j].x * rs * ww.x, v[j].y * rs * ww.y); o.y = pk2(v[j].z * rs * ww.z, v[j].w * rs * ww.w); o8[64 * j] = o; }
}
__device__ __forceinline__ float wave_sum63(float v) {
    v += __builtin_bit_cast(float, __builtin_amdgcn_mov_dpp(__builtin_bit_cast(int, v), 0xB1, 0xf, 0xf, true));
    v += __builtin_bit_cast(float, __builtin_amdgcn_mov_dpp(__builtin_bit_cast(int, v), 0x4E, 0xf, 0xf, true));
    v += __builtin_bit_cast(float, __builtin_amdgcn_mov_dpp(__builtin_bit_cast(int, v), 0x141, 0xf, 0xf, true));
    v += __builtin_bit_cast(float, __builtin_amdgcn_mov_dpp(__builtin_bit_cast(int, v), 0x128, 0xf, 0xf, true));
    v += __builtin_bit_cast(float, __builtin_amdgcn_update_dpp(0, __builtin_bit_cast(int, v), 0x142, 0xa, 0xf, false));
    v += __builtin_bit_cast(float, __builtin_amdgcn_update_dpp(0, __builtin_bit_cast(int, v), 0x143, 0xc, 0xf, false));
    return v;
}
__device__ __forceinline__ void hn_token_rows2(const Ctx& C, int b, int s0, int s1) {
    const int lane = C.lane;
    const f32x4* x0 = (const f32x4*)(C.in[I_X] + ((size_t)b * SEQ + s0) * D) + lane; const f32x4* x1 = (const f32x4*)(C.in[I_X] + ((size_t)b * SEQ + s1) * D) + lane;
    const f32x4* wr_ = (const f32x4*)C.in[I_LNMIX] + lane;
    f32x4 v[4], u[4]; float q0 = 0.f, q1 = 0.f;
#pragma unroll
    for (int j = 0; j < 4; ++j) { v[j] = x0[64 * j]; u[j] = x1[64 * j]; }
#pragma unroll
    for (int j = 0; j < 4; ++j) { q0 += (v[j].x * v[j].x + v[j].y * v[j].y) + (v[j].z * v[j].z + v[j].w * v[j].w); q1 += (u[j].x * u[j].x + u[j].y * u[j].y) + (u[j].z * u[j].z + u[j].w * u[j].w); }
    const float r0 = rsqrtf(wave_sum(q0) * (1.f / D) + RMS_EPS), r1 = rsqrtf(wave_sum(q1) * (1.f / D) + RMS_EPS);
    v2u* o0 = (v2u*)((bf16*)(C.ws + WS_HN) + (size_t)s0 * D) + lane; v2u* o1 = (v2u*)((bf16*)(C.ws + WS_HN) + (size_t)s1 * D) + lane;
#pragma unroll
    for (int j = 0; j < 4; ++j) { const f32x4 ww = wr_[64 * j]; const f32x4 a = v[j] * r0 * ww, bq = u[j] * r1 * ww;
        o0[64 * j] = (v2u){pk2(a.x, a.y), pk2(a.z, a.w)}; o1[64 * j] = (v2u){pk2(bq.x, bq.y), pk2(bq.z, bq.w)}; }
}
__device__ __forceinline__ void hn_batch(const Ctx& C, int b, int first_blk) {
    if (C.bid < first_blk) return;
    const int gw = (C.bid - first_blk) * NWAVES + C.wave, NGW = (C.G - first_blk) * NWAVES;
    for (int s = gw; s < SEQ / 2; s += NGW) hn_token_rows2(C, b, s, s + SEQ / 2);
}
__device__ __forceinline__ void meta_proj(const Ctx& C) {
    const bf16* HNM = (const bf16*)(C.ws + WS_HNM); const bf16* W1T = (const bf16*)(C.ws + WS_W1T);
    bf16* PJ = (bf16*)(C.ws + WS_PJ); float* TL = (float*)(C.ws + WS_TL);
    const int gw = C.bid * NWAVES + C.wave, NGW = C.G * NWAVES, fr = C.lane & 15, fq = C.lane >> 4;
    for (int nt = gw; nt < 643; nt += NGW) {
        f32x4 acc = {0.f, 0.f, 0.f, 0.f};
#pragma unroll 8
        for (int ks = 0; ks < 32; ++ks) acc = mma16(*(const GAS bf16x8*)(HNM + fr * D + 32 * ks + 8 * fq), *(const GAS bf16x8*)(W1T + (size_t)(16 * nt + fr) * D + 32 * ks + 8 * fq), acc);
        const int n = 16 * nt + 4 * fq;
        if (n >= NPJ) { if (n < NPJ + 48) *(GAS f32x4*)(TL + (size_t)(RFRONT + fr) * 48 + (n - NPJ)) = acc; continue; }
        if (n < 512) acc = acc * 0.08838834764831845f;
        else if ((n >= PJ_GO && n < PJ_XBC)) { acc[0] = siluf_(acc[0]); acc[1] = siluf_(acc[1]); acc[2] = siluf_(acc[2]); acc[3] = siluf_(acc[3]); }
        else if (n >= PJ_GA) { acc[0] = sigmoidf_(acc[0]); acc[1] = sigmoidf_(acc[1]); acc[2] = sigmoidf_(acc[2]); acc[3] = sigmoidf_(acc[3]); }
        *(GAS v2u*)(PJ + (size_t)(RFRONT + fr) * NPJ + n) = (v2u){pk2(acc[0], acc[1]), pk2(acc[2], acc[3])};
    }
}
__device__ __forceinline__ void tail_proj(const Ctx& C) {
    int tid_ = C.tid; asm volatile("" : "+v"(tid_));
    const int lane_ = tid_ & 63, wave_ = __builtin_amdgcn_readfirstlane(tid_ >> 6), fr = lane_ & 15, fq = lane_ >> 4;
    const bf16* HN = (const bf16*)(C.ws + WS_HN); const bf16* WT = (const bf16*)(C.ws + WS_W1T) + (size_t)NPJ * D; float* TL = (float*)(C.ws + WS_TL);
    constexpr int PW = 2064;
    ldsp WL = C.lds; LAS f32x4* PR = (LAS f32x4*)(C.lds + 48 * PW);
    { v4u ww[12];
#pragma unroll
      for (int i = 0; i < 12; ++i) { const int e = tid_ + NT * i, row = e >> 7, ch = e & 127; ww[i] = *(const GAS v4u*)(WT + (size_t)row * D + 8 * ch); }
#pragma unroll
      for (int i = 0; i < 12; ++i) { const int e = tid_ + NT * i, row = e >> 7, ch = e & 127; *(LAS v4u*)(WL + row * PW + ch * 16) = ww[i]; } }
    const int rsel = wave_ & 1, kq = wave_ >> 1;
    for (int rp = C.bid; rp < SEQ / 32; rp += C.G) {
        const int rt = 2 * rp + rsel;
        bf16x8 a[8];
#pragma unroll
        for (int i = 0; i < 8; ++i) a[i] = *(const GAS bf16x8*)(HN + (size_t)(16 * rt + fr) * D + 32 * (8 * kq + i) + 8 * fq);
        __syncthreads();
        f32x4 acc[3] = {{0.f, 0.f, 0.f, 0.f}, {0.f, 0.f, 0.f, 0.f}, {0.f, 0.f, 0.f, 0.f}};
#pragma unroll
        for (int i = 0; i < 8; ++i)
#pragma unroll
            for (int n = 0; n < 3; ++n) acc[n] = mma16(a[i], lds_frag(WL + (16 * n + fr) * PW + (32 * (8 * kq + i) + 8 * fq) * 2), acc[n]);
#pragma unroll
        for (int n = 0; n < 3; ++n) PR[(wave_ * 3 + n) * 64 + lane_] = acc[n];
        __syncthreads();
        if (wave_ < 2) {
#pragma unroll
            for (int n = 0; n < 3; ++n) { f32x4 s = PR[((0 * 2 + wave_) * 3 + n) * 64 + lane_] + PR[((1 * 2 + wave_) * 3 + n) * 64 + lane_] + PR[((2 * 2 + wave_) * 3 + n) * 64 + lane_] + PR[((3 * 2 + wave_) * 3 + n) * 64 + lane_];
                *(GAS f32x4*)(TL + (size_t)(RTOK + 16 * (2 * rp + wave_) + fr) * 48 + 16 * n + 4 * fq) = s; }
        }
    }
    __syncthreads();
}
__device__ __forceinline__ void p0b_prologue(const Ctx& C) {
    const int gw = C.bid * NWAVES + C.wave;
    if (gw < NMETA) norm_row_bf16(C.in[I_META] + (size_t)gw * D, C.in[I_LNMIX], (bf16*)(C.ws + WS_HNM) + (size_t)gw * D, C.lane);
    { v4u* z = (v4u*)(C.ws + WS_PJ); const size_t n = (size_t)RFRONT * NPJ * 2 / 16; for (size_t i = (size_t)C.bid * NT + C.tid; i < n; i += (size_t)C.G * NT) z[i] = (v4u){0u, 0u, 0u, 0u}; }
    { v4u* z = (v4u*)(C.ws + WS_TL); const size_t n = (size_t)RFRONT * 48 * 4 / 16; for (size_t i = (size_t)C.bid * NT + C.tid; i < n; i += (size_t)C.G * NT) z[i] = (v4u){0u, 0u, 0u, 0u}; }
    hn_batch(C, 0, 0);
}
__device__ __forceinline__ void weff_unit(const Ctx& C, int unit) {
    int tid_ = C.tid; asm volatile("" : "+v"(tid_));
    const int lane_ = tid_ & 63, wave_ = __builtin_amdgcn_readfirstlane(tid_ >> 6); (void)lane_; (void)wave_;
    const int blk = unit >> 4, d0 = (unit & 15) * 64;
    LAS float* KT = (LAS float*)C.lds;
    LAS float* WQ = (LAS float*)(C.lds + 128 * 132 * 4);
    const float* keys = C.in[I_KEYS] + (size_t)blk * 128 * 128; const float* wq = C.in[I_WQ];
    { f32x4 kv_[8];
#pragma unroll
      for (int i = 0; i < 8; ++i) { const int e = tid_ + NT * i, key = e >> 5, j4 = e & 31; kv_[i] = *(const GAS f32x4*)(keys + key * 128 + 4 * j4); }
#pragma unroll
      for (int i = 0; i < 8; ++i) { const int e = tid_ + NT * i, key = e >> 5, j4 = e & 31; *(LAS f32x4*)(KT + key * 132 + 4 * j4) = kv_[i]; } }
    { f32x4 wv_[4];
#pragma unroll
      for (int i = 0; i < 4; ++i) { const int e = tid_ + NT * i, dd = e >> 5, j4 = e & 31; wv_[i] = *(const GAS f32x4*)(wq + (size_t)(d0 + dd) * 2048 + blk * 128 + 4 * j4); }
#pragma unroll
      for (int i = 0; i < 4; ++i) { const int e = tid_ + NT * i, dd = e >> 5, j4 = e & 31; *(LAS f32x4*)(WQ + dd * 128 + 4 * j4) = wv_[i]; } }
    __syncthreads();
    const int key = tid_ & 127, dg = tid_ >> 7;
    float acc[16];
#pragma unroll
    for (int i = 0; i < 16; ++i) acc[i] = 0.f;
    for (int j4 = 0; j4 < 32; ++j4) {
        const f32x4 kv = *(const LAS f32x4*)(KT + key * 132 + 4 * j4);
#pragma unroll
        for (int i = 0; i < 16; ++i) { const f32x4 wv = *(const LAS f32x4*)(WQ + (dg * 16 + i) * 128 + 4 * j4); acc[i] += kv.x * wv.x + kv.y * wv.y + kv.z * wv.z + kv.w * wv.w; }
    }
    bf16* WET = (bf16*)(C.ws + WS_WET) + (size_t)(blk * 128 + key) * D + d0 + dg * 16;
    v4u o0, o1; o0.x = pk2(acc[0], acc[1]); o0.y = pk2(acc[2], acc[3]); o0.z = pk2(acc[4], acc[5]); o0.w = pk2(acc[6], acc[7]);
    o1.x = pk2(acc[8], acc[9]); o1.y = pk2(acc[10], acc[11]); o1.z = pk2(acc[12], acc[13]); o1.w = pk2(acc[14], acc[15]);
    *(v4u*)WET = o0; *(GAS v4u*)(WET + 8) = o1;
    __syncthreads();
}
__device__ __forceinline__ void p0_prologue(const Ctx& C) {
    LAS float* scr = (LAS float*)(C.lds + C.wave * 16384);
    const int gw = C.bid * NWAVES + C.wave, NGW = C.G * NWAVES;
    constexpr int I_1 = (D / 64) * (N1 / 32), I_A = (1024 / 64) * (1024 / 32), I_B = (2048 / 64) * (1024 / 32), I_O = I_A;
    constexpr int NITEMS = I_1 + I_A + I_B + I_O;
    for (int it = gw; it < NITEMS; it += NGW) {
        int r = it;
        if (r < I_1) { transpose_item(C.in[I_WIN], 1024, 10288, N1, (bf16*)(C.ws + WS_W1T), scr, r, C.lane, MapW1()); continue; } r -= I_1;
        if (r < I_A) { transpose_item(C.in[I_WUG], 1024, 1024, 1024, (bf16*)(C.ws + WS_WAT), scr, r, C.lane, MapIdent()); continue; } r -= I_A;
        if (r < I_B) { transpose_item(C.in[I_WUS], 2048, 1024, 1024, (bf16*)(C.ws + WS_WBT), scr, r, C.lane, MapIdent()); continue; } r -= I_B;
        transpose_item(C.in[I_WOUT], 1024, 1024, 1024, (bf16*)(C.ws + WS_WOT), scr, r, C.lane, MapIdent());
    }
    __syncthreads();
    for (int u = C.bid; u < 256; u += C.G) weff_unit(C, u);
}

__device__ __forceinline__ float softplusf_(float x) { return fmaxf(x, 0.f) + log1pf(__expf(-fabsf(x))); }
__device__ __forceinline__ void conv_batch(const Ctx& C) {
    const bf16* PJ = (const bf16*)(C.ws + WS_PJ); bf16* XC = (bf16*)(C.ws + WS_XC);
    const float* cw = C.in[I_CONVW]; const float* cb = C.in[I_CONVB];
    constexpr int SL = 25, NSEG = (REND + SL - 1) / SL, NITEM = 384 * NSEG;
    for (int id = C.bid * NT + C.tid; id < NITEM; id += C.G * NT) {
        const int ch = id % 384, seg = id / 384, col = 8 * ch, rb = SL * seg;
        v4u xr[SL + 3];
#pragma unroll
        for (int t = 0; t < SL + 3; ++t) { const int r = rb - 3 + t; xr[t] = (r >= 0 && r < REND) ? *(const GAS v4u*)(PJ + (size_t)r * NPJ + PJ_XBC + col) : (v4u){0u, 0u, 0u, 0u}; }
        f32x4 w[4][2], bb[2];
#pragma unroll
        for (int i = 0; i < 4; ++i) { w[i][0] = *(const GAS f32x4*)(cw + i * 3072 + col); w[i][1] = *(const GAS f32x4*)(cw + i * 3072 + col + 4); }
        bb[0] = *(const GAS f32x4*)(cb + col); bb[1] = *(const GAS f32x4*)(cb + col + 4);
#pragma unroll
        for (int t = 0; t < SL; ++t) {
            f32x4 o0 = bb[0], o1 = bb[1];
#pragma unroll
            for (int i = 0; i < 4; ++i) { const v4u x = xr[t + i];
                o0 += w[i][0] * (f32x4){bflo(x.x), bfhi(x.x), bflo(x.y), bfhi(x.y)}; o1 += w[i][1] * (f32x4){bflo(x.z), bfhi(x.z), bflo(x.w), bfhi(x.w)}; }
            v4u o = {pk2(siluf_(o0.x), siluf_(o0.y)), pk2(siluf_(o0.z), siluf_(o0.w)), pk2(siluf_(o1.x), siluf_(o1.y)), pk2(siluf_(o1.z), siluf_(o1.w))};
            if (rb + t < RFRONT) o = (v4u){0u, 0u, 0u, 0u};
            if (rb + t < REND) *(GAS v4u*)(XC + (size_t)(rb + t) * 3072 + col) = o;
        }
    }
}
__device__ __forceinline__ void phaseC_unit(const Ctx& C, int c, int k) {
    int tid_ = C.tid; asm volatile("" : "+v"(tid_));
    const int lane_ = tid_ & 63, wave_ = __builtin_amdgcn_readfirstlane(tid_ >> 6); (void)lane_; (void)wave_;
    const bf16* PJ = (const bf16*)(C.ws + WS_PJ); const float* TL = (const float*)(C.ws + WS_TL);
    bf16* XC = (bf16*)(C.ws + WS_XC); float* GG = (float*)(C.ws + WS_GG); float* DT = (float*)(C.ws + WS_DT); float* AC = (float*)(C.ws + WS_AC);
    const int r0 = 64 * c;
    if (k < 6) {
        const float* cw = C.in[I_CONVW]; const float* cb = C.in[I_CONVB];
        const int col = 512 * k + 2 * (tid_ & 255), rb = r0 + 32 * (tid_ >> 8);
        const f32x2 w0 = *(const GAS f32x2*)(cw + col), w1 = *(const GAS f32x2*)(cw + 3072 + col), w2 = *(const GAS f32x2*)(cw + 2 * 3072 + col), w3 = *(const GAS f32x2*)(cw + 3 * 3072 + col), bb = *(const GAS f32x2*)(cb + col);
        unsigned xr[35];
#pragma unroll
        for (int t = 0; t < 35; ++t) { const int r = rb - 3 + t; xr[t] = (r >= 0) ? *(const GAS unsigned*)(PJ + (size_t)r * NPJ + PJ_XBC + col) : 0u; }
#pragma unroll
        for (int t = 0; t < 32; ++t) {
            const int r = rb + t;
            const f32x2 xm3 = {bflo(xr[t]), bfhi(xr[t])}, xm2 = {bflo(xr[t + 1]), bfhi(xr[t + 1])}, xm1 = {bflo(xr[t + 2]), bfhi(xr[t + 2])}, x0 = {bflo(xr[t + 3]), bfhi(xr[t + 3])};
            f32x2 o = bb + w0 * xm3 + w1 * xm2 + w2 * xm1 + w3 * x0;
            o.x = siluf_(o.x); o.y = siluf_(o.y);
            if (r < RFRONT) { o.x = 0.f; o.y = 0.f; }
            *(GAS unsigned*)(XC + (size_t)r * 3072 + col) = pk2(o.x, o.y);
        }
        return;
    }
    if (k < 10) {
        const int col = 128 * (k - 6) + (tid_ & 127), rq = tid_ >> 7; const float* w2p = C.in[I_WG2]; float w2[16];
        LAS float* PS = (LAS float*)C.lds;
#pragma unroll
        for (int j = 0; j < 16; ++j) w2[j] = w2p[j * 512 + col];
        const float bg = C.in[I_BG][col]; float G = 0.f; float gv[16];
#pragma unroll
        for (int t = 0; t < 16; ++t) {
            const int r = r0 + 16 * rq + t; const float* gl = TL + (size_t)r * 48;
            float z = bg;
#pragma unroll
            for (int j4 = 0; j4 < 4; ++j4) { const f32x4 g = *(const GAS f32x4*)(gl + 4 * j4); z += g.x * w2[4 * j4] + g.y * w2[4 * j4 + 1] + g.z * w2[4 * j4 + 2] + g.w * w2[4 * j4 + 3]; }
            float ls = fminf(z, 0.f) - __logf(1.f + __expf(-fabsf(z)));
            if (r < RFRONT) ls = 0.f;
            G += ls * (1.f / 16.f); gv[t] = G;
        }
        PS[rq * 128 + (tid_ & 127)] = G;
        __syncthreads();
        float base = 0.f;
#pragma unroll
        for (int q = 0; q < 3; ++q) base += (q < rq) ? PS[q * 128 + (tid_ & 127)] : 0.f;
#pragma unroll
        for (int t = 0; t < 16; ++t) GG[(size_t)(r0 + 16 * rq + t) * 512 + col] = gv[t] + base;
        __syncthreads();
        return;
    }
    {
        const int hd = tid_ & 31, rg = tid_ >> 5; const float bias = C.in[I_DTB][hd], A = -__expf(C.in[I_ALOG][hd]);
        LAS float* PS = (LAS float*)C.lds;
        float dtv[4], av[4], acum = 0.f;
#pragma unroll
        for (int t = 0; t < 4; ++t) {
            const int r = r0 + 4 * rg + t; const float x = TL[(size_t)r * 48 + 16 + hd] + bias;
            float dt = fmaxf(x, 0.f) + __logf(1.f + __expf(-fabsf(x)));
            if (r < RFRONT) dt = 0.f;
            acum += A * dt; dtv[t] = dt; av[t] = acum;
        }
        PS[rg * 32 + hd] = acum;
        __syncthreads();
        float base = 0.f;
#pragma unroll
        for (int q = 0; q < 15; ++q) base += (q < rg) ? PS[q * 32 + hd] : 0.f;
#pragma unroll
        for (int t = 0; t < 4; ++t) { const size_t r = (size_t)(r0 + 4 * rg + t); DT[r * 32 + hd] = dtv[t]; AC[r * 32 + hd] = av[t] + base; }
        __syncthreads();
    }
}

constexpr int P136 = 272, P264 = 528, P520 = 1040, P72 = 144;
__device__ __forceinline__ void gla_pass1_unit(const Ctx& C, int c, int h) {
    int tid_ = C.tid; asm volatile("" : "+v"(tid_));
    const int lane_ = tid_ & 63, wave_ = __builtin_amdgcn_readfirstlane(tid_ >> 6); (void)lane_; (void)wave_;
    const bf16* PJ = (const bf16*)(C.ws + WS_PJ); const float* GG = (const float*)(C.ws + WS_GG); bf16* LG = (bf16*)(C.ws + WS_LG);
    ldsp KD = C.lds, VT = C.lds + 64 * P136;
    const int r0 = 64 * c;
    v4u ka_[2], vv[4]; f32x4 a0_[2], a1_[2], l0_[2], l1_[2];
#pragma unroll
    for (int i = 0; i < 2; ++i) { const int e = tid_ + NT * i, s = e >> 4, k0 = (e & 15) * 8; const size_t r = (size_t)(r0 + s);
        ka_[i] = *(const GAS v4u*)(PJ + r * NPJ + PJ_K + 128 * h + k0);
        const float* g = GG + r * 512 + 128 * h + k0; const float* gl = GG + (size_t)(r0 + 63) * 512 + 128 * h + k0;
        a0_[i] = *(const GAS f32x4*)g; a1_[i] = *(const GAS f32x4*)(g + 4); l0_[i] = *(const GAS f32x4*)gl; l1_[i] = *(const GAS f32x4*)(gl + 4); }
#pragma unroll
    for (int i = 0; i < 4; ++i) { const int e = tid_ + NT * i, s = e >> 5, v0 = (e & 31) * 8; vv[i] = *(const GAS v4u*)(PJ + (size_t)(r0 + s) * NPJ + PJ_V + 256 * h + v0); }
#pragma unroll
    for (int i = 0; i < 2; ++i) {
        const int e = tid_ + NT * i, s = e >> 4, k0 = (e & 15) * 8;
        const v4u ka = ka_[i]; const f32x4 a0 = a0_[i], a1 = a1_[i], l0 = l0_[i], l1 = l1_[i];
        v4u o;
        o.x = pk2(bflo(ka.x) * __expf(l0.x - a0.x), bfhi(ka.x) * __expf(l0.y - a0.y)); o.y = pk2(bflo(ka.y) * __expf(l0.z - a0.z), bfhi(ka.y) * __expf(l0.w - a0.w));
        o.z = pk2(bflo(ka.z) * __expf(l1.x - a1.x), bfhi(ka.z) * __expf(l1.y - a1.y)); o.w = pk2(bflo(ka.w) * __expf(l1.z - a1.z), bfhi(ka.w) * __expf(l1.w - a1.w));
        *(LAS v4u*)(KD + s * P136 + k0 * 2) = o;
    }
#pragma unroll
    for (int i = 0; i < 4; ++i) { const int e = tid_ + NT * i, s = e >> 5, v0 = (e & 31) * 8; *(LAS v4u*)(VT + s * P264 + v0 * 2) = vv[i]; }
    __syncthreads();
    const int fr = lane_ & 15, fq = lane_ >> 4, w = wave_;
    f32x4 acc[2][8];
#pragma unroll
    for (int mi = 0; mi < 2; ++mi)
#pragma unroll
        for (int nt = 0; nt < 8; ++nt) acc[mi][nt] = (f32x4){0.f, 0.f, 0.f, 0.f};
#pragma unroll
    for (int ks = 0; ks < 2; ++ks) {
        bf16x8 af[2];
#pragma unroll
        for (int mi = 0; mi < 2; ++mi) af[mi] = tr_frag(VT, P264, 32 * ks, 32 * w + 16 * mi, fr, fq);
#pragma unroll
        for (int nt = 0; nt < 8; ++nt) { const bf16x8 bfm = tr_frag(KD, P136, 32 * ks, 16 * nt, fr, fq);
#pragma unroll
            for (int mi = 0; mi < 2; ++mi) acc[mi][nt] = mma16(af[mi], bfm, acc[mi][nt]); }
    }
    unsigned char* Lb = (unsigned char*)LG + ((size_t)(c * 4 + h) * 256) * 128;
#pragma unroll
    for (int mi = 0; mi < 2; ++mi)
#pragma unroll
        for (int nt = 0; nt < 8; ++nt) { const int v = 32 * w + 16 * mi + fr, k = 16 * nt + 4 * fq; const f32x4 a = acc[mi][nt];
            *(GAS unsigned*)(Lb + (size_t)v * 128 + k) = pack4_fp8(a[0], a[1], a[2], a[3]); }
    __syncthreads();
}
__device__ __forceinline__ void ssd_pass1_unit(const Ctx& C, int c, int g) {
    int tid_ = C.tid; asm volatile("" : "+v"(tid_));
    const int lane_ = tid_ & 63, wave_ = __builtin_amdgcn_readfirstlane(tid_ >> 6); (void)lane_; (void)wave_;
    const bf16* XC = (const bf16*)(C.ws + WS_XC); const float* DT = (const float*)(C.ws + WS_DT); const float* AC = (const float*)(C.ws + WS_AC); bf16* LS = (bf16*)(C.ws + WS_LS);
    ldsp XW = C.lds, BM = C.lds + 64 * P520;
    const int r0 = 64 * c;
    { const int ch = tid_ & 63, hd = 8 * g + (ch >> 3); const float al = AC[(size_t)(r0 + 63) * 32 + hd];
      v4u xx[8], bb[2]; float dd[8], aa[8];
#pragma unroll
      for (int i = 0; i < 8; ++i) { const size_t r = (size_t)(r0 + (tid_ >> 6) + 8 * i); xx[i] = *(const GAS v4u*)(XC + r * 3072 + 512 * g + 8 * ch); dd[i] = DT[r * 32 + hd]; aa[i] = AC[r * 32 + hd]; }
#pragma unroll
      for (int i = 0; i < 2; ++i) { const int e = tid_ + NT * i, s = e >> 4, c2 = e & 15; bb[i] = *(const GAS v4u*)(XC + (size_t)(r0 + s) * 3072 + 2048 + 128 * g + 8 * c2); }
#pragma unroll
      for (int i = 0; i < 2; ++i) { const int e = tid_ + NT * i, s = e >> 4, c2 = e & 15; *(LAS v4u*)(BM + s * P136 + c2 * 16) = bb[i]; }
#pragma unroll
      for (int i = 0; i < 8; ++i) { const int s = (tid_ >> 6) + 8 * i;
        const float sc = dd[i] * __expf(al - aa[i]); const v4u x = xx[i]; v4u o;
        o.x = pk2(bflo(x.x) * sc, bfhi(x.x) * sc); o.y = pk2(bflo(x.y) * sc, bfhi(x.y) * sc); o.z = pk2(bflo(x.z) * sc, bfhi(x.z) * sc); o.w = pk2(bflo(x.w) * sc, bfhi(x.w) * sc);
        *(LAS v4u*)(XW + s * P520 + ch * 16) = o; } }
    __syncthreads();
    const int fr = lane_ & 15, fq = lane_ >> 4, w = wave_;
    unsigned char* Lb = (unsigned char*)LS + ((size_t)(c * 32 + 8 * g + w) * 64) * 128; const float sg = ssd_gain(C.in[I_DTB], 8 * g + w);
#pragma unroll
    for (int nh = 0; nh < 2; ++nh) {
        f32x4 acc[4][4];
#pragma unroll
        for (int mi = 0; mi < 4; ++mi)
#pragma unroll
            for (int nt = 0; nt < 4; ++nt) acc[mi][nt] = (f32x4){0.f, 0.f, 0.f, 0.f};
#pragma unroll
        for (int ks = 0; ks < 2; ++ks) {
            bf16x8 af[4];
#pragma unroll
            for (int mi = 0; mi < 4; ++mi) af[mi] = tr_frag(XW, P520, 32 * ks, 64 * w + 16 * mi, fr, fq);
#pragma unroll
            for (int nt = 0; nt < 4; ++nt) { const bf16x8 bfm = tr_frag(BM, P136, 32 * ks, 64 * nh + 16 * nt, fr, fq);
#pragma unroll
                for (int mi = 0; mi < 4; ++mi) acc[mi][nt] = mma16(af[mi], bfm, acc[mi][nt]); }
        }
#pragma unroll
        for (int mi = 0; mi < 4; ++mi)
#pragma unroll
            for (int nt = 0; nt < 4; ++nt) { const int p = 16 * mi + fr, n = 64 * nh + 16 * nt + 4 * fq; const f32x4 a = acc[mi][nt];
                *(GAS unsigned*)(Lb + (size_t)p * 128 + n) = pack4_fp8(a[0] * sg, a[1] * sg, a[2] * sg, a[3] * sg); }
    }
    __syncthreads();
}

__device__ __forceinline__ void phaseE(const Ctx& C) {
    const float* GG = (const float*)(C.ws + WS_GG); const float* AC = (const float*)(C.ws + WS_AC);
    constexpr int NB = 8;
    for (int vb = C.bid; vb < 192; vb += C.G) {
        unsigned l[2][NB]; f32x4 d[2][NB];
        float s0 = 0.f, s1 = 0.f, s2 = 0.f, s3 = 0.f;
        GAS unsigned* Lp; const GAS float* dp; size_t lstride, dstride; bool gla;
        if (vb < 64) {
            const int e = vb * NT + C.tid, k4 = e & 31, v = (e >> 5) & 255, h = e >> 13; gla = true;
            Lp = (GAS unsigned*)(C.ws + WS_LG) + ((size_t)h * 256 + v) * 32 + k4; lstride = 4 * 256 * 32;
            dp = (const GAS float*)GG + 63 * 512 + 128 * h + 4 * k4; dstride = 64 * 512;
        } else {
            const int e = (vb - 64) * NT + C.tid, n4 = e & 31, p = (e >> 5) & 63, hd = e >> 11; gla = false;
            Lp = (GAS unsigned*)(C.ws + WS_LS) + ((size_t)hd * 64 + p) * 32 + n4; lstride = 32 * 64 * 32;
            dp = (const GAS float*)AC + 63 * 32 + hd; dstride = 64 * 32;
        }
#define E_LOAD(B, CI) do { l[B][i] = Lp[(size_t)(CI) * lstride]; if (gla) d[B][i] = *(const GAS f32x4*)(dp + (size_t)(CI) * dstride); else { const float a_ = dp[(size_t)(CI) * dstride]; d[B][i] = (f32x4){a_, a_, a_, a_}; } } while (0)
#pragma unroll
        for (int i = 0; i < NB; ++i) E_LOAD(0, i);
#pragma unroll 1
        for (int c0 = 0; c0 < NCHUNK; c0 += 2 * NB) {
#pragma unroll
            for (int hb = 0; hb < 2; ++hb) {
                const int cb = c0 + hb * NB, cn = cb + NB;
#pragma unroll
                for (int i = 0; i < NB; ++i) if (cn + i < NCHUNK) E_LOAD(hb ^ 1, cn + i);
#pragma unroll
                for (int i = 0; i < NB; ++i) if (cb + i < NCHUNK) {
                    Lp[(size_t)(cb + i) * lstride] = pack4_fp8(s0, s1, s2, s3);
                    const f32x2 p0 = __builtin_amdgcn_cvt_pk_f32_fp8((int)l[hb][i], false), p1 = __builtin_amdgcn_cvt_pk_f32_fp8((int)l[hb][i], true);
                    s0 = s0 * __expf(d[hb][i].x) + p0.x; s1 = s1 * __expf(d[hb][i].y) + p0.y; s2 = s2 * __expf(d[hb][i].z) + p1.x; s3 = s3 * __expf(d[hb][i].w) + p1.y; }
            }
        }
#undef E_LOAD
    }
}

__device__ __forceinline__ void gla_pass3_unit(const Ctx& C, int c, int h, int bp) {
    int tid_ = C.tid; asm volatile("" : "+v"(tid_));
    const int lane_ = tid_ & 63, wave_ = __builtin_amdgcn_readfirstlane(tid_ >> 6); (void)lane_; (void)wave_;
    const bf16* PJ = (const bf16*)(C.ws + WS_PJ); const float* GG = (const float*)(C.ws + WS_GG); const unsigned char* LG = C.ws + WS_LG; bf16* OG = (bf16*)(C.ws + WS_OG);
    ldsp QE = C.lds, QN = QE + 64 * P136, KE = QN + 64 * P136, KN = KE + 64 * P136, VT = KN + 64 * P136, ATT = VT + 64 * P264;
    LAS float* RED = (LAS float*)(ATT + 64 * P72);
    const int r0 = 64 * c;
    v4u sraw[2][2];
    { const unsigned char* Sb = (const unsigned char*)LG + ((size_t)(c * 4 + h) * 256) * 128; const int fr_ = lane_ & 15, fq_ = lane_ >> 4;
#pragma unroll
      for (int kp = 0; kp < 2; ++kp)
#pragma unroll
        for (int nt = 0; nt < 2; ++nt) sraw[kp][nt] = *(const GAS v4u*)(Sb + (size_t)(32 * wave_ + 16 * nt + fr_) * 128 + 64 * kp + 16 * fq_); }
    v4u qa_[2], ka_[2]; f32x4 g0_[2], g1_[2];
#pragma unroll
    for (int i = 0; i < 2; ++i) { const int e = tid_ + NT * i, s = e >> 4, k0 = (e & 15) * 8; const size_t r = (size_t)(r0 + s);
        qa_[i] = *(const GAS v4u*)(PJ + r * NPJ + PJ_Q + 128 * h + k0); ka_[i] = *(const GAS v4u*)(PJ + r * NPJ + PJ_K + 128 * h + k0);
        const float* g = GG + r * 512 + 128 * h + k0; g0_[i] = *(const GAS f32x4*)g; g1_[i] = *(const GAS f32x4*)(g + 4); }
#pragma unroll
    for (int i = 0; i < 2; ++i) {
        const int e = tid_ + NT * i, s = e >> 4, k0 = (e & 15) * 8;
        const v4u qa = qa_[i], ka = ka_[i]; const f32x4 g0 = g0_[i], g1 = g1_[i];
        const float gv[8] = {g0.x, g0.y, g0.z, g0.w, g1.x, g1.y, g1.z, g1.w};
        const unsigned qs[4] = {qa.x, qa.y, qa.z, qa.w}, ksr[4] = {ka.x, ka.y, ka.z, ka.w};
        unsigned oqe[4], oqn[4], oke[4], okn[4];
#pragma unroll
        for (int j = 0; j < 4; ++j) { const float e0 = __expf(gv[2 * j]), e1 = __expf(gv[2 * j + 1]), n0 = __expf(-gv[2 * j]), n1 = __expf(-gv[2 * j + 1]);
            const float q0 = bflo(qs[j]), q1 = bfhi(qs[j]), kk0 = bflo(ksr[j]), kk1 = bfhi(ksr[j]);
            oqe[j] = pk2(q0 * e0, q1 * e1); oqn[j] = pk2(q0 * n0, q1 * n1); oke[j] = pk2(kk0 * e0, kk1 * e1); okn[j] = pk2(kk0 * n0, kk1 * n1); }
        const int off = s * P136 + k0 * 2;
        *(LAS v4u*)(QE + off) = (v4u){oqe[0], oqe[1], oqe[2], oqe[3]}; *(LAS v4u*)(QN + off) = (v4u){oqn[0], oqn[1], oqn[2], oqn[3]};
        *(LAS v4u*)(KE + off) = (v4u){oke[0], oke[1], oke[2], oke[3]}; *(LAS v4u*)(KN + off) = (v4u){okn[0], okn[1], okn[2], okn[3]};
    }
    { v4u vv[4];
#pragma unroll
      for (int i = 0; i < 4; ++i) { const int e = tid_ + NT * i, s = e >> 5, v0 = (e & 31) * 8; vv[i] = *(const GAS v4u*)(PJ + (size_t)(r0 + s) * NPJ + PJ_V + 256 * h + v0); }
#pragma unroll
      for (int i = 0; i < 4; ++i) { const int e = tid_ + NT * i, s = e >> 5, v0 = (e & 31) * 8; *(LAS v4u*)(VT + s * P264 + v0 * 2) = vv[i]; } }
    __syncthreads();
    const int fr = lane_ & 15, fq = lane_ >> 4, w = wave_;
#pragma unroll
    for (int ti = 0; ti < 2; ++ti) {
        const int id = 2 * w + ti, tm = id >> 2, sn = id & 3;
        f32x4 ac = {0.f, 0.f, 0.f, 0.f}, aa = {0.f, 0.f, 0.f, 0.f};
#pragma unroll
        for (int ks = 0; ks < 4; ++ks) {
            const int ao = (16 * tm + fr) * P136 + (32 * ks + 8 * fq) * 2, bo = (16 * sn + fr) * P136 + (32 * ks + 8 * fq) * 2;
            ac = mma16(lds_frag(QE + ao), lds_frag(KN + bo), ac);
            aa = mma16(lds_frag(QN + ao), lds_frag(KE + bo), aa);
        }
        const int t = 16 * tm + fr, s0 = 16 * sn + 4 * fq;
        float o[4];
#pragma unroll
        for (int j = 0; j < 4; ++j) o[j] = (s0 + j <= t) ? ac[j] : aa[j];
        *(LAS v2u*)(ATT + t * P72 + s0 * 2) = (v2u){pk2(o[0], o[1]), pk2(o[2], o[3])};
    }
    __syncthreads();
    f32x4 acc[4][2];
#pragma unroll
    for (int tm = 0; tm < 4; ++tm)
#pragma unroll
        for (int nt = 0; nt < 2; ++nt) acc[tm][nt] = (f32x4){0.f, 0.f, 0.f, 0.f};
#pragma unroll
    for (int kp = 0; kp < 2; ++kp)
#pragma unroll
        for (int hf = 0; hf < 2; ++hf) {
            bf16x8 sb[2];
#pragma unroll
            for (int nt = 0; nt < 2; ++nt) sb[nt] = hf ? fp8x8_to_bf16(sraw[kp][nt].z, sraw[kp][nt].w) : fp8x8_to_bf16(sraw[kp][nt].x, sraw[kp][nt].y);
#pragma unroll
            for (int tm = 0; tm < 4; ++tm) { const bf16x8 af = lds_frag(QE + (16 * tm + fr) * P136 + (64 * kp + 16 * fq + 8 * hf) * 2);
#pragma unroll
                for (int nt = 0; nt < 2; ++nt) acc[tm][nt] = mma16(af, sb[nt], acc[tm][nt]); }
        }
#pragma unroll
    for (int ks = 0; ks < 2; ++ks) {
        bf16x8 bfm[2];
#pragma unroll
        for (int nt = 0; nt < 2; ++nt) bfm[nt] = tr_frag(VT, P264, 32 * ks, 32 * w + 16 * nt, fr, fq);
#pragma unroll
        for (int tm = 0; tm < 4; ++tm) { const bf16x8 af = lds_frag(ATT + (16 * tm + fr) * P72 + (32 * ks + 8 * fq) * 2);
#pragma unroll
            for (int nt = 0; nt < 2; ++nt) acc[tm][nt] = mma16(af, bfm[nt], acc[tm][nt]); }
    }
    v2u gvp[4][2]; f32x4 wvp[2];
#pragma unroll
    for (int nt = 0; nt < 2; ++nt) { const int v = 32 * w + 16 * nt + 4 * fq; wvp[nt] = *(const GAS f32x4*)(C.in[I_GNW] + v);
#pragma unroll
        for (int tm = 0; tm < 4; ++tm) gvp[tm][nt] = *(const GAS v2u*)(PJ + (size_t)(r0 + 16 * tm + fr) * NPJ + PJ_GO + 256 * h + v); }
#pragma unroll
    for (int tm = 0; tm < 4; ++tm) { float s = 0.f;
#pragma unroll
        for (int nt = 0; nt < 2; ++nt) { const f32x4 a = acc[tm][nt]; s += (a[0] * a[0] + a[1] * a[1]) + (a[2] * a[2] + a[3] * a[3]); }
        s += __shfl_xor(s, 16); s += __shfl_xor(s, 32);
        if (fq == 0) RED[w * 64 + 16 * tm + fr] = s; }
    __syncthreads();
    const float* nw = C.in[I_GNW];
#pragma unroll
    for (int tm = 0; tm < 4; ++tm) { const int t = 16 * tm + fr; float tot = 0.f;
#pragma unroll
        for (int ww = 0; ww < 8; ++ww) tot += RED[ww * 64 + t];
        const float rs = rsqrtf(tot * (1.f / 256.f) + RMS_EPS); const size_t r = (size_t)bp * SEQ + (r0 - RTOK + t);
#pragma unroll
        for (int nt = 0; nt < 2; ++nt) { const int v = 32 * w + 16 * nt + 4 * fq; const f32x4 a = acc[tm][nt];
            const f32x4 wv = wvp[nt]; const v2u gv = gvp[tm][nt];
            *(GAS v2u*)(OG + r * 1024 + 256 * h + v) = (v2u){pk2(a[0] * rs * wv.x * bflo(gv.x), a[1] * rs * wv.y * bfhi(gv.x)), pk2(a[2] * rs * wv.z * bflo(gv.y), a[3] * rs * wv.w * bfhi(gv.y))}; } }
    __syncthreads();
}
__device__ __forceinline__ void ssd_pass3_unit(const Ctx& C, int c, int g, int bp) {
    int tid_ = C.tid; asm volatile("" : "+v"(tid_));
    const int lane_ = tid_ & 63, wave_ = __builtin_amdgcn_readfirstlane(tid_ >> 6); (void)lane_; (void)wave_;
    const bf16* PJ = (const bf16*)(C.ws + WS_PJ); const bf16* XC = (const bf16*)(C.ws + WS_XC); const float* DT = (const float*)(C.ws + WS_DT); const float* AC = (const float*)(C.ws + WS_AC);
    const bf16* LS = (const bf16*)(C.ws + WS_LS); bf16* YS = (bf16*)(C.ws + WS_YS);
    ldsp XD = C.lds, CM = XD + 64 * P520, BM = CM + 64 * P136, WT = BM + 64 * P136;
    LAS float* ACL = (LAS float*)(WT + 8 * 32 * P72);
    LAS float* DTL = ACL + 8 * 64;
    LAS float* RED = DTL + 8 * 64;
    const int r0 = 64 * c;
    v4u sraw[2][4];
    { const unsigned char* Sb = (const unsigned char*)LS + ((size_t)(c * 32 + 8 * g + (wave_ >> 1)) * 64) * 128; const int fr_ = lane_ & 15, fq_ = lane_ >> 4;
#pragma unroll
      for (int kp = 0; kp < 2; ++kp)
#pragma unroll
        for (int pn = 0; pn < 4; ++pn) sraw[kp][pn] = *(const GAS v4u*)(Sb + (size_t)(16 * pn + fr_) * 128 + 64 * kp + 16 * fq_); }
    { v4u xx[8], bb[2], cc[2]; float a1, d1;
      { const int s = tid_ >> 3, hl = tid_ & 7; const size_t ri = (size_t)(r0 + s) * 32 + 8 * g + hl; a1 = AC[ri]; d1 = DT[ri]; }
#pragma unroll
      for (int i = 0; i < 8; ++i) { const int s = (tid_ >> 6) + 8 * i, ch = tid_ & 63; xx[i] = *(const GAS v4u*)(XC + (size_t)(r0 + s) * 3072 + 512 * g + 8 * ch); }
#pragma unroll
      for (int i = 0; i < 2; ++i) { const int e = tid_ + NT * i, s = e >> 4, ch = e & 15; const size_t r = (size_t)(r0 + s);
        bb[i] = *(const GAS v4u*)(XC + r * 3072 + 2048 + 128 * g + 8 * ch); cc[i] = *(const GAS v4u*)(XC + r * 3072 + 2560 + 128 * g + 8 * ch); }
      { const int s = tid_ >> 3, hl = tid_ & 7; ACL[hl * 64 + s] = a1; DTL[hl * 64 + s] = d1; }
#pragma unroll
      for (int i = 0; i < 8; ++i) { const int s = (tid_ >> 6) + 8 * i, ch = tid_ & 63; *(LAS v4u*)(XD + s * P520 + ch * 16) = xx[i]; }
#pragma unroll
      for (int i = 0; i < 2; ++i) { const int e = tid_ + NT * i, s = e >> 4, ch = e & 15; *(LAS v4u*)(BM + s * P136 + ch * 16) = bb[i]; *(LAS v4u*)(CM + s * P136 + ch * 16) = cc[i]; } }
    __syncthreads();
    const int fr = lane_ & 15, fq = lane_ >> 4, w = wave_, rh = w & 1, hq = w >> 1, t0 = 32 * rh;
    ldsp WW = WT + w * 32 * P72;
    f32x4 cb[2][4];
#pragma unroll
    for (int tm = 0; tm < 2; ++tm)
#pragma unroll
        for (int sn = 0; sn < 4; ++sn) cb[tm][sn] = (f32x4){0.f, 0.f, 0.f, 0.f};
#pragma unroll
    for (int ks = 0; ks < 4; ++ks) {
        bf16x8 af[2];
#pragma unroll
        for (int tm = 0; tm < 2; ++tm) af[tm] = lds_frag(CM + (t0 + 16 * tm + fr) * P136 + (32 * ks + 8 * fq) * 2);
#pragma unroll
        for (int sn = 0; sn < 4; ++sn) { const bf16x8 bfm = lds_frag(BM + (16 * sn + fr) * P136 + (32 * ks + 8 * fq) * 2);
#pragma unroll
            for (int tm = 0; tm < 2; ++tm) cb[tm][sn] = mma16(af[tm], bfm, cb[tm][sn]); }
    }
    v2u yp[2][2][4];
    float ss[2] = {0.f, 0.f};
    const float* dsk = C.in[I_DSKIP]; const float* nw = C.in[I_SNW];
#pragma unroll
    for (int rd = 0; rd < 2; ++rd) {
        const int hl = hq + 4 * rd, hd = 8 * g + hl;
        float at[2];
#pragma unroll
        for (int tm = 0; tm < 2; ++tm) at[tm] = ACL[hl * 64 + t0 + 16 * tm + fr];
#pragma unroll
        for (int sn = 0; sn < 4; ++sn) { const f32x4 as = *(const LAS f32x4*)(ACL + hl * 64 + 16 * sn + 4 * fq), ds = *(const LAS f32x4*)(DTL + hl * 64 + 16 * sn + 4 * fq);
#pragma unroll
            for (int tm = 0; tm < 2; ++tm) { const f32x4 cv = cb[tm][sn];
                const float w0 = cv[0] * ds.x * __expf(-fabsf(at[tm] - as.x)), w1 = cv[1] * ds.y * __expf(-fabsf(at[tm] - as.y)), w2 = cv[2] * ds.z * __expf(-fabsf(at[tm] - as.z)), w3 = cv[3] * ds.w * __expf(-fabsf(at[tm] - as.w));
                *(LAS v2u*)(WW + (16 * tm + fr) * P72 + (16 * sn + 4 * fq) * 2) = (v2u){pk2(w0, w1), pk2(w2, w3)}; } }
        f32x4 y[2][4];
#pragma unroll
        for (int tm = 0; tm < 2; ++tm)
#pragma unroll
            for (int pn = 0; pn < 4; ++pn) y[tm][pn] = (f32x4){0.f, 0.f, 0.f, 0.f};
#pragma unroll
        for (int kp = 0; kp < 2; ++kp)
#pragma unroll
            for (int hf = 0; hf < 2; ++hf) {
                bf16x8 af[2];
#pragma unroll
                for (int tm = 0; tm < 2; ++tm) af[tm] = lds_frag(CM + (t0 + 16 * tm + fr) * P136 + (64 * kp + 16 * fq + 8 * hf) * 2);
#pragma unroll
                for (int pn = 0; pn < 4; ++pn) { const bf16x8 sb = hf ? fp8x8_to_bf16(sraw[kp][pn].z, sraw[kp][pn].w) : fp8x8_to_bf16(sraw[kp][pn].x, sraw[kp][pn].y);
#pragma unroll
                    for (int tm = 0; tm < 2; ++tm) y[tm][pn] = mma16(af[tm], sb, y[tm][pn]); }
            }
        if (rd == 0) {
            const unsigned char* Sb = (const unsigned char*)LS + ((size_t)(c * 32 + 8 * g + hq + 4) * 64) * 128;
#pragma unroll
            for (int kp = 0; kp < 2; ++kp)
#pragma unroll
                for (int pn = 0; pn < 4; ++pn) sraw[kp][pn] = *(const GAS v4u*)(Sb + (size_t)(16 * pn + fr) * 128 + 64 * kp + 16 * fq);
        }
        const float isg = 1.f / ssd_gain(C.in[I_DTB], hd);
#pragma unroll
        for (int tm = 0; tm < 2; ++tm) { const float ea = __expf(at[tm]) * isg;
#pragma unroll
            for (int pn = 0; pn < 4; ++pn) y[tm][pn] = y[tm][pn] * ea; }
        LDS_WAIT(); asm volatile("" ::: "memory");
#pragma unroll
        for (int ks = 0; ks < 2; ++ks) {
            bf16x8 af[2];
#pragma unroll
            for (int tm = 0; tm < 2; ++tm) af[tm] = lds_frag(WW + (16 * tm + fr) * P72 + (32 * ks + 8 * fq) * 2);
#pragma unroll
            for (int pn = 0; pn < 4; ++pn) { const bf16x8 bfm = tr_frag(XD, P520, 32 * ks, 64 * hl + 16 * pn, fr, fq);
#pragma unroll
                for (int tm = 0; tm < 2; ++tm) y[tm][pn] = mma16(af[tm], bfm, y[tm][pn]); }
        }
        LDS_WAIT(); asm volatile("" ::: "memory");
        const float dk = dsk[hd];
#pragma unroll
        for (int tm = 0; tm < 2; ++tm) { const size_t r = (size_t)(r0 + t0 + 16 * tm + fr);
#pragma unroll
            for (int pn = 0; pn < 4; ++pn) { const int col = 64 * hd + 16 * pn + 4 * fq;
                const v2u xv = *(const LAS v2u*)(XD + (t0 + 16 * tm + fr) * P520 + (64 * hl + 16 * pn + 4 * fq) * 2), zv = *(const GAS v2u*)(PJ + r * NPJ + PJ_Z + col);
                f32x4 a = y[tm][pn];
                a[0] = (a[0] + dk * bflo(xv.x)) * bflo(zv.x); a[1] = (a[1] + dk * bfhi(xv.x)) * bfhi(zv.x); a[2] = (a[2] + dk * bflo(xv.y)) * bflo(zv.y); a[3] = (a[3] + dk * bfhi(xv.y)) * bfhi(zv.y);
                ss[tm] += (a[0] * a[0] + a[1] * a[1]) + (a[2] * a[2] + a[3] * a[3]); yp[rd][tm][pn] = (v2u){pk2(a[0], a[1]), pk2(a[2], a[3])}; } }
    }
#pragma unroll
    for (int tm = 0; tm < 2; ++tm) { float s = ss[tm]; s += __shfl_xor(s, 16); s += __shfl_xor(s, 32); if (fq == 0) RED[w * 32 + 16 * tm + fr] = s; }
    __syncthreads();
#pragma unroll
    for (int tm = 0; tm < 2; ++tm) { const int tl = 16 * tm + fr; float tot = 0.f;
#pragma unroll
        for (int q = 0; q < 4; ++q) tot += RED[(2 * q + rh) * 32 + tl];
        const float rs = rsqrtf(tot * (1.f / 512.f) + RMS_EPS); const size_t r = (size_t)bp * SEQ + (r0 - RTOK + t0 + tl);
#pragma unroll
        for (int rd = 0; rd < 2; ++rd) { const int hd = 8 * g + hq + 4 * rd;
#pragma unroll
            for (int pn = 0; pn < 4; ++pn) { const int col = 64 * hd + 16 * pn + 4 * fq; const v2u a = yp[rd][tm][pn]; const f32x4 wv = *(const GAS f32x4*)(nw + col);
                *(GAS v2u*)(YS + r * 2048 + col) = (v2u){pk2(bflo(a.x) * rs * wv.x, bfhi(a.x) * rs * wv.y), pk2(bflo(a.y) * rs * wv.z, bfhi(a.y) * rs * wv.w)}; } } }
    __syncthreads();
}

__device__ __forceinline__ void phaseJ(const Ctx& C) {
    const int gw = C.bid * NWAVES + C.wave, NGW = C.G * NWAVES;
    bf16* HN2 = (bf16*)(C.ws + WS_HN2);
    for (int r = gw; r < NTOK / 2; r += NGW) {
        const int r1 = r + NTOK / 2, lane = C.lane;
        const f32x4* x0 = (const f32x4*)(C.out + (size_t)r * D) + lane; const f32x4* x1 = (const f32x4*)(C.out + (size_t)r1 * D) + lane; const f32x4* wr_ = (const f32x4*)C.in[I_LNFFN] + lane;
        f32x4 v[4], u[4]; float q0 = 0.f, q1 = 0.f;
#pragma unroll
        for (int j = 0; j < 4; ++j) { v[j] = *(const GAS f32x4*)(x0 + 64 * j); u[j] = *(const GAS f32x4*)(x1 + 64 * j); }
#pragma unroll
        for (int j = 0; j < 4; ++j) { q0 += (v[j].x * v[j].x + v[j].y * v[j].y) + (v[j].z * v[j].z + v[j].w * v[j].w); q1 += (u[j].x * u[j].x + u[j].y * u[j].y) + (u[j].z * u[j].z + u[j].w * u[j].w); }
        const float s0 = rsqrtf(wave_sum(q0) * (1.f / D) + RMS_EPS), s1 = rsqrtf(wave_sum(q1) * (1.f / D) + RMS_EPS);
        v2u* o0 = (v2u*)(HN2 + (size_t)r * D) + lane; v2u* o1 = (v2u*)(HN2 + (size_t)r1 * D) + lane;
#pragma unroll
        for (int j = 0; j < 4; ++j) { const f32x4 ww = *(const GAS f32x4*)(wr_ + 64 * j); const f32x4 a = v[j] * s0 * ww, bq = u[j] * s1 * ww;
            *(GAS v2u*)(o0 + 64 * j) = (v2u){pk2(a.x, a.y), pk2(a.z, a.w)}; *(GAS v2u*)(o1 + 64 * j) = (v2u){pk2(bq.x, bq.y), pk2(bq.z, bq.w)};
            int w0 = 0, w1 = 0;
            w0 = __builtin_amdgcn_cvt_pk_fp8_f32(a.x * 16.f, a.y * 16.f, w0, false); w0 = __builtin_amdgcn_cvt_pk_fp8_f32(a.z * 16.f, a.w * 16.f, w0, true);
            w1 = __builtin_amdgcn_cvt_pk_fp8_f32(bq.x * 16.f, bq.y * 16.f, w1, false); w1 = __builtin_amdgcn_cvt_pk_fp8_f32(bq.z * 16.f, bq.w * 16.f, w1, true);
            *(GAS unsigned*)(C.ws + WS_HN8 + (size_t)r * D + 4 * lane + 256 * j) = (unsigned)w0; *(GAS unsigned*)(C.ws + WS_HN8 + (size_t)r1 * D + 4 * lane + 256 * j) = (unsigned)w1; }
    }
}
#ifndef PEER_SWAP_NIBBLES
#define PEER_SWAP_NIBBLES 0
#endif
__device__ __forceinline__ void conv_table(const Ctx& C, int tb, int first_blk) {
    if (C.bid < first_blk) return;
    const size_t n16 = (size_t)16384 * 1024 / 16, gt = (size_t)(C.bid - first_blk) * NT + C.tid, GT = (size_t)(C.G - first_blk) * NT;
    const float* src = C.in[tb ? I_PV : I_PU]; unsigned char* dst = C.ws + WS_U8 + (tb ? 512 : 0); const float gain = tb ? 5.656854249f : 64.f;
    for (size_t i0 = gt; i0 < n16; i0 += 4 * GT) { f32x4 a[4][4];
#pragma unroll
        for (int p = 0; p < 4; ++p) { const size_t i = i0 + p * GT;
#pragma unroll
            for (int q = 0; q < 4; ++q) a[p][q] = (i < n16) ? *(const GAS f32x4*)(src + 16 * i + 4 * q) : (f32x4){0.f, 0.f, 0.f, 0.f}; }
#pragma unroll
        for (int p = 0; p < 4; ++p) { const size_t i = i0 + p * GT; v2u o;
#pragma unroll
            for (int h = 0; h < 2; ++h) { unsigned w = 0;
                if (tb == 0 && PEER_SWAP_NIBBLES) {
                w = __builtin_amdgcn_cvt_scalef32_pk_fp4_f32(w, a[p][2 * h].y * gain, a[p][2 * h].x * gain, 1.0f, 0); w = __builtin_amdgcn_cvt_scalef32_pk_fp4_f32(w, a[p][2 * h].w * gain, a[p][2 * h].z * gain, 1.0f, 1);
                w = __builtin_amdgcn_cvt_scalef32_pk_fp4_f32(w, a[p][2 * h + 1].y * gain, a[p][2 * h + 1].x * gain, 1.0f, 2); w = __builtin_amdgcn_cvt_scalef32_pk_fp4_f32(w, a[p][2 * h + 1].w * gain, a[p][2 * h + 1].z * gain, 1.0f, 3); } else {
                w = __builtin_amdgcn_cvt_scalef32_pk_fp4_f32(w, a[p][2 * h].x * gain, a[p][2 * h].y * gain, 1.0f, 0); w = __builtin_amdgcn_cvt_scalef32_pk_fp4_f32(w, a[p][2 * h].z * gain, a[p][2 * h].w * gain, 1.0f, 1);
                w = __builtin_amdgcn_cvt_scalef32_pk_fp4_f32(w, a[p][2 * h + 1].x * gain, a[p][2 * h + 1].y * gain, 1.0f, 2); w = __builtin_amdgcn_cvt_scalef32_pk_fp4_f32(w, a[p][2 * h + 1].z * gain, a[p][2 * h + 1].w * gain, 1.0f, 3); }
                o[h] = w; }
            if (i < n16) *(GAS v2u*)(dst + (i >> 6) * 1024 + (i & 63) * 8) = o; } }
}

__device__ __forceinline__ float gelu_tanh(float x) {
    const float y = 0.7978845608028654f * (x + 0.044715f * x * x * x);
    const float e = __expf(2.f * y);
    const float th = 1.f - 2.f * fast_rcp(e + 1.f);
    return 0.5f * x * (1.f + th);
}
typedef _Float16 h16x2 __attribute__((ext_vector_type(2)));
typedef int v8i __attribute__((ext_vector_type(8)));

template <int CTRL> __device__ __forceinline__ unsigned dppu(unsigned x) { return (unsigned)__builtin_amdgcn_mov_dpp((int)x, CTRL, 0xf, 0xf, true); }
template <int CTRL> __device__ __forceinline__ float dppf(float x) { return __builtin_bit_cast(float, __builtin_amdgcn_mov_dpp(__builtin_bit_cast(int, x), CTRL, 0xf, 0xf, true)); }
__device__ __forceinline__ unsigned row_max_u(unsigned m) { m = max(m, dppu<0xB1>(m)); m = max(m, dppu<0x4E>(m)); m = max(m, dppu<0x141>(m)); m = max(m, dppu<0x128>(m)); return m; }
__device__ __forceinline__ float row_sum_f(float v) { v += dppf<0xB1>(v); v += dppf<0x4E>(v); v += dppf<0x141>(v); v += dppf<0x128>(v); return v; }
__device__ __forceinline__ unsigned mono(float f) { const unsigned b = __builtin_bit_cast(unsigned, f); return b ^ ((unsigned)((int)b >> 31) | 0x80000000u); }
__device__ __forceinline__ float unmono(unsigned u) { const unsigned b = (u & 0x80000000u) ? (u ^ 0x80000000u) : ~u; return __builtin_bit_cast(float, b); }
__device__ __forceinline__ void cand_ij(int c, int& ci, int& cj) {
    if (c < 16) { ci = 0; cj = c; } else if (c < 24) { ci = 1; cj = c - 16; } else if (c < 29) { ci = 2; cj = c - 24; } else if (c < 33) { ci = 3; cj = c - 29; }
    else if (c < 36) { ci = 4; cj = c - 33; } else if (c < 38) { ci = 5; cj = c - 36; } else if (c < 40) { ci = 6; cj = c - 38; } else if (c < 42) { ci = 7; cj = c - 40; }
    else if (c < 50) { ci = c - 34; cj = 0; } else { ci = 0; cj = 0; }
}
constexpr int PEER_LDS_PER_WAVE = 3072;
__device__ __forceinline__ void peer_token(const Ctx& C, int t, bool dry = false) {
    const int lane = C.lane, g = lane >> 4, j = lane & 15;
    const _Float16* SC = (const _Float16*)(C.ws + WS_SC) + (size_t)t * 2048;
    const bf16* HN2 = (const bf16*)(C.ws + WS_HN2) + (size_t)t * D;
    ldsp LST = C.lds + C.wave * PEER_LDS_PER_WAVE; ldsp EL = LST + 2048;
#pragma unroll 1
    for (int P = 0; P < 2; ++P) {
        typedef _Float16 h8 __attribute__((ext_vector_type(8)));
        const h8 ha8 = *(const GAS h8*)(SC + (4 * P + g) * 128 + 8 * j), hb8 = *(const GAS h8*)(SC + (4 * (P + 2) + g) * 128 + 8 * j);
        unsigned k[8], kb[8];
        float sa[8], sb[8];
#pragma unroll
        for (int q = 0; q < 8; ++q) { sa[q] = (float)ha8[q]; sb[q] = (float)hb8[q]; }
#pragma unroll
        for (int q = 0; q < 8; ++q) { k[q] = (mono(sa[q]) & ~127u) | (unsigned)(127 - (8 * j + q)); kb[q] = (mono(sb[q]) & ~127u) | (unsigned)(127 - (8 * j + q)); }
#define CEX(A, B) do { const unsigned hi_ = max(A, B), lo_ = min(A, B); A = hi_; B = lo_; } while (0)
#define SORT8(K) do { CEX(K[0], K[1]); CEX(K[2], K[3]); CEX(K[4], K[5]); CEX(K[6], K[7]); CEX(K[0], K[2]); CEX(K[1], K[3]); CEX(K[4], K[6]); CEX(K[5], K[7]); \
        CEX(K[1], K[2]); CEX(K[5], K[6]); CEX(K[0], K[4]); CEX(K[3], K[7]); CEX(K[1], K[5]); CEX(K[2], K[6]); CEX(K[1], K[4]); CEX(K[3], K[6]); CEX(K[2], K[4]); CEX(K[3], K[5]); CEX(K[3], K[4]); } while (0)
        SORT8(k); SORT8(kb);
#undef SORT8
#undef CEX
        unsigned res = 0u, resb = 0u;
#pragma unroll 4
        for (int it = 0; it < 16; ++it) {
            unsigned m = k[0], mb = kb[0];
            m = max(m, dppu<0xB1>(m)); mb = max(mb, dppu<0xB1>(mb)); m = max(m, dppu<0x4E>(m)); mb = max(mb, dppu<0x4E>(mb));
            m = max(m, dppu<0x141>(m)); mb = max(mb, dppu<0x141>(mb)); m = max(m, dppu<0x128>(m)); mb = max(mb, dppu<0x128>(mb));
            const bool pa = (k[0] == m), pb = (kb[0] == mb);
#pragma unroll
            for (int q = 0; q < 7; ++q) { k[q] = pa ? k[q + 1] : k[q]; kb[q] = pb ? kb[q + 1] : kb[q]; }
            k[7] = pa ? 0u : k[7]; kb[7] = pb ? 0u : kb[7];
            res = (j == it) ? m : res; resb = (j == it) ? mb : resb;
        }
        *(LAS v2u*)(LST + ((4 * P + g) * 16 + j) * 8) = (v2u){__builtin_bit_cast(unsigned, unmono(res & ~127u)), 127u - (res & 127u)};
        *(LAS v2u*)(LST + ((4 * (P + 2) + g) * 16 + j) * 8) = (v2u){__builtin_bit_cast(unsigned, unmono(resb & ~127u)), 127u - (resb & 127u)};
    }
    LDS_WAIT(); asm volatile("" ::: "memory");
    int eA = 0, eB = 0; float wA = 0.f, wB = 0.f;
#pragma unroll
    for (int Q = 0; Q < 2; ++Q) {
        const int h = 4 * Q + g;
        unsigned k[4];
#pragma unroll
        for (int m = 0; m < 4; ++m) {
            const int c = j + 16 * m; int ci, cj; cand_ij(c, ci, cj);
            const v2u a = *(const LAS v2u*)(LST + ((2 * h) * 16 + ci) * 8), b = *(const LAS v2u*)(LST + ((2 * h + 1) * 16 + cj) * 8);
            const float val = __builtin_bit_cast(float, a.x) + __builtin_bit_cast(float, b.x);
            k[m] = (c < 50) ? ((mono(val) & ~63u) | (unsigned)(63 - c)) : 0u;
            *(LAS unsigned*)(EL + (g * 64 + c) * 4) = a.y * 128u + b.y;
        }
        { unsigned h_, l_;
#define CEX(A, B) do { h_ = max(A, B); l_ = min(A, B); A = h_; B = l_; } while (0)
          CEX(k[0], k[1]); CEX(k[2], k[3]); CEX(k[0], k[2]); CEX(k[1], k[3]); CEX(k[1], k[2]);
#undef CEX
        }
        unsigned res = 0u, mtop = 0u;
#pragma unroll 4
        for (int it = 0; it < 16; ++it) {
            const unsigned m = row_max_u(k[0]);
            if (it == 0) mtop = m;
            const bool pa = (k[0] == m);
            k[0] = pa ? k[1] : k[0]; k[1] = pa ? k[2] : k[1]; k[2] = pa ? k[3] : k[2]; k[3] = pa ? 0u : k[3];
            res = (j == it) ? m : res;
        }
        LDS_WAIT(); asm volatile("" ::: "memory");
        const int cw = 63 - (int)(res & 63u);
        const int e = (int)*(const LAS unsigned*)(EL + (g * 64 + cw) * 4);
        const float ex = __expf(unmono(res & ~63u) - unmono(mtop & ~63u));
        const float wgt = ex / row_sum_f(ex);
        if (Q == 0) { eA = e; wA = wgt; } else { eB = e; wB = wgt; }
        LDS_WAIT(); asm volatile("" ::: "memory");
    }
#ifdef DRY_TOPK_ONLY
    if (dry) { ((float*)(C.ws + WS_T1))[(size_t)t * 64 + lane] = (float)(eA + eB) + wA + wB; return; }
#endif
    const unsigned char* U8 = C.ws + WS_U8; const unsigned char* V8 = C.ws + WS_U8 + 512;
    const int li = lane & 15, lg = lane >> 4;
    v4u hb[16];
    { const unsigned char* H8 = C.ws + WS_HN8 + (size_t)t * D + 16 * lg;
#pragma unroll
      for (int m = 0; m < 8; ++m) { hb[2 * m] = *(const GAS v4u*)(H8 + 128 * m); hb[2 * m + 1] = *(const GAS v4u*)(H8 + 128 * m + 64); } }
    f32x2 acc[8];
#pragma unroll
    for (int i = 0; i < 8; ++i) acc[i] = (f32x2){0.f, 0.f};
#pragma unroll 1
    for (int gi = 0; gi < 8; ++gi) {
        const int ev = gi < 4 ? eA : eB; const float wv = gi < 4 ? wA : wB; const int lb = 16 * (gi & 3);
        const int ei = __shfl(ev, lb + li);
        const unsigned char* up = U8 + (size_t)ei * 1024 + 16 * lg;
        v4u uq[8];
#pragma unroll
        for (int m = 0; m < 8; ++m) uq[m] = *(const GAS v4u*)(up + 64 * m);
        v2u vq[8];
#pragma unroll
        for (int q = 0; q < 8; ++q) vq[q] = *(const GAS v2u*)(V8 + (size_t)__builtin_amdgcn_readlane(ev, lb + q) * 1024 + 8 * lane);
        float wr[4];
#pragma unroll
        for (int r = 0; r < 4; ++r) wr[r] = __shfl(wv, lb + 4 * lg + r);
        f32x4 dots = {0.f, 0.f, 0.f, 0.f};
#pragma unroll
        for (int m = 0; m < 8; ++m) {
            const v8i av = {(int)uq[m].x, (int)uq[m].y, (int)uq[m].z, (int)uq[m].w, 0, 0, 0, 0};
            const v8i bv = {(int)hb[2 * m].x, (int)hb[2 * m].y, (int)hb[2 * m].z, (int)hb[2 * m].w, (int)hb[2 * m + 1].x, (int)hb[2 * m + 1].y, (int)hb[2 * m + 1].z, (int)hb[2 * m + 1].w};
            dots = __builtin_amdgcn_mfma_scale_f32_16x16x128_f8f6f4(av, bv, dots, 4, 0, 0, 0x7f7f7f7f, 0, 0x7f7f7f7f);
        }
        float cfr[4];
#pragma unroll
        for (int r = 0; r < 4; ++r) cfr[r] = wr[r] * gelu_tanh(dots[r] * (1.f / 1024.f)) * 0.1767766953f;
#pragma unroll
        for (int hf = 0; hf < 2; ++hf) {
            if (hf == 1) {
#pragma unroll
                for (int q = 0; q < 8; ++q) vq[q] = *(const GAS v2u*)(V8 + (size_t)__builtin_amdgcn_readlane(ev, lb + 8 + q) * 1024 + 8 * lane);
            }
#pragma unroll
            for (int q = 0; q < 8; ++q) { const int pl = 8 * hf + q;
                const float cf = __builtin_bit_cast(float, __builtin_amdgcn_readlane(__builtin_bit_cast(int, cfr[pl & 3]), 16 * (pl >> 2)));
#pragma unroll
                for (int w2 = 0; w2 < 2; ++w2) { acc[4 * w2 + 0] = __builtin_amdgcn_cvt_scalef32_pk_f32_fp4(vq[q][w2], 1.0f, 0) * cf + acc[4 * w2 + 0]; acc[4 * w2 + 1] = __builtin_amdgcn_cvt_scalef32_pk_f32_fp4(vq[q][w2], 1.0f, 1) * cf + acc[4 * w2 + 1];
                    acc[4 * w2 + 2] = __builtin_amdgcn_cvt_scalef32_pk_f32_fp4(vq[q][w2], 1.0f, 2) * cf + acc[4 * w2 + 2]; acc[4 * w2 + 3] = __builtin_amdgcn_cvt_scalef32_pk_f32_fp4(vq[q][w2], 1.0f, 3) * cf + acc[4 * w2 + 3]; }
            }
        }
    }
    float* orow = C.out + (size_t)t * D + 16 * lane; const float* lw = C.in[I_LNF] + 16 * lane;
    f32x4 hv[4]; float s = 0.f;
#pragma unroll
    for (int i = 0; i < 4; ++i) { hv[i] = *(const GAS f32x4*)(orow + 4 * i); hv[i].x += acc[2 * i].x; hv[i].y += acc[2 * i].y; hv[i].z += acc[2 * i + 1].x; hv[i].w += acc[2 * i + 1].y;
        s += (hv[i].x * hv[i].x + hv[i].y * hv[i].y) + (hv[i].z * hv[i].z + hv[i].w * hv[i].w); }
    const float rs = rsqrtf(wave_sum(s) * (1.f / D) + RMS_EPS);
    if (dry) return;
#pragma unroll
    for (int i = 0; i < 4; ++i) { const f32x4 w4 = *(const GAS f32x4*)(lw + 4 * i); *(GAS f32x4*)(orow + 4 * i) = hv[i] * rs * w4; }
}

constexpr int NSTEPS = 30;
#ifndef TIMEGK
#define TIMEGK -1
#endif
#ifndef PH_MASK
#define PH_MASK 0xFF
#endif
#define PH_ON(k) (((PH_MASK) >> (k)) & 1)
struct Args { const float* in[22]; float* out; unsigned char* ws; int ph_lo, ph_hi; };
typedef const __attribute__((address_space(4))) Args* kargp;
__device__ __forceinline__ void ctx_init(Ctx& C, unsigned char* smem) {
    kargp ap = (kargp)__builtin_amdgcn_kernarg_segment_ptr();
    asm volatile("" : "+s"(ap));
    int tid_ = threadIdx.x; asm volatile("" : "+v"(tid_));
    C.lds = (ldsp)smem; C.tid = tid_; C.lane = C.tid & 63; C.wave = __builtin_amdgcn_readfirstlane(C.tid >> 6); C.G = gridDim.x; C.bid = blockIdx.x;
#pragma unroll
    for (int i = 0; i < 22; ++i) C.in[i] = ap->in[i];
    C.out = ap->out; C.ws = ap->ws;
}
__global__ void __launch_bounds__(NT, 2) hyb_fwd(Args args) {
    extern __shared__ __attribute__((aligned(16))) unsigned char smem[];
    volatile LAS unsigned* MISC = (volatile LAS unsigned*)((ldsp)smem + LDSCTL_OFF);
    for (int u = threadIdx.x; u < (LDS_BYTES - LDSCTL_OFF) / 4; u += NT) MISC[u] = 0u;
    __syncthreads();
    const int lo = args.ph_lo, hi = args.ph_hi;
    unsigned* barw = (unsigned*)(args.ws + WS_CTL) + CW_BAR;
    XcdBarrier bar; bar.bar = barw; bar.x = 0; bar.st = MISC + 8;
    if (hi - lo > 1) bar = xcd_barrier_post(barw, MISC + 8);
#ifdef TIMEK
    unsigned long long tsum_ = 0ull;
#endif
#pragma unroll 1
    for (int step = lo; step < hi; ++step) {
#ifdef TIMEK
        const unsigned long long tbeg_ = __builtin_amdgcn_s_memrealtime();
#endif
        int kind, b = 0, gk = 0;
        if (step == 0) kind = 0;
        else if (step <= 26) { const int q = step - 1, pr = q / 13, r = q % 13;
            if (r < 10) { b = 2 * pr + r / 5; const int k = r % 5; gk = 0; kind = k == 0 ? 1 : k + 1; }
            else { b = 2 * pr + 1; gk = 5 + (r - 10); kind = 1; } }
        else if (step == 27) kind = 6;
        else if (step == 28) { kind = 1; gk = 8; }
        else kind = 7;
#ifdef REP_KIND
#ifndef REP_GK
#define REP_GK -1
#endif
        for (int rep = ((kind == REP_KIND && (REP_GK < 0 || gk == REP_GK)) ? 0 : 1); rep < 2; ++rep) {
        const bool dry = (rep == 0);
#else
        const bool dry = false; {
#endif
        Ctx C; ctx_init(C, smem);
        if (kind == 0 && PH_ON(0)) { p0_prologue(C); p0b_prologue(C); }
        else if (kind == 1 && PH_ON(1)) {
            pg8::Gemm g; EpiAny E; E.P.PJ = (bf16*)(C.ws + WS_PJ); E.P.TL = (float*)(C.ws + WS_TL); E.P.GT = (b & 1) ? nullptr : (bf16*)(C.ws + WS_GT);
            E.PJ = (const bf16*)(C.ws + WS_PJ); E.GT = (const bf16*)(C.ws + WS_GT); E.T = nullptr; E.O = nullptr; E.gsel = 0; E.X = C.in[I_X]; E.OF = C.out; E.pair = b >> 1; E.ldc = 2048;
            if (gk == 0)      { g = pg8::Gemm{(const bf16*)(C.ws + WS_HN), (const bf16*)(C.ws + WS_W1T), SEQ, NPJ, 1024}; E.mode = 0; if (b == 0) meta_proj(C); tail_proj(C); }
            else if (gk == 5) { g = pg8::Gemm{(const bf16*)(C.ws + WS_OG), (const bf16*)(C.ws + WS_WAT), 2 * SEQ, 1024, 1024}; E.mode = 1; E.O = (bf16*)(C.ws + WS_T1); E.gsel = 0; }
            else if (gk == 6) { g = pg8::Gemm{(const bf16*)(C.ws + WS_YS), (const bf16*)(C.ws + WS_WBT), 2 * SEQ, 1024, 2048}; E.mode = 1; E.O = (bf16*)(C.ws + WS_MX); E.gsel = 1; E.T = (const bf16*)(C.ws + WS_T1); }
            else if (gk == 7) { g = pg8::Gemm{(const bf16*)(C.ws + WS_MX), (const bf16*)(C.ws + WS_WOT), 2 * SEQ, 1024, 1024}; E.mode = 2; }
            else              { g = pg8::Gemm{(const bf16*)(C.ws + WS_HN2), (const bf16*)(C.ws + WS_WET), NTOK, 2048, 1024}; E.mode = 3; E.OF = (float*)(C.ws + WS_SC); }
            pg8::StaticOrder S; S.init(g.M, g.N, C.G, C.bid);
#ifdef REP_TAIL_ONLY
            if (!dry)
#endif
            pg8::gemm_phase<EpiAny, pg8::StaticOrder, true, true>(C.lds, g, S, E);
        }
        else if (kind == 2 && PH_ON(2)) {
#ifdef DRYC
            if (!dry || DRYC == 1) conv_batch(C);
            if (!dry || DRYC == 2) for (int u = C.bid; u < NCHUNK * 5; u += C.G) phaseC_unit(C, u / 5, 6 + u % 5);
#else
            conv_batch(C); for (int u = C.bid; u < NCHUNK * 5; u += C.G) phaseC_unit(C, u / 5, 6 + u % 5);
#endif
            if (!dry && b + 1 < BATCH) hn_batch(C, b + 1, 0);
 }
        else if ((kind == 3 && PH_ON(3)) || (kind == 5 && PH_ON(5))) {
            unsigned* qc = (unsigned*)(C.ws + WS_CTL) + CW_QUEUE + 2 * step + (dry ? 1 : 0);
            for (;;) {
                if (C.tid == 0) MISC[16] = atomicAdd(qc, 1u);
                __syncthreads();
                const int u = (int)MISC[16];
                __syncthreads();
                if (u >= NCHUNK * 8) break;
                const bool ssd = u < NCHUNK * 4; const int v = ssd ? u : u - NCHUNK * 4, c = v >> 2, k = v & 3;
#ifdef DRYF
                if (dry && ssd != (DRYF == 2)) continue;
#endif
                if (kind == 3) { if (ssd) ssd_pass1_unit(C, c, k); else gla_pass1_unit(C, c, k); }
                else if (c > 0) { if (ssd) ssd_pass3_unit(C, c, k, b & 1); else gla_pass3_unit(C, c, k, b & 1); }
            }
        }
        else if (kind == 4 && PH_ON(4)) { phaseE(C); if (!dry && b < 2) conv_table(C, b, 192); }
        else if (kind == 6 && PH_ON(6)) phaseJ(C);
        else if (kind == 7 && PH_ON(7)) { const int gw = C.bid * NWAVES + C.wave, NGW = C.G * NWAVES; for (int t = gw; t < NTOK; t += NGW) peer_token(C, t, dry); }
#ifdef REP_KIND
        if (rep == 0) xcd_barrier(bar);
#endif
        }
#ifdef TIMEK
        if (step + 1 >= hi || (kind == 1 && gk == 5)) xcd_barrier(bar);
#endif
        if (step + 1 < hi && !(kind == 1 && gk == 5)) xcd_barrier(bar);
#ifdef TIMEK
        if (kind == TIMEK && (TIMEGK < 0 || gk == TIMEGK)) tsum_ += __builtin_amdgcn_s_memrealtime() - tbeg_;
#endif
    }
#ifdef TIMEK
    if (blockIdx.x == 0 && threadIdx.x == 0) args.out[0] = (float)tsum_ * 0.0005f;
#endif
}

#ifdef DBG_STOP
__global__ void dbg_digest(const unsigned* w, size_t nwords, float* out, size_t nout) {
    for (size_t i = (size_t)blockIdx.x * blockDim.x + threadIdx.x; i < nout; i += (size_t)gridDim.x * blockDim.x) {
        unsigned h = 0; for (size_t j = i; j < nwords; j += nout) h ^= w[j] * 2654435761u + (unsigned)(j / nout);
        out[i] = (float)(h & 0xFFFFFFu);
    }
}
#endif
#ifndef HYB_N_LAUNCHES
#define HYB_N_LAUNCHES 1
#endif
extern "C" void kernel_launch(void* const* d_in, const int* in_sizes, int n_in, void* d_out, int out_size, void* d_ws, size_t ws_size, hipStream_t stream) {
    static int grid = 0;
    if (grid == 0) {
        if (n_in != 22 || out_size != NTOK * D || ws_size < WS_END) { fprintf(stderr, "kernel_launch: unexpected shapes: n_in %d out %d ws %zu (need %zu)\n", n_in, out_size, ws_size, (size_t)WS_END); grid = -1; return; }
        int dev = 0, cus = 0, per_cu = 0;
        if (hipGetDevice(&dev) != hipSuccess || hipDeviceGetAttribute(&cus, hipDeviceAttributeMultiprocessorCount, dev) != hipSuccess) { grid = -1; return; }
        if (hipFuncSetAttribute((const void*)hyb_fwd, hipFuncAttributeMaxDynamicSharedMemorySize, LDS_BYTES) != hipSuccess) { fprintf(stderr, "kernel_launch: hipFuncSetAttribute failed\n"); grid = -1; return; }
        if (hipOccupancyMaxActiveBlocksPerMultiprocessor(&per_cu, (const void*)hyb_fwd, NT, LDS_BYTES) != hipSuccess || per_cu < 1) { fprintf(stderr, "kernel_launch: occupancy query says %d blocks per CU\n", per_cu); per_cu = 1; }
        (void)hipGetLastError();
        grid = cus;
    }
    if (grid < 0) return;
    (void)hipMemsetAsync((char*)d_ws + WS_CTL, 0, CTL_ZERO_BYTES, stream);
    Args a{};
    for (int i = 0; i < 22; ++i) a.in[i] = (const float*)d_in[i];
    a.out = (float*)d_out; a.ws = (unsigned char*)d_ws;
    if (HYB_N_LAUNCHES == 1) { a.ph_lo = 0; a.ph_hi = NSTEPS; hipLaunchKernelGGL(hyb_fwd, dim3(grid), dim3(NT), LDS_BYTES, stream, a); }
    else {
#ifdef DBG_STOP
        for (int s = 0; s <= DBG_STOP; ++s) { a.ph_lo = s; a.ph_hi = s + 1; hipLaunchKernelGGL(hyb_fwd, dim3(grid), dim3(NT), LDS_BYTES, stream, a); }
        hipLaunchKernelGGL(dbg_digest, dim3(2048), dim3(256), 0, stream, (const unsigned*)((char*)d_ws + (size_t)(DBG_OFF)), (size_t)(DBG_LEN) / 4, (float*)d_out, (size_t)NTOK * D);
#else
        for (int s = 0; s < NSTEPS; ++s) { a.ph_lo = s; a.ph_hi = s + 1; hipLaunchKernelGGL(hyb_fwd, dim3(grid), dim3(NT), LDS_BYTES, stream, a); }
#endif
    }
}
```
